# Optimizing an MI355X kernel written in HIP

```python
import jax, jax.numpy as jnp
from jax import lax
import numpy as np

D_MODEL = 1024
BATCH = 8
SEQ = 2048
DEPTH = 2
DEC_BATCH = 128
DEC_SEQ = 1
PAST_LEN = 16384
PAGE_SIZE = 128

N_MIXERS = 2
N_RET_LAYERS = (DEPTH + N_MIXERS - 1) // N_MIXERS
N_LRU_LAYERS = DEPTH // N_MIXERS
RET_HEADS = 4
RET_DK = D_MODEL // RET_HEADS
RET_DV = 2 * D_MODEL // RET_HEADS
RET_CHUNK = 128
ROPE_BASE = 10000.0
LRU_WIDTH = D_MODEL
LRU_BLOCKS = 4
LRU_BW = LRU_WIDTH // LRU_BLOCKS
LRU_CONV = 4
LRU_C = 8.0
MEM_LEN = 256
XA_HEADS = 4
XA_HD = D_MODEL // XA_HEADS
FFN_DIM = 3 * D_MODEL
FFN_CONV = 3
EPS = 1e-6

kernel_name = 'hybrid_retention_rglru_memxattn_convffn_step'

F32 = jnp.float32


def rmsnorm(x, g):
    xf = x.astype(F32)
    y = xf * lax.rsqrt(jnp.mean(xf * xf, axis=-1, keepdims=True) + EPS)
    return (y * g.astype(F32)).astype(x.dtype)


def causal_dwconv(x, buf, w, b):
    width = w.shape[0]
    L = x.shape[1]
    xp = jnp.concatenate([buf.astype(x.dtype), x], axis=1)
    y = b.astype(x.dtype) + xp[:, 0:L] * w[0]
    for t in range(1, width):
        y = y + xp[:, t:t + L] * w[t]
    return y, xp[:, L:]


def rotary(x, offset):
    L, dh = x.shape[1], x.shape[-1]
    half = dh // 2
    inv = ROPE_BASE ** (-jnp.arange(half, dtype=F32) / half)
    pos = offset + jnp.arange(L, dtype=F32)
    ang = pos[:, None] * inv[None, :]
    cos = jnp.cos(ang)[None, :, None, :]
    sin = jnp.sin(ang)[None, :, None, :]
    x1, x2 = x[..., :half], x[..., half:]
    return jnp.concatenate([x1 * cos - x2 * sin, x1 * sin + x2 * cos], axis=-1)


def retention_scan(q, k, v, s0):
    B, L = q.shape[0], q.shape[1]
    C = RET_CHUNK if L % RET_CHUNK == 0 else L
    n = L // C
    log_g = jnp.log(1.0 - 2.0 ** (-5.0 - jnp.arange(RET_HEADS, dtype=F32)))
    idx = jnp.arange(C, dtype=F32)
    rel = idx[:, None] - idx[None, :]
    intra = jnp.where(rel[None] >= 0, jnp.exp(log_g[:, None, None] * jnp.maximum(rel, 0.0)[None]), 0.0)
    q_dec = jnp.exp(log_g[None, :] * (idx[:, None] + 1.0))
    k_dec = jnp.exp(log_g[None, :] * (C - 1.0 - idx[:, None]))
    chunk_dec = jnp.exp(log_g * C)

    def to_chunks(t):
        return t.reshape(B, n, C, *t.shape[2:]).swapaxes(0, 1)

    def step(s, inp):
        qc, kc, vc = inp
        att = jnp.einsum('bihd,bjhd->bhij', qc, kc) * intra
        o = (jnp.einsum('bhij,bjhe->bihe', att, vc)
             + jnp.einsum('bihd,bhde->bihe', qc * q_dec[:, :, None], s))
        s = s * chunk_dec[:, None, None] + jnp.einsum('bjhd,bjhe->bhde', kc * k_dec[:, :, None], vc)
        return s, o

    s, o = lax.scan(step, s0, (to_chunks(q), to_chunks(k), to_chunks(v)))
    return o.swapaxes(0, 1).reshape(B, L, RET_HEADS, RET_DV), s


def retention_mixer(h, s0, offset, w_in, w_out):
    B, L, _ = h.shape
    nqk = RET_HEADS * RET_DK
    nv = RET_HEADS * RET_DV
    q, k, v, g = jnp.split(h @ w_in, [nqk, 2 * nqk, 2 * nqk + nv], axis=-1)
    q = rotary(q.reshape(B, L, RET_HEADS, RET_DK).astype(F32), offset)
    k = rotary(k.reshape(B, L, RET_HEADS, RET_DK).astype(F32), offset) * (RET_DK ** -0.5)
    v = v.reshape(B, L, RET_HEADS, RET_DV).astype(F32)
    o, s = retention_scan(q, k, v, s0.astype(F32))
    o = o * lax.rsqrt(jnp.mean(o * o, axis=-1, keepdims=True) + EPS)
    o = (jax.nn.silu(g.astype(F32)) * o.reshape(B, L, nv)).astype(h.dtype)
    return o @ w_out, s.astype(s0.dtype)


def block_diag(x, w, b):
    B, L, _ = x.shape
    xb = x.reshape(B, L, LRU_BLOCKS, LRU_BW)
    return (jnp.einsum('blhi,hij->blhj', xb, w) + b).reshape(B, L, LRU_WIDTH)


def linear_recurrence(a, u, h0):
    def comb(l, r):
        return (l[0] * r[0], r[0] * l[1] + r[1])
    a_cum, u_cum = lax.associative_scan(comb, (a, u), axis=1)
    return a_cum * h0[:, None, :] + u_cum


def rglru_mixer(h, h0, conv_buf, w_in, conv_w, conv_b, wa, ba, wx, bx, lam, w_out):
    xb, gb = jnp.split(h @ w_in, 2, axis=-1)
    xc, new_buf = causal_dwconv(xb, conv_buf, conv_w, conv_b)
    r = jax.nn.sigmoid(block_diag(xc, wa, ba).astype(F32))
    i = jax.nn.sigmoid(block_diag(xc, wx, bx).astype(F32))
    log_a = LRU_C * r * jax.nn.log_sigmoid(lam.astype(F32))
    a = jnp.exp(log_a)
    u = jnp.sqrt(-jnp.expm1(2.0 * log_a)) * (i * xc.astype(F32))
    hs = linear_recurrence(a, u, h0.astype(F32))
    y = (jax.nn.gelu(gb.astype(F32)) * hs).astype(h.dtype)
    return y @ w_out, hs[:, -1].astype(h0.dtype), new_buf.astype(conv_buf.dtype)


def memory_kv(mem, g, w_kv):
    B, M, _ = mem.shape
    k, v = jnp.split(rmsnorm(mem, g) @ w_kv, 2, axis=-1)
    return k.reshape(B, M, XA_HEADS, XA_HD), v.reshape(B, M, XA_HEADS, XA_HD)


def cross_attn(h, mk, mv, w_q, w_o):
    B, L, _ = h.shape
    q = (h @ w_q).reshape(B, L, XA_HEADS, XA_HD).astype(F32)
    s = jnp.einsum('blhd,bmhd->bhlm', q, mk.astype(F32)) * (XA_HD ** -0.5)
    p = jax.nn.softmax(s, axis=-1)
    o = jnp.einsum('bhlm,bmhd->blhd', p, mv.astype(F32)).reshape(B, L, XA_HEADS * XA_HD)
    return o.astype(h.dtype) @ w_o


def conv_ffn(h, buf, w_up, conv_w, conv_b, w_down):
    u, g = jnp.split(h @ w_up, 2, axis=-1)
    uc, new_buf = causal_dwconv(u, buf, conv_w, conv_b)
    y = (jax.nn.gelu(uc.astype(F32)) * g.astype(F32)).astype(h.dtype)
    return y @ w_down, new_buf.astype(buf.dtype)


def trunk(x, offset, ret_s, lru_h, lru_conv, ffn_conv, mem_k, mem_v, p):
    new_ret, new_h, new_conv, new_ffn = [], [], [], []
    for i in range(DEPTH):
        j = i // N_MIXERS
        hn = rmsnorm(x, p['norm_mix'][i])
        if i % N_MIXERS == 0:
            y, s = retention_mixer(hn, ret_s[j], offset, p['ret_w_in'][j], p['ret_w_out'][j])
            new_ret.append(s)
        else:
            y, hl, cb = rglru_mixer(hn, lru_h[j], lru_conv[j], p['lru_w_in'][j], p['lru_conv_w'][j],
                                    p['lru_conv_b'][j], p['lru_wa'][j], p['lru_ba'][j], p['lru_wx'][j],
                                    p['lru_bx'][j], p['lru_lambda'][j], p['lru_w_out'][j])
            new_h.append(hl)
            new_conv.append(cb)
        x = x + y
        x = x + cross_attn(rmsnorm(x, p['norm_xa'][i]), mem_k[i], mem_v[i], p['xa_w_q'][i], p['xa_w_o'][i])
        y, fb = conv_ffn(rmsnorm(x, p['norm_ffn'][i]), ffn_conv[i], p['ffn_w_up'][i], p['ffn_conv_w'][i],
                         p['ffn_conv_b'][i], p['ffn_w_down'][i])
        x = x + y
        new_ffn.append(fb)
    x = rmsnorm(x, p['norm_final'])
    return x, jnp.stack(new_ret), jnp.stack(new_h), jnp.stack(new_conv), jnp.stack(new_ffn)


def setup_inputs(seed: int = 0) -> dict:
    key = jax.random.key(seed)
    ks = iter(jax.random.split(key, 40))

    def nrm(shape, scale):
        return jax.random.normal(next(ks), shape, F32) * scale

    def gain(shape):
        return 1.0 + nrm(shape, 0.05)

    D = D_MODEL
    a_target = jax.random.uniform(next(ks), (N_LRU_LAYERS, LRU_WIDTH), F32, minval=0.9, maxval=0.999)
    s_base = a_target ** (1.0 / LRU_C)
    lru_lambda = jnp.log(s_base) - jnp.log1p(-s_base)
    ret_cols = 2 * RET_HEADS * RET_DK + 2 * RET_HEADS * RET_DV
    return {
        'x_prompt': nrm((BATCH, SEQ, D), 1.0),
        'x_sample': nrm((DEC_BATCH, DEC_SEQ, D), 1.0),
        'state_ret': nrm((N_RET_LAYERS, DEC_BATCH, RET_HEADS, RET_DK, RET_DV), 0.1),
        'state_lru_h': nrm((N_LRU_LAYERS, DEC_BATCH, LRU_WIDTH), 0.5),
        'state_lru_conv': nrm((N_LRU_LAYERS, DEC_BATCH, LRU_CONV - 1, LRU_WIDTH), 1.0),
        'state_ffn_conv': nrm((DEPTH, DEC_BATCH, FFN_CONV - 1, FFN_DIM), 1.0),
        'cache_mem_k': nrm((DEPTH, DEC_BATCH, MEM_LEN, XA_HEADS, XA_HD), 1.0),
        'cache_mem_v': nrm((DEPTH, DEC_BATCH, MEM_LEN, XA_HEADS, XA_HD), 1.0),
        'mem_prompt': nrm((BATCH, MEM_LEN, D), 1.0),
        'norm_mix': gain((DEPTH, D)),
        'norm_xa': gain((DEPTH, D)),
        'norm_mem': gain((DEPTH, D)),
        'norm_ffn': gain((DEPTH, D)),
        'norm_final': gain((D,)),
        'ret_w_in': nrm((N_RET_LAYERS, D, ret_cols), D ** -0.5),
        'ret_w_out': nrm((N_RET_LAYERS, RET_HEADS * RET_DV, D), (RET_HEADS * RET_DV) ** -0.5),
        'lru_w_in': nrm((N_LRU_LAYERS, D, 2 * LRU_WIDTH), D ** -0.5),
        'lru_conv_w': nrm((N_LRU_LAYERS, LRU_CONV, LRU_WIDTH), LRU_CONV ** -0.5),
        'lru_conv_b': nrm((N_LRU_LAYERS, LRU_WIDTH), 0.01),
        'lru_wa': nrm((N_LRU_LAYERS, LRU_BLOCKS, LRU_BW, LRU_BW), LRU_BW ** -0.5),
        'lru_ba': nrm((N_LRU_LAYERS, LRU_BLOCKS, LRU_BW), 0.01),
        'lru_wx': nrm((N_LRU_LAYERS, LRU_BLOCKS, LRU_BW, LRU_BW), LRU_BW ** -0.5),
        'lru_bx': nrm((N_LRU_LAYERS, LRU_BLOCKS, LRU_BW), 0.01),
        'lru_lambda': lru_lambda,
        'lru_w_out': nrm((N_LRU_LAYERS, LRU_WIDTH, D), LRU_WIDTH ** -0.5),
        'xa_w_q': nrm((DEPTH, D, XA_HEADS * XA_HD), D ** -0.5),
        'xa_w_kv': nrm((DEPTH, D, 2 * XA_HEADS * XA_HD), D ** -0.5),
        'xa_w_o': nrm((DEPTH, XA_HEADS * XA_HD, D), (XA_HEADS * XA_HD) ** -0.5),
        'ffn_w_up': nrm((DEPTH, D, 2 * FFN_DIM), D ** -0.5),
        'ffn_conv_w': nrm((DEPTH, FFN_CONV, FFN_DIM), FFN_CONV ** -0.5),
        'ffn_conv_b': nrm((DEPTH, FFN_DIM), 0.01),
        'ffn_w_down': nrm((DEPTH, FFN_DIM, D), FFN_DIM ** -0.5),
    }


def reference(x_prompt, x_sample, state_ret, state_lru_h, state_lru_conv, state_ffn_conv,
              cache_mem_k, cache_mem_v, mem_prompt, norm_mix, norm_xa, norm_mem, norm_ffn, norm_final,
              ret_w_in, ret_w_out, lru_w_in, lru_conv_w, lru_conv_b, lru_wa, lru_ba, lru_wx, lru_bx,
              lru_lambda, lru_w_out, xa_w_q, xa_w_kv, xa_w_o, ffn_w_up, ffn_conv_w, ffn_conv_b, ffn_w_down):
    p = {
        'norm_mix': norm_mix, 'norm_xa': norm_xa, 'norm_ffn': norm_ffn, 'norm_final': norm_final,
        'ret_w_in': ret_w_in, 'ret_w_out': ret_w_out,
        'lru_w_in': lru_w_in, 'lru_conv_w': lru_conv_w, 'lru_conv_b': lru_conv_b,
        'lru_wa': lru_wa, 'lru_ba': lru_ba, 'lru_wx': lru_wx, 'lru_bx': lru_bx,
        'lru_lambda': lru_lambda, 'lru_w_out': lru_w_out,
        'xa_w_q': xa_w_q, 'xa_w_o': xa_w_o,
        'ffn_w_up': ffn_w_up, 'ffn_conv_w': ffn_conv_w, 'ffn_conv_b': ffn_conv_b, 'ffn_w_down': ffn_w_down,
    }
    bp = x_prompt.shape[0]
    dt = x_prompt.dtype
    mk_list, mv_list = [], []
    for i in range(DEPTH):
        mk_i, mv_i = memory_kv(mem_prompt, norm_mem[i], xa_w_kv[i])
        mk_list.append(mk_i)
        mv_list.append(mv_i)
    new_mem_k_p = jnp.stack(mk_list)
    new_mem_v_p = jnp.stack(mv_list)
    ret0 = jnp.zeros((N_RET_LAYERS, bp, RET_HEADS, RET_DK, RET_DV), dt)
    h0 = jnp.zeros((N_LRU_LAYERS, bp, LRU_WIDTH), dt)
    lconv0 = jnp.zeros((N_LRU_LAYERS, bp, LRU_CONV - 1, LRU_WIDTH), dt)
    fconv0 = jnp.zeros((DEPTH, bp, FFN_CONV - 1, FFN_DIM), dt)
    y_prompt, new_ret_p, new_lru_h_p, new_lru_conv_p, new_ffn_conv_p = trunk(
        x_prompt, 0, ret0, h0, lconv0, fconv0, new_mem_k_p, new_mem_v_p, p)
    y_sample, new_ret_s, new_lru_h_s, new_lru_conv_s, new_ffn_conv_s = trunk(
        x_sample, PAST_LEN, state_ret, state_lru_h, state_lru_conv, state_ffn_conv,
        cache_mem_k, cache_mem_v, p)
    return (y_prompt, y_sample, new_ret_p, new_ret_s, new_lru_h_p, new_lru_h_s,
            new_lru_conv_p, new_lru_conv_s, new_ffn_conv_p, new_ffn_conv_s, new_mem_k_p, new_mem_v_p)
```

```cpp
#include <hip/hip_runtime.h>
#include <hip/hip_cooperative_groups.h>
#include <cstdio>
#include <cstring>
#include <cmath>
namespace cg = cooperative_groups;

#ifndef MASK
#define MASK 0xffffffffu
#endif
#define EN(k) (((MASK) >> (k)) & 1u)
#define LAS __attribute__((address_space(3)))
#define DEVI __device__ __forceinline__
typedef unsigned short bf16_t;
typedef short bf16x8 __attribute__((ext_vector_type(8)));
typedef float f32x4 __attribute__((ext_vector_type(4)));
typedef unsigned u32x2 __attribute__((ext_vector_type(2)));
typedef unsigned u32x4 __attribute__((ext_vector_type(4)));

constexpr int PR = 16384;
constexpr int SR = 128;
constexpr int TR = PR + SR;
constexpr int TP = 16640;
constexpr int LDS_BYTES = 153600;

constexpr size_t O_YP = 0, O_YS = 16777216, O_RETP = 16908288, O_RETS = 21102592, O_LHP = 88211456, O_LHS = 88219648,
                 O_LCP = 88350720, O_LCS = 88375296, O_FCP = 88768512, O_FCS = 88866816, O_MKP = 90439680, O_MVP = 94633984;

constexpr size_t W_RIN = 0;
constexpr size_t W_ROUT = W_RIN + 12582912;
constexpr size_t W_LIN = W_ROUT + 4194304;
constexpr size_t W_AX = W_LIN + 4194304;
constexpr size_t W_LOUT = W_AX + 1048576;
constexpr size_t W_XQ = W_LOUT + 2097152;
constexpr size_t W_XKV = W_XQ + 2 * 2097152;
constexpr size_t W_XO = W_XKV + 2 * 4194304;
constexpr size_t W_UP = W_XO + 2 * 2097152;
constexpr size_t W_DN = W_UP + 2 * 12582912;
constexpr size_t W_ROTC = W_DN + 2 * 6291456;
constexpr size_t W_ROTS = W_ROTC + 1049088;
constexpr size_t W_LSG = W_ROTS + 1049088;
constexpr size_t W_HN = W_LSG + 4096;
constexpr size_t W_MN = W_HN + (size_t)TP * 2048;
constexpr size_t W_MK = W_MN + 8388608;
constexpr size_t W_MVT = W_MK + 8388608;
constexpr size_t W_BIG = W_MVT + 8388608;
constexpr size_t W_X = W_BIG + (size_t)TP * 12288;
constexpr size_t W_QX = W_X + (size_t)TP * 4096;
constexpr size_t W_AO = W_QX + (size_t)TP * 2048;
constexpr size_t W_Y = W_AO + (size_t)TP * 2048;
constexpr size_t W_L = W_Y + (size_t)TP * 6144;
constexpr size_t W_KT = W_L;
constexpr size_t W_VT = W_KT + 33554432;
constexpr size_t W_O = W_VT + 67108864;
constexpr size_t W_OG = W_O + (size_t)TP * 4096;
constexpr size_t W_END0 = W_OG + (size_t)TP * 4096;
constexpr size_t W_XC = W_L;
constexpr size_t W_AA = W_XC + (size_t)TP * 2048;
constexpr size_t W_UU = W_AA + (size_t)TP * 4096;
constexpr size_t W_CH = W_UU + (size_t)TP * 4096;
constexpr size_t W_YL = W_CH + 2097152;
constexpr size_t W_END1 = W_YL + (size_t)TP * 2048;
constexpr size_t W_TOTAL = W_END0 > W_END1 ? W_END0 : W_END1;

struct TJob { const float* src; bf16_t* dst; int ld, K, N, tile0; };
constexpr int NJOBS = 30;
struct Params {
    const float* in[34];
    double rope_c1;
    TJob jobs[NJOBS];
    int ntiles;
    int pad0;
};

typedef float f32x2 __attribute__((ext_vector_type(2)));
typedef __bf16 bf16x2_t __attribute__((ext_vector_type(2)));
DEVI unsigned cvt_pk_bf16(float lo, float hi) { f32x2 v = {lo, hi}; bf16x2_t r = __builtin_convertvector(v, bf16x2_t); return __builtin_bit_cast(unsigned, r); }
DEVI bf16_t f2bf(float f) { return (bf16_t)(cvt_pk_bf16(f, 0.f) & 0xffffu); }
DEVI float bflo(unsigned u) { return __uint_as_float(u << 16); }
DEVI float bfhi(unsigned u) { return __uint_as_float(u & 0xffff0000u); }
DEVI float bf2f(bf16_t b) { return __uint_as_float(((unsigned)b) << 16); }
DEVI u32x2 pack4(f32x4 v) { u32x2 r; r.x = cvt_pk_bf16(v[0], v[1]); r.y = cvt_pk_bf16(v[2], v[3]); return r; }
DEVI float wave_sum(float v) {
#pragma unroll
    for (int o = 32; o; o >>= 1) v += __shfl_xor(v, o);
    return v;
}
DEVI float sigmoidf_(float x) { return 1.f / (1.f + __expf(-x)); }
DEVI float gelu_tanh(float x) { const float z = 1.5957691216057308f * (x + 0.044715f * x * x * x); return x / (1.f + __expf(-z)); }
DEVI int zero_() { int z = 0; asm volatile("" : "+s"(z)); return z; }
DEVI int tid_() { int t = threadIdx.x; asm volatile("" : "+v"(t)); return t; }
DEVI f32x4 mfma16(bf16x8 a, bf16x8 b, f32x4 c) { return __builtin_amdgcn_mfma_f32_16x16x32_bf16(a, b, c, 0, 0, 0); }

namespace pg8 {
constexpr int BM = 256, BK = 64, HALF = 128, HTB = HALF * BK * 2, NXCD = 8, WGM = 8;
__host__ __device__ __forceinline__ int lds_byte(int r, int c) { const int st = (r >> 4) * 2 + (c >> 5), rr = r & 15, cc = c & 31, ob = rr * 64 + cc * 2; return st * 1024 + (ob ^ (((ob >> 9) & 1) << 5)); }
__host__ __device__ __forceinline__ void stage_rc(int b, int& R, int& C) { const int st = b / 1024, sb = b % 1024, swz = sb ^ (((sb >> 9) & 1) << 5); R = (st >> 1) * 16 + swz / 64; C = (st & 1) * 32 + (swz % 64) / 2; }
struct Unit { int pm, pn; };
struct Gemm { const bf16_t* A; const bf16_t* Bt; int M, N, K, lda, ldb, diag; };
struct StaticOrder {
    int nM, nN, nwg, G, c;
    DEVI void init(int M, int N, int G_, int c_) { nM = M / BM; nN = N / BM; nwg = nM * nN; G = G_; c = c_; }
    DEVI bool next(int i, Unit& u) const {
        const long L = (long)i * G + c; if (L >= nwg) return false;
        int wgid = (int)L; { const int q = nwg / NXCD, r = nwg % NXCD, xcd = wgid % NXCD, off = wgid / NXCD; wgid = (xcd < r ? xcd * (q + 1) : r * (q + 1) + (xcd - r) * q) + off; }
        const int nig = WGM * nN, gid = wgid / nig, fm = gid * WGM, gsz = (nM - fm) < WGM ? (nM - fm) : WGM;
        u.pm = fm + ((wgid % nig) % gsz); u.pn = (wgid % nig) / gsz; return true;
    }
};

template <class Q>
DEVI void gemm_phase(LAS unsigned char* lds, const Gemm g, const StaticOrder& S, const Q& E) {
    const int tid = tid_(), wid = __builtin_amdgcn_readfirstlane(tid >> 6), lane = tid & 63, wr = wid >> 2, wc = wid & 3, fr = lane & 15, fq = lane >> 4;
    const int K = g.K, nt = K / BK;
    unsigned voffA[2], voffB[2];
#pragma unroll
    for (int i = 0; i < 2; ++i) { int R, C; stage_rc(tid * 16 + i * 8192, R, C);
        voffA[i] = (unsigned)(R * g.lda + C) * 2u; voffB[i] = (unsigned)(R * g.ldb + C) * 2u; }
    const size_t kstep = (size_t)(BK * 2);
    const size_t hstepA = (size_t)HALF * g.lda * 2, hstepB = (size_t)HALF * g.ldb * 2;
    const size_t tstepA = 2 * hstepA, tstepB = 2 * hstepB;
    const unsigned ldsw = (unsigned)wid * 1024u;
    const int aoff = lds_byte(wr * 64 + fr, fq * 8), boff = lds_byte(wc * 32 + fr, fq * 8);
#define PG8_SA(b, h) (((b) * 2 + (h)) * HTB)
#define PG8_SB(b, h) ((4 + (b) * 2 + (h)) * HTB)
#define PG8_STAGE(bufoff, gbase, voff) do { _Pragma("unroll") for (int _i = 0; _i < 2; ++_i) \
        __builtin_amdgcn_global_load_lds((const unsigned*)((const char*)(gbase) + (voff)[_i]), (LAS unsigned*)(lds + (bufoff) + ldsw + _i * 8192), 16, 0, 0); } while (0)
#define PG8_LDA(dst, b, h) do { _Pragma("unroll") for (int m = 0; m < 4; ++m) _Pragma("unroll") for (int k = 0; k < 2; ++k) dst[m][k] = *(const LAS bf16x8*)(lds + PG8_SA(b, h) + aoff + m * 2048 + k * 1024); } while (0)
#define PG8_LDB(dst, b, h) do { _Pragma("unroll") for (int n = 0; n < 2; ++n) _Pragma("unroll") for (int k = 0; k < 2; ++k) dst[n][k] = *(const LAS bf16x8*)(lds + PG8_SB(b, h) + boff + n * 2048 + k * 1024); } while (0)
#define PG8_MMA(ai, bj, At, Bt) do { __builtin_amdgcn_s_setprio(1); _Pragma("unroll") for (int m = 0; m < 4; ++m) _Pragma("unroll") for (int n = 0; n < 2; ++n) _Pragma("unroll") for (int k = 0; k < 2; ++k) \
        acc[ai][bj][m][n] = __builtin_amdgcn_mfma_f32_16x16x32_bf16(Bt[n][k], At[m][k], acc[ai][bj][m][n], 0, 0, 0); __builtin_amdgcn_s_setprio(0); } while (0)
#define PG8_WAIT_V(n) asm volatile("s_waitcnt vmcnt(" #n ")" ::: "memory")
#define PG8_WAIT_L(n) asm volatile("s_waitcnt lgkmcnt(" #n ")" ::: "memory")
#define PG8_BAR __builtin_amdgcn_s_barrier()
#define PG8_SCHED __builtin_amdgcn_sched_barrier(0)
    Unit cur, nxt; int ui = 0;
    if (!S.next(0, cur)) return;
    f32x4 acc[2][2][4][2];
#pragma unroll
    for (int a = 0; a < 2; ++a)
#pragma unroll
        for (int b = 0; b < 2; ++b)
#pragma unroll
            for (int m = 0; m < 4; ++m)
#pragma unroll
                for (int n = 0; n < 2; ++n) acc[a][b][m][n] = (f32x4){0.f, 0.f, 0.f, 0.f};
    bf16x8 At[4][2], B0[2][2], B1[2][2];
    const char* cA = (const char*)g.A + (size_t)cur.pm * tstepA + (g.diag ? (size_t)(cur.pn >> 1) * 512 : 0); const char* cB = (const char*)g.Bt + (size_t)cur.pn * tstepB;
    PG8_STAGE(PG8_SB(0, 0), cB, voffB); PG8_STAGE(PG8_SA(0, 0), cA, voffA); PG8_STAGE(PG8_SB(0, 1), cB + hstepB, voffB); PG8_STAGE(PG8_SA(0, 1), cA + hstepA, voffA);
    if (wr == 1) PG8_BAR;
    PG8_WAIT_V(4); PG8_BAR;
    PG8_STAGE(PG8_SB(1, 0), cB + kstep, voffB); PG8_STAGE(PG8_SA(1, 0), cA + kstep, voffA); PG8_STAGE(PG8_SB(1, 1), cB + hstepB + kstep, voffB);
    PG8_WAIT_V(6); PG8_BAR;
    for (;;) {
        const bool has_next = S.next(ui + 1, nxt);
        const char* nA = has_next ? (const char*)g.A + (size_t)nxt.pm * tstepA + (g.diag ? (size_t)(nxt.pn >> 1) * 512 : 0) : cA; const char* nB = has_next ? (const char*)g.Bt + (size_t)nxt.pn * tstepB : cB;
        for (int t = 0; t < nt; t += 2) {
            const bool last = (t == nt - 2);
            const char* a1 = cA + (size_t)(t + 1) * kstep;
            const char* a2 = last ? nA : cA + (size_t)(t + 2) * kstep; const char* b2 = last ? nB : cB + (size_t)(t + 2) * kstep;
            const char* a3 = a2 + kstep; const char* b3 = b2 + kstep;
            PG8_LDB(B0, 0, 0); PG8_SCHED; PG8_LDA(At, 0, 0); PG8_STAGE(PG8_SA(1, 1), a1 + hstepA, voffA);
            PG8_WAIT_L(8); PG8_BAR; PG8_WAIT_L(0); PG8_MMA(0, 0, At, B0); PG8_BAR; PG8_SCHED;
            PG8_LDB(B1, 0, 1); PG8_STAGE(PG8_SB(0, 0), b2, voffB);
            PG8_BAR; PG8_WAIT_L(0); PG8_MMA(0, 1, At, B1); PG8_BAR;
            PG8_LDA(At, 0, 1); PG8_STAGE(PG8_SA(0, 0), a2, voffA);
            PG8_BAR; PG8_WAIT_L(0); PG8_MMA(1, 0, At, B0); PG8_BAR; PG8_SCHED;
            PG8_STAGE(PG8_SB(0, 1), b2 + hstepB, voffB);
            PG8_WAIT_V(6); PG8_BAR; PG8_MMA(1, 1, At, B1); PG8_BAR;
            PG8_LDB(B0, 1, 0); PG8_SCHED; PG8_LDA(At, 1, 0); PG8_STAGE(PG8_SA(0, 1), a2 + hstepA, voffA);
            PG8_WAIT_L(8); PG8_BAR; PG8_WAIT_L(0); PG8_MMA(0, 0, At, B0); PG8_BAR; PG8_SCHED;
            PG8_LDB(B1, 1, 1); PG8_STAGE(PG8_SB(1, 0), b3, voffB);
            PG8_BAR; PG8_WAIT_L(0); PG8_MMA(0, 1, At, B1); PG8_BAR;
            PG8_LDA(At, 1, 1); PG8_STAGE(PG8_SA(1, 0), a3, voffA);
            PG8_BAR; PG8_WAIT_L(0); PG8_MMA(1, 0, At, B0); PG8_BAR; PG8_SCHED;
            PG8_STAGE(PG8_SB(1, 1), b3 + hstepB, voffB);
            PG8_WAIT_V(6); PG8_BAR; PG8_MMA(1, 1, At, B1); PG8_BAR;
        }
#pragma unroll
        for (int ai = 0; ai < 2; ++ai)
#pragma unroll
            for (int m = 0; m < 4; ++m)
#pragma unroll
                for (int n = 0; n < 2; ++n)
                    E.quad(cur.pm * BM + ai * HALF + wr * 64 + m * 16 + fr, cur.pn, wc * 32 + n * 16 + fq * 4, acc[ai][0][m][n], acc[ai][1][m][n]);
        if (!has_next) break;
#pragma unroll
        for (int a = 0; a < 2; ++a)
#pragma unroll
            for (int b = 0; b < 2; ++b)
#pragma unroll
                for (int m = 0; m < 4; ++m)
#pragma unroll
                    for (int n = 0; n < 2; ++n) acc[a][b][m][n] = (f32x4){0.f, 0.f, 0.f, 0.f};
        cur = nxt; cA = nA; cB = nB; ++ui;
    }
    PG8_WAIT_V(0);
    if (wr == 0) PG8_BAR;
    PG8_BAR;
#undef PG8_SA
#undef PG8_SB
#undef PG8_STAGE
#undef PG8_LDA
#undef PG8_LDB
#undef PG8_MMA
#undef PG8_WAIT_V
#undef PG8_WAIT_L
#undef PG8_BAR
#undef PG8_SCHED
}
}

template <class Q>
DEVI void run_gemm(LAS unsigned char* lds, const bf16_t* A, int lda, const bf16_t* Bt, int ldb, int M, int N, int K, int diag, int rot, const Q& q) {
    pg8::Gemm g; g.A = A; g.Bt = Bt; g.M = M; g.N = N; g.K = K; g.lda = lda; g.ldb = ldb; g.diag = diag;
    pg8::StaticOrder S; S.init(M, N, (int)gridDim.x, (int)((blockIdx.x + gridDim.x - (rot % gridDim.x)) % gridDim.x));
    pg8::gemm_phase<Q>(lds, g, S, q);
}

template <class Q>
DEVI void skinny_phase(LAS unsigned char* lds, const bf16_t* A, int lda, const bf16_t* Bt, int ldb, int N, int K, int diag, const Q& q) {
    const int tid = tid_(), w = tid >> 6, lane = tid & 63, fr = lane & 15, fq = lane >> 4;
    const int nitems = N / 32, kw = K / 8;
    for (int it = blockIdx.x; it < nitems; it += gridDim.x) {
        const int pn = it >> 3, g = it & 7;
        const bf16_t* a0 = A + (size_t)fr * lda + (diag ? (pn >> 1) * 256 : 0) + w * kw + fq * 8;
        const bf16_t* b0 = Bt + (size_t)(pn * 256 + g * 16 + fr) * ldb + w * kw + fq * 8;
        const bf16_t* b1 = b0 + (size_t)128 * ldb;
        f32x4 acc[8][2];
#pragma unroll
        for (int rt = 0; rt < 8; ++rt) { acc[rt][0] = (f32x4){0.f, 0.f, 0.f, 0.f}; acc[rt][1] = (f32x4){0.f, 0.f, 0.f, 0.f}; }
#pragma unroll 1
        for (int k = 0; k < kw; k += 32) {
            const bf16x8 bf0 = *(const bf16x8*)(b0 + k), bf1 = *(const bf16x8*)(b1 + k);
#pragma unroll
            for (int rt = 0; rt < 8; ++rt) {
                const bf16x8 af = *(const bf16x8*)(a0 + (size_t)rt * 16 * lda + k);
                acc[rt][0] = mfma16(bf0, af, acc[rt][0]); acc[rt][1] = mfma16(bf1, af, acc[rt][1]);
            }
        }
#pragma unroll
        for (int rt = 0; rt < 8; ++rt) {
            *(LAS f32x4*)(lds + (size_t)((((w * 8 + rt) * 2 + 0) * 64 + lane) * 16)) = acc[rt][0];
            *(LAS f32x4*)(lds + (size_t)((((w * 8 + rt) * 2 + 1) * 64 + lane) * 16)) = acc[rt][1];
        }
        __syncthreads();
        {
            f32x4 v0 = (f32x4){0.f, 0.f, 0.f, 0.f}, v1 = v0;
#pragma unroll
            for (int ww = 0; ww < 8; ++ww) {
                v0 += *(const LAS f32x4*)(lds + (size_t)((((ww * 8 + w) * 2 + 0) * 64 + lane) * 16));
                v1 += *(const LAS f32x4*)(lds + (size_t)((((ww * 8 + w) * 2 + 1) * 64 + lane) * 16));
            }
            q.quad(PR + w * 16 + fr, pn, g * 16 + fq * 4, v0, v1);
        }
        __syncthreads();
    }
}

struct QRetIn {
    bf16_t* big; bf16_t* kt; bf16_t* vt; const float* rc; const float* rs;
    DEVI void quad(int row, int pn, int cl, f32x4 v0, f32x4 v1) const {
        const bool smp = row >= PR; const int b = row >> 11, t = row & 2047;
        bf16_t* nat = big + (size_t)row * 6144 + pn * 256 + cl;
        if (pn < 8) {
            const int h = pn & 3; const int pi = smp ? 2048 : t;
            const f32x4 c = *(const f32x4*)(rc + pi * 128 + cl), s = *(const f32x4*)(rs + pi * 128 + cl);
            f32x4 o0 = v0 * c - v1 * s, o1 = v0 * s + v1 * c;
            const float l2g = log2f(1.f - exp2f(-5.f - (float)h));
            const float tt = smp ? 0.f : (float)(t & 127);
            const float sc = pn < 4 ? exp2f(l2g * tt) : 0.0625f * exp2f(-l2g * tt);
            o0 *= sc; o1 *= sc;
            *(u32x2*)nat = pack4(o0); *(u32x2*)(nat + 128) = pack4(o1);
            if (pn >= 4 && !smp) {
                bf16_t* q = kt + ((size_t)(b * 4 + h) * 256 + cl) * 2048 + t;
#pragma unroll
                for (int r = 0; r < 4; ++r) { q[(size_t)r * 2048] = f2bf(o0[r]); q[(size_t)(128 + r) * 2048] = f2bf(o1[r]); }
            }
        } else if (pn < 16) {
            if (smp) { *(u32x2*)nat = pack4(v0); *(u32x2*)(nat + 128) = pack4(v1); }
            else {
                const int c0 = (pn - 8) * 256 + cl; const int head = c0 >> 9, e0 = c0 & 511;
                bf16_t* q = vt + ((size_t)(b * 4 + head) * 512 + e0) * 2048 + t;
#pragma unroll
                for (int r = 0; r < 4; ++r) { q[(size_t)r * 2048] = f2bf(v0[r]); q[(size_t)(128 + r) * 2048] = f2bf(v1[r]); }
            }
        } else { *(u32x2*)nat = pack4(v0); *(u32x2*)(nat + 128) = pack4(v1); }
    }
};
struct QResid {
    const float* rinP; const float* rinS; float* xout;
    DEVI void quad(int row, int pn, int cl, f32x4 v0, f32x4 v1) const {
        const float* r = (row < PR ? rinP + (size_t)row * 1024 : rinS + (size_t)(row - PR) * 1024) + pn * 256 + cl;
        float* o = xout + (size_t)row * 1024 + pn * 256 + cl;
        *(f32x4*)o = *(const f32x4*)r + v0; *(f32x4*)(o + 128) = *(const f32x4*)(r + 128) + v1;
    }
};
struct QBf16 {
    bf16_t* out; int ld;
    DEVI void quad(int row, int pn, int cl, f32x4 v0, f32x4 v1) const {
        bf16_t* o = out + (size_t)row * ld + pn * 256 + cl;
        *(u32x2*)o = pack4(v0); *(u32x2*)(o + 128) = pack4(v1);
    }
};
struct QMemKV {
    float* outk; float* outv; bf16_t* mk; bf16_t* mvt;
    DEVI void quad(int row, int pn, int cl, f32x4 v0, f32x4 v1) const {
        if (pn < 4) {
            const size_t o = (size_t)row * 1024 + pn * 256 + cl;
            *(f32x4*)(outk + o) = v0; *(f32x4*)(outk + o + 128) = v1;
            *(u32x2*)(mk + o) = pack4(v0); *(u32x2*)(mk + o + 128) = pack4(v1);
        } else {
            const int h = pn - 4; const size_t o = (size_t)row * 1024 + h * 256 + cl;
            *(f32x4*)(outv + o) = v0; *(f32x4*)(outv + o + 128) = v1;
            const int b = row >> 8, m = row & 255;
            bf16_t* q = mvt + ((size_t)(b * 4 + h) * 256 + cl) * 256 + m;
#pragma unroll
            for (int r = 0; r < 4; ++r) { q[r * 256] = f2bf(v0[r]); q[(128 + r) * 256] = f2bf(v1[r]); }
        }
    }
};
struct QLru {
    const float* ba; const float* bx; const float* lam; const bf16_t* xc; float* aa; float* uu;
    const float* h0; float* hout; const bf16_t* big; bf16_t* yl;
    DEVI void quad(int row, int pn, int cl, f32x4 v0, f32x4 v1) const {
        const int ch = (pn >> 1) * 256 + (pn & 1) * 128 + cl;
        const f32x4 ba4 = *(const f32x4*)(ba + ch), bx4 = *(const f32x4*)(bx + ch), lm4 = *(const f32x4*)(lam + ch);
        const u32x2 xp = *(const u32x2*)(xc + (size_t)row * 1024 + ch);
        const float xv[4] = {bflo(xp.x), bfhi(xp.x), bflo(xp.y), bfhi(xp.y)};
        f32x4 a4, u4;
#pragma unroll
        for (int r = 0; r < 4; ++r) {
            const float rr = sigmoidf_(v0[r] + ba4[r]), ii = sigmoidf_(v1[r] + bx4[r]);
            const float la = 8.f * rr * lm4[r];
            const float av = __expf(la);
            a4[r] = av; u4[r] = sqrtf(fmaxf(1.f - av * av, 0.f)) * (ii * xv[r]);
        }
        if (row < PR) { *(f32x4*)(aa + (size_t)row * 1024 + ch) = a4; *(f32x4*)(uu + (size_t)row * 1024 + ch) = u4; }
        else {
            const int sb = row - PR;
            const f32x4 hp = *(const f32x4*)(h0 + (size_t)sb * 1024 + ch);
            const f32x4 hn = a4 * hp + u4;
            *(f32x4*)(hout + (size_t)sb * 1024 + ch) = hn;
            const u32x2 gp = *(const u32x2*)(big + (size_t)row * 2048 + 1024 + ch);
            f32x4 y; y[0] = gelu_tanh(bflo(gp.x)) * hn[0]; y[1] = gelu_tanh(bfhi(gp.x)) * hn[1]; y[2] = gelu_tanh(bflo(gp.y)) * hn[2]; y[3] = gelu_tanh(bfhi(gp.y)) * hn[3];
            *(u32x2*)(yl + (size_t)row * 1024 + ch) = pack4(y);
        }
    }
};

template <bool F32OUT>
DEVI void norm_phase(const float* srcP, const float* srcS, const float* gain, bf16_t* dstb, float* dstP, float* dstS, int nrows) {
    const int tid = tid_(); const int lane = tid & 63, wave = blockIdx.x * 8 + (tid >> 6), nw = gridDim.x * 8;
    f32x4 g[4];
#pragma unroll
    for (int i = 0; i < 4; ++i) g[i] = *(const f32x4*)(gain + i * 256 + lane * 4);
    for (int r = wave; r < nrows; r += nw) {
        const float* s = r < PR ? srcP + (size_t)r * 1024 : srcS + (size_t)(r - PR) * 1024;
        f32x4 v[4]; float ss = 0.f;
#pragma unroll
        for (int i = 0; i < 4; ++i) { v[i] = *(const f32x4*)(s + i * 256 + lane * 4); ss += v[i][0] * v[i][0] + v[i][1] * v[i][1] + v[i][2] * v[i][2] + v[i][3] * v[i][3]; }
        ss = wave_sum(ss);
        const float rs = rsqrtf(ss * (1.f / 1024.f) + 1e-6f);
        if (F32OUT) {
            float* d = r < PR ? dstP + (size_t)r * 1024 : dstS + (size_t)(r - PR) * 1024;
#pragma unroll
            for (int i = 0; i < 4; ++i) *(f32x4*)(d + i * 256 + lane * 4) = v[i] * rs * g[i];
        } else {
            bf16_t* d = dstb + (size_t)r * 1024;
#pragma unroll
            for (int i = 0; i < 4; ++i) *(u32x2*)(d + i * 256 + lane * 4) = pack4(v[i] * rs * g[i]);
        }
    }
}

DEVI void transpose_phase(LAS unsigned char* lds, const Params& p) {
    LAS float* tile = (LAS float*)lds;
    const int tid = tid_();
    for (int ti = blockIdx.x; ti < p.ntiles; ti += gridDim.x) {
        int j = 0;
        while (j + 1 < NJOBS && p.jobs[j + 1].tile0 <= ti) ++j;
        const TJob jb = p.jobs[j];
        const int lt = ti - jb.tile0, ntn = jb.N >> 6, tk = lt / ntn, tn = lt - tk * ntn, k0 = tk * 64, n0 = tn * 64;
        {
            const int kk = tid >> 4, nq = tid & 15;
#pragma unroll
            for (int i = 0; i < 2; ++i) {
                const f32x4 v = *(const f32x4*)(jb.src + (size_t)(k0 + kk + 32 * i) * jb.ld + n0 + nq * 4);
#pragma unroll
                for (int c = 0; c < 4; ++c) tile[(kk + 32 * i) * 65 + nq * 4 + c] = v[c];
            }
        }
        __syncthreads();
        {
            const int n = tid >> 3, kq = tid & 7;
            float f[8];
#pragma unroll
            for (int c = 0; c < 8; ++c) f[c] = tile[(kq * 8 + c) * 65 + n];
            u32x4 o; o.x = cvt_pk_bf16(f[0], f[1]); o.y = cvt_pk_bf16(f[2], f[3]); o.z = cvt_pk_bf16(f[4], f[5]); o.w = cvt_pk_bf16(f[6], f[7]);
            *(u32x4*)(jb.dst + (size_t)(n0 + n) * jb.K + k0 + kq * 8) = o;
        }
        __syncthreads();
    }
}

DEVI void rot_phase(float* rc, float* rs, double c1) {
    const int gt = blockIdx.x * 512 + tid_(), ng = gridDim.x * 512;
    for (int i = gt; i < 2049 * 128; i += ng) {
        const int pi = i >> 7, j = i & 127;
        double inv = 1.0, bb = c1; int e = j;
        while (e) { if (e & 1) inv *= bb; bb *= bb; e >>= 1; }
        const double pos = pi == 2048 ? 16384.0 : (double)pi;
        const double ang = pos * inv;
        const double twopi_hi = 6.283185307179586232, twopi_lo = 2.449293598294706414e-16;
        const double nn = rint(ang * 0.15915494309189534561);
        double r = fma(-nn, twopi_hi, ang); r = fma(-nn, twopi_lo, r);
        const double hlf = 0.5 * r, h2 = hlf * hlf;
        double sn = 1.0, cs = 1.0;
        sn = 1.0 / 51090942171709440000.0;
        sn = fma(sn, h2, -1.0 / 121645100408832000.0);
        sn = fma(sn, h2, 1.0 / 355687428096000.0);
        sn = fma(sn, h2, -1.0 / 1307674368000.0);
        sn = fma(sn, h2, 1.0 / 6227020800.0);
        sn = fma(sn, h2, -1.0 / 39916800.0);
        sn = fma(sn, h2, 1.0 / 362880.0);
        sn = fma(sn, h2, -1.0 / 5040.0);
        sn = fma(sn, h2, 1.0 / 120.0);
        sn = fma(sn, h2, -1.0 / 6.0);
        sn = fma(sn, h2, 1.0);
        sn *= hlf;
        cs = 1.0 / 2432902008176640000.0;
        cs = fma(cs, h2, -1.0 / 6402373705728000.0);
        cs = fma(cs, h2, 1.0 / 20922789888000.0);
        cs = fma(cs, h2, -1.0 / 87178291200.0);
        cs = fma(cs, h2, 1.0 / 479001600.0);
        cs = fma(cs, h2, -1.0 / 3628800.0);
        cs = fma(cs, h2, 1.0 / 40320.0);
        cs = fma(cs, h2, -1.0 / 720.0);
        cs = fma(cs, h2, 1.0 / 24.0);
        cs = fma(cs, h2, -0.5);
        cs = fma(cs, h2, 1.0);
        rs[i] = (float)(2.0 * sn * cs);
        rc[i] = (float)(1.0 - 2.0 * sn * sn);
    }
}

DEVI void lsg_phase(const float* lam, float* lsg) { for (int i = blockIdx.x * 512 + tid_(); i < 1024; i += gridDim.x * 512) { const float e = __expf(-lam[i]); lsg[i] = -log1pf(e); } }

DEVI void gate_phase(const bf16_t* o, const bf16_t* big, bf16_t* og) {
    const int tid = tid_(); const int lane = tid & 63, wave = blockIdx.x * 8 + (tid >> 6), nw = gridDim.x * 8;
    for (int it = wave; it < TR * 4; it += nw) {
        const int row = it >> 2, h = it & 3;
        const u32x4 ov = *(const u32x4*)(o + (size_t)row * 2048 + h * 512 + lane * 8);
        const u32x4 gv = *(const u32x4*)(big + (size_t)row * 6144 + 4096 + h * 512 + lane * 8);
        float of[8] = {bflo(ov.x), bfhi(ov.x), bflo(ov.y), bfhi(ov.y), bflo(ov.z), bfhi(ov.z), bflo(ov.w), bfhi(ov.w)};
        float gf[8] = {bflo(gv.x), bfhi(gv.x), bflo(gv.y), bfhi(gv.y), bflo(gv.z), bfhi(gv.z), bflo(gv.w), bfhi(gv.w)};
        float ss = 0.f;
#pragma unroll
        for (int c = 0; c < 8; ++c) ss += of[c] * of[c];
        ss = wave_sum(ss);
        const float rs = rsqrtf(ss * (1.f / 512.f) + 1e-6f);
        float y[8];
#pragma unroll
        for (int c = 0; c < 8; ++c) y[c] = gf[c] * sigmoidf_(gf[c]) * of[c] * rs;
        u32x4 w; w.x = cvt_pk_bf16(y[0], y[1]); w.y = cvt_pk_bf16(y[2], y[3]); w.z = cvt_pk_bf16(y[4], y[5]); w.w = cvt_pk_bf16(y[6], y[7]);
        *(u32x4*)(og + (size_t)row * 2048 + h * 512 + lane * 8) = w;
    }
}

DEVI void unpack8(u32x4 v, float* f) { f[0] = bflo(v.x); f[1] = bfhi(v.x); f[2] = bflo(v.y); f[3] = bfhi(v.y); f[4] = bflo(v.z); f[5] = bfhi(v.z); f[6] = bflo(v.w); f[7] = bfhi(v.w); }

DEVI void ffn_gate_phase(const bf16_t* big, bf16_t* y, const float* cw, const float* cb, const float* sbuf  , float* outp  , float* outs  ) {
    const int gt = blockIdx.x * 512 + tid_(), ng = gridDim.x * 512;
    for (int it = gt; it < TR * 384; it += ng) {
        const int row = it / 384, c = (it - row * 384) * 8;
        float u0[8], u1[8], u2[8], gg[8];
        unpack8(*(const u32x4*)(big + (size_t)row * 6144 + c), u0);
        unpack8(*(const u32x4*)(big + (size_t)row * 6144 + 3072 + c), gg);
        if (row < PR) {
            const int t = row & 2047;
            if (t >= 1) unpack8(*(const u32x4*)(big + (size_t)(row - 1) * 6144 + c), u1); else { for (int k = 0; k < 8; ++k) u1[k] = 0.f; }
            if (t >= 2) unpack8(*(const u32x4*)(big + (size_t)(row - 2) * 6144 + c), u2); else { for (int k = 0; k < 8; ++k) u2[k] = 0.f; }
            if (t >= 2046) { float* o = outp + ((size_t)(row >> 11) * 2 + (t - 2046)) * 3072 + c; *(f32x4*)o = (f32x4){u0[0], u0[1], u0[2], u0[3]}; *(f32x4*)(o + 4) = (f32x4){u0[4], u0[5], u0[6], u0[7]}; }
        } else {
            const int sb = row - PR;
            const float* b0 = sbuf + ((size_t)sb * 2 + 0) * 3072 + c; const float* b1 = b0 + 3072;
            const f32x4 p0 = *(const f32x4*)b0, p1 = *(const f32x4*)(b0 + 4), q0 = *(const f32x4*)b1, q1 = *(const f32x4*)(b1 + 4);
            for (int k = 0; k < 4; ++k) { u2[k] = p0[k]; u2[4 + k] = p1[k]; u1[k] = q0[k]; u1[4 + k] = q1[k]; }
            float* o = outs + ((size_t)sb * 2) * 3072 + c;
            *(f32x4*)o = q0; *(f32x4*)(o + 4) = q1;
            *(f32x4*)(o + 3072) = (f32x4){u0[0], u0[1], u0[2], u0[3]}; *(f32x4*)(o + 3072 + 4) = (f32x4){u0[4], u0[5], u0[6], u0[7]};
        }
        float r[8];
#pragma unroll
        for (int k = 0; k < 8; ++k) {
            const float uc = cb[c + k] + u2[k] * cw[c + k] + u1[k] * cw[3072 + c + k] + u0[k] * cw[6144 + c + k];
            r[k] = gelu_tanh(uc) * gg[k];
        }
        u32x4 w; w.x = cvt_pk_bf16(r[0], r[1]); w.y = cvt_pk_bf16(r[2], r[3]); w.z = cvt_pk_bf16(r[4], r[5]); w.w = cvt_pk_bf16(r[6], r[7]);
        *(u32x4*)(y + (size_t)row * 3072 + c) = w;
    }
}

DEVI void lru_conv_phase(const bf16_t* big, bf16_t* xc, const float* cw, const float* cb, const float* sbuf  , float* outp  , float* outs  ) {
    const int gt = blockIdx.x * 512 + tid_(), ng = gridDim.x * 512;
    for (int it = gt; it < TR * 128; it += ng) {
        const int row = it >> 7, c = (it & 127) * 8;
        float x0[8], x1[8], x2[8], x3[8];
        unpack8(*(const u32x4*)(big + (size_t)row * 2048 + c), x0);
        if (row < PR) {
            const int t = row & 2047;
            if (t >= 1) unpack8(*(const u32x4*)(big + (size_t)(row - 1) * 2048 + c), x1); else { for (int k = 0; k < 8; ++k) x1[k] = 0.f; }
            if (t >= 2) unpack8(*(const u32x4*)(big + (size_t)(row - 2) * 2048 + c), x2); else { for (int k = 0; k < 8; ++k) x2[k] = 0.f; }
            if (t >= 3) unpack8(*(const u32x4*)(big + (size_t)(row - 3) * 2048 + c), x3); else { for (int k = 0; k < 8; ++k) x3[k] = 0.f; }
            if (t >= 2045) { float* o = outp + ((size_t)(row >> 11) * 3 + (t - 2045)) * 1024 + c; *(f32x4*)o = (f32x4){x0[0], x0[1], x0[2], x0[3]}; *(f32x4*)(o + 4) = (f32x4){x0[4], x0[5], x0[6], x0[7]}; }
        } else {
            const int sb = row - PR;
            const float* b0 = sbuf + (size_t)sb * 3 * 1024 + c;
            float* o = outs + (size_t)sb * 3 * 1024 + c;
            for (int k = 0; k < 8; ++k) { x3[k] = b0[k]; x2[k] = b0[1024 + k]; x1[k] = b0[2048 + k]; }
            for (int k = 0; k < 8; ++k) { o[k] = x2[k]; o[1024 + k] = x1[k]; o[2048 + k] = x0[k]; }
        }
        float r[8];
#pragma unroll
        for (int k = 0; k < 8; ++k) r[k] = cb[c + k] + x3[k] * cw[c + k] + x2[k] * cw[1024 + c + k] + x1[k] * cw[2048 + c + k] + x0[k] * cw[3072 + c + k];
        u32x4 w; w.x = cvt_pk_bf16(r[0], r[1]); w.y = cvt_pk_bf16(r[2], r[3]); w.z = cvt_pk_bf16(r[4], r[5]); w.w = cvt_pk_bf16(r[6], r[7]);
        *(u32x4*)(xc + (size_t)row * 1024 + c) = w;
    }
}

DEVI void scan1_phase(const float* aa, const float* uu, float* chs) {
    const int gt = blockIdx.x * 512 + tid_(), ng = gridDim.x * 512;
    for (int it = gt; it < 8 * 32 * 1024; it += ng) {
        const int c = it & 1023, ck = (it >> 10) & 31, b = it >> 15;
        const size_t base = ((size_t)b * 2048 + ck * 64) * 1024 + c;
        float ap = 1.f, h = 0.f;
#pragma unroll 8
        for (int t = 0; t < 64; ++t) { const float a = aa[base + (size_t)t * 1024], u = uu[base + (size_t)t * 1024]; h = a * h + u; ap *= a; }
        chs[(size_t)it * 2] = ap; chs[(size_t)it * 2 + 1] = h;
    }
}
DEVI void scan2_phase(const float* aa, const float* uu, const float* chs, const bf16_t* big, bf16_t* yl, float* hout  ) {
    const int gt = blockIdx.x * 512 + tid_(), ng = gridDim.x * 512;
    for (int it = gt; it < 8 * 32 * 1024; it += ng) {
        const int c = it & 1023, ck = (it >> 10) & 31, b = it >> 15;
        float h = 0.f;
        for (int k = 0; k < ck; ++k) { const size_t ci = ((size_t)(b * 32 + k) * 1024 + c) * 2; h = chs[ci] * h + chs[ci + 1]; }
        const size_t row0 = (size_t)b * 2048 + ck * 64;
#pragma unroll 8
        for (int t = 0; t < 64; ++t) {
            const size_t row = row0 + t;
            h = aa[row * 1024 + c] * h + uu[row * 1024 + c];
            const float gb = bf2f(big[row * 2048 + 1024 + c]);
            yl[row * 1024 + c] = f2bf(gelu_tanh(gb) * h);
        }
        if (ck == 31) hout[b * 1024 + c] = h;
    }
}

DEVI void retention_prompt_phase(LAS unsigned char* lds, const bf16_t* big, const bf16_t* ktg, const bf16_t* vtg, bf16_t* og, float* sout  ) {
    constexpr int KS_STR = 528, VT_STR = 272, ST_STR = 528, AT_STR = 272;
    constexpr int KS_OFF = 0, VT_OFF = 128 * KS_STR, ST_OFF = VT_OFF + 64 * VT_STR, AT_OFF = ST_OFF + 64 * ST_STR;
    const int tid = tid_(), w = tid >> 6, lane = tid & 63, fr = lane & 15, fq = lane >> 4;
    LAS unsigned char* att = lds + AT_OFF + w * (16 * AT_STR);
    for (int it = blockIdx.x; it < 256; it += gridDim.x) {
        const int b = it >> 5, h = (it >> 3) & 3, es = it & 7;
        const float l2g = log2f(1.f - exp2f(-5.f - (float)h));
        const float gam = exp2f(l2g), gam127 = exp2f(127.f * l2g);
        f32x4 sacc[2][4];
#pragma unroll
        for (int a = 0; a < 2; ++a)
#pragma unroll
            for (int e = 0; e < 4; ++e) sacc[a][e] = (f32x4){0.f, 0.f, 0.f, 0.f};
        __syncthreads();
        for (int i = tid; i < 64 * ST_STR / 16; i += 512) *(LAS u32x4*)(lds + ST_OFF + i * 16) = (u32x4){0u, 0u, 0u, 0u};
        for (int n = 0; n < 16; ++n) {
            const size_t row0 = (size_t)b * 2048 + n * 128;
            __syncthreads();
#pragma unroll
            for (int i = 0; i < 8; ++i) { const int idx = tid + 512 * i, j = idx >> 5, dq = idx & 31;
                *(LAS u32x4*)(lds + KS_OFF + j * KS_STR + dq * 16) = *(const u32x4*)(big + (row0 + j) * 6144 + 1024 + h * 256 + dq * 8); }
#pragma unroll
            for (int i = 0; i < 2; ++i) { const int idx = tid + 512 * i, e = idx >> 4, jq = idx & 15;
                *(LAS u32x4*)(lds + VT_OFF + e * VT_STR + jq * 16) = *(const u32x4*)(vtg + ((size_t)(b * 4 + h) * 512 + es * 64 + e) * 2048 + n * 128 + jq * 8); }
            bf16x8 qf[8];
#pragma unroll
            for (int ks = 0; ks < 8; ++ks) qf[ks] = *(const bf16x8*)(big + (row0 + 16 * w + fr) * 6144 + h * 256 + ks * 32 + fq * 8);
            __syncthreads();
            for (int jt = 0; jt <= w; ++jt) {
                f32x4 acc = (f32x4){0.f, 0.f, 0.f, 0.f};
#pragma unroll
                for (int ks = 0; ks < 8; ++ks) {
                    const bf16x8 kf = *(const LAS bf16x8*)(lds + KS_OFF + (jt * 16 + fr) * KS_STR + ks * 64 + fq * 16);
                    acc = mfma16(kf, qf[ks], acc);
                }
                if (jt == w) {
#pragma unroll
                    for (int r = 0; r < 4; ++r) if (fq * 4 + r > fr) acc[r] = 0.f;
                }
                *(LAS u32x2*)(att + fr * AT_STR + (jt * 16 + fq * 4) * 2) = pack4(acc);
            }
            if ((w & 1) == 0) *(LAS u32x2*)(att + fr * AT_STR + ((w + 1) * 16 + fq * 4) * 2) = (u32x2){0u, 0u};
            __builtin_amdgcn_fence(__ATOMIC_SEQ_CST, "wavefront"); asm volatile("s_waitcnt lgkmcnt(0)" ::: "memory"); __builtin_amdgcn_wave_barrier();
#pragma unroll
            for (int et = 0; et < 4; ++et) {
                f32x4 ao = (f32x4){0.f, 0.f, 0.f, 0.f}, ac = (f32x4){0.f, 0.f, 0.f, 0.f};
                for (int js = 0; js <= (w >> 1); ++js) {
                    const bf16x8 af = *(const LAS bf16x8*)(att + fr * AT_STR + js * 64 + fq * 16);
                    const bf16x8 vf = *(const LAS bf16x8*)(lds + VT_OFF + (et * 16 + fr) * VT_STR + js * 64 + fq * 16);
                    ao = mfma16(vf, af, ao);
                }
#pragma unroll
                for (int ks = 0; ks < 8; ++ks) {
                    const bf16x8 sf = *(const LAS bf16x8*)(lds + ST_OFF + (et * 16 + fr) * ST_STR + ks * 64 + fq * 16);
                    ac = mfma16(sf, qf[ks], ac);
                }
                const f32x4 o = ao + ac * gam;
                *(u32x2*)(og + (row0 + 16 * w + fr) * 2048 + h * 512 + es * 64 + et * 16 + fq * 4) = pack4(o);
            }
#pragma unroll
            for (int a = 0; a < 2; ++a)
#pragma unroll
                for (int e = 0; e < 4; ++e) sacc[a][e] *= gam;
#pragma unroll
            for (int js = 0; js < 4; ++js) {
                bf16x8 kf[2];
#pragma unroll
                for (int a = 0; a < 2; ++a) kf[a] = *(const bf16x8*)(ktg + ((size_t)(b * 4 + h) * 256 + 32 * w + a * 16 + fr) * 2048 + n * 128 + js * 32 + fq * 8);
#pragma unroll
                for (int e = 0; e < 4; ++e) {
                    const bf16x8 vf = *(const LAS bf16x8*)(lds + VT_OFF + (e * 16 + fr) * VT_STR + js * 64 + fq * 16);
#pragma unroll
                    for (int a = 0; a < 2; ++a) sacc[a][e] = mfma16(kf[a], vf, sacc[a][e]);
                }
            }
#pragma unroll
            for (int a = 0; a < 2; ++a)
#pragma unroll
                for (int e = 0; e < 4; ++e) sacc[a][e] *= gam127;
            __syncthreads();
#pragma unroll
            for (int a = 0; a < 2; ++a)
#pragma unroll
                for (int e = 0; e < 4; ++e)
                    *(LAS u32x2*)(lds + ST_OFF + (e * 16 + fr) * ST_STR + (32 * w + a * 16 + fq * 4) * 2) = pack4(sacc[a][e]);
        }
#pragma unroll
        for (int a = 0; a < 2; ++a)
#pragma unroll
            for (int e = 0; e < 4; ++e)
#pragma unroll
                for (int r = 0; r < 4; ++r)
                    sout[((size_t)(b * 4 + h) * 256 + 32 * w + a * 16 + fq * 4 + r) * 512 + es * 64 + e * 16 + fr] = sacc[a][e][r];
    }
}

DEVI void retention_sample_phase(LAS unsigned char* lds, const bf16_t* big, const float* sin_, float* sout, bf16_t* og) {
    const int tid = tid_(), ec = tid & 31, dr = tid >> 5;
    LAS float* red = (LAS float*)lds;
    for (int it = blockIdx.x; it < 128 * 4 * 4; it += gridDim.x) {
        const int sb = it >> 4, h = (it >> 2) & 3, eq = it & 3;
        const float gam = 1.f - exp2f(-5.f - (float)h);
        const size_t row = (size_t)PR + sb;
        const bf16_t* qp = big + row * 6144 + h * 256;
        const bf16_t* kp = qp + 1024;
        const u32x2 vp = *(const u32x2*)(big + row * 6144 + 2048 + h * 512 + eq * 128 + ec * 4);
        const f32x4 v4 = (f32x4){bflo(vp.x), bfhi(vp.x), bflo(vp.y), bfhi(vp.y)};
        const size_t sbase = ((size_t)(sb * 4 + h) * 256) * 512 + eq * 128 + ec * 4;
        f32x4 o4 = (f32x4){0.f, 0.f, 0.f, 0.f};
#pragma unroll 4
        for (int i = 0; i < 16; ++i) {
            const int d = dr + 16 * i;
            const f32x4 s = *(const f32x4*)(sin_ + sbase + (size_t)d * 512);
            const float kd = bf2f(kp[d]), qd = bf2f(qp[d]);
            const f32x4 sn = s * gam + v4 * kd;
            *(f32x4*)(sout + sbase + (size_t)d * 512) = sn;
            o4 += sn * qd;
        }
        __syncthreads();
        *(LAS f32x4*)(red + (dr * 32 + ec) * 4) = o4;
        __syncthreads();
        if (tid < 32) {
            f32x4 s = (f32x4){0.f, 0.f, 0.f, 0.f};
#pragma unroll
            for (int k = 0; k < 16; ++k) s += *(const LAS f32x4*)(red + (k * 32 + tid) * 4);
            *(u32x2*)(og + row * 2048 + h * 512 + eq * 128 + tid * 4) = pack4(s);
        }
    }
}

DEVI void xattn_prompt_phase(LAS unsigned char* lds, const bf16_t* qx, const bf16_t* mk  , const bf16_t* mvt  , bf16_t* ao) {
    constexpr int STR = 528;
    const int tid = tid_(), w = tid >> 6, lane = tid & 63, fr = lane & 15, fq = lane >> 4;
    for (int it = blockIdx.x; it < 512; it += gridDim.x) {
        const int b = it >> 6, h = (it >> 4) & 3, qt = it & 15;
        const size_t row = (size_t)b * 2048 + qt * 128 + 16 * w + fr;
        __syncthreads();
#pragma unroll
        for (int i = 0; i < 16; ++i) { const int idx = tid + 512 * i, m = idx >> 5, dq = idx & 31;
            *(LAS u32x4*)(lds + m * STR + dq * 16) = *(const u32x4*)(mk + ((size_t)b * 256 + m) * 1024 + h * 256 + dq * 8); }
        bf16x8 qf[8];
#pragma unroll
        for (int ks = 0; ks < 8; ++ks) qf[ks] = *(const bf16x8*)(qx + row * 1024 + h * 256 + ks * 32 + fq * 8);
        __syncthreads();
        f32x4 s[16];
#pragma unroll
        for (int mt = 0; mt < 16; ++mt) {
            f32x4 acc = (f32x4){0.f, 0.f, 0.f, 0.f};
#pragma unroll
            for (int ks = 0; ks < 8; ++ks) {
                const bf16x8 kf = *(const LAS bf16x8*)(lds + (mt * 16 + fr) * STR + ks * 64 + fq * 16);
                acc = mfma16(kf, qf[ks], acc);
            }
            s[mt] = acc;
            __builtin_amdgcn_sched_barrier(0);
        }
        float mx = -3.0e38f;
#pragma unroll
        for (int mt = 0; mt < 16; ++mt)
#pragma unroll
            for (int r = 0; r < 4; ++r) mx = fmaxf(mx, s[mt][r]);
        mx = fmaxf(mx, __shfl_xor(mx, 16)); mx = fmaxf(mx, __shfl_xor(mx, 32));
        float sum = 0.f;
        const float sc = 0.0625f * 1.4426950408889634f;
#pragma unroll
        for (int mt = 0; mt < 16; ++mt)
#pragma unroll
            for (int r = 0; r < 4; ++r) { const float e = exp2f((s[mt][r] - mx) * sc); s[mt][r] = e; sum += e; }
        sum += __shfl_xor(sum, 16); sum += __shfl_xor(sum, 32);
        const float inv = 1.f / sum;
        bf16x8 pf[8];
#pragma unroll
        for (int ms = 0; ms < 8; ++ms) {
            u32x4 u; u.x = cvt_pk_bf16(s[2 * ms][0], s[2 * ms][1]); u.y = cvt_pk_bf16(s[2 * ms][2], s[2 * ms][3]);
            u.z = cvt_pk_bf16(s[2 * ms + 1][0], s[2 * ms + 1][1]); u.w = cvt_pk_bf16(s[2 * ms + 1][2], s[2 * ms + 1][3]);
            pf[ms] = __builtin_bit_cast(bf16x8, u);
        }
        __syncthreads();
#pragma unroll
        for (int i = 0; i < 16; ++i) { const int idx = tid + 512 * i, d = idx >> 5, mq = idx & 31;
            *(LAS u32x4*)(lds + d * STR + mq * 16) = *(const u32x4*)(mvt + ((size_t)(b * 4 + h) * 256 + d) * 256 + mq * 8); }
        __syncthreads();
#pragma unroll 2
        for (int dt = 0; dt < 16; ++dt) {
            f32x4 acc = (f32x4){0.f, 0.f, 0.f, 0.f};
#pragma unroll
            for (int ms = 0; ms < 8; ++ms) {
                const u32x2 lo = *(const LAS u32x2*)(lds + (dt * 16 + fr) * STR + (ms * 32 + fq * 4) * 2);
                const u32x2 hi = *(const LAS u32x2*)(lds + (dt * 16 + fr) * STR + (ms * 32 + 16 + fq * 4) * 2);
                u32x4 u; u.x = lo.x; u.y = lo.y; u.z = hi.x; u.w = hi.y;
                acc = mfma16(__builtin_bit_cast(bf16x8, u), pf[ms], acc);
            }
            *(u32x2*)(ao + row * 1024 + h * 256 + dt * 16 + fq * 4) = pack4(acc * inv);
        }
    }
}

DEVI void xattn_sample_phase(LAS unsigned char* lds, const bf16_t* qx, const float* ck, const float* cv, bf16_t* ao) {
    const int tid = tid_(), w = tid >> 6, lane = tid & 63;
    LAS float* sc = (LAS float*)lds;
    LAS float* red = (LAS float*)(lds + 2048);
    for (int it = blockIdx.x; it < 512; it += gridDim.x) {
        const int sb = it >> 2, h = it & 3;
        const size_t row = (size_t)PR + sb;
        const u32x2 qp = *(const u32x2*)(qx + row * 1024 + h * 256 + lane * 4);
        const f32x4 q4 = (f32x4){bflo(qp.x), bfhi(qp.x), bflo(qp.y), bfhi(qp.y)};
        const size_t base = ((size_t)sb * 256 * 4 + h) * 256 + lane * 4;
        __syncthreads();
#pragma unroll 8
        for (int i = 0; i < 32; ++i) {
            const int m = w + 8 * i;
            const f32x4 k4 = *(const f32x4*)(ck + base + (size_t)m * 1024);
            float d = k4[0] * q4[0] + k4[1] * q4[1] + k4[2] * q4[2] + k4[3] * q4[3];
            d = wave_sum(d);
            if (lane == 0) sc[m] = d * 0.0625f;
        }
        __syncthreads();
        float mx = -3.0e38f;
        for (int m = lane; m < 256; m += 64) mx = fmaxf(mx, sc[m]);
#pragma unroll
        for (int o = 32; o; o >>= 1) mx = fmaxf(mx, __shfl_xor(mx, o));
        float sum = 0.f;
        for (int m = lane; m < 256; m += 64) sum += __expf(sc[m] - mx);
        sum = wave_sum(sum);
        const float inv = 1.f / sum;
        f32x4 o4 = (f32x4){0.f, 0.f, 0.f, 0.f};
#pragma unroll 8
        for (int i = 0; i < 32; ++i) {
            const int m = w + 8 * i;
            const float pm = __expf(sc[m] - mx) * inv;
            const f32x4 v4 = *(const f32x4*)(cv + base + (size_t)m * 1024);
            o4 += v4 * pm;
        }
        *(LAS f32x4*)(red + (w * 64 + lane) * 4) = o4;
        __syncthreads();
        if (tid < 64) {
            f32x4 s = (f32x4){0.f, 0.f, 0.f, 0.f};
#pragma unroll
            for (int k = 0; k < 8; ++k) s += *(const LAS f32x4*)(red + (k * 64 + tid) * 4);
            *(u32x2*)(ao + row * 1024 + h * 256 + tid * 4) = pack4(s);
        }
    }
}

enum { K_PREP = 0, K_RETIN, K_RET, K_GATE, K_RESID, K_NORM, K_BF16, K_XATTN, K_FFNGATE, K_LRUCONV, K_LRU, K_SCAN1, K_SCAN2, K_NORMF };
constexpr int NPH = 29;
struct Step { int kind, L, lda, N, K, ldo; const bf16_t* A; const bf16_t* Bt; bf16_t* ob; const float* rinP; const float* rinS; const float* gain; };

template <int ONLY>
__global__ void __launch_bounds__(512) mega(Params p, int lo, int hi) {
    extern __shared__ __attribute__((aligned(16))) unsigned char shm[];
    LAS unsigned char* lds = (LAS unsigned char*)shm;
    cg::grid_group grid = cg::this_grid();
#define WS_ ((unsigned char*)p.in[33 + zero_()])
#define OUT_ ((float*)p.in[32 + zero_()])
#define x_prompt (p.in[0 + zero_()])
#define x_sample (p.in[1 + zero_()])
#define state_ret (p.in[2 + zero_()])
#define state_lru_h (p.in[3 + zero_()])
#define state_lru_conv (p.in[4 + zero_()])
#define state_ffn_conv (p.in[5 + zero_()])
#define cache_k (p.in[6 + zero_()])
#define cache_v (p.in[7 + zero_()])
#define mem_prompt (p.in[8 + zero_()])
#define norm_mix (p.in[9 + zero_()])
#define norm_xa (p.in[10 + zero_()])
#define norm_mem (p.in[11 + zero_()])
#define norm_ffn (p.in[12 + zero_()])
#define norm_final (p.in[13 + zero_()])
#define lru_conv_w (p.in[17 + zero_()])
#define lru_conv_b (p.in[18 + zero_()])
#define lru_ba (p.in[20 + zero_()])
#define lru_bx (p.in[22 + zero_()])
#define lru_lambda (p.in[23 + zero_()])
#define ffn_conv_w (p.in[29 + zero_()])
#define ffn_conv_b (p.in[30 + zero_()])
#define HN ((bf16_t*)(WS_ + W_HN))
#define MN ((bf16_t*)(WS_ + W_MN))
#define MK ((bf16_t*)(WS_ + W_MK))
#define MVT ((bf16_t*)(WS_ + W_MVT))
#define BIG ((bf16_t*)(WS_ + W_BIG))
#define X ((float*)(WS_ + W_X))
#define XS ((float*)(WS_ + W_X) + (size_t)PR * 1024)
#define QX ((bf16_t*)(WS_ + W_QX))
#define AO ((bf16_t*)(WS_ + W_AO))
#define Y ((bf16_t*)(WS_ + W_Y))
#define KT ((bf16_t*)(WS_ + W_KT))
#define VT ((bf16_t*)(WS_ + W_VT))
#define O ((bf16_t*)(WS_ + W_O))
#define OG ((bf16_t*)(WS_ + W_OG))
#define XC ((bf16_t*)(WS_ + W_XC))
#define AA ((float*)(WS_ + W_AA))
#define UU ((float*)(WS_ + W_UU))
#define CH ((float*)(WS_ + W_CH))
#define YL ((bf16_t*)(WS_ + W_YL))
#define ROTC ((float*)(WS_ + W_ROTC))
#define ROTS ((float*)(WS_ + W_ROTS))
#define LSG ((float*)(WS_ + W_LSG))
    const int hi2 = hi < NPH ? hi : NPH;
    for (int ph = lo; ph < hi2; ++ph) {
        Step st; st.kind = K_NORM; st.L = ph >= 13 ? 1 : 0; st.lda = 1024; st.N = 1024; st.K = 1024; st.ldo = 1024; st.A = HN; st.Bt = nullptr; st.ob = nullptr; st.rinP = X; st.rinS = XS; st.gain = nullptr;
        switch (ph) {
            case 0: st.kind = K_PREP; break;
            case 1: st.kind = K_RETIN; break;
            case 2: st.kind = K_RET; break;
            case 3: st.kind = K_GATE; break;
            case 4: st.kind = K_RESID; st.A = OG; st.lda = 2048; st.K = 2048; st.Bt = (const bf16_t*)(WS_ + W_ROUT); st.rinP = x_prompt; st.rinS = x_sample; break;
            case 5: st.gain = norm_xa; break;
            case 6: st.kind = K_BF16; st.Bt = (const bf16_t*)(WS_ + W_XQ); st.ob = QX; break;
            case 7: st.kind = K_XATTN; break;
            case 8: st.kind = K_RESID; st.A = AO; st.Bt = (const bf16_t*)(WS_ + W_XO); break;
            case 9: st.gain = norm_ffn; break;
            case 10: st.kind = K_BF16; st.Bt = (const bf16_t*)(WS_ + W_UP); st.N = 6144; st.ob = BIG; st.ldo = 6144; break;
            case 11: st.kind = K_FFNGATE; break;
            case 12: st.kind = K_RESID; st.A = Y; st.lda = 3072; st.K = 3072; st.Bt = (const bf16_t*)(WS_ + W_DN); break;
            case 13: st.gain = norm_mix + 1024; break;
            case 14: st.kind = K_BF16; st.Bt = (const bf16_t*)(WS_ + W_LIN); st.N = 2048; st.ob = BIG; st.ldo = 2048; break;
            case 15: st.kind = K_LRUCONV; break;
            case 16: st.kind = K_LRU; break;
            case 17: st.kind = K_SCAN1; break;
            case 18: st.kind = K_SCAN2; break;
            case 19: st.kind = K_RESID; st.A = YL; st.Bt = (const bf16_t*)(WS_ + W_LOUT); break;
            case 20: st.gain = norm_xa + 1024; break;
            case 21: st.kind = K_BF16; st.Bt = (const bf16_t*)(WS_ + W_XQ + 2097152); st.ob = QX; break;
            case 22: st.kind = K_XATTN; break;
            case 23: st.kind = K_RESID; st.A = AO; st.Bt = (const bf16_t*)(WS_ + W_XO + 2097152); break;
            case 24: st.gain = norm_ffn + 1024; break;
            case 25: st.kind = K_BF16; st.Bt = (const bf16_t*)(WS_ + W_UP + 12582912); st.N = 6144; st.ob = BIG; st.ldo = 6144; break;
            case 26: st.kind = K_FFNGATE; break;
            case 27: st.kind = K_RESID; st.A = Y; st.lda = 3072; st.K = 3072; st.Bt = (const bf16_t*)(WS_ + W_DN + 6291456); break;
            default: st.kind = K_NORMF; break;
        }
        const int L = st.L;
        switch (st.kind) {
            case K_PREP: if constexpr (ONLY < 0 || ONLY == K_PREP) {
#if EN(0)
                transpose_phase(lds, p);
                rot_phase(ROTC, ROTS, p.rope_c1);
                lsg_phase(lru_lambda, LSG);
                norm_phase<false>(x_prompt, x_sample, norm_mix, HN, nullptr, nullptr, TR);
                for (int i = 0; i < 2; ++i) norm_phase<false>(mem_prompt, nullptr, norm_mem + i * 1024, MN + (size_t)i * 2097152, nullptr, nullptr, 2048);
#endif
            } break;
            case K_RETIN: if constexpr (ONLY < 0 || ONLY == K_RETIN) {
                QRetIn q; q.big = BIG; q.kt = KT; q.vt = VT; q.rc = ROTC; q.rs = ROTS;
#if EN(1)
                run_gemm(lds, HN, 1024, (const bf16_t*)(WS_ + W_RIN), 1024, PR, 6144, 1024, 0, 0, q);
#endif
#if EN(13)
                skinny_phase(lds, HN + (size_t)PR * 1024, 1024, (const bf16_t*)(WS_ + W_RIN), 1024, 6144, 1024, 0, q);
#endif
#if EN(14)
                for (int i = 0; i < 2; ++i) {
                    QMemKV m; m.outk = OUT_ + O_MKP + (size_t)i * 2097152; m.outv = OUT_ + O_MVP + (size_t)i * 2097152; m.mk = MK + (size_t)i * 2097152; m.mvt = MVT + (size_t)i * 2097152;
                    run_gemm(lds, MN + (size_t)i * 2097152, 1024, (const bf16_t*)(WS_ + W_XKV + (size_t)i * 4194304), 1024, 2048, 2048, 1024, 0, 64 + 64 * i, m);
                }
#endif
            } break;
            case K_RET: if constexpr (ONLY < 0 || ONLY == K_RET) {
#if EN(2)
                retention_prompt_phase(lds, BIG, KT, VT, O, OUT_ + O_RETP);
#endif
#if EN(3)
                retention_sample_phase(lds, BIG, state_ret, OUT_ + O_RETS, O);
#endif
            } break;
            case K_GATE: if constexpr (ONLY < 0 || ONLY == K_GATE) {
#if EN(4)
                gate_phase(O, BIG, OG);
#endif
            } break;
            case K_RESID: if constexpr (ONLY < 0 || ONLY == K_RESID) {
                QResid q; q.rinP = st.rinP; q.rinS = st.rinS; q.xout = X;
#if EN(5)
                run_gemm(lds, st.A, st.lda, st.Bt, st.K, PR, 1024, st.K, 0, 0, q);
#endif
#if EN(15)
                skinny_phase(lds, st.A + (size_t)PR * st.lda, st.lda, st.Bt, st.K, 1024, st.K, 0, q);
#endif
            } break;
            case K_NORM: if constexpr (ONLY < 0 || ONLY == K_NORM) {
#if EN(0)
                norm_phase<false>(X, XS, st.gain, HN, nullptr, nullptr, TR);
#endif
            } break;
            case K_BF16: if constexpr (ONLY < 0 || ONLY == K_BF16) {
                QBf16 q; q.out = st.ob; q.ld = st.ldo;
#if EN(6)
                run_gemm(lds, HN, 1024, st.Bt, 1024, PR, st.N, 1024, 0, 0, q);
#endif
#if EN(16)
                skinny_phase(lds, HN + (size_t)PR * 1024, 1024, st.Bt, 1024, st.N, 1024, 0, q);
#endif
            } break;
            case K_XATTN: if constexpr (ONLY < 0 || ONLY == K_XATTN) {
#if EN(10)
                xattn_prompt_phase(lds, QX, MK + (size_t)L * 2097152, MVT + (size_t)L * 2097152, AO);
#endif
#if EN(11)
                xattn_sample_phase(lds, QX, cache_k + (size_t)L * 33554432, cache_v + (size_t)L * 33554432, AO);
#endif
            } break;
            case K_FFNGATE: if constexpr (ONLY < 0 || ONLY == K_FFNGATE) {
#if EN(12)
                ffn_gate_phase(BIG, Y, ffn_conv_w + (size_t)L * 9216, ffn_conv_b + (size_t)L * 3072, state_ffn_conv + (size_t)L * 786432,
                               OUT_ + O_FCP + (size_t)L * 49152, OUT_ + O_FCS + (size_t)L * 786432);
#endif
            } break;
            case K_LRUCONV: if constexpr (ONLY < 0 || ONLY == K_LRUCONV) {
#if EN(7)
                lru_conv_phase(BIG, XC, lru_conv_w, lru_conv_b, state_lru_conv, OUT_ + O_LCP, OUT_ + O_LCS);
#endif
            } break;
            case K_LRU: if constexpr (ONLY < 0 || ONLY == K_LRU) {
                QLru q; q.ba = lru_ba; q.bx = lru_bx; q.lam = LSG; q.xc = XC; q.aa = AA; q.uu = UU; q.h0 = state_lru_h; q.hout = OUT_ + O_LHS; q.big = BIG; q.yl = YL;
#if EN(8)
                run_gemm(lds, XC, 1024, (const bf16_t*)(WS_ + W_AX), 256, PR, 2048, 256, 1, 0, q);
#endif
#if EN(18)
                skinny_phase(lds, XC + (size_t)PR * 1024, 1024, (const bf16_t*)(WS_ + W_AX), 256, 2048, 256, 1, q);
#endif
            } break;
            case K_SCAN1: if constexpr (ONLY < 0 || ONLY == K_SCAN1) {
#if EN(9)
                scan1_phase(AA, UU, CH);
#endif
            } break;
            case K_SCAN2: if constexpr (ONLY < 0 || ONLY == K_SCAN2) {
#if EN(9)
                scan2_phase(AA, UU, CH, BIG, YL, OUT_ + O_LHP);
#endif
            } break;
            default: if constexpr (ONLY < 0 || ONLY == K_NORMF) {
#if EN(0)
                norm_phase<true>(X, XS, norm_final, nullptr, OUT_ + O_YP, OUT_ + O_YS, TR);
#endif
            } break;
        }
        if (ph + 1 < hi2) grid.sync();
    }
}

#undef WS_
#undef OUT_
#undef x_prompt
#undef x_sample
#undef state_ret
#undef state_lru_h
#undef state_lru_conv
#undef state_ffn_conv
#undef cache_k
#undef cache_v
#undef mem_prompt
#undef norm_mix
#undef norm_xa
#undef norm_mem
#undef norm_ffn
#undef norm_final
#undef lru_conv_w
#undef lru_conv_b
#undef lru_ba
#undef lru_bx
#undef lru_lambda
#undef ffn_conv_w
#undef ffn_conv_b
#undef HN
#undef MN
#undef MK
#undef MVT
#undef BIG
#undef X
#undef XS
#undef QX
#undef AO
#undef Y
#undef KT
#undef VT
#undef O
#undef OG
#undef XC
#undef AA
#undef UU
#undef CH
#undef YL
#undef ROTC
#undef ROTS
#undef LSG
__global__ void dump_k(const float* src, float* dst, size_t n) { for (size_t i = (size_t)blockIdx.x * blockDim.x + threadIdx.x; i < n; i += (size_t)gridDim.x * blockDim.x) dst[i] = src[i]; }
#ifndef MULTI
#define MULTI 1
#endif
static const int h_kinds[NPH] = {K_PREP, K_RETIN, K_RET, K_GATE, K_RESID, K_NORM, K_BF16, K_XATTN, K_RESID, K_NORM, K_BF16, K_FFNGATE, K_RESID, K_NORM, K_BF16, K_LRUCONV, K_LRU, K_SCAN1, K_SCAN2,
                                 K_RESID, K_NORM, K_BF16, K_XATTN, K_RESID, K_NORM, K_BF16, K_FFNGATE, K_RESID, K_NORMF};
typedef void (*mega_fn)(Params, int, int);
template <int K> static mega_fn get_fn() { return mega<K>; }
static mega_fn fn_of_kind(int k) {
    switch (k) {
        case 0: return get_fn<0>(); case 1: return get_fn<1>(); case 2: return get_fn<2>(); case 3: return get_fn<3>(); case 4: return get_fn<4>(); case 5: return get_fn<5>(); case 6: return get_fn<6>();
        case 7: return get_fn<7>(); case 8: return get_fn<8>(); case 9: return get_fn<9>(); case 10: return get_fn<10>(); case 11: return get_fn<11>(); case 12: return get_fn<12>(); default: return get_fn<13>();
    }
}

extern "C" void kernel_launch(void* const* d_in, const int* in_sizes, int n_in, void* d_out, int out_size, void* d_ws, size_t ws_size, hipStream_t stream) {
    (void)in_sizes; (void)n_in; (void)out_size;
    static int grid_blocks = 0;
    if (!grid_blocks) {
        int dev = 0, cus = 0;
        (void)hipGetDevice(&dev);
        (void)hipDeviceGetAttribute(&cus, hipDeviceAttributeMultiprocessorCount, dev);
#if MULTI
        for (int k = 0; k < 14; ++k) (void)hipFuncSetAttribute((const void*)fn_of_kind(k), hipFuncAttributeMaxDynamicSharedMemorySize, LDS_BYTES);
#else
        (void)hipFuncSetAttribute((const void*)mega<-1>, hipFuncAttributeMaxDynamicSharedMemorySize, LDS_BYTES);
#endif
        grid_blocks = cus;
        if (ws_size < W_TOTAL) fprintf(stderr, "workspace too small: %zu < %zu\n", ws_size, (size_t)W_TOTAL);
    }
    Params p; memset(&p, 0, sizeof(p));
    for (int i = 0; i < 32; ++i) p.in[i] = (const float*)d_in[i];
    p.in[32] = (const float*)d_out; p.in[33] = (const float*)d_ws;
    p.rope_c1 = pow(10000.0, -1.0 / 128.0);
    unsigned char* ws = (unsigned char*)d_ws;
    int nj = 0, tiles = 0;
    auto add = [&](const float* src, size_t dst_off, int ld, int K, int N) {
        TJob& j = p.jobs[nj++]; j.src = src; j.dst = (bf16_t*)(ws + dst_off); j.ld = ld; j.K = K; j.N = N; j.tile0 = tiles; tiles += (K / 64) * (N / 64);
    };
    const float* ret_w_in = p.in[14]; const float* ret_w_out = p.in[15]; const float* lru_w_in = p.in[16]; const float* lru_wa = p.in[19]; const float* lru_wx = p.in[21];
    const float* lru_w_out = p.in[24]; const float* xa_w_q = p.in[25]; const float* xa_w_kv = p.in[26]; const float* xa_w_o = p.in[27]; const float* ffn_w_up = p.in[28]; const float* ffn_w_down = p.in[31];
    add(ret_w_in, W_RIN, 6144, 1024, 6144);
    add(ffn_w_up, W_UP, 6144, 1024, 6144);
    add(ffn_w_up + (size_t)1024 * 6144, W_UP + 12582912, 6144, 1024, 6144);
    add(ret_w_out, W_ROUT, 1024, 2048, 1024);
    add(lru_w_in, W_LIN, 2048, 1024, 2048);
    for (int h = 0; h < 4; ++h)
        for (int s = 0; s < 2; ++s)
            for (int half = 0; half < 2; ++half)
                add((half ? lru_wx : lru_wa) + (size_t)h * 65536 + s * 128, W_AX + (size_t)(h * 512 + s * 256 + half * 128) * 256 * 2, 256, 256, 128);
    add(lru_w_out, W_LOUT, 1024, 1024, 1024);
    for (int i = 0; i < 2; ++i) add(xa_w_q + (size_t)i * 1048576, W_XQ + (size_t)i * 2097152, 1024, 1024, 1024);
    for (int i = 0; i < 2; ++i) add(xa_w_kv + (size_t)i * 2097152, W_XKV + (size_t)i * 4194304, 2048, 1024, 2048);
    for (int i = 0; i < 2; ++i) add(xa_w_o + (size_t)i * 1048576, W_XO + (size_t)i * 2097152, 1024, 1024, 1024);
    for (int i = 0; i < 2; ++i) add(ffn_w_down + (size_t)i * 3145728, W_DN + (size_t)i * 6291456, 1024, 3072, 1024);
    p.ntiles = tiles;
    if (nj != NJOBS) fprintf(stderr, "job count mismatch %d\n", nj);
#if MULTI
#ifndef HI_LIMIT
#define HI_LIMIT NPH
#endif
    for (int ph0 = 0; ph0 < HI_LIMIT; ++ph0) {
        const int ph = ph0;
        int lo = ph, hi = ph + 1;
        void* args[] = {&p, &lo, &hi};
        hipError_t e = hipLaunchKernel((const void*)fn_of_kind(h_kinds[ph]), dim3(grid_blocks), dim3(512), args, LDS_BYTES, stream);
        if (e != hipSuccess) fprintf(stderr, "launch %d failed: %s\n", ph, hipGetErrorString(e));
    }
#ifdef DUMP_OFF
    dump_k<<<1024, 256, 0, stream>>>((const float*)((unsigned char*)d_ws + DUMP_OFF), (float*)d_out, (size_t)16000000);
#endif
#else
    int lo = 0, hi = NPH;
    void* args[] = {&p, &lo, &hi};
    hipError_t e = hipLaunchCooperativeKernel((const void*)mega<-1>, dim3(grid_blocks), dim3(512), args, LDS_BYTES, stream);
    if (e != hipSuccess) fprintf(stderr, "cooperative launch failed: %s (grid %d)\n", hipGetErrorString(e), grid_blocks);
#endif
}
```

```cpp
#include <hip/hip_runtime.h>
#include <hip/hip_cooperative_groups.h>
#include <cstdio>
#include <cstring>
#include <cmath>
namespace cg = cooperative_groups;

#ifndef MASK
#define MASK 0xffffffffu
#endif
#define EN(k) (((MASK) >> (k)) & 1u)
#define LAS __attribute__((address_space(3)))
#define DEVI __device__ __forceinline__
typedef unsigned short bf16_t;
typedef short bf16x8 __attribute__((ext_vector_type(8)));
typedef float f32x4 __attribute__((ext_vector_type(4)));
typedef unsigned u32x2 __attribute__((ext_vector_type(2)));
typedef unsigned u32x4 __attribute__((ext_vector_type(4)));

constexpr int PR = 16384;
constexpr int SR = 128;
constexpr int TR = PR + SR;
constexpr int TP = 16640;
constexpr int LDS_BYTES = 153600 + 16 + 8192;

constexpr size_t O_YP = 0, O_YS = 16777216, O_RETP = 16908288, O_RETS = 21102592, O_LHP = 88211456, O_LHS = 88219648,
                 O_LCP = 88350720, O_LCS = 88375296, O_FCP = 88768512, O_FCS = 88866816, O_MKP = 90439680, O_MVP = 94633984;

constexpr size_t W_RIN = 0;
constexpr size_t W_ROUT = W_RIN + 12582912;
constexpr size_t W_LIN = W_ROUT + 4194304;
constexpr size_t W_AX = W_LIN + 4194304;
constexpr size_t W_LOUT = W_AX + 1048576;
constexpr size_t W_XQ = W_LOUT + 2097152;
constexpr size_t W_XKV = W_XQ + 2 * 2097152;
constexpr size_t W_XO = W_XKV + 2 * 4194304;
constexpr size_t W_UP = W_XO + 2 * 2097152;
constexpr size_t W_DN = W_UP + 2 * 12582912;
constexpr size_t W_ROTC = W_DN + 2 * 6291456;
constexpr size_t W_ROTS = W_ROTC + 1049088;
constexpr size_t W_LSG = W_ROTS + 1049088;
constexpr size_t W_DEC = W_LSG + 4096;
constexpr size_t W_SS = W_DEC + 4096;
constexpr size_t W_HN = W_SS + (size_t)7 * TP * 32 * 4;
constexpr size_t W_MN = W_HN + (size_t)TP * 2048;
constexpr size_t W_MK = W_MN + 8388608;
constexpr size_t W_MVT = W_MK + 8388608;
constexpr size_t W_BIG = W_MVT + 8388608;
constexpr size_t W_X = W_BIG + (size_t)TP * 12288;
constexpr size_t W_QX = W_X + (size_t)TP * 4096;
constexpr size_t W_AO = W_QX + (size_t)TP * 2048;
constexpr size_t W_Y = W_AO + (size_t)TP * 2048;
constexpr size_t W_L = W_Y + (size_t)TP * 6144;
constexpr size_t W_KT = W_L;
constexpr size_t W_VT = W_KT + 33554432;
constexpr size_t W_O = W_VT + 67108864;
constexpr size_t W_OG = W_O + (size_t)TP * 4096;
constexpr size_t W_END0 = W_OG + (size_t)TP * 4096;
constexpr size_t W_XC = W_L;
constexpr size_t W_AA = W_XC + (size_t)TP * 2048;
constexpr size_t W_UU = W_AA + (size_t)TP * 4096;
constexpr size_t W_CH = W_UU + (size_t)TP * 4096;
constexpr size_t W_YL = W_CH + 4194304;
constexpr size_t W_END1 = W_YL + (size_t)TP * 2048;
constexpr size_t W_BAR = (W_END0 > W_END1 ? W_END0 : W_END1);
constexpr size_t W_TOTAL = W_BAR + 256;

struct TJob { const float* src; bf16_t* dst; const float* gain; int ld, K, N, tile0; };
constexpr int NJOBS = 30;
struct Params {
    const float* in[34];
    double rope_c1;
    TJob jobs[NJOBS];
    int ntiles;
    int pad0;
};

typedef float f32x2 __attribute__((ext_vector_type(2)));
typedef __bf16 bf16x2_t __attribute__((ext_vector_type(2)));
DEVI unsigned cvt_pk_bf16(float lo, float hi) { f32x2 v = {lo, hi}; bf16x2_t r = __builtin_convertvector(v, bf16x2_t); return __builtin_bit_cast(unsigned, r); }
DEVI bf16_t f2bf(float f) { return (bf16_t)(cvt_pk_bf16(f, 0.f) & 0xffffu); }
DEVI float bflo(unsigned u) { return __uint_as_float(u << 16); }
DEVI float bfhi(unsigned u) { return __uint_as_float(u & 0xffff0000u); }
DEVI float bf2f(bf16_t b) { return __uint_as_float(((unsigned)b) << 16); }
DEVI u32x2 pack4(f32x4 v) { u32x2 r; r.x = cvt_pk_bf16(v[0], v[1]); r.y = cvt_pk_bf16(v[2], v[3]); return r; }
DEVI float shx(float v, int o, int lane) { return __int_as_float(__builtin_amdgcn_ds_bpermute((lane ^ o) << 2, __float_as_int(v))); }
DEVI float dpp_f(float v, const int ctrl_sel) {
    const int x = __float_as_int(v);
    int r;
    if (ctrl_sel == 0) r = __builtin_amdgcn_update_dpp(x, x, 0xB1, 0xf, 0xf, false);
    else if (ctrl_sel == 1) r = __builtin_amdgcn_update_dpp(x, x, 0x4E, 0xf, 0xf, false);
    else if (ctrl_sel == 2) r = __builtin_amdgcn_update_dpp(x, x, 0x141, 0xf, 0xf, false);
    else r = __builtin_amdgcn_update_dpp(x, x, 0x140, 0xf, 0xf, false);
    return __int_as_float(r);
}
DEVI float wave_sum(float v, int lane) {
    (void)lane;
    v += dpp_f(v, 0); v += dpp_f(v, 1); v += dpp_f(v, 2); v += dpp_f(v, 3);
    const int x = __float_as_int(v);
    const float s0 = __int_as_float(__builtin_amdgcn_readlane(x, 0)), s1 = __int_as_float(__builtin_amdgcn_readlane(x, 16));
    const float s2 = __int_as_float(__builtin_amdgcn_readlane(x, 32)), s3 = __int_as_float(__builtin_amdgcn_readlane(x, 48));
    return (s0 + s1) + (s2 + s3);
}
DEVI float rcp_(float x) { return __builtin_amdgcn_rcpf(x); }
DEVI float ex2_(float x) { return __builtin_amdgcn_exp2f(x); }
DEVI float exp_(float x) { return __builtin_amdgcn_exp2f(x * 1.4426950408889634f); }
DEVI float sigmoidf_(float x) { return rcp_(1.f + exp_(-x)); }
DEVI float gelu_tanh(float x) { const float z = 1.5957691216057308f * (x + 0.044715f * x * x * x); return x * rcp_(1.f + exp_(-z)); }
DEVI int zero_() { int z = 0; asm volatile("" : "+s"(z)); return z; }
DEVI int bid_() { int b = blockIdx.x; asm volatile("" : "+s"(b)); return b; }
DEVI int nblk_() { int b = gridDim.x; asm volatile("" : "+s"(b)); return b; }
DEVI unsigned zv_() { unsigned z = 0; asm volatile("" : "+v"(z)); return z; }
DEVI int tid_() { int t = threadIdx.x; asm volatile("" : "+v"(t)); return t; }
DEVI f32x4 mfma16(bf16x8 a, bf16x8 b, f32x4 c) { return __builtin_amdgcn_mfma_f32_16x16x32_bf16(a, b, c, 0, 0, 0); }

DEVI float rstd_of(const float* ss, int row) {
    const f32x4* p = (const f32x4*)(ss + (unsigned)row * 32u);
    f32x4 a = p[0];
#pragma unroll
    for (int i = 1; i < 8; ++i) a += p[i];
    return __builtin_amdgcn_rsqf(__fadd_rn(__fmul_rn((a[0] + a[1]) + (a[2] + a[3]), 1.f / 1024.f), 1e-6f));
}

namespace pg8 {
constexpr int BM = 256, BK = 64, HALF = 128, HTB = HALF * BK * 2, NXCD = 8, WGM = 8;
__host__ __device__ __forceinline__ int lds_byte(int r, int c) { const int st = (r >> 4) * 2 + (c >> 5), rr = r & 15, cc = c & 31, ob = rr * 64 + cc * 2; return st * 1024 + (ob ^ (((ob >> 9) & 1) << 5)); }
__host__ __device__ __forceinline__ void stage_rc(int b, int& R, int& C) { const int st = b / 1024, sb = b % 1024, swz = sb ^ (((sb >> 9) & 1) << 5); R = (st >> 1) * 16 + swz / 64; C = (st & 1) * 32 + (swz % 64) / 2; }
__host__ __device__ __forceinline__ int perm32(int rho) { const int n = rho >> 4, i = rho & 15; return 8 * (i >> 2) + 4 * n + (i & 3); }
struct Unit { int pm, pn; };
struct Gemm { const bf16_t* A; const bf16_t* Bt; int M, N, K, lda, ldb, diag; };
struct StaticOrder {
    int nM, nN, nwg, G, c;
    DEVI void init(int M, int N, int G_, int c_) { nM = M / BM; nN = N / BM; nwg = nM * nN; G = G_; c = c_; }
    DEVI bool next(int i, Unit& u) const {
        const long L = (long)i * G + c; if (L >= nwg) return false;
        int wgid = (int)L; { const int q = nwg / NXCD, r = nwg % NXCD, xcd = wgid % NXCD, off = wgid / NXCD; wgid = (xcd < r ? xcd * (q + 1) : r * (q + 1) + (xcd - r) * q) + off; }
        const int nig = WGM * nN, gid = wgid / nig, fm = gid * WGM, gsz = (nM - fm) < WGM ? (nM - fm) : WGM;
        u.pm = fm + ((wgid % nig) % gsz); u.pn = (wgid % nig) / gsz; return true;
    }
};

template <class Q>
DEVI void gemm_phase(LAS unsigned char* lds, const Gemm g, const StaticOrder& S, const Q& E) {
    const int tid = tid_(), wid = __builtin_amdgcn_readfirstlane(tid >> 6), lane = tid & 63, wr = wid >> 2, wc = wid & 3, fr = lane & 15, fq = lane >> 4;
    const int K = g.K, nt = K / BK;
    unsigned voffA, voffB;
    { int R, C; stage_rc(tid * 16, R, C); const int Rb = Q::PERM ? ((R & ~31) + perm32(R & 31)) : R; voffA = (unsigned)(R * g.lda + C) * 2u; voffB = (unsigned)(Rb * g.ldb + C) * 2u; }
    const size_t r64voffA = (size_t)64 * g.lda * 2, r64voffB = (size_t)64 * g.ldb * 2;
    const size_t kstep = (size_t)(BK * 2);
    const size_t hstepA = (size_t)HALF * g.lda * 2, hstepB = (g.diag == 2 ? (size_t)3072 : (size_t)HALF) * g.ldb * 2;
    const size_t tstepA = 2 * hstepA, tstepB = (g.diag == 2 ? (size_t)HALF : (size_t)2 * HALF) * g.ldb * 2;
    const unsigned ldsw = (unsigned)wid * 1024u;
    const int aoff = lds_byte(wr * 64 + fr, fq * 8), boff = lds_byte(wc * 32 + fr, fq * 8);
#define PG8_SA(b, h) (((b) * 2 + (h)) * HTB)
#define PG8_SB(b, h) ((4 + (b) * 2 + (h)) * HTB)
#define PG8_STAGE(bufoff, gbase, voff) do { _Pragma("unroll") for (int _i = 0; _i < 2; ++_i) \
        __builtin_amdgcn_global_load_lds((const unsigned*)((const char*)(gbase) + (size_t)_i * r64##voff + voff), (LAS unsigned*)(lds + (bufoff) + ldsw + _i * 8192), 16, 0, 0); } while (0)
#define PG8_LDA(dst, b, h) do { _Pragma("unroll") for (int m = 0; m < 4; ++m) _Pragma("unroll") for (int k = 0; k < 2; ++k) dst[m][k] = *(const LAS bf16x8*)(lds + PG8_SA(b, h) + aoff + m * 2048 + k * 1024); } while (0)
#define PG8_LDB(dst, b, h) do { _Pragma("unroll") for (int n = 0; n < 2; ++n) _Pragma("unroll") for (int k = 0; k < 2; ++k) dst[n][k] = *(const LAS bf16x8*)(lds + PG8_SB(b, h) + boff + n * 2048 + k * 1024); } while (0)
#define PG8_MMA(ai, bj, At, Bt) do { __builtin_amdgcn_s_setprio(1); _Pragma("unroll") for (int m = 0; m < 4; ++m) _Pragma("unroll") for (int n = 0; n < 2; ++n) _Pragma("unroll") for (int k = 0; k < 2; ++k) \
        acc[ai][bj][m][n] = __builtin_amdgcn_mfma_f32_16x16x32_bf16(Bt[n][k], At[m][k], acc[ai][bj][m][n], 0, 0, 0); __builtin_amdgcn_s_setprio(0); } while (0)
#define PG8_WAIT_V(n) asm volatile("s_waitcnt vmcnt(" #n ")" ::: "memory")
#define PG8_WAIT_L(n) asm volatile("s_waitcnt lgkmcnt(" #n ")" ::: "memory")
#define PG8_BAR __builtin_amdgcn_s_barrier()
#define PG8_SCHED __builtin_amdgcn_sched_barrier(0)
    Unit cur, nxt; int ui = 0;
    if (!S.next(0, cur)) return;
    f32x4 acc[2][2][4][2];
#pragma unroll
    for (int a = 0; a < 2; ++a)
#pragma unroll
        for (int b = 0; b < 2; ++b)
#pragma unroll
            for (int m = 0; m < 4; ++m)
#pragma unroll
                for (int n = 0; n < 2; ++n) acc[a][b][m][n] = (f32x4){0.f, 0.f, 0.f, 0.f};
    bf16x8 At[4][2], B0[2][2], B1[2][2];
    const char* cA = (const char*)g.A + (size_t)cur.pm * tstepA + (g.diag == 1 ? (size_t)(cur.pn >> 1) * 512 : 0); const char* cB = (const char*)g.Bt + (size_t)cur.pn * tstepB;
#define PG8_RSTD(unit, par) do { if constexpr (Q::NEEDS_RSTD) { \
        const int _rl = tid >> 1, _hf = tid & 1; \
        const f32x4* _p = (const f32x4*)(E.ss + ((size_t)((unit).pm * BM + _rl)) * 32 + _hf * 16); \
        const f32x4 _a = (_p[0] + _p[1]) + (_p[2] + _p[3]); \
        float _sm = (_a[0] + _a[1]) + (_a[2] + _a[3]); \
        _sm += shx(_sm, 1, lane); \
        if (!_hf) *(LAS float*)(lds + 131072 + (par) * 1024 + _rl * 4) = __builtin_amdgcn_rsqf(__fadd_rn(__fmul_rn(_sm, 1.f / 1024.f), 1e-6f)); } } while (0)
    PG8_RSTD(cur, 0);
    PG8_STAGE(PG8_SB(0, 0), cB, voffB); PG8_STAGE(PG8_SA(0, 0), cA, voffA); PG8_STAGE(PG8_SB(0, 1), cB + hstepB, voffB); PG8_STAGE(PG8_SA(0, 1), cA + hstepA, voffA);
    if (wr == 1) PG8_BAR;
    PG8_WAIT_V(4); PG8_BAR;
    PG8_STAGE(PG8_SB(1, 0), cB + kstep, voffB); PG8_STAGE(PG8_SA(1, 0), cA + kstep, voffA); PG8_STAGE(PG8_SB(1, 1), cB + hstepB + kstep, voffB);
    PG8_WAIT_V(6); PG8_BAR;
    for (;;) {
        const bool has_next = S.next(ui + 1, nxt);
        const char* nA = has_next ? (const char*)g.A + (size_t)nxt.pm * tstepA + (g.diag == 1 ? (size_t)(nxt.pn >> 1) * 512 : 0) : cA; const char* nB = has_next ? (const char*)g.Bt + (size_t)nxt.pn * tstepB : cB;
        for (int t = 0; t < nt; t += 2) {
            const bool last = (t == nt - 2);
            const char* a1 = cA + (size_t)(t + 1) * kstep;
            const char* a2 = last ? nA : cA + (size_t)(t + 2) * kstep; const char* b2 = last ? nB : cB + (size_t)(t + 2) * kstep;
            const char* a3 = a2 + kstep; const char* b3 = b2 + kstep;
            PG8_LDB(B0, 0, 0); PG8_SCHED; PG8_LDA(At, 0, 0); PG8_STAGE(PG8_SA(1, 1), a1 + hstepA, voffA);
            PG8_WAIT_L(8); PG8_BAR; PG8_WAIT_L(0); PG8_MMA(0, 0, At, B0); PG8_BAR; PG8_SCHED;
            PG8_LDB(B1, 0, 1); PG8_STAGE(PG8_SB(0, 0), b2, voffB);
            PG8_BAR; PG8_WAIT_L(0); PG8_MMA(0, 1, At, B1); PG8_BAR;
            PG8_LDA(At, 0, 1); PG8_STAGE(PG8_SA(0, 0), a2, voffA);
            PG8_BAR; PG8_WAIT_L(0); PG8_MMA(1, 0, At, B0); PG8_BAR; PG8_SCHED;
            PG8_STAGE(PG8_SB(0, 1), b2 + hstepB, voffB);
            PG8_WAIT_V(6); PG8_BAR; PG8_MMA(1, 1, At, B1); PG8_BAR;
            PG8_LDB(B0, 1, 0); PG8_SCHED; PG8_LDA(At, 1, 0); PG8_STAGE(PG8_SA(0, 1), a2 + hstepA, voffA);
            PG8_WAIT_L(8); PG8_BAR; PG8_WAIT_L(0); PG8_MMA(0, 0, At, B0); PG8_BAR; PG8_SCHED;
            PG8_LDB(B1, 1, 1); PG8_STAGE(PG8_SB(1, 0), b3, voffB);
            PG8_BAR; PG8_WAIT_L(0); PG8_MMA(0, 1, At, B1); PG8_BAR;
            PG8_LDA(At, 1, 1); PG8_STAGE(PG8_SA(1, 0), a3, voffA);
            PG8_BAR; PG8_WAIT_L(0); PG8_MMA(1, 0, At, B0); PG8_BAR; PG8_SCHED;
            PG8_STAGE(PG8_SB(1, 1), b3 + hstepB, voffB);
            PG8_WAIT_V(6); PG8_BAR; PG8_MMA(1, 1, At, B1); PG8_BAR;
        }
#pragma unroll
        for (int ai = 0; ai < 2; ++ai)
#pragma unroll
            for (int m = 0; m < 4; ++m) {
                int l2 = lane; asm volatile("" : "+v"(l2));
                const int rloc = ai * HALF + wr * 64 + m * 16 + (l2 & 15);
                float rsc = 1.f;
                if constexpr (Q::NEEDS_RSTD) rsc = *(const LAS float*)(lds + 131072 + (ui & 1) * 1024 + rloc * 4);
                if constexpr (Q::PERM) E.oct(cur.pm * BM + rloc, cur.pn, wc * 32 + (l2 >> 4) * 8, acc[ai][0][m][0], acc[ai][0][m][1], acc[ai][1][m][0], acc[ai][1][m][1], rsc);
                else {
#pragma unroll
                    for (int n = 0; n < 2; ++n)
                        E.quad(cur.pm * BM + rloc, cur.pn, wc * 32 + n * 16 + (l2 >> 4) * 4, acc[ai][0][m][n], acc[ai][1][m][n], rsc);
                }
            }
        if (!has_next) break;
        PG8_RSTD(nxt, (ui + 1) & 1);
#pragma unroll
        for (int a = 0; a < 2; ++a)
#pragma unroll
            for (int b = 0; b < 2; ++b)
#pragma unroll
                for (int m = 0; m < 4; ++m)
#pragma unroll
                    for (int n = 0; n < 2; ++n) acc[a][b][m][n] = (f32x4){0.f, 0.f, 0.f, 0.f};
        cur = nxt; cA = nA; cB = nB; ++ui;
    }
    PG8_WAIT_V(0);
    if (wr == 0) PG8_BAR;
    PG8_BAR;
#undef PG8_RSTD
#undef PG8_SA
#undef PG8_SB
#undef PG8_STAGE
#undef PG8_LDA
#undef PG8_LDB
#undef PG8_MMA
#undef PG8_WAIT_V
#undef PG8_WAIT_L
#undef PG8_BAR
#undef PG8_SCHED
}
}

template <class Q>
DEVI void run_gemm(LAS unsigned char* lds, const bf16_t* A, int lda, const bf16_t* Bt, int ldb, int M, int N, int K, int diag, int rot, const Q& q) {
    pg8::Gemm g; g.A = A; g.Bt = Bt; g.M = M; g.N = N; g.K = K; g.lda = lda; g.ldb = ldb; g.diag = diag;
    pg8::StaticOrder S; const int G_ = nblk_(); S.init(M, N, G_, (bid_() + G_ - (rot % G_)) % G_);
    pg8::gemm_phase<Q>(lds, g, S, q);
}

template <int RT, class Q>
DEVI void skinny_phase_t(LAS unsigned char* lds, const bf16_t* A, int lda, const bf16_t* Bt, int ldb, int N, int K, int diag, const Q& q, int nbuse = 0) {
    constexpr int RS = 8 / RT;
    const int tid = tid_(), w = tid >> 6, lane = tid & 63, fr = lane & 15, fq = lane >> 4;
    const int nitems = (N / 32) * RS, kw = K / 8;
    const int stride_ = nbuse > 0 ? nbuse : nblk_();
    for (int it = bid_() < stride_ ? bid_() : nitems; it < nitems; it += stride_) {
        const int ci = it / RS, rs = it - ci * RS, pn = ci >> 3, g = ci & 7;
        const bf16_t* a0 = A + (size_t)(rs * RT * 16 + fr) * lda + (diag == 1 ? (pn >> 1) * 256 : 0) + w * kw + fq * 8;
        const bf16_t* b0 = Bt + (size_t)((diag == 2 ? pn * 128 : pn * 256) + g * 16 + fr) * ldb + w * kw + fq * 8;
        const bf16_t* b1 = b0 + (size_t)(diag == 2 ? 3072 : 128) * ldb;
        f32x4 acc[RT][2];
#pragma unroll
        for (int rt = 0; rt < RT; ++rt) { acc[rt][0] = (f32x4){0.f, 0.f, 0.f, 0.f}; acc[rt][1] = (f32x4){0.f, 0.f, 0.f, 0.f}; }
        bf16x8 cb0 = *(const bf16x8*)(b0), cb1 = *(const bf16x8*)(b1), ca[RT];
#pragma unroll
        for (int rt = 0; rt < RT; ++rt) ca[rt] = *(const bf16x8*)(a0 + (size_t)rt * 16 * lda);
#pragma unroll 1
        for (int k = 32; k <= kw; k += 32) {
            const int kn = k < kw ? k : 0;
            const bf16x8 nb0 = *(const bf16x8*)(b0 + kn), nb1 = *(const bf16x8*)(b1 + kn);
            bf16x8 na[RT];
#pragma unroll
            for (int rt = 0; rt < RT; ++rt) na[rt] = *(const bf16x8*)(a0 + (size_t)rt * 16 * lda + kn);
#pragma unroll
            for (int rt = 0; rt < RT; ++rt) { acc[rt][0] = mfma16(cb0, ca[rt], acc[rt][0]); acc[rt][1] = mfma16(cb1, ca[rt], acc[rt][1]); }
            cb0 = nb0; cb1 = nb1;
#pragma unroll
            for (int rt = 0; rt < RT; ++rt) ca[rt] = na[rt];
        }
#pragma unroll
        for (int rt = 0; rt < RT; ++rt) {
            *(LAS f32x4*)(lds + (size_t)((((w * 8 + rt) * 2 + 0) * 64 + lane) * 16)) = acc[rt][0];
            *(LAS f32x4*)(lds + (size_t)((((w * 8 + rt) * 2 + 1) * 64 + lane) * 16)) = acc[rt][1];
        }
        __syncthreads();
        if (w < RT) {
            f32x4 v0 = *(const LAS f32x4*)(lds + (size_t)((((0 * 8 + w) * 2 + 0) * 64 + lane) * 16));
            f32x4 v1 = *(const LAS f32x4*)(lds + (size_t)((((0 * 8 + w) * 2 + 1) * 64 + lane) * 16));
#pragma unroll
            for (int ww = 1; ww < 8; ++ww) {
                v0 += *(const LAS f32x4*)(lds + (size_t)((((ww * 8 + w) * 2 + 0) * 64 + lane) * 16));
                v1 += *(const LAS f32x4*)(lds + (size_t)((((ww * 8 + w) * 2 + 1) * 64 + lane) * 16));
            }
            const int row = PR + (rs * RT + w) * 16 + fr;
            float rsc = 1.f;
            if constexpr (Q::NEEDS_RSTD) rsc = rstd_of(q.ss, row);
            q.quad(row, pn, g * 16 + fq * 4, v0, v1, rsc);
        }
        __syncthreads();
    }
}
template <class Q>
DEVI void skinny_phase(LAS unsigned char* lds, const bf16_t* A, int lda, const bf16_t* Bt, int ldb, int N, int K, int diag, const Q& q, int nbuse = 0) {
    skinny_phase_t<8, Q>(lds, A, lda, Bt, ldb, N, K, diag, q, nbuse);
}
template <class Q>
DEVI void skinny_phase1(LAS unsigned char* lds, const bf16_t* A, int lda, const bf16_t* Bt, int ldb, int N, int K, int diag, const Q& q) {
    skinny_phase_t<1, Q>(lds, A, lda, Bt, ldb, N, K, diag, q);
}

struct QRetIn {
    static constexpr bool PERM = true;
    DEVI void oct(int row, int pn, int cl8, f32x4 a0, f32x4 a1, f32x4 b0, f32x4 b1, float rsc) const {
        a0 *= rsc; a1 *= rsc; b0 *= rsc; b1 *= rsc;
        const int b = row >> 11, t = row & 2047;
        bf16_t* nat = big + ((unsigned)row * 6144u + (unsigned)(pn * 256 + cl8));
        if (pn < 8) {
            const int h = pn & 3;
            const float* pc = rc + t * 128 + cl8; const float* ps = rs + t * 128 + cl8;
            const f32x4 c0 = *(const f32x4*)pc, c1 = *(const f32x4*)(pc + 4), s0 = *(const f32x4*)ps, s1 = *(const f32x4*)(ps + 4);
            const float sc = dec[pn * 128 + (t & 127)];
            const f32x4 o0 = (a0 * c0 - b0 * s0) * sc, o1 = (a1 * c1 - b1 * s1) * sc, o2 = (a0 * s0 + b0 * c0) * sc, o3 = (a1 * s1 + b1 * c1) * sc;
            const u32x2 p0 = pack4(o0), p1 = pack4(o1), p2 = pack4(o2), p3 = pack4(o3);
            *(u32x4*)nat = (u32x4){p0.x, p0.y, p1.x, p1.y}; *(u32x4*)(nat + 128) = (u32x4){p2.x, p2.y, p3.x, p3.y};
            if (pn >= 4) {
                bf16_t* q = kt + (((unsigned)(b * 4 + h) * 256u + (unsigned)cl8) * 2048u + (unsigned)t);
#pragma unroll
                for (int r = 0; r < 4; ++r) { q[(size_t)r * 2048] = f2bf(o0[r]); q[(size_t)(4 + r) * 2048] = f2bf(o1[r]); q[(size_t)(128 + r) * 2048] = f2bf(o2[r]); q[(size_t)(132 + r) * 2048] = f2bf(o3[r]); }
            }
        } else if (pn < 16) {
            const int c0i = (pn - 8) * 256 + cl8; const int head = c0i >> 9, e0 = c0i & 511;
            bf16_t* q = vt + (((unsigned)(b * 4 + head) * 512u + (unsigned)e0) * 2048u + (unsigned)t);
#pragma unroll
            for (int r = 0; r < 4; ++r) { q[(size_t)r * 2048] = f2bf(a0[r]); q[(size_t)(4 + r) * 2048] = f2bf(a1[r]); q[(size_t)(128 + r) * 2048] = f2bf(b0[r]); q[(size_t)(132 + r) * 2048] = f2bf(b1[r]); }
        } else {
            const u32x2 p0 = pack4(a0), p1 = pack4(a1), p2 = pack4(b0), p3 = pack4(b1);
            *(u32x4*)nat = (u32x4){p0.x, p0.y, p1.x, p1.y}; *(u32x4*)(nat + 128) = (u32x4){p2.x, p2.y, p3.x, p3.y};
        }
    }
    static constexpr bool NEEDS_RSTD = true;
    bf16_t* big; bf16_t* kt; bf16_t* vt; const float* rc; const float* rs; const float* dec; const float* ss;
    DEVI void quad(int row, int pn, int cl, f32x4 v0, f32x4 v1, float rsc) const {
        v0 *= rsc; v1 *= rsc;
        const bool smp = row >= PR; const int b = row >> 11, t = row & 2047;
        bf16_t* nat = big + ((unsigned)row * 6144u + (unsigned)(pn * 256 + cl));
        if (pn < 8) {
            const int h = pn & 3; const int pi = smp ? 2048 : t;
            const f32x4 c = *(const f32x4*)(rc + pi * 128 + cl), s = *(const f32x4*)(rs + pi * 128 + cl);
            f32x4 o0 = v0 * c - v1 * s, o1 = v0 * s + v1 * c;
            const float sc = dec[pn * 128 + (smp ? 0 : (t & 127))];
            o0 *= sc; o1 *= sc;
            *(u32x2*)nat = pack4(o0); *(u32x2*)(nat + 128) = pack4(o1);
            if (pn >= 4 && !smp) {
                bf16_t* q = kt + (((unsigned)(b * 4 + h) * 256u + (unsigned)cl) * 2048u + (unsigned)t);
#pragma unroll
                for (int r = 0; r < 4; ++r) { q[(size_t)r * 2048] = f2bf(o0[r]); q[(size_t)(128 + r) * 2048] = f2bf(o1[r]); }
            }
        } else if (pn < 16) {
            if (smp) { *(u32x2*)nat = pack4(v0); *(u32x2*)(nat + 128) = pack4(v1); }
            else {
                const int c0 = (pn - 8) * 256 + cl; const int head = c0 >> 9, e0 = c0 & 511;
                bf16_t* q = vt + (((unsigned)(b * 4 + head) * 512u + (unsigned)e0) * 2048u + (unsigned)t);
#pragma unroll
                for (int r = 0; r < 4; ++r) { q[(size_t)r * 2048] = f2bf(v0[r]); q[(size_t)(128 + r) * 2048] = f2bf(v1[r]); }
            }
        } else { *(u32x2*)nat = pack4(v0); *(u32x2*)(nat + 128) = pack4(v1); }
    }
};
struct QResid {
    static constexpr bool PERM = true;
    DEVI void oct(int row, int pn, int cl8, f32x4 a0, f32x4 a1, f32x4 b0, f32x4 b1, float rsc) const {
        (void)rsc;
        const float* r = (row < PR ? rinP + (size_t)row * 1024 : rinS + (size_t)(row - PR) * 1024) + pn * 256 + cl8;
        const unsigned off = (unsigned)row * 1024u + (unsigned)(pn * 256 + cl8);
        a0 += __builtin_nontemporal_load((const f32x4*)r); a1 += __builtin_nontemporal_load((const f32x4*)(r + 4)); b0 += __builtin_nontemporal_load((const f32x4*)(r + 128)); b1 += __builtin_nontemporal_load((const f32x4*)(r + 132));
        __builtin_nontemporal_store(a0, (f32x4*)(xout + off)); __builtin_nontemporal_store(a1, (f32x4*)(xout + off + 4)); __builtin_nontemporal_store(b0, (f32x4*)(xout + off + 128)); __builtin_nontemporal_store(b1, (f32x4*)(xout + off + 132));
        const u32x2 pa0 = pack4(a0), pa1 = pack4(a1), pb0 = pack4(b0), pb1 = pack4(b1);
        *(u32x4*)(xb + off) = (u32x4){pa0.x, pa0.y, pa1.x, pa1.y}; *(u32x4*)(xb + off + 128) = (u32x4){pb0.x, pb0.y, pb1.x, pb1.y};
        float sa = a0[0] * a0[0] + a0[1] * a0[1] + a0[2] * a0[2] + a0[3] * a0[3] + a1[0] * a1[0] + a1[1] * a1[1] + a1[2] * a1[2] + a1[3] * a1[3];
        float sb = b0[0] * b0[0] + b0[1] * b0[1] + b0[2] * b0[2] + b0[3] * b0[3] + b1[0] * b1[0] + b1[1] * b1[1] + b1[2] * b1[2] + b1[3] * b1[3];
        const int lane = (row & 15) | (((cl8 >> 3) & 3) << 4);
        sa += shx(sa, 16, lane); sa += shx(sa, 32, lane); sb += shx(sb, 16, lane); sb += shx(sb, 32, lane);
        if (lane < 16) { float* sp = ssout + ((unsigned)row * 32u + (unsigned)(pn * 8 + (cl8 >> 5))); sp[0] = sa; sp[4] = sb; }
    }
    static constexpr bool NEEDS_RSTD = false;
    const float* rinP; const float* rinS; float* xout; bf16_t* xb; float* ssout;
    DEVI void quad(int row, int pn, int cl, f32x4 v0, f32x4 v1, float rsc) const {
        (void)rsc;
        const float* r = (row < PR ? rinP + (size_t)row * 1024 : rinS + (size_t)(row - PR) * 1024) + pn * 256 + cl;
        const unsigned off = (unsigned)row * 1024u + (unsigned)(pn * 256 + cl);
        const f32x4 a = *(const f32x4*)r + v0, b = *(const f32x4*)(r + 128) + v1;
        *(f32x4*)(xout + off) = a; *(f32x4*)(xout + off + 128) = b;
        *(u32x2*)(xb + off) = pack4(a); *(u32x2*)(xb + off + 128) = pack4(b);
        float sq = a[0] * a[0] + a[1] * a[1] + a[2] * a[2] + a[3] * a[3] + b[0] * b[0] + b[1] * b[1] + b[2] * b[2] + b[3] * b[3];
        const int lane = (row & 15) | (((cl >> 2) & 3) << 4);
        sq += shx(sq, 16, lane); sq += shx(sq, 32, lane);
        if (lane < 16) ssout[(unsigned)row * 32u + (unsigned)(pn * 8 + (cl >> 4))] = sq;
    }
};
struct QBf16 {
    static constexpr bool NEEDS_RSTD = true;
    static constexpr bool PERM = true;
    bf16_t* out; int ld; const float* ss;
    DEVI void oct(int row, int pn, int cl8, f32x4 a0, f32x4 a1, f32x4 b0, f32x4 b1, float rsc) const {
        bf16_t* o = out + ((unsigned)row * (unsigned)ld + (unsigned)(pn * 256 + cl8));
        const u32x2 pa0 = pack4(a0 * rsc), pa1 = pack4(a1 * rsc), pb0 = pack4(b0 * rsc), pb1 = pack4(b1 * rsc);
        *(u32x4*)o = (u32x4){pa0.x, pa0.y, pa1.x, pa1.y}; *(u32x4*)(o + 128) = (u32x4){pb0.x, pb0.y, pb1.x, pb1.y};
    }
    DEVI void quad(int row, int pn, int cl, f32x4 v0, f32x4 v1, float rsc) const {
        v0 *= rsc; v1 *= rsc;
        bf16_t* o = out + ((unsigned)row * (unsigned)ld + (unsigned)(pn * 256 + cl));
        *(u32x2*)o = pack4(v0); *(u32x2*)(o + 128) = pack4(v1);
    }
};
DEVI float dpp_shr(float v, const int n) {
    const int x = __float_as_int(v);
    return __int_as_float(n == 1 ? __builtin_amdgcn_update_dpp(x, x, 0x111, 0xf, 0xf, false) : __builtin_amdgcn_update_dpp(x, x, 0x112, 0xf, 0xf, false));
}
struct QFfn {
    static constexpr bool NEEDS_RSTD = true;
    static constexpr bool PERM = true;
    bf16_t* y; bf16_t* big; const float* ss; const float* cw; const float* cb; const float* sbuf; float* outp; float* outs;
    DEVI void oct(int row, int pn, int cl8, f32x4 a0, f32x4 a1, f32x4 b0, f32x4 b1, float rsc) const {
        a0 *= rsc; a1 *= rsc; b0 *= rsc; b1 *= rsc;
        const int ch = pn * 128 + cl8, fr = row & 15;
        f32x4 p10, p11, p20, p21;
#pragma unroll
        for (int k = 0; k < 4; ++k) { p10[k] = dpp_shr(a0[k], 1); p11[k] = dpp_shr(a1[k], 1); p20[k] = dpp_shr(a0[k], 2); p21[k] = dpp_shr(a1[k], 2); }
        if (fr >= 2) {
            const f32x4 w00 = *(const f32x4*)(cw + ch), w01 = *(const f32x4*)(cw + ch + 4), w10 = *(const f32x4*)(cw + 3072 + ch), w11 = *(const f32x4*)(cw + 3072 + ch + 4);
            const f32x4 w20 = *(const f32x4*)(cw + 6144 + ch), w21 = *(const f32x4*)(cw + 6144 + ch + 4), c0 = *(const f32x4*)(cb + ch), c1 = *(const f32x4*)(cb + ch + 4);
            float o[8];
#pragma unroll
            for (int k = 0; k < 4; ++k) {
                o[k] = gelu_tanh(c0[k] + p20[k] * w00[k] + p10[k] * w10[k] + a0[k] * w20[k]) * b0[k];
                o[4 + k] = gelu_tanh(c1[k] + p21[k] * w01[k] + p11[k] * w11[k] + a1[k] * w21[k]) * b1[k];
            }
            u32x4 w; w.x = cvt_pk_bf16(o[0], o[1]); w.y = cvt_pk_bf16(o[2], o[3]); w.z = cvt_pk_bf16(o[4], o[5]); w.w = cvt_pk_bf16(o[6], o[7]);
            *(u32x4*)(y + ((unsigned)row * 3072u + (unsigned)ch)) = w;
        }
        if (fr < 2 || fr >= 14) {
            const u32x2 p0 = pack4(a0), p1 = pack4(a1);
            *(u32x4*)(big + ((unsigned)row * 6144u + (unsigned)ch)) = (u32x4){p0.x, p0.y, p1.x, p1.y};
            if (fr < 2) { const u32x2 g0 = pack4(b0), g1 = pack4(b1); *(u32x4*)(big + ((unsigned)row * 6144u + 3072u + (unsigned)ch)) = (u32x4){g0.x, g0.y, g1.x, g1.y}; }
            else if ((row & 2047) >= 2046) { float* q = outp + ((size_t)(row >> 11) * 2 + ((row & 2047) - 2046)) * 3072 + ch; *(f32x4*)q = a0; *(f32x4*)(q + 4) = a1; }
        }
    }
    DEVI void quad(int row, int pn, int cl, f32x4 v0, f32x4 v1, float rsc) const {
        v0 *= rsc; v1 *= rsc;
        const int ch = pn * 128 + cl, sb = row - PR;
        const float* b0 = sbuf + ((size_t)sb * 2) * 3072 + ch;
        const f32x4 h2 = *(const f32x4*)b0, h1 = *(const f32x4*)(b0 + 3072);
        const f32x4 w0 = *(const f32x4*)(cw + ch), w1 = *(const f32x4*)(cw + 3072 + ch), w2 = *(const f32x4*)(cw + 6144 + ch), c = *(const f32x4*)(cb + ch);
        float* q = outs + ((size_t)sb * 2) * 3072 + ch;
        *(f32x4*)q = h1; *(f32x4*)(q + 3072) = v0;
        f32x4 o;
#pragma unroll
        for (int k = 0; k < 4; ++k) o[k] = gelu_tanh(c[k] + h2[k] * w0[k] + h1[k] * w1[k] + v0[k] * w2[k]) * v1[k];
        *(u32x2*)(y + ((unsigned)row * 3072u + (unsigned)ch)) = pack4(o);
    }
};
struct QMemKV {
    static constexpr bool PERM = false;
    static constexpr bool NEEDS_RSTD = false;
    float* outk; float* outv; bf16_t* mk; bf16_t* mvt;
    DEVI void quad(int row, int pn, int cl, f32x4 v0, f32x4 v1, float rsc) const {
        if (pn < 4) {
            const size_t o = (size_t)row * 1024 + pn * 256 + cl;
            __builtin_nontemporal_store(v0, (f32x4*)(outk + o)); __builtin_nontemporal_store(v1, (f32x4*)(outk + o + 128));
            *(u32x2*)(mk + o) = pack4(v0); *(u32x2*)(mk + o + 128) = pack4(v1);
        } else {
            const int h = pn - 4; const size_t o = (size_t)row * 1024 + h * 256 + cl;
            __builtin_nontemporal_store(v0, (f32x4*)(outv + o)); __builtin_nontemporal_store(v1, (f32x4*)(outv + o + 128));
            const int b = row >> 8, m = row & 255;
            bf16_t* q = mvt + ((size_t)(b * 4 + h) * 256 + cl) * 256 + m;
#pragma unroll
            for (int r = 0; r < 4; ++r) { q[r * 256] = f2bf(v0[r]); q[(128 + r) * 256] = f2bf(v1[r]); }
        }
    }
};
struct QLru {
    static constexpr bool PERM = false;
    static constexpr bool NEEDS_RSTD = false;
    const float* ba; const float* bx; const float* lam; const bf16_t* xc; float* aa; float* uu;
    const float* h0; float* hout; const bf16_t* big; bf16_t* yl;
    DEVI void quad(int row, int pn, int cl, f32x4 v0, f32x4 v1, float rsc) const {
        const int ch = (pn >> 1) * 256 + (pn & 1) * 128 + cl;
        const f32x4 ba4 = *(const f32x4*)(ba + ch), bx4 = *(const f32x4*)(bx + ch), lm4 = *(const f32x4*)(lam + ch);
        const u32x2 xp = *(const u32x2*)(xc + (size_t)row * 1024 + ch);
        const float xv[4] = {bflo(xp.x), bfhi(xp.x), bflo(xp.y), bfhi(xp.y)};
        f32x4 a4, u4;
#pragma unroll
        for (int r = 0; r < 4; ++r) {
            const float rr = sigmoidf_(v0[r] + ba4[r]), ii = sigmoidf_(v1[r] + bx4[r]);
            const float la = 8.f * rr * lm4[r];
            const float av = exp_(la);
            a4[r] = av; u4[r] = __builtin_amdgcn_sqrtf(fmaxf(1.f - av * av, 0.f)) * (ii * xv[r]);
        }
        if (row < PR) { *(f32x4*)(aa + (size_t)row * 1024 + ch) = a4; *(f32x4*)(uu + (size_t)row * 1024 + ch) = u4; }
        else {
            const int sb = row - PR;
            const f32x4 hp = *(const f32x4*)(h0 + (size_t)sb * 1024 + ch);
            const f32x4 hn = a4 * hp + u4;
            *(f32x4*)(hout + (size_t)sb * 1024 + ch) = hn;
            const u32x2 gp = *(const u32x2*)(big + (size_t)row * 2048 + 1024 + ch);
            f32x4 y; y[0] = gelu_tanh(bflo(gp.x)) * hn[0]; y[1] = gelu_tanh(bfhi(gp.x)) * hn[1]; y[2] = gelu_tanh(bflo(gp.y)) * hn[2]; y[3] = gelu_tanh(bfhi(gp.y)) * hn[3];
            *(u32x2*)(yl + (size_t)row * 1024 + ch) = pack4(y);
        }
    }
};

template <bool F32OUT>
DEVI void norm_phase(const float* srcP, const float* srcS, const float* gain, bf16_t* dstb, float* dstP, float* dstS, int nrows) {
    const int tid = tid_(); const int lane = tid & 63, wave = bid_() * 8 + (tid >> 6), nw = nblk_() * 8;
    f32x4 g[4];
#pragma unroll
    for (int i = 0; i < 4; ++i) g[i] = *(const f32x4*)(gain + i * 256 + lane * 4);
    for (int r0 = wave; r0 < nrows; r0 += 2 * nw) {
        f32x4 v[2][4]; float ss[2];
#pragma unroll
        for (int u = 0; u < 2; ++u) {
            const int r = r0 + u * nw < nrows ? r0 + u * nw : r0;
            const float* s = r < PR ? srcP + (size_t)r * 1024 : srcS + (size_t)(r - PR) * 1024;
#pragma unroll
            for (int i = 0; i < 4; ++i) v[u][i] = *(const f32x4*)(s + i * 256 + lane * 4);
        }
#pragma unroll
        for (int u = 0; u < 2; ++u) {
            float q = 0.f;
#pragma unroll
            for (int i = 0; i < 4; ++i) q += v[u][i][0] * v[u][i][0] + v[u][i][1] * v[u][i][1] + v[u][i][2] * v[u][i][2] + v[u][i][3] * v[u][i][3];
            ss[u] = q;
        }
#pragma unroll
        for (int o = 32; o; o >>= 1) { ss[0] += shx(ss[0], o, lane); ss[1] += shx(ss[1], o, lane); }
#pragma unroll
        for (int u = 0; u < 2; ++u) {
            const int r = r0 + u * nw;
            if (r < nrows) {
                const float rs = __builtin_amdgcn_rsqf(__fadd_rn(__fmul_rn(ss[u], 1.f / 1024.f), 1e-6f));
                if (F32OUT) {
                    float* d = r < PR ? dstP + (size_t)r * 1024 : dstS + (size_t)(r - PR) * 1024;
#pragma unroll
                    for (int i = 0; i < 4; ++i) __builtin_nontemporal_store(v[u][i] * rs * g[i], (f32x4*)(d + i * 256 + lane * 4));
                } else {
                    bf16_t* d = dstb + (size_t)r * 1024;
#pragma unroll
                    for (int i = 0; i < 4; ++i) *(u32x2*)(d + i * 256 + lane * 4) = pack4(v[u][i] * rs * g[i]);
                }
            }
        }
    }
}

DEVI void cast_ss_phase(const float* srcP, const float* srcS, bf16_t* xb, float* ss) {
    const int tid = tid_(); const int lane = tid & 63, wave = bid_() * 8 + (tid >> 6), nw = nblk_() * 8;
    for (int r = wave; r < TR; r += nw) {
        const float* s = r < PR ? srcP + (size_t)r * 1024 : srcS + (size_t)(r - PR) * 1024;
        f32x4 v[4]; float q = 0.f;
#pragma unroll
        for (int i = 0; i < 4; ++i) { v[i] = __builtin_nontemporal_load((const f32x4*)(s + i * 256 + lane * 4)); q += v[i][0] * v[i][0] + v[i][1] * v[i][1] + v[i][2] * v[i][2] + v[i][3] * v[i][3]; }
        q = wave_sum(q, lane);
#pragma unroll
        for (int i = 0; i < 4; ++i) *(u32x2*)(xb + (size_t)r * 1024 + i * 256 + lane * 4) = pack4(v[i]);
        if (lane < 32) ss[(size_t)r * 32 + lane] = lane == 0 ? q : 0.f;
    }
}

DEVI void transpose_phase(LAS unsigned char* lds, const Params& p) {
    LAS float* tile = (LAS float*)lds;
    const int tid = tid_();
    for (int ti = bid_(); ti < p.ntiles; ti += nblk_()) {
        int j = 0;
        while (j + 1 < NJOBS && p.jobs[j + 1].tile0 <= ti) ++j;
        const TJob jb = p.jobs[j];
        const int lt = ti - jb.tile0, ntn = jb.N >> 6, tk = lt / ntn, tn = lt - tk * ntn, k0 = tk * 64, n0 = tn * 64;
        {
            const int kk = tid >> 4, nq = tid & 15;
#pragma unroll
            for (int i = 0; i < 2; ++i) {
                const f32x4 v = __builtin_nontemporal_load((const f32x4*)(jb.src + (size_t)(k0 + kk + 32 * i) * jb.ld + n0 + nq * 4));
                const float gk = jb.gain ? jb.gain[k0 + kk + 32 * i] : 1.f;
#pragma unroll
                for (int c = 0; c < 4; ++c) tile[(kk + 32 * i) * 65 + nq * 4 + c] = v[c] * gk;
            }
        }
        __syncthreads();
        {
            const int n = tid >> 3, kq = tid & 7;
            float f[8];
#pragma unroll
            for (int c = 0; c < 8; ++c) f[c] = tile[(kq * 8 + c) * 65 + n];
            u32x4 o; o.x = cvt_pk_bf16(f[0], f[1]); o.y = cvt_pk_bf16(f[2], f[3]); o.z = cvt_pk_bf16(f[4], f[5]); o.w = cvt_pk_bf16(f[6], f[7]);
            *(u32x4*)(jb.dst + (size_t)(n0 + n) * jb.K + k0 + kq * 8) = o;
        }
        __syncthreads();
    }
}

DEVI void rot_phase(float* rc, float* rs, double c1) {
    const int gt = bid_() * 512 + tid_(), ng = nblk_() * 512;
    for (int i = gt; i < 2049 * 128; i += ng) {
        const int pi = i >> 7, j = i & 127;
        double inv = 1.0, bb = c1; int e = j;
        while (e) { if (e & 1) inv *= bb; bb *= bb; e >>= 1; }
        const double pos = pi == 2048 ? 16384.0 : (double)pi;
        const double ang = pos * inv;
        const double rev = ang * 0.15915494309189534561;
        const float fr_ = (float)(rev - rint(rev));
        rs[i] = __builtin_amdgcn_sinf(fr_);
        rc[i] = __builtin_amdgcn_cosf(fr_);
    }
}

DEVI void dec_phase(float* dec) { for (int i = bid_() * 512 + tid_(); i < 1024; i += nblk_() * 512) { const int r = i >> 7, t = i & 127, h = r & 3; const float l2g = __builtin_amdgcn_logf(1.f - 1.f / (float)(32 << h)); dec[i] = r < 4 ? ex2_(l2g * (float)t) : 0.0625f * ex2_(-l2g * (float)t); } }
DEVI void lsg_phase(const float* lam, float* lsg) { for (int i = bid_() * 512 + tid_(); i < 1024; i += nblk_() * 512) { const float e = exp_(-lam[i]); const float ser = e * (1.f - e * (0.5f - e * (0.33333333f - e * (0.25f - e * 0.2f)))); lsg[i] = e < 0.03f ? -ser : -0.69314718056f * __builtin_amdgcn_logf(1.f + e); } }

DEVI void gate_phase(const bf16_t* o, const bf16_t* big, bf16_t* og) {
    const int tid = tid_(); const int lane = tid & 63, wave = bid_() * 8 + (tid >> 6), nw = nblk_() * 8;
    for (int it0 = wave; it0 < TR * 4; it0 += 4 * nw) {
        u32x4 ov[4], gv[4];
#pragma unroll
        for (int u = 0; u < 4; ++u) {
            const int it = it0 + u * nw < TR * 4 ? it0 + u * nw : it0;
            const int row = it >> 2, h = it & 3;
            ov[u] = *(const u32x4*)(o + (size_t)row * 2048 + h * 512 + lane * 8);
            gv[u] = *(const u32x4*)(big + (size_t)row * 6144 + 4096 + h * 512 + lane * 8);
        }
#pragma unroll
        for (int u = 0; u < 4; ++u) {
            const int it = it0 + u * nw;
            const int row = it >> 2, h = it & 3;
            float of[8], gf[8];
            of[0] = bflo(ov[u].x); of[1] = bfhi(ov[u].x); of[2] = bflo(ov[u].y); of[3] = bfhi(ov[u].y); of[4] = bflo(ov[u].z); of[5] = bfhi(ov[u].z); of[6] = bflo(ov[u].w); of[7] = bfhi(ov[u].w);
            gf[0] = bflo(gv[u].x); gf[1] = bfhi(gv[u].x); gf[2] = bflo(gv[u].y); gf[3] = bfhi(gv[u].y); gf[4] = bflo(gv[u].z); gf[5] = bfhi(gv[u].z); gf[6] = bflo(gv[u].w); gf[7] = bfhi(gv[u].w);
            float ss = 0.f;
#pragma unroll
            for (int c = 0; c < 8; ++c) ss += of[c] * of[c];
            ss = wave_sum(ss, lane);
            const float rs = __builtin_amdgcn_rsqf(__fadd_rn(__fmul_rn(ss, 1.f / 512.f), 1e-6f));
            float y[8];
#pragma unroll
            for (int c = 0; c < 8; ++c) y[c] = gf[c] * sigmoidf_(gf[c]) * of[c] * rs;
            u32x4 w; w.x = cvt_pk_bf16(y[0], y[1]); w.y = cvt_pk_bf16(y[2], y[3]); w.z = cvt_pk_bf16(y[4], y[5]); w.w = cvt_pk_bf16(y[6], y[7]);
            if (it < TR * 4) *(u32x4*)(og + (size_t)row * 2048 + h * 512 + lane * 8) = w;
        }
    }
}

DEVI void unpack8(u32x4 v, float* f) { f[0] = bflo(v.x); f[1] = bfhi(v.x); f[2] = bflo(v.y); f[3] = bfhi(v.y); f[4] = bflo(v.z); f[5] = bfhi(v.z); f[6] = bflo(v.w); f[7] = bfhi(v.w); }

DEVI void ffn_gate_phase(const bf16_t* big, bf16_t* y, const float* cw, const float* cb, const float* sbuf  , float* outp  , float* outs  ) {
    const int gt = bid_() * 512 + tid_(), ng = nblk_() * 512;
    for (int it = gt; it < 256 * 384 + SR * 384; it += ng) {
        const bool smp = it >= 256 * 384;
        const int li = smp ? it - 256 * 384 : it;
        const int seg = li / 384, c = (li - seg * 384) * 8;
        float w0[8], w1[8], w2[8], bb[8];
#pragma unroll
        for (int k = 0; k < 8; k += 4) {
            const f32x4 a0 = *(const f32x4*)(cw + c + k), a1 = *(const f32x4*)(cw + 3072 + c + k), a2 = *(const f32x4*)(cw + 6144 + c + k), a3 = *(const f32x4*)(cb + c + k);
#pragma unroll
            for (int j = 0; j < 4; ++j) { w0[k + j] = a0[j]; w1[k + j] = a1[j]; w2[k + j] = a2[j]; bb[k + j] = a3[j]; }
        }
        float u1[8], u2[8];
        if (!smp) {
            const int row0 = seg * 64, t0 = row0 & 2047;
            if (t0 > 0) { unpack8(*(const u32x4*)(big + (size_t)(row0 - 1) * 6144 + c), u1); unpack8(*(const u32x4*)(big + (size_t)(row0 - 2) * 6144 + c), u2); }
            else {
#pragma unroll
                for (int k = 0; k < 8; ++k) { u1[k] = 0.f; u2[k] = 0.f; }
            }
#pragma unroll 8
            for (int r = 0; r < 64; ++r) {
                const size_t row = (size_t)row0 + r;
                float u0[8], gg[8], o[8];
                unpack8(*(const u32x4*)(big + row * 6144 + c), u0);
                unpack8(*(const u32x4*)(big + row * 6144 + 3072 + c), gg);
#pragma unroll
                for (int k = 0; k < 8; ++k) { const float uc = bb[k] + u2[k] * w0[k] + u1[k] * w1[k] + u0[k] * w2[k]; o[k] = gelu_tanh(uc) * gg[k]; }
                u32x4 w; w.x = cvt_pk_bf16(o[0], o[1]); w.y = cvt_pk_bf16(o[2], o[3]); w.z = cvt_pk_bf16(o[4], o[5]); w.w = cvt_pk_bf16(o[6], o[7]);
                *(u32x4*)(y + row * 3072 + c) = w;
                if (t0 + r >= 2046) { float* q = outp + ((size_t)(row >> 11) * 2 + (t0 + r - 2046)) * 3072 + c; *(f32x4*)q = (f32x4){u0[0], u0[1], u0[2], u0[3]}; *(f32x4*)(q + 4) = (f32x4){u0[4], u0[5], u0[6], u0[7]}; }
#pragma unroll
                for (int k = 0; k < 8; ++k) { u2[k] = u1[k]; u1[k] = u0[k]; }
            }
        } else {
            const int sb = seg; const size_t row = (size_t)PR + sb;
            float u0[8], gg[8], o[8];
            unpack8(*(const u32x4*)(big + row * 6144 + c), u0);
            unpack8(*(const u32x4*)(big + row * 6144 + 3072 + c), gg);
            const float* b0 = sbuf + ((size_t)sb * 2 + 0) * 3072 + c; const float* b1 = b0 + 3072;
            const f32x4 p0 = *(const f32x4*)b0, p1 = *(const f32x4*)(b0 + 4), q0 = *(const f32x4*)b1, q1 = *(const f32x4*)(b1 + 4);
#pragma unroll
            for (int k = 0; k < 4; ++k) { u2[k] = p0[k]; u2[4 + k] = p1[k]; u1[k] = q0[k]; u1[4 + k] = q1[k]; }
            float* q = outs + ((size_t)sb * 2) * 3072 + c;
            *(f32x4*)q = q0; *(f32x4*)(q + 4) = q1;
            *(f32x4*)(q + 3072) = (f32x4){u0[0], u0[1], u0[2], u0[3]}; *(f32x4*)(q + 3072 + 4) = (f32x4){u0[4], u0[5], u0[6], u0[7]};
#pragma unroll
            for (int k = 0; k < 8; ++k) { const float uc = bb[k] + u2[k] * w0[k] + u1[k] * w1[k] + u0[k] * w2[k]; o[k] = gelu_tanh(uc) * gg[k]; }
            u32x4 w; w.x = cvt_pk_bf16(o[0], o[1]); w.y = cvt_pk_bf16(o[2], o[3]); w.z = cvt_pk_bf16(o[4], o[5]); w.w = cvt_pk_bf16(o[6], o[7]);
            *(u32x4*)(y + row * 3072 + c) = w;
        }
    }
}

DEVI void ffn_fix_phase(const bf16_t* big, bf16_t* y, const float* cw, const float* cb) {
    const int gt = bid_() * 512 + tid_(), ng = nblk_() * 512;
    for (int it = gt; it < 2048 * 384; it += ng) {
        const int ri = it / 384, c = (it - ri * 384) * 8;
        const int row = (ri >> 1) * 16 + (ri & 1), t = row & 2047;
        float u0[8], u1[8], u2[8], gg[8];
        unpack8(*(const u32x4*)(big + (size_t)row * 6144 + c), u0);
        unpack8(*(const u32x4*)(big + (size_t)row * 6144 + 3072 + c), gg);
        unpack8(*(const u32x4*)(big + (size_t)(t >= 1 ? row - 1 : row) * 6144 + c), u1);
        unpack8(*(const u32x4*)(big + (size_t)(t >= 2 ? row - 2 : row) * 6144 + c), u2);
#pragma unroll
        for (int k = 0; k < 8; ++k) { u1[k] = t >= 1 ? u1[k] : 0.f; u2[k] = t >= 2 ? u2[k] : 0.f; }
        float r[8];
#pragma unroll
        for (int k = 0; k < 8; ++k) {
            const float uc = cb[c + k] + u2[k] * cw[c + k] + u1[k] * cw[3072 + c + k] + u0[k] * cw[6144 + c + k];
            r[k] = gelu_tanh(uc) * gg[k];
        }
        u32x4 w; w.x = cvt_pk_bf16(r[0], r[1]); w.y = cvt_pk_bf16(r[2], r[3]); w.z = cvt_pk_bf16(r[4], r[5]); w.w = cvt_pk_bf16(r[6], r[7]);
        *(u32x4*)(y + (size_t)row * 3072 + c) = w;
    }
}

DEVI void lru_conv_phase(const bf16_t* big, bf16_t* xc, const float* cw, const float* cb, const float* sbuf  , float* outp  , float* outs  ) {
    const int gt = bid_() * 512 + tid_(), ng = nblk_() * 512;
    for (int it = gt; it < 1024 * 128 + SR * 128; it += ng) {
        const bool smp = it >= 1024 * 128;
        const int li = smp ? it - 1024 * 128 : it;
        const int seg = li >> 7, c = (li & 127) * 8;
        float w0[8], w1[8], w2[8], w3[8], bb[8];
#pragma unroll
        for (int k = 0; k < 8; k += 4) {
            const f32x4 a0 = *(const f32x4*)(cw + c + k), a1 = *(const f32x4*)(cw + 1024 + c + k), a2 = *(const f32x4*)(cw + 2048 + c + k), a3 = *(const f32x4*)(cw + 3072 + c + k), a4 = *(const f32x4*)(cb + c + k);
#pragma unroll
            for (int j = 0; j < 4; ++j) { w0[k + j] = a0[j]; w1[k + j] = a1[j]; w2[k + j] = a2[j]; w3[k + j] = a3[j]; bb[k + j] = a4[j]; }
        }
        if (!smp) {
            const int row0 = seg * 16, t0 = row0 & 2047;
            u32x4 raw[19];
#pragma unroll
            for (int r = 0; r < 19; ++r) {
                const int rr = (t0 == 0 && r < 3) ? row0 : row0 - 3 + r;
                raw[r] = *(const u32x4*)(big + (size_t)rr * 2048 + c);
            }
            float x1[8], x2[8], x3[8];
            if (t0 > 0) { unpack8(raw[0], x3); unpack8(raw[1], x2); unpack8(raw[2], x1); }
            else {
#pragma unroll
                for (int k = 0; k < 8; ++k) { x1[k] = 0.f; x2[k] = 0.f; x3[k] = 0.f; }
            }
#pragma unroll
            for (int r = 0; r < 16; ++r) {
                const size_t row = (size_t)row0 + r;
                float x0[8], o[8];
                unpack8(raw[3 + r], x0);
#pragma unroll
                for (int k = 0; k < 8; ++k) o[k] = bb[k] + x3[k] * w0[k] + x2[k] * w1[k] + x1[k] * w2[k] + x0[k] * w3[k];
                u32x4 w; w.x = cvt_pk_bf16(o[0], o[1]); w.y = cvt_pk_bf16(o[2], o[3]); w.z = cvt_pk_bf16(o[4], o[5]); w.w = cvt_pk_bf16(o[6], o[7]);
                *(u32x4*)(xc + row * 1024 + c) = w;
                if (t0 + r >= 2045) { float* q = outp + ((size_t)(row >> 11) * 3 + (t0 + r - 2045)) * 1024 + c; *(f32x4*)q = (f32x4){x0[0], x0[1], x0[2], x0[3]}; *(f32x4*)(q + 4) = (f32x4){x0[4], x0[5], x0[6], x0[7]}; }
#pragma unroll
                for (int k = 0; k < 8; ++k) { x3[k] = x2[k]; x2[k] = x1[k]; x1[k] = x0[k]; }
            }
        } else {
            const int sb = seg; const size_t row = (size_t)PR + sb;
            float x0[8], x1[8], x2[8], x3[8], o[8];
            unpack8(*(const u32x4*)(big + row * 2048 + c), x0);
            const float* b0 = sbuf + (size_t)sb * 3 * 1024 + c;
            float* q = outs + (size_t)sb * 3 * 1024 + c;
#pragma unroll
            for (int k = 0; k < 8; k += 4) {
                const f32x4 p3 = *(const f32x4*)(b0 + k), p2 = *(const f32x4*)(b0 + 1024 + k), p1 = *(const f32x4*)(b0 + 2048 + k);
#pragma unroll
                for (int j = 0; j < 4; ++j) { x3[k + j] = p3[j]; x2[k + j] = p2[j]; x1[k + j] = p1[j]; }
                *(f32x4*)(q + k) = p2; *(f32x4*)(q + 1024 + k) = p1; *(f32x4*)(q + 2048 + k) = (f32x4){x0[k], x0[k + 1], x0[k + 2], x0[k + 3]};
            }
#pragma unroll
            for (int k = 0; k < 8; ++k) o[k] = bb[k] + x3[k] * w0[k] + x2[k] * w1[k] + x1[k] * w2[k] + x0[k] * w3[k];
            u32x4 w; w.x = cvt_pk_bf16(o[0], o[1]); w.y = cvt_pk_bf16(o[2], o[3]); w.z = cvt_pk_bf16(o[4], o[5]); w.w = cvt_pk_bf16(o[6], o[7]);
            *(u32x4*)(xc + row * 1024 + c) = w;
        }
    }
}

DEVI void scan1_phase(const float* aa, const float* uu, float* chs  ) {
    const int gt = bid_() * 512 + tid_(), ng = nblk_() * 512;
    for (int it = gt; it < 8 * 64 * 256; it += ng) {
        const int c = (it & 255) * 4, ck = (it >> 8) & 63, b = it >> 14;
        const size_t base = ((size_t)b * 2048 + ck * 32) * 1024 + c;
        f32x4 ap = (f32x4){1.f, 1.f, 1.f, 1.f}, h = (f32x4){0.f, 0.f, 0.f, 0.f};
#pragma unroll 8
        for (int t = 0; t < 32; ++t) { const f32x4 a = *(const f32x4*)(aa + base + (size_t)t * 1024), u = *(const f32x4*)(uu + base + (size_t)t * 1024); h = a * h + u; ap *= a; }
        float* o = chs + ((size_t)(b * 64 + ck) * 1024 + c) * 2;
        *(f32x4*)o = (f32x4){ap[0], h[0], ap[1], h[1]}; *(f32x4*)(o + 4) = (f32x4){ap[2], h[2], ap[3], h[3]};
    }
}
DEVI void scan2_phase(const float* aa, const float* uu, const float* chs, const bf16_t* big, bf16_t* yl, float* hout  ) {
    const int gt = bid_() * 512 + tid_(), ng = nblk_() * 512;
    for (int it = gt; it < 8 * 64 * 256; it += ng) {
        const int c = (it & 255) * 4, ck = (it >> 8) & 63, b = it >> 14;
        f32x4 h = (f32x4){0.f, 0.f, 0.f, 0.f};
        for (int k = 0; k < ck; ++k) {
            const float* ci = chs + ((size_t)(b * 64 + k) * 1024 + c) * 2;
            const f32x4 p0 = *(const f32x4*)ci, p1 = *(const f32x4*)(ci + 4);
            h[0] = p0[0] * h[0] + p0[1]; h[1] = p0[2] * h[1] + p0[3]; h[2] = p1[0] * h[2] + p1[1]; h[3] = p1[2] * h[3] + p1[3];
        }
        const size_t row0 = (size_t)b * 2048 + ck * 32;
#pragma unroll 8
        for (int t = 0; t < 32; ++t) {
            const size_t row = row0 + t;
            h = *(const f32x4*)(aa + row * 1024 + c) * h + *(const f32x4*)(uu + row * 1024 + c);
            const u32x2 gp = *(const u32x2*)(big + row * 2048 + 1024 + c);
            f32x4 y; y[0] = gelu_tanh(bflo(gp.x)) * h[0]; y[1] = gelu_tanh(bfhi(gp.x)) * h[1]; y[2] = gelu_tanh(bflo(gp.y)) * h[2]; y[3] = gelu_tanh(bfhi(gp.y)) * h[3];
            *(u32x2*)(yl + row * 1024 + c) = pack4(y);
        }
        if (ck == 63) *(f32x4*)(hout + b * 1024 + c) = h;
    }
}

DEVI void retention_prompt_phase(LAS unsigned char* lds, const bf16_t* big, const bf16_t* ktg, const bf16_t* vtg, bf16_t* og, float* sout  , const float* dec,
                                 const bool fuse, const float* sin_, float* sout_s) {
    constexpr int KS_STR = 528, VT_STR = 272, ST_STR = 528, AT_STR = 272;
    constexpr int KS_OFF = 0, VT_OFF = 128 * KS_STR, ST_OFF = VT_OFF + 64 * VT_STR, AT_OFF = ST_OFF + 64 * ST_STR;
    const int tid = tid_(), w = tid >> 6, lane = tid & 63, fr = lane & 15, fq = lane >> 4;
    LAS unsigned char* att = lds + AT_OFF + w * (16 * AT_STR);
    for (int it = bid_(); it < 256; it += nblk_()) {
        const int b = it >> 5, h = (it >> 3) & 3, es = it & 7;
        const float gam = 1.f - 1.f / (float)(32 << h), gam127 = dec[h * 128 + 127];
        f32x4 sacc[2][4];
#pragma unroll
        for (int a = 0; a < 2; ++a)
#pragma unroll
            for (int e = 0; e < 4; ++e) sacc[a][e] = (f32x4){0.f, 0.f, 0.f, 0.f};
        __syncthreads();
        { const unsigned z = zv_(); for (int i = tid; i < 64 * ST_STR / 16; i += 512) *(LAS u32x4*)(lds + ST_OFF + i * 16) = (u32x4){z, z, z, z}; }
        f32x4 o4s = (f32x4){0.f, 0.f, 0.f, 0.f};
        u32x4 pk[8], pv[2];
        {   const bf16_t* src = big + ((size_t)b * 2048 + (tid >> 5)) * 6144 + 1024 + h * 256 + (tid & 31) * 8;
#pragma unroll
            for (int i = 0; i < 8; ++i) pk[i] = *(const u32x4*)(src + (size_t)i * 16 * 6144);
            const bf16_t* vsrc = vtg + ((size_t)(b * 4 + h) * 512 + es * 64 + (tid >> 4)) * 2048 + (tid & 15) * 8;
#pragma unroll
            for (int i = 0; i < 2; ++i) pv[i] = *(const u32x4*)(vsrc + (size_t)i * 32 * 2048);
        }
        for (int n = 0; n < 16; ++n) {
            const size_t row0 = (size_t)b * 2048 + n * 128;
            __syncthreads();
            f32x4 sv[8]; size_t s_base = 0; int s_sb = 0, s_h = 0, s_eq = 0;
            if (fuse) {
                const int sit = it * 8 + (n >> 1);
                s_sb = sit >> 4; s_h = (sit >> 2) & 3; s_eq = sit & 3;
                s_base = ((size_t)(s_sb * 4 + s_h) * 256) * 512 + s_eq * 128 + (tid & 31) * 4 + (size_t)(8 * (tid >> 5) + 128 * (n & 1)) * 512;
#pragma unroll
                for (int i = 0; i < 8; ++i) sv[i] = __builtin_nontemporal_load((const f32x4*)(sin_ + s_base + (size_t)i * 512));
            }
            {
                LAS unsigned char* dst = lds + KS_OFF + (tid >> 5) * KS_STR + (tid & 31) * 16;
#pragma unroll
                for (int i = 0; i < 8; ++i) *(LAS u32x4*)(dst + i * 16 * KS_STR) = pk[i];
                LAS unsigned char* vdst = lds + VT_OFF + (tid >> 4) * VT_STR + (tid & 15) * 16;
#pragma unroll
                for (int i = 0; i < 2; ++i) *(LAS u32x4*)(vdst + i * 32 * VT_STR) = pv[i];
            }
            bf16x8 qf[8];
#pragma unroll
            for (int ks = 0; ks < 8; ++ks) qf[ks] = *(const bf16x8*)(big + (row0 + 16 * w + fr) * 6144 + h * 256 + ks * 32 + fq * 8);
            __syncthreads();
            {   const int nn = n + 1 < 16 ? n + 1 : n;
                const bf16_t* src = big + ((size_t)b * 2048 + nn * 128 + (tid >> 5)) * 6144 + 1024 + h * 256 + (tid & 31) * 8;
#pragma unroll
                for (int i = 0; i < 8; ++i) pk[i] = *(const u32x4*)(src + (size_t)i * 16 * 6144);
                const bf16_t* vsrc = vtg + ((size_t)(b * 4 + h) * 512 + es * 64 + (tid >> 4)) * 2048 + nn * 128 + (tid & 15) * 8;
#pragma unroll
                for (int i = 0; i < 2; ++i) pv[i] = *(const u32x4*)(vsrc + (size_t)i * 32 * 2048);
            }
            for (int jt = 0; jt <= w; ++jt) {
                f32x4 acc = (f32x4){0.f, 0.f, 0.f, 0.f};
#pragma unroll
                for (int ks = 0; ks < 8; ++ks) {
                    const bf16x8 kf = *(const LAS bf16x8*)(lds + KS_OFF + (jt * 16 + fr) * KS_STR + ks * 64 + fq * 16);
                    acc = mfma16(kf, qf[ks], acc);
                }
                if (jt == w) {
#pragma unroll
                    for (int r = 0; r < 4; ++r) if (fq * 4 + r > fr) acc[r] = 0.f;
                }
                *(LAS u32x2*)(att + fr * AT_STR + (jt * 16 + fq * 4) * 2) = pack4(acc);
            }
            if ((w & 1) == 0) { const unsigned z = zv_(); *(LAS u32x2*)(att + fr * AT_STR + ((w + 1) * 16 + fq * 4) * 2) = (u32x2){z, z}; }
            __builtin_amdgcn_fence(__ATOMIC_SEQ_CST, "wavefront"); asm volatile("s_waitcnt lgkmcnt(0)" ::: "memory"); __builtin_amdgcn_wave_barrier();
#pragma unroll
            for (int et = 0; et < 4; ++et) {
                f32x4 ao = (f32x4){0.f, 0.f, 0.f, 0.f}, ac = (f32x4){0.f, 0.f, 0.f, 0.f};
                for (int js = 0; js <= (w >> 1); ++js) {
                    const bf16x8 af = *(const LAS bf16x8*)(att + fr * AT_STR + js * 64 + fq * 16);
                    const bf16x8 vf = *(const LAS bf16x8*)(lds + VT_OFF + (et * 16 + fr) * VT_STR + js * 64 + fq * 16);
                    ao = mfma16(vf, af, ao);
                }
#pragma unroll
                for (int ks = 0; ks < 8; ++ks) {
                    const bf16x8 sf = *(const LAS bf16x8*)(lds + ST_OFF + (et * 16 + fr) * ST_STR + ks * 64 + fq * 16);
                    ac = mfma16(sf, qf[ks], ac);
                }
                const f32x4 o = ao + ac * gam;
                *(u32x2*)(og + (row0 + 16 * w + fr) * 2048 + h * 512 + es * 64 + et * 16 + fq * 4) = pack4(o);
            }
#pragma unroll
            for (int a = 0; a < 2; ++a)
#pragma unroll
                for (int e = 0; e < 4; ++e) sacc[a][e] *= gam;
#pragma unroll
            for (int js = 0; js < 4; ++js) {
                bf16x8 kf[2];
#pragma unroll
                for (int a = 0; a < 2; ++a) kf[a] = *(const bf16x8*)(ktg + ((size_t)(b * 4 + h) * 256 + 32 * w + a * 16 + fr) * 2048 + n * 128 + js * 32 + fq * 8);
#pragma unroll
                for (int e = 0; e < 4; ++e) {
                    const bf16x8 vf = *(const LAS bf16x8*)(lds + VT_OFF + (e * 16 + fr) * VT_STR + js * 64 + fq * 16);
#pragma unroll
                    for (int a = 0; a < 2; ++a) sacc[a][e] = mfma16(kf[a], vf, sacc[a][e]);
                }
            }
#pragma unroll
            for (int a = 0; a < 2; ++a)
#pragma unroll
                for (int e = 0; e < 4; ++e) sacc[a][e] *= gam127;
            if (fuse) {
                const size_t srow = (size_t)PR + s_sb;
                const bf16_t* qp = big + srow * 6144 + s_h * 256 + 8 * (tid >> 5) + 128 * (n & 1);
                float qd8[8], kd8[8];
                unpack8(*(const u32x4*)qp, qd8); unpack8(*(const u32x4*)(qp + 1024), kd8);
                const u32x2 vp = *(const u32x2*)(big + srow * 6144 + 2048 + s_h * 512 + s_eq * 128 + (tid & 31) * 4);
                const f32x4 v4 = (f32x4){bflo(vp.x), bfhi(vp.x), bflo(vp.y), bfhi(vp.y)};
                const float sgam = 1.f - 1.f / (float)(32 << s_h);
                if ((n & 1) == 0) o4s = (f32x4){0.f, 0.f, 0.f, 0.f};
#pragma unroll
                for (int i = 0; i < 8; ++i) {
                    const f32x4 sn = sv[i] * sgam + v4 * kd8[i];
                    __builtin_nontemporal_store(sn, (f32x4*)(sout_s + s_base + (size_t)i * 512));
                    o4s += sn * qd8[i];
                }
                if (n & 1) *(LAS f32x4*)(lds + 153616 + tid * 16) = o4s;
            }
            __syncthreads();
            if (fuse && (n & 1) && tid < 32) {
                f32x4 sm = *(const LAS f32x4*)(lds + 153616 + tid * 16);
#pragma unroll
                for (int k = 1; k < 16; ++k) sm += *(const LAS f32x4*)(lds + 153616 + (k * 32 + tid) * 16);
                *(u32x2*)(og + ((size_t)PR + s_sb) * 2048 + s_h * 512 + s_eq * 128 + tid * 4) = pack4(sm);
            }
#pragma unroll
            for (int a = 0; a < 2; ++a)
#pragma unroll
                for (int e = 0; e < 4; ++e)
                    *(LAS u32x2*)(lds + ST_OFF + (e * 16 + fr) * ST_STR + (32 * w + a * 16 + fq * 4) * 2) = pack4(sacc[a][e]);
        }
#pragma unroll
        for (int a = 0; a < 2; ++a)
#pragma unroll
            for (int e = 0; e < 4; ++e)
#pragma unroll
                for (int r = 0; r < 4; ++r)
                    __builtin_nontemporal_store(sacc[a][e][r], sout + ((size_t)(b * 4 + h) * 256 + 32 * w + a * 16 + fq * 4 + r) * 512 + es * 64 + e * 16 + fr);
    }
}

DEVI void retention_sample_phase(LAS unsigned char* lds, const bf16_t* big, const float* sin_, float* sout, bf16_t* og) {
    const int tid = tid_(), ec = tid & 31, dr = tid >> 5;
    LAS float* red = (LAS float*)lds;
    for (int it = bid_(); it < 128 * 4 * 4; it += nblk_()) {
        const int sb = it >> 4, h = (it >> 2) & 3, eq = it & 3;
        const float gam = 1.f - 1.f / (float)(32 << h);
        const size_t row = (size_t)PR + sb;
        const bf16_t* qp = big + row * 6144 + h * 256;
        const bf16_t* kp = qp + 1024;
        const u32x2 vp = *(const u32x2*)(big + row * 6144 + 2048 + h * 512 + eq * 128 + ec * 4);
        const f32x4 v4 = (f32x4){bflo(vp.x), bfhi(vp.x), bflo(vp.y), bfhi(vp.y)};
        const size_t sbase = ((size_t)(sb * 4 + h) * 256) * 512 + eq * 128 + ec * 4;
        f32x4 o4 = (f32x4){0.f, 0.f, 0.f, 0.f};
#pragma unroll
        for (int i = 0; i < 16; ++i) {
            const int d = dr + 16 * i;
            const f32x4 s = *(const f32x4*)(sin_ + sbase + (size_t)d * 512);
            const float kd = bf2f(kp[d]), qd = bf2f(qp[d]);
            const f32x4 sn = s * gam + v4 * kd;
            *(f32x4*)(sout + sbase + (size_t)d * 512) = sn;
            o4 += sn * qd;
        }
        __syncthreads();
        *(LAS f32x4*)(red + (dr * 32 + ec) * 4) = o4;
        __syncthreads();
        if (tid < 32) {
            f32x4 s = (f32x4){0.f, 0.f, 0.f, 0.f};
#pragma unroll
            for (int k = 0; k < 16; ++k) s += *(const LAS f32x4*)(red + (k * 32 + tid) * 4);
            *(u32x2*)(og + row * 2048 + h * 512 + eq * 128 + tid * 4) = pack4(s);
        }
    }
}

DEVI void xattn_prompt_phase(LAS unsigned char* lds, const bf16_t* qx, const bf16_t* mk  , const bf16_t* mvt  , bf16_t* ao) {
    constexpr int STR = 528;
    const int tid = tid_(), w = tid >> 6, lane = tid & 63, fr = lane & 15, fq = lane >> 4;
    for (int it = bid_(); it < 512; it += nblk_()) {
        const int b = it >> 6, h = (it >> 4) & 3, qt = it & 15;
        const size_t row = (size_t)b * 2048 + qt * 128 + 16 * w + fr;
        __syncthreads();
        {   const int m0 = tid >> 5, dq = tid & 31;
            const bf16_t* src = mk + ((size_t)b * 256 + m0) * 1024 + h * 256 + dq * 8;
            LAS unsigned char* dst = lds + m0 * STR + dq * 16;
#pragma unroll
            for (int i = 0; i < 16; ++i) *(LAS u32x4*)(dst + i * 16 * STR) = *(const u32x4*)(src + (size_t)i * 16 * 1024);
        }
        bf16x8 qf[8];
#pragma unroll
        for (int ks = 0; ks < 8; ++ks) qf[ks] = *(const bf16x8*)(qx + row * 1024 + h * 256 + ks * 32 + fq * 8);
        __syncthreads();
        bf16x8 pf[8];
        float hmx[2], hsum[2];
        const float sc = 0.0625f * 1.4426950408889634f;
#pragma unroll
        for (int hf = 0; hf < 2; ++hf) {
            f32x4 s[8];
#pragma unroll
            for (int mt = 0; mt < 8; ++mt) {
                f32x4 acc = (f32x4){0.f, 0.f, 0.f, 0.f};
#pragma unroll
                for (int ks = 0; ks < 8; ++ks) {
                    const bf16x8 kf = *(const LAS bf16x8*)(lds + ((hf * 8 + mt) * 16 + fr) * STR + ks * 64 + fq * 16);
                    acc = mfma16(kf, qf[ks], acc);
                }
                s[mt] = acc;
                __builtin_amdgcn_sched_barrier(0);
            }
            float mx = -3.0e38f;
#pragma unroll
            for (int mt = 0; mt < 8; ++mt)
#pragma unroll
                for (int r = 0; r < 4; ++r) mx = fmaxf(mx, s[mt][r]);
            mx = fmaxf(mx, shx(mx, 16, lane)); mx = fmaxf(mx, shx(mx, 32, lane));
            float sum = 0.f;
#pragma unroll
            for (int mt = 0; mt < 8; ++mt)
#pragma unroll
                for (int r = 0; r < 4; ++r) { const float e = ex2_((s[mt][r] - mx) * sc); s[mt][r] = e; sum += e; }
            sum += shx(sum, 16, lane); sum += shx(sum, 32, lane);
            hmx[hf] = mx; hsum[hf] = sum;
#pragma unroll
            for (int ms = 0; ms < 4; ++ms) {
                u32x4 u; u.x = cvt_pk_bf16(s[2 * ms][0], s[2 * ms][1]); u.y = cvt_pk_bf16(s[2 * ms][2], s[2 * ms][3]);
                u.z = cvt_pk_bf16(s[2 * ms + 1][0], s[2 * ms + 1][1]); u.w = cvt_pk_bf16(s[2 * ms + 1][2], s[2 * ms + 1][3]);
                pf[hf * 4 + ms] = __builtin_bit_cast(bf16x8, u);
            }
        }
        const float mxa = fmaxf(hmx[0], hmx[1]);
        float al0 = ex2_((hmx[0] - mxa) * sc), al1 = ex2_((hmx[1] - mxa) * sc);
        const float inv = rcp_(hsum[0] * al0 + hsum[1] * al1);
        al0 *= inv; al1 *= inv;
        __syncthreads();
        {   const int d0 = tid >> 5, mq = tid & 31;
            const bf16_t* src = mvt + ((size_t)(b * 4 + h) * 256 + d0) * 256 + mq * 8;
            LAS unsigned char* dst = lds + d0 * STR + mq * 16;
#pragma unroll
            for (int i = 0; i < 16; ++i) *(LAS u32x4*)(dst + i * 16 * STR) = *(const u32x4*)(src + (size_t)i * 16 * 256);
        }
        __syncthreads();
#pragma unroll 2
        for (int dt = 0; dt < 16; ++dt) {
            f32x4 acc0 = (f32x4){0.f, 0.f, 0.f, 0.f}, acc1 = acc0;
#pragma unroll
            for (int ms = 0; ms < 8; ++ms) {
                const u32x2 lo = *(const LAS u32x2*)(lds + (dt * 16 + fr) * STR + (ms * 32 + fq * 4) * 2);
                const u32x2 hi = *(const LAS u32x2*)(lds + (dt * 16 + fr) * STR + (ms * 32 + 16 + fq * 4) * 2);
                u32x4 u; u.x = lo.x; u.y = lo.y; u.z = hi.x; u.w = hi.y;
                if (ms < 4) acc0 = mfma16(__builtin_bit_cast(bf16x8, u), pf[ms], acc0);
                else acc1 = mfma16(__builtin_bit_cast(bf16x8, u), pf[ms], acc1);
            }
            *(u32x2*)(ao + row * 1024 + h * 256 + dt * 16 + fq * 4) = pack4(acc0 * al0 + acc1 * al1);
        }
    }
}

DEVI void xattn_sample_phase(LAS unsigned char* lds, const bf16_t* qx, const float* ck, const float* cv, bf16_t* ao) {
    const int tid = tid_(), w = tid >> 6, lane = tid & 63;
    LAS float* sc = (LAS float*)lds;
    LAS float* red = (LAS float*)(lds + 2048);
    for (int it = bid_(); it < 512; it += nblk_()) {
        const int sb = it >> 2, h = it & 3;
        const size_t row = (size_t)PR + sb;
        const u32x2 qp = *(const u32x2*)(qx + row * 1024 + h * 256 + lane * 4);
        const f32x4 q4 = (f32x4){bflo(qp.x), bfhi(qp.x), bflo(qp.y), bfhi(qp.y)};
        const size_t base = ((size_t)sb * 256 * 4 + h) * 256 + lane * 4;
        __syncthreads();
#pragma unroll 16
        for (int i = 0; i < 32; ++i) {
            const int m = w + 8 * i;
            const f32x4 k4 = __builtin_nontemporal_load((const f32x4*)(ck + base + (size_t)m * 1024));
            float d = k4[0] * q4[0] + k4[1] * q4[1] + k4[2] * q4[2] + k4[3] * q4[3];
            d = wave_sum(d, lane);
            if (lane == 0) sc[m] = d * 0.0625f;
        }
        __syncthreads();
        float mx = -3.0e38f;
        for (int m = lane; m < 256; m += 64) mx = fmaxf(mx, sc[m]);
#pragma unroll
        for (int o = 32; o; o >>= 1) mx = fmaxf(mx, shx(mx, o, lane));
        float sum = 0.f;
        for (int m = lane; m < 256; m += 64) sum += exp_(sc[m] - mx);
        sum = wave_sum(sum, lane);
        const float inv = rcp_(sum);
        f32x4 o4 = (f32x4){0.f, 0.f, 0.f, 0.f};
#pragma unroll 16
        for (int i = 0; i < 32; ++i) {
            const int m = w + 8 * i;
            const float pm = exp_(sc[m] - mx) * inv;
            const f32x4 v4 = __builtin_nontemporal_load((const f32x4*)(cv + base + (size_t)m * 1024));
            o4 += v4 * pm;
        }
        *(LAS f32x4*)(red + (w * 64 + lane) * 4) = o4;
        __syncthreads();
        if (tid < 64) {
            f32x4 s = (f32x4){0.f, 0.f, 0.f, 0.f};
#pragma unroll
            for (int k = 0; k < 8; ++k) s += *(const LAS f32x4*)(red + (k * 64 + tid) * 4);
            *(u32x2*)(ao + row * 1024 + h * 256 + tid * 4) = pack4(s);
        }
    }
}

#define XB_TMO      128
#define XB_XCNT(j)  (256  + 64 * (j))
#define XB_XSUB(j)  (1280 + 64 * (j))
#define XB_XGEN(j)  (2304 + 64 * (j))
#define XB_TOP      3328
#define XB_TOPGEN   3392
#define XCD_BAR_WORDS 3456
#define XB_SPIN_CAP (1u << 18)
DEVI unsigned xb_ld(unsigned* p)              { return __hip_atomic_load(p, __ATOMIC_RELAXED, __HIP_MEMORY_SCOPE_AGENT); }
DEVI unsigned xb_add(unsigned* p, unsigned v) { return __hip_atomic_fetch_add(p, v, __ATOMIC_RELAXED, __HIP_MEMORY_SCOPE_AGENT); }
DEVI unsigned xb_xcc_id() { return (unsigned)__builtin_amdgcn_s_getreg((3 << 11) | 20) & 0xFu; }
#define XB_SPIN(cond, bar) do { unsigned _sp = 0; while (cond) { __builtin_amdgcn_s_sleep(1); \
    if ((++_sp & 255u) == 0u) { if (xb_ld(&(bar)[XB_TMO])) break; if (_sp > XB_SPIN_CAP) { atomicAdd(&(bar)[XB_TMO], 1u); break; } } } } while (0)
struct XcdBarrier { unsigned* bar; unsigned x; volatile LAS unsigned* st; };
DEVI XcdBarrier xcd_barrier_post(unsigned* bar, volatile LAS unsigned* st) {
    XcdBarrier b; b.bar = bar; b.x = xb_xcc_id(); b.st = st;
    if (threadIdx.x == 0) (void)xb_add(&bar[XB_XCNT(b.x)], 1u);
    return b;
}
DEVI void xcd_barrier_complete(unsigned* bar, unsigned x, unsigned& nloc, unsigned& nx) {
    const unsigned G = gridDim.x * gridDim.y * gridDim.z;
    unsigned sum, cnt, mine, sp = 0u;
    for (;;) {
        sum = 0u; cnt = 0u; mine = 0u;
#pragma unroll
        for (unsigned j = 0; j < 16; ++j) { const unsigned c = xb_ld(&bar[XB_XCNT(j)]); sum += c; cnt += (c > 0u) ? 1u : 0u; mine = (j == x) ? c : mine; }
        if (sum == G) break;
        __builtin_amdgcn_s_sleep(1);
        if ((++sp & 255u) == 0u) { if (xb_ld(&bar[XB_TMO])) break; if (sp > XB_SPIN_CAP) { atomicAdd(&bar[XB_TMO], 1u); break; } }
    }
    nloc = mine > 0u ? mine : 1u; nx = cnt > 0u ? cnt : 1u;
}
DEVI void xcd_barrier(const XcdBarrier& b) {
    asm volatile("s_waitcnt vmcnt(0)" ::: "memory");
    __syncthreads();
    if (threadIdx.x == 0) {
        unsigned* bar = b.bar;
        __builtin_amdgcn_s_waitcnt(0);
        unsigned nloc = b.st[0], nx = b.st[1];
        if (nloc == 0u) { xcd_barrier_complete(bar, b.x, nloc, nx); b.st[0] = nloc; b.st[1] = nx; }
        const unsigned old = xb_add(&bar[XB_XSUB(b.x)], 1u);
        const unsigned gen = old / nloc;
        if (old + 1u == (gen + 1u) * nloc) {
            __builtin_amdgcn_fence(__ATOMIC_RELEASE, "agent");
            asm volatile("s_waitcnt vmcnt(0)" ::: "memory");
            const unsigned og = xb_add(&bar[XB_TOP], 1u);
            const unsigned tg = og / nx;
            if (og + 1u == (tg + 1u) * nx) xb_add(&bar[XB_TOPGEN], 1u);
            else XB_SPIN(xb_ld(&bar[XB_TOPGEN]) == tg, bar);
            __builtin_amdgcn_fence(__ATOMIC_ACQUIRE, "agent");
            xb_add(&bar[XB_XGEN(b.x)], 1u);
            asm volatile("s_waitcnt vmcnt(0)" ::: "memory");
        } else {
            XB_SPIN(xb_ld(&bar[XB_XGEN(b.x)]) == gen, bar);
            __builtin_amdgcn_fence(__ATOMIC_ACQUIRE, "agent");
            asm volatile("s_waitcnt vmcnt(0)" ::: "memory");
        }
    }
    __syncthreads();
}

enum { K_PREP = 0, K_RETIN, K_RET, K_GATE, K_RESID, K_NORM, K_BF16, K_XATTN, K_FFNGATE, K_LRUCONV, K_LRU, K_SCAN1, K_SCAN2, K_NORMF };
constexpr int NPH = 24;
struct Step { int kind, L, lda, N, K, ldo, ssi; const bf16_t* A; const bf16_t* Bt; bf16_t* ob; const float* rinP; const float* rinS; };

template <int ONLY>
__global__ void __launch_bounds__(512) mega(Params p, int lo, int hi) {
    extern __shared__ __attribute__((aligned(16))) unsigned char shm[];
    LAS unsigned char* lds = (LAS unsigned char*)shm;
    cg::grid_group grid = cg::this_grid();
#define WS_ ((unsigned char*)p.in[33 + zero_()])
#define OUT_ ((float*)p.in[32 + zero_()])
#define x_prompt (p.in[0 + zero_()])
#define x_sample (p.in[1 + zero_()])
#define state_ret (p.in[2 + zero_()])
#define state_lru_h (p.in[3 + zero_()])
#define state_lru_conv (p.in[4 + zero_()])
#define state_ffn_conv (p.in[5 + zero_()])
#define cache_k (p.in[6 + zero_()])
#define cache_v (p.in[7 + zero_()])
#define mem_prompt (p.in[8 + zero_()])
#define norm_mix (p.in[9 + zero_()])
#define norm_xa (p.in[10 + zero_()])
#define norm_mem (p.in[11 + zero_()])
#define norm_ffn (p.in[12 + zero_()])
#define norm_final (p.in[13 + zero_()])
#define lru_conv_w (p.in[17 + zero_()])
#define lru_conv_b (p.in[18 + zero_()])
#define lru_ba (p.in[20 + zero_()])
#define lru_bx (p.in[22 + zero_()])
#define lru_lambda (p.in[23 + zero_()])
#define ffn_conv_w (p.in[29 + zero_()])
#define ffn_conv_b (p.in[30 + zero_()])
#define HN ((bf16_t*)(WS_ + W_HN))
#define MN ((bf16_t*)(WS_ + W_MN))
#define MK ((bf16_t*)(WS_ + W_MK))
#define MVT ((bf16_t*)(WS_ + W_MVT))
#define BIG ((bf16_t*)(WS_ + W_BIG))
#define X ((float*)(WS_ + W_X))
#define XS ((float*)(WS_ + W_X) + (size_t)PR * 1024)
#define QX ((bf16_t*)(WS_ + W_QX))
#define AO ((bf16_t*)(WS_ + W_AO))
#define Y ((bf16_t*)(WS_ + W_Y))
#define KT ((bf16_t*)(WS_ + W_KT))
#define VT ((bf16_t*)(WS_ + W_VT))
#define O ((bf16_t*)(WS_ + W_O))
#define OG ((bf16_t*)(WS_ + W_OG))
#define XC ((bf16_t*)(WS_ + W_XC))
#define AA ((float*)(WS_ + W_AA))
#define UU ((float*)(WS_ + W_UU))
#define CH ((float*)(WS_ + W_CH))
#define YL ((bf16_t*)(WS_ + W_YL))
#define ROTC ((float*)(WS_ + W_ROTC))
#define ROTS ((float*)(WS_ + W_ROTS))
#define LSG ((float*)(WS_ + W_LSG))
#define SS ((float*)(WS_ + W_SS))
#define DEC ((float*)(WS_ + W_DEC))
    volatile LAS unsigned* xst = (volatile LAS unsigned*)(lds + 153600);
    if (threadIdx.x < 4) xst[threadIdx.x] = 0u;
    __syncthreads();
    const XcdBarrier xbar = xcd_barrier_post((unsigned*)(WS_ + W_BAR), xst);
    const int hi2 = hi < NPH ? hi : NPH;
    for (int ph = lo; ph < hi2; ++ph) {
        Step st; st.kind = K_NORMF; st.L = ph >= 11 ? 1 : 0; st.lda = 1024; st.N = 1024; st.K = 1024; st.ldo = 1024; st.ssi = 0; st.A = HN; st.Bt = nullptr; st.ob = nullptr; st.rinP = X; st.rinS = XS;
        switch (ph) {
            case 0: st.kind = K_PREP; break;
            case 1: st.kind = K_RETIN; break;
            case 2: st.kind = K_RET; break;
            case 3: st.kind = K_GATE; break;
            case 4: st.kind = K_RESID; st.ssi = 1; st.A = OG; st.lda = 2048; st.K = 2048; st.Bt = (const bf16_t*)(WS_ + W_ROUT); st.rinP = x_prompt; st.rinS = x_sample; break;
            case 5: st.kind = K_BF16; st.ssi = 1; st.Bt = (const bf16_t*)(WS_ + W_XQ); st.ob = QX; break;
            case 6: st.kind = K_XATTN; break;
            case 7: st.kind = K_RESID; st.ssi = 2; st.A = AO; st.Bt = (const bf16_t*)(WS_ + W_XO); break;
            case 8: st.kind = K_BF16; st.ssi = 2; st.Bt = (const bf16_t*)(WS_ + W_UP); st.N = 6144; st.ob = BIG; st.ldo = 6144; break;
            case 9: st.kind = K_FFNGATE; break;
            case 10: st.kind = K_RESID; st.ssi = 3; st.A = Y; st.lda = 3072; st.K = 3072; st.Bt = (const bf16_t*)(WS_ + W_DN); break;
            case 11: st.kind = K_BF16; st.ssi = 3; st.Bt = (const bf16_t*)(WS_ + W_LIN); st.N = 2048; st.ob = BIG; st.ldo = 2048; break;
            case 12: st.kind = K_LRUCONV; break;
            case 13: st.kind = K_LRU; break;
            case 14: st.kind = K_SCAN1; break;
            case 15: st.kind = K_SCAN2; break;
            case 16: st.kind = K_RESID; st.ssi = 4; st.A = YL; st.Bt = (const bf16_t*)(WS_ + W_LOUT); break;
            case 17: st.kind = K_BF16; st.ssi = 4; st.Bt = (const bf16_t*)(WS_ + W_XQ + 2097152); st.ob = QX; break;
            case 18: st.kind = K_XATTN; break;
            case 19: st.kind = K_RESID; st.ssi = 5; st.A = AO; st.Bt = (const bf16_t*)(WS_ + W_XO + 2097152); break;
            case 20: st.kind = K_BF16; st.ssi = 5; st.Bt = (const bf16_t*)(WS_ + W_UP + 12582912); st.N = 6144; st.ob = BIG; st.ldo = 6144; break;
            case 21: st.kind = K_FFNGATE; break;
            case 22: st.kind = K_RESID; st.ssi = 6; st.A = Y; st.lda = 3072; st.K = 3072; st.Bt = (const bf16_t*)(WS_ + W_DN + 6291456); break;
            default: st.kind = K_NORMF; break;
        }
        const int L = st.L;
#ifndef DUP_MASK
#define DUP_MASK 0
#endif
        const int nrep = 1 + (int)(((unsigned)(DUP_MASK) >> st.kind) & 1u);
        for (int rep = 0; rep < nrep; ++rep) {
        if (rep) grid.sync();
        switch (st.kind) {
            case K_PREP: if constexpr (ONLY < 0 || ONLY == K_PREP) {
#if EN(0)
                transpose_phase(lds, p);
                rot_phase(ROTC, ROTS, p.rope_c1);
                lsg_phase(lru_lambda, LSG);
                dec_phase(DEC);
                cast_ss_phase(x_prompt, x_sample, HN, SS);
                for (int i = 0; i < 2; ++i) norm_phase<false>(mem_prompt, nullptr, norm_mem + i * 1024, MN + (size_t)i * 2097152, nullptr, nullptr, 2048);
#endif
            } break;
            case K_RETIN: if constexpr (ONLY < 0 || ONLY == K_RETIN) {
                QRetIn q; q.big = BIG; q.kt = KT; q.vt = VT; q.rc = ROTC; q.rs = ROTS; q.dec = DEC; q.ss = SS;
#if EN(1)
                run_gemm(lds, HN, 1024, (const bf16_t*)(WS_ + W_RIN), 1024, PR, 6144, 1024, 0, 0, q);
#endif
#if EN(13)
                skinny_phase(lds, HN + (size_t)PR * 1024, 1024, (const bf16_t*)(WS_ + W_RIN), 1024, 6144, 1024, 0, q, nblk_() == 256 ? 128 : 0);
#endif
#if EN(14)
                for (int i = 0; i < 2; ++i) {
                    QMemKV m; m.outk = OUT_ + O_MKP + (size_t)i * 2097152; m.outv = OUT_ + O_MVP + (size_t)i * 2097152; m.mk = MK + (size_t)i * 2097152; m.mvt = MVT + (size_t)i * 2097152;
                    run_gemm(lds, MN + (size_t)i * 2097152, 1024, (const bf16_t*)(WS_ + W_XKV + (size_t)i * 4194304), 1024, 2048, 2048, 1024, 0, 128 + 64 * i, m);
                }
#endif
            } break;
            case K_RET: if constexpr (ONLY < 0 || ONLY == K_RET) {
#if EN(2)
                retention_prompt_phase(lds, BIG, KT, VT, O, OUT_ + O_RETP, DEC, nblk_() == 256, state_ret, OUT_ + O_RETS);
#endif
#if EN(3)
                if (nblk_() != 256) retention_sample_phase(lds, BIG, state_ret, OUT_ + O_RETS, O);
#endif
            } break;
            case K_GATE: if constexpr (ONLY < 0 || ONLY == K_GATE) {
#if EN(4)
                gate_phase(O, BIG, OG);
#endif
            } break;
            case K_RESID: if constexpr (ONLY < 0 || ONLY == K_RESID) {
                QResid q; q.rinP = st.rinP; q.rinS = st.rinS; q.xout = X; q.xb = HN; q.ssout = SS + (size_t)st.ssi * TP * 32;
#if EN(5)
                run_gemm(lds, st.A, st.lda, st.Bt, st.K, PR, 1024, st.K, 0, 0, q);
#endif
#if EN(15)
                skinny_phase1(lds, st.A + (size_t)PR * st.lda, st.lda, st.Bt, st.K, 1024, st.K, 0, q);
#endif
            } break;
            case K_BF16: if constexpr (ONLY < 0 || ONLY == K_BF16) {
                if (st.N == 6144) {
                    unsigned char* wsb = WS_; float* ob = OUT_;
                    QFfn q; q.y = (bf16_t*)(wsb + W_Y); q.big = (bf16_t*)(wsb + W_BIG); q.ss = (const float*)(wsb + W_SS) + (size_t)st.ssi * TP * 32; q.cw = ffn_conv_w + (size_t)L * 9216; q.cb = ffn_conv_b + (size_t)L * 3072;
                    q.sbuf = state_ffn_conv + (size_t)L * 786432; q.outp = ob + O_FCP + (size_t)L * 49152; q.outs = ob + O_FCS + (size_t)L * 786432;
                    const bf16_t* hn = (const bf16_t*)(wsb + W_HN);
                    run_gemm(lds, hn, 1024, st.Bt, 1024, PR, 6144, 1024, 2, 0, q);
                    skinny_phase(lds, hn + (size_t)PR * 1024, 1024, st.Bt, 1024, 6144, 1024, 2, q);
                } else {
                QBf16 q; q.out = st.ob; q.ld = st.ldo; q.ss = SS + (size_t)st.ssi * TP * 32;
#if EN(6)
                run_gemm(lds, HN, 1024, st.Bt, 1024, PR, st.N, 1024, 0, 0, q);
#endif
#if EN(16)
                skinny_phase(lds, HN + (size_t)PR * 1024, 1024, st.Bt, 1024, st.N, 1024, 0, q);
#endif
                }
            } break;
            case K_XATTN: if constexpr (ONLY < 0 || ONLY == K_XATTN) {
#if EN(10)
                xattn_prompt_phase(lds, QX, MK + (size_t)L * 2097152, MVT + (size_t)L * 2097152, AO);
#endif
#if EN(11)
                xattn_sample_phase(lds, QX, cache_k + (size_t)L * 33554432, cache_v + (size_t)L * 33554432, AO);
#endif
            } break;
            case K_FFNGATE: if constexpr (ONLY < 0 || ONLY == K_FFNGATE) {
#if EN(12)
                ffn_fix_phase(BIG, Y, ffn_conv_w + (size_t)L * 9216, ffn_conv_b + (size_t)L * 3072);
#endif
            } break;
            case K_LRUCONV: if constexpr (ONLY < 0 || ONLY == K_LRUCONV) {
#if EN(7)
                lru_conv_phase(BIG, XC, lru_conv_w, lru_conv_b, state_lru_conv, OUT_ + O_LCP, OUT_ + O_LCS);
#endif
            } break;
            case K_LRU: if constexpr (ONLY < 0 || ONLY == K_LRU) {
                QLru q; q.ba = lru_ba; q.bx = lru_bx; q.lam = LSG; q.xc = XC; q.aa = AA; q.uu = UU; q.h0 = state_lru_h; q.hout = OUT_ + O_LHS; q.big = BIG; q.yl = YL;
#if EN(8)
                run_gemm(lds, XC, 1024, (const bf16_t*)(WS_ + W_AX), 256, PR, 2048, 256, 1, 0, q);
#endif
#if EN(18)
                skinny_phase(lds, XC + (size_t)PR * 1024, 1024, (const bf16_t*)(WS_ + W_AX), 256, 2048, 256, 1, q);
#endif
            } break;
            case K_SCAN1: if constexpr (ONLY < 0 || ONLY == K_SCAN1) {
#if EN(9)
                scan1_phase(AA, UU, CH);
#endif
            } break;
            case K_SCAN2: if constexpr (ONLY < 0 || ONLY == K_SCAN2) {
#if EN(9)
                scan2_phase(AA, UU, CH, BIG, YL, OUT_ + O_LHP);
#endif
            } break;
            default: if constexpr (ONLY < 0 || ONLY == K_NORMF) {
#if EN(0)
                norm_phase<true>(X, XS, norm_final, nullptr, OUT_ + O_YP, OUT_ + O_YS, TR);
#endif
            } break;
        }
        }
        if (ph + 1 < hi2) { if (lo < 0) grid.sync(); else xcd_barrier(xbar); }
    }
#ifdef EXTRA_SYNCS
    for (int i = 0; i < EXTRA_SYNCS; ++i) grid.sync();
#endif
}

#undef WS_
#undef OUT_
#undef x_prompt
#undef x_sample
#undef state_ret
#undef state_lru_h
#undef state_lru_conv
#undef state_ffn_conv
#undef cache_k
#undef cache_v
#undef mem_prompt
#undef norm_mix
#undef norm_xa
#undef norm_mem
#undef norm_ffn
#undef norm_final
#undef lru_conv_w
#undef lru_conv_b
#undef lru_ba
#undef lru_bx
#undef lru_lambda
#undef ffn_conv_w
#undef ffn_conv_b
#undef HN
#undef MN
#undef MK
#undef MVT
#undef BIG
#undef X
#undef XS
#undef QX
#undef AO
#undef Y
#undef KT
#undef VT
#undef O
#undef OG
#undef XC
#undef AA
#undef UU
#undef CH
#undef YL
#undef ROTC
#undef ROTS
#undef LSG
#undef SS
#undef DEC
__global__ void dump_k(const float* src, float* dst, size_t n) { for (size_t i = (size_t)bid_() * blockDim.x + threadIdx.x; i < n; i += (size_t)nblk_() * blockDim.x) dst[i] = src[i]; }
#ifndef MULTI
#define MULTI 0
#endif
static const int h_kinds[NPH] = {K_PREP, K_RETIN, K_RET, K_GATE, K_RESID, K_BF16, K_XATTN, K_RESID, K_BF16, K_FFNGATE, K_RESID, K_BF16, K_LRUCONV, K_LRU, K_SCAN1, K_SCAN2,
                                 K_RESID, K_BF16, K_XATTN, K_RESID, K_BF16, K_FFNGATE, K_RESID, K_NORMF};
typedef void (*mega_fn)(Params, int, int);
template <int K> static mega_fn get_fn() { return mega<K>; }
static mega_fn fn_of_kind(int k) {
    switch (k) {
        case 0: return get_fn<0>(); case 1: return get_fn<1>(); case 2: return get_fn<2>(); case 3: return get_fn<3>(); case 4: return get_fn<4>(); case 5: return get_fn<5>(); case 6: return get_fn<6>();
        case 7: return get_fn<7>(); case 8: return get_fn<8>(); case 9: return get_fn<9>(); case 10: return get_fn<10>(); case 11: return get_fn<11>(); case 12: return get_fn<12>(); default: return get_fn<13>();
    }
}

extern "C" void kernel_launch(void* const* d_in, const int* in_sizes, int n_in, void* d_out, int out_size, void* d_ws, size_t ws_size, hipStream_t stream) {
    (void)in_sizes; (void)n_in; (void)out_size;
    static int grid_blocks = 0;
    if (!grid_blocks) {
        int dev = 0, cus = 0;
        (void)hipGetDevice(&dev);
        (void)hipDeviceGetAttribute(&cus, hipDeviceAttributeMultiprocessorCount, dev);
#if MULTI
        for (int k = 0; k < 14; ++k) (void)hipFuncSetAttribute((const void*)fn_of_kind(k), hipFuncAttributeMaxDynamicSharedMemorySize, LDS_BYTES);
#else
        (void)hipFuncSetAttribute((const void*)mega<-1>, hipFuncAttributeMaxDynamicSharedMemorySize, LDS_BYTES);
#endif
        grid_blocks = cus;
        if (ws_size < W_TOTAL) fprintf(stderr, "workspace too small: %zu < %zu\n", ws_size, (size_t)W_TOTAL);
    }
    Params p; memset(&p, 0, sizeof(p));
    for (int i = 0; i < 32; ++i) p.in[i] = (const float*)d_in[i];
    p.in[32] = (const float*)d_out; p.in[33] = (const float*)d_ws;
    p.rope_c1 = pow(10000.0, -1.0 / 128.0);
    unsigned char* ws = (unsigned char*)d_ws;
    int nj = 0, tiles = 0;
    auto add = [&](const float* src, size_t dst_off, int ld, int K, int N, const float* gain = nullptr) {
        TJob& j = p.jobs[nj++]; j.gain = gain; j.src = src; j.dst = (bf16_t*)(ws + dst_off); j.ld = ld; j.K = K; j.N = N; j.tile0 = tiles; tiles += (K / 64) * (N / 64);
    };
    const float* ret_w_in = p.in[14]; const float* ret_w_out = p.in[15]; const float* lru_w_in = p.in[16]; const float* lru_wa = p.in[19]; const float* lru_wx = p.in[21];
    const float* lru_w_out = p.in[24]; const float* xa_w_q = p.in[25]; const float* xa_w_kv = p.in[26]; const float* xa_w_o = p.in[27]; const float* ffn_w_up = p.in[28]; const float* ffn_w_down = p.in[31];
    const float* g_mix = p.in[9]; const float* g_xa = p.in[10]; const float* g_ffn = p.in[12];
    add(ret_w_in, W_RIN, 6144, 1024, 6144, g_mix);
    add(ffn_w_up, W_UP, 6144, 1024, 6144, g_ffn);
    add(ffn_w_up + (size_t)1024 * 6144, W_UP + 12582912, 6144, 1024, 6144, g_ffn + 1024);
    add(ret_w_out, W_ROUT, 1024, 2048, 1024);
    add(lru_w_in, W_LIN, 2048, 1024, 2048, g_mix + 1024);
    for (int h = 0; h < 4; ++h)
        for (int s = 0; s < 2; ++s)
            for (int half = 0; half < 2; ++half)
                add((half ? lru_wx : lru_wa) + (size_t)h * 65536 + s * 128, W_AX + (size_t)(h * 512 + s * 256 + half * 128) * 256 * 2, 256, 256, 128);
    add(lru_w_out, W_LOUT, 1024, 1024, 1024);
    for (int i = 0; i < 2; ++i) add(xa_w_q + (size_t)i * 1048576, W_XQ + (size_t)i * 2097152, 1024, 1024, 1024, g_xa + i * 1024);
    for (int i = 0; i < 2; ++i) add(xa_w_kv + (size_t)i * 2097152, W_XKV + (size_t)i * 4194304, 2048, 1024, 2048);
    for (int i = 0; i < 2; ++i) add(xa_w_o + (size_t)i * 1048576, W_XO + (size_t)i * 2097152, 1024, 1024, 1024);
    for (int i = 0; i < 2; ++i) add(ffn_w_down + (size_t)i * 3145728, W_DN + (size_t)i * 6291456, 1024, 3072, 1024);
    p.ntiles = tiles;
    if (nj != NJOBS) fprintf(stderr, "job count mismatch %d\n", nj);
#if MULTI
#ifndef HI_LIMIT
#define HI_LIMIT NPH
#endif
    for (int ph0 = 0; ph0 < HI_LIMIT; ++ph0) {
        const int ph = ph0;
        int lo = ph, hi = ph + 1;
        void* args[] = {&p, &lo, &hi};
        hipError_t e = hipLaunchKernel((const void*)fn_of_kind(h_kinds[ph]), dim3(grid_blocks), dim3(512), args, LDS_BYTES, stream);
        if (e != hipSuccess) fprintf(stderr, "launch %d failed: %s\n", ph, hipGetErrorString(e));
    }
#ifdef DUMP_OFF
    dump_k<<<1024, 256, 0, stream>>>((const float*)((unsigned char*)d_ws + DUMP_OFF), (float*)d_out, (size_t)16000000);
#endif
#else
    (void)hipMemsetAsync((unsigned char*)d_ws + W_BAR, 0, 16384, stream);
    int lo = 0, hi = NPH;
    void* args[] = {&p, &lo, &hi};
    hipError_t e = hipLaunchCooperativeKernel((const void*)mega<-1>, dim3(grid_blocks), dim3(512), args, LDS_BYTES, stream);
    if (e != hipSuccess) fprintf(stderr, "cooperative launch failed: %s (grid %d)\n", hipGetErrorString(e), grid_blocks);
#endif
}
```

```cpp
#include <hip/hip_runtime.h>
#include <hip/hip_cooperative_groups.h>
#include <cstdio>
#include <cstring>
#include <cmath>
namespace cg = cooperative_groups;

#ifndef MASK
#define MASK 0xffffffffu
#endif
#define EN(k) (((MASK) >> (k)) & 1u)
#define LAS __attribute__((address_space(3)))
#define DEVI __device__ __forceinline__
typedef unsigned short bf16_t;
typedef short bf16x8 __attribute__((ext_vector_type(8)));
typedef float f32x4 __attribute__((ext_vector_type(4)));
typedef unsigned u32x2 __attribute__((ext_vector_type(2)));
typedef unsigned u32x4 __attribute__((ext_vector_type(4)));

constexpr int PR = 16384;
constexpr int SR = 128;
constexpr int TR = PR + SR;
constexpr int TP = 16640;
constexpr int LDS_BYTES = 153600 + 16 + 8192;

constexpr size_t O_YP = 0, O_YS = 16777216, O_RETP = 16908288, O_RETS = 21102592, O_LHP = 88211456, O_LHS = 88219648,
                 O_LCP = 88350720, O_LCS = 88375296, O_FCP = 88768512, O_FCS = 88866816, O_MKP = 90439680, O_MVP = 94633984;

constexpr size_t W_RIN = 0;
constexpr size_t W_ROUT = W_RIN + 12582912;
constexpr size_t W_LIN = W_ROUT + 4194304;
constexpr size_t W_AX = W_LIN + 4194304;
constexpr size_t W_LOUT = W_AX + 1048576;
constexpr size_t W_XQ = W_LOUT + 2097152;
constexpr size_t W_XKV = W_XQ + 2 * 2097152;
constexpr size_t W_XO = W_XKV + 2 * 4194304;
constexpr size_t W_UP = W_XO + 2 * 2097152;
constexpr size_t W_DN = W_UP + 2 * 12582912;
constexpr size_t W_ROTC = W_DN + 2 * 6291456;
constexpr size_t W_ROTS = W_ROTC + 1049088;
constexpr size_t W_LSG = W_ROTS + 1049088;
constexpr size_t W_DEC = W_LSG + 4096;
constexpr size_t W_SS = W_DEC + 4096;
constexpr size_t W_HN = W_SS + (size_t)7 * TP * 32 * 4;
constexpr size_t W_MN = W_HN + (size_t)TP * 2048;
constexpr size_t W_MK = W_MN + 8388608;
constexpr size_t W_MVT = W_MK + 8388608;
constexpr size_t W_BIG = W_MVT + 8388608;
constexpr size_t W_X = W_BIG + (size_t)TP * 12288;
constexpr size_t W_QX = W_X + (size_t)TP * 4096;
constexpr size_t W_AO = W_QX + (size_t)TP * 2048;
constexpr size_t W_Y = W_AO + (size_t)TP * 2048;
constexpr size_t W_L = W_Y + (size_t)TP * 6144;
constexpr size_t W_KT = W_L;
constexpr size_t W_VT = W_KT + 33554432;
constexpr size_t W_O = W_VT + 67108864;
constexpr size_t W_OG = W_O + (size_t)TP * 4096;
constexpr size_t W_END0 = W_OG + (size_t)TP * 4096;
constexpr size_t W_XC = W_L;
constexpr size_t W_AA = W_XC + (size_t)TP * 2048;
constexpr size_t W_UU = W_AA + (size_t)TP * 4096;
constexpr size_t W_CH = W_UU + (size_t)TP * 4096;
constexpr size_t W_YL = W_CH + 4194304;
constexpr size_t W_END1 = W_YL + (size_t)TP * 2048;
constexpr size_t W_BAR = (W_END0 > W_END1 ? W_END0 : W_END1);
constexpr size_t W_TOTAL = W_BAR + 256;

struct TJob { const float* src; bf16_t* dst; const float* gain; int ld, K, N, tile0; };
constexpr int NJOBS = 30;
struct Params {
    const float* in[34];
    double rope_c1;
    TJob jobs[NJOBS];
    int ntiles;
    int pad0;
};

typedef float f32x2 __attribute__((ext_vector_type(2)));
typedef __bf16 bf16x2_t __attribute__((ext_vector_type(2)));
DEVI unsigned cvt_pk_bf16(float lo, float hi) { f32x2 v = {lo, hi}; bf16x2_t r = __builtin_convertvector(v, bf16x2_t); return __builtin_bit_cast(unsigned, r); }
DEVI bf16_t f2bf(float f) { return (bf16_t)(cvt_pk_bf16(f, 0.f) & 0xffffu); }
DEVI float bflo(unsigned u) { return __uint_as_float(u << 16); }
DEVI float bfhi(unsigned u) { return __uint_as_float(u & 0xffff0000u); }
DEVI float bf2f(bf16_t b) { return __uint_as_float(((unsigned)b) << 16); }
DEVI u32x2 pack4(f32x4 v) { u32x2 r; r.x = cvt_pk_bf16(v[0], v[1]); r.y = cvt_pk_bf16(v[2], v[3]); return r; }
DEVI float shx(float v, int o, int lane) { return __int_as_float(__builtin_amdgcn_ds_bpermute((lane ^ o) << 2, __float_as_int(v))); }
DEVI float dpp_f(float v, const int ctrl_sel) {
    const int x = __float_as_int(v);
    int r;
    if (ctrl_sel == 0) r = __builtin_amdgcn_update_dpp(x, x, 0xB1, 0xf, 0xf, false);
    else if (ctrl_sel == 1) r = __builtin_amdgcn_update_dpp(x, x, 0x4E, 0xf, 0xf, false);
    else if (ctrl_sel == 2) r = __builtin_amdgcn_update_dpp(x, x, 0x141, 0xf, 0xf, false);
    else r = __builtin_amdgcn_update_dpp(x, x, 0x140, 0xf, 0xf, false);
    return __int_as_float(r);
}
DEVI float wave_sum(float v, int lane) {
    (void)lane;
    v += dpp_f(v, 0); v += dpp_f(v, 1); v += dpp_f(v, 2); v += dpp_f(v, 3);
    const int x = __float_as_int(v);
    const float s0 = __int_as_float(__builtin_amdgcn_readlane(x, 0)), s1 = __int_as_float(__builtin_amdgcn_readlane(x, 16));
    const float s2 = __int_as_float(__builtin_amdgcn_readlane(x, 32)), s3 = __int_as_float(__builtin_amdgcn_readlane(x, 48));
    return (s0 + s1) + (s2 + s3);
}
DEVI float rcp_(float x) { return __builtin_amdgcn_rcpf(x); }
DEVI float ex2_(float x) { return __builtin_amdgcn_exp2f(x); }
DEVI float exp_(float x) { return __builtin_amdgcn_exp2f(x * 1.4426950408889634f); }
DEVI float sigmoidf_(float x) { return rcp_(1.f + exp_(-x)); }
DEVI float gelu_tanh(float x) { const float z = 1.5957691216057308f * (x + 0.044715f * x * x * x); return x * rcp_(1.f + exp_(-z)); }
DEVI int zero_() { int z = 0; asm volatile("" : "+s"(z)); return z; }
DEVI int bid_() { int b = blockIdx.x; asm volatile("" : "+s"(b)); return b; }
DEVI int nblk_() { int b = gridDim.x; asm volatile("" : "+s"(b)); return b; }
DEVI unsigned zv_() { unsigned z = 0; asm volatile("" : "+v"(z)); return z; }
DEVI int tid_() { int t = threadIdx.x; asm volatile("" : "+v"(t)); return t; }
DEVI f32x4 mfma16(bf16x8 a, bf16x8 b, f32x4 c) { return __builtin_amdgcn_mfma_f32_16x16x32_bf16(a, b, c, 0, 0, 0); }

DEVI float rstd_of(const float* ss, int row) {
    const f32x4* p = (const f32x4*)(ss + (unsigned)row * 32u);
    f32x4 a = p[0];
#pragma unroll
    for (int i = 1; i < 8; ++i) a += p[i];
    return __builtin_amdgcn_rsqf(__fadd_rn(__fmul_rn((a[0] + a[1]) + (a[2] + a[3]), 1.f / 1024.f), 1e-6f));
}

namespace pg8 {
constexpr int BM = 256, BK = 64, HALF = 128, HTB = HALF * BK * 2, NXCD = 8, WGM = 8;
__host__ __device__ __forceinline__ int lds_byte(int r, int c) { const int st = (r >> 4) * 2 + (c >> 5), rr = r & 15, cc = c & 31, ob = rr * 64 + cc * 2; return st * 1024 + (ob ^ (((ob >> 9) & 1) << 5)); }
__host__ __device__ __forceinline__ void stage_rc(int b, int& R, int& C) { const int st = b / 1024, sb = b % 1024, swz = sb ^ (((sb >> 9) & 1) << 5); R = (st >> 1) * 16 + swz / 64; C = (st & 1) * 32 + (swz % 64) / 2; }
__host__ __device__ __forceinline__ int perm32(int rho) { const int n = rho >> 4, i = rho & 15; return 8 * (i >> 2) + 4 * n + (i & 3); }
struct Unit { int pm, pn; };
struct Gemm { const bf16_t* A; const bf16_t* Bt; int M, N, K, lda, ldb, diag; };
struct StaticOrder {
    int nM, nN, nwg, G, c;
    DEVI void init(int M, int N, int G_, int c_) { nM = M / BM; nN = N / BM; nwg = nM * nN; G = G_; c = c_; }
    DEVI bool next(int i, Unit& u) const {
        const long L = (long)i * G + c; if (L >= nwg) return false;
        int wgid = (int)L; { const int q = nwg / NXCD, r = nwg % NXCD, xcd = wgid % NXCD, off = wgid / NXCD; wgid = (xcd < r ? xcd * (q + 1) : r * (q + 1) + (xcd - r) * q) + off; }
        const int nig = WGM * nN, gid = wgid / nig, fm = gid * WGM, gsz = (nM - fm) < WGM ? (nM - fm) : WGM;
        u.pm = fm + ((wgid % nig) % gsz); u.pn = (wgid % nig) / gsz; return true;
    }
};

template <class Q>
DEVI void gemm_phase(LAS unsigned char* lds, const Gemm g, const StaticOrder& S, const Q& E) {
    const int tid = tid_(), wid = __builtin_amdgcn_readfirstlane(tid >> 6), lane = tid & 63, wr = wid >> 2, wc = wid & 3, fr = lane & 15, fq = lane >> 4;
    const int K = g.K, nt = K / BK;
    unsigned voffA, voffB;
    { int R, C; stage_rc(tid * 16, R, C); const int Rb = Q::PERM ? ((R & ~31) + perm32(R & 31)) : R; voffA = (unsigned)(R * g.lda + C) * 2u; voffB = (unsigned)(Rb * g.ldb + C) * 2u; }
    const size_t r64voffA = (size_t)64 * g.lda * 2, r64voffB = (size_t)64 * g.ldb * 2;
    const size_t kstep = (size_t)(BK * 2);
    const size_t hstepA = (size_t)HALF * g.lda * 2, hstepB = (g.diag == 2 ? (size_t)3072 : (size_t)HALF) * g.ldb * 2;
    const size_t tstepA = 2 * hstepA, tstepB = (g.diag == 2 ? (size_t)HALF : (size_t)2 * HALF) * g.ldb * 2;
    const unsigned ldsw = (unsigned)wid * 1024u;
    const int aoff = lds_byte(wr * 64 + fr, fq * 8), boff = lds_byte(wc * 32 + fr, fq * 8);
#define PG8_SA(b, h) (((b) * 2 + (h)) * HTB)
#define PG8_SB(b, h) ((4 + (b) * 2 + (h)) * HTB)
#define PG8_STAGE(bufoff, gbase, voff) do { _Pragma("unroll") for (int _i = 0; _i < 2; ++_i) \
        __builtin_amdgcn_global_load_lds((const unsigned*)((const char*)(gbase) + (size_t)_i * r64##voff + voff), (LAS unsigned*)(lds + (bufoff) + ldsw + _i * 8192), 16, 0, 0); } while (0)
#define PG8_LDA(dst, b, h) do { _Pragma("unroll") for (int m = 0; m < 4; ++m) _Pragma("unroll") for (int k = 0; k < 2; ++k) dst[m][k] = *(const LAS bf16x8*)(lds + PG8_SA(b, h) + aoff + m * 2048 + k * 1024); } while (0)
#define PG8_LDB(dst, b, h) do { _Pragma("unroll") for (int n = 0; n < 2; ++n) _Pragma("unroll") for (int k = 0; k < 2; ++k) dst[n][k] = *(const LAS bf16x8*)(lds + PG8_SB(b, h) + boff + n * 2048 + k * 1024); } while (0)
#define PG8_MMA(ai, bj, At, Bt) do { __builtin_amdgcn_s_setprio(1); _Pragma("unroll") for (int m = 0; m < 4; ++m) _Pragma("unroll") for (int n = 0; n < 2; ++n) _Pragma("unroll") for (int k = 0; k < 2; ++k) \
        acc[ai][bj][m][n] = __builtin_amdgcn_mfma_f32_16x16x32_bf16(Bt[n][k], At[m][k], acc[ai][bj][m][n], 0, 0, 0); __builtin_amdgcn_s_setprio(0); } while (0)
#define PG8_WAIT_V(n) asm volatile("s_waitcnt vmcnt(" #n ")" ::: "memory")
#define PG8_WAIT_L(n) asm volatile("s_waitcnt lgkmcnt(" #n ")" ::: "memory")
#define PG8_BAR __builtin_amdgcn_s_barrier()
#define PG8_SCHED __builtin_amdgcn_sched_barrier(0)
    Unit cur, nxt; int ui = 0;
    if (!S.next(0, cur)) return;
    f32x4 acc[2][2][4][2];
#pragma unroll
    for (int a = 0; a < 2; ++a)
#pragma unroll
        for (int b = 0; b < 2; ++b)
#pragma unroll
            for (int m = 0; m < 4; ++m)
#pragma unroll
                for (int n = 0; n < 2; ++n) acc[a][b][m][n] = (f32x4){0.f, 0.f, 0.f, 0.f};
    bf16x8 At[4][2], B0[2][2], B1[2][2];
    const char* cA = (const char*)g.A + (size_t)cur.pm * tstepA + (g.diag == 1 ? (size_t)(cur.pn >> 1) * 512 : 0); const char* cB = (const char*)g.Bt + (size_t)cur.pn * tstepB;
#define PG8_RSTD(unit, par) do { if constexpr (Q::NEEDS_RSTD) { \
        const int _rl = tid >> 1, _hf = tid & 1; \
        const f32x4* _p = (const f32x4*)(E.ss + ((size_t)((unit).pm * BM + _rl)) * 32 + _hf * 16); \
        const f32x4 _a = (_p[0] + _p[1]) + (_p[2] + _p[3]); \
        float _sm = (_a[0] + _a[1]) + (_a[2] + _a[3]); \
        _sm += shx(_sm, 1, lane); \
        if (!_hf) *(LAS float*)(lds + 131072 + (par) * 1024 + _rl * 4) = __builtin_amdgcn_rsqf(__fadd_rn(__fmul_rn(_sm, 1.f / 1024.f), 1e-6f)); } } while (0)
    PG8_RSTD(cur, 0);
    PG8_STAGE(PG8_SB(0, 0), cB, voffB); PG8_STAGE(PG8_SA(0, 0), cA, voffA); PG8_STAGE(PG8_SB(0, 1), cB + hstepB, voffB); PG8_STAGE(PG8_SA(0, 1), cA + hstepA, voffA);
    if (wr == 1) PG8_BAR;
    PG8_WAIT_V(4); PG8_BAR;
    PG8_STAGE(PG8_SB(1, 0), cB + kstep, voffB); PG8_STAGE(PG8_SA(1, 0), cA + kstep, voffA); PG8_STAGE(PG8_SB(1, 1), cB + hstepB + kstep, voffB);
    PG8_WAIT_V(6); PG8_BAR;
    for (;;) {
        const bool has_next = S.next(ui + 1, nxt);
        const char* nA = has_next ? (const char*)g.A + (size_t)nxt.pm * tstepA + (g.diag == 1 ? (size_t)(nxt.pn >> 1) * 512 : 0) : cA; const char* nB = has_next ? (const char*)g.Bt + (size_t)nxt.pn * tstepB : cB;
        for (int t = 0; t < nt; t += 2) {
            const bool last = (t == nt - 2);
            const char* a1 = cA + (size_t)(t + 1) * kstep;
            const char* a2 = last ? nA : cA + (size_t)(t + 2) * kstep; const char* b2 = last ? nB : cB + (size_t)(t + 2) * kstep;
            const char* a3 = a2 + kstep; const char* b3 = b2 + kstep;
            PG8_LDB(B0, 0, 0); PG8_SCHED; PG8_LDA(At, 0, 0); PG8_STAGE(PG8_SA(1, 1), a1 + hstepA, voffA);
            PG8_WAIT_L(8); PG8_BAR; PG8_WAIT_L(0); PG8_MMA(0, 0, At, B0); PG8_BAR; PG8_SCHED;
            PG8_LDB(B1, 0, 1); PG8_STAGE(PG8_SB(0, 0), b2, voffB);
            PG8_BAR; PG8_WAIT_L(0); PG8_MMA(0, 1, At, B1); PG8_BAR;
            PG8_LDA(At, 0, 1); PG8_STAGE(PG8_SA(0, 0), a2, voffA);
            PG8_BAR; PG8_WAIT_L(0); PG8_MMA(1, 0, At, B0); PG8_BAR; PG8_SCHED;
            PG8_STAGE(PG8_SB(0, 1), b2 + hstepB, voffB);
            PG8_WAIT_V(6); PG8_BAR; PG8_MMA(1, 1, At, B1); PG8_BAR;
            PG8_LDB(B0, 1, 0); PG8_SCHED; PG8_LDA(At, 1, 0); PG8_STAGE(PG8_SA(0, 1), a2 + hstepA, voffA);
            PG8_WAIT_L(8); PG8_BAR; PG8_WAIT_L(0); PG8_MMA(0, 0, At, B0); PG8_BAR; PG8_SCHED;
            PG8_LDB(B1, 1, 1); PG8_STAGE(PG8_SB(1, 0), b3, voffB);
            PG8_BAR; PG8_WAIT_L(0); PG8_MMA(0, 1, At, B1); PG8_BAR;
            PG8_LDA(At, 1, 1); PG8_STAGE(PG8_SA(1, 0), a3, voffA);
            PG8_BAR; PG8_WAIT_L(0); PG8_MMA(1, 0, At, B0); PG8_BAR; PG8_SCHED;
            PG8_STAGE(PG8_SB(1, 1), b3 + hstepB, voffB);
            PG8_WAIT_V(6); PG8_BAR; PG8_MMA(1, 1, At, B1); PG8_BAR;
        }
#pragma unroll
        for (int ai = 0; ai < 2; ++ai)
#pragma unroll
            for (int m = 0; m < 4; ++m) {
                int l2 = lane; asm volatile("" : "+v"(l2));
                const int rloc = ai * HALF + wr * 64 + m * 16 + (l2 & 15);
                float rsc = 1.f;
                if constexpr (Q::NEEDS_RSTD) rsc = *(const LAS float*)(lds + 131072 + (ui & 1) * 1024 + rloc * 4);
                if constexpr (Q::PERM) E.oct(cur.pm * BM + rloc, cur.pn, wc * 32 + (l2 >> 4) * 8, acc[ai][0][m][0], acc[ai][0][m][1], acc[ai][1][m][0], acc[ai][1][m][1], rsc);
                else {
#pragma unroll
                    for (int n = 0; n < 2; ++n)
                        E.quad(cur.pm * BM + rloc, cur.pn, wc * 32 + n * 16 + (l2 >> 4) * 4, acc[ai][0][m][n], acc[ai][1][m][n], rsc);
                }
            }
        if (!has_next) break;
        PG8_RSTD(nxt, (ui + 1) & 1);
#pragma unroll
        for (int a = 0; a < 2; ++a)
#pragma unroll
            for (int b = 0; b < 2; ++b)
#pragma unroll
                for (int m = 0; m < 4; ++m)
#pragma unroll
                    for (int n = 0; n < 2; ++n) acc[a][b][m][n] = (f32x4){0.f, 0.f, 0.f, 0.f};
        cur = nxt; cA = nA; cB = nB; ++ui;
    }
    PG8_WAIT_V(0);
    if (wr == 0) PG8_BAR;
    PG8_BAR;
#undef PG8_RSTD
#undef PG8_SA
#undef PG8_SB
#undef PG8_STAGE
#undef PG8_LDA
#undef PG8_LDB
#undef PG8_MMA
#undef PG8_WAIT_V
#undef PG8_WAIT_L
#undef PG8_BAR
#undef PG8_SCHED
}
}

template <class Q>
DEVI void run_gemm(LAS unsigned char* lds, const bf16_t* A, int lda, const bf16_t* Bt, int ldb, int M, int N, int K, int diag, int rot, const Q& q) {
    pg8::Gemm g; g.A = A; g.Bt = Bt; g.M = M; g.N = N; g.K = K; g.lda = lda; g.ldb = ldb; g.diag = diag;
    pg8::StaticOrder S; const int G_ = nblk_(); S.init(M, N, G_, (bid_() + G_ - (rot % G_)) % G_);
    pg8::gemm_phase<Q>(lds, g, S, q);
}

template <int RT, class Q>
DEVI void skinny_phase_t(LAS unsigned char* lds, const bf16_t* A, int lda, const bf16_t* Bt, int ldb, int N, int K, int diag, const Q& q, int nbuse = 0) {
    constexpr int RS = 8 / RT;
    const int tid = tid_(), w = tid >> 6, lane = tid & 63, fr = lane & 15, fq = lane >> 4;
    const int nitems = (N / 32) * RS, kw = K / 8;
    const int stride_ = nbuse > 0 ? nbuse : nblk_();
    for (int it = bid_() < stride_ ? bid_() : nitems; it < nitems; it += stride_) {
        const int ci = it / RS, rs = it - ci * RS, pn = ci >> 3, g = ci & 7;
        const bf16_t* a0 = A + (size_t)(rs * RT * 16 + fr) * lda + (diag == 1 ? (pn >> 1) * 256 : 0) + w * kw + fq * 8;
        const bf16_t* b0 = Bt + (size_t)((diag == 2 ? pn * 128 : pn * 256) + g * 16 + fr) * ldb + w * kw + fq * 8;
        const bf16_t* b1 = b0 + (size_t)(diag == 2 ? 3072 : 128) * ldb;
        f32x4 acc[RT][2];
#pragma unroll
        for (int rt = 0; rt < RT; ++rt) { acc[rt][0] = (f32x4){0.f, 0.f, 0.f, 0.f}; acc[rt][1] = (f32x4){0.f, 0.f, 0.f, 0.f}; }
        bf16x8 cb0 = *(const bf16x8*)(b0), cb1 = *(const bf16x8*)(b1), ca[RT];
#pragma unroll
        for (int rt = 0; rt < RT; ++rt) ca[rt] = *(const bf16x8*)(a0 + (size_t)rt * 16 * lda);
#pragma unroll 1
        for (int k = 32; k <= kw; k += 32) {
            const int kn = k < kw ? k : 0;
            const bf16x8 nb0 = *(const bf16x8*)(b0 + kn), nb1 = *(const bf16x8*)(b1 + kn);
            bf16x8 na[RT];
#pragma unroll
            for (int rt = 0; rt < RT; ++rt) na[rt] = *(const bf16x8*)(a0 + (size_t)rt * 16 * lda + kn);
#pragma unroll
            for (int rt = 0; rt < RT; ++rt) { acc[rt][0] = mfma16(cb0, ca[rt], acc[rt][0]); acc[rt][1] = mfma16(cb1, ca[rt], acc[rt][1]); }
            cb0 = nb0; cb1 = nb1;
#pragma unroll
            for (int rt = 0; rt < RT; ++rt) ca[rt] = na[rt];
        }
#pragma unroll
        for (int rt = 0; rt < RT; ++rt) {
            *(LAS f32x4*)(lds + (size_t)((((w * 8 + rt) * 2 + 0) * 64 + lane) * 16)) = acc[rt][0];
            *(LAS f32x4*)(lds + (size_t)((((w * 8 + rt) * 2 + 1) * 64 + lane) * 16)) = acc[rt][1];
        }
        __syncthreads();
        if (w < RT) {
            f32x4 v0 = *(const LAS f32x4*)(lds + (size_t)((((0 * 8 + w) * 2 + 0) * 64 + lane) * 16));
            f32x4 v1 = *(const LAS f32x4*)(lds + (size_t)((((0 * 8 + w) * 2 + 1) * 64 + lane) * 16));
#pragma unroll
            for (int ww = 1; ww < 8; ++ww) {
                v0 += *(const LAS f32x4*)(lds + (size_t)((((ww * 8 + w) * 2 + 0) * 64 + lane) * 16));
                v1 += *(const LAS f32x4*)(lds + (size_t)((((ww * 8 + w) * 2 + 1) * 64 + lane) * 16));
            }
            const int row = PR + (rs * RT + w) * 16 + fr;
            float rsc = 1.f;
            if constexpr (Q::NEEDS_RSTD) rsc = rstd_of(q.ss, row);
            q.quad(row, pn, g * 16 + fq * 4, v0, v1, rsc);
        }
        __syncthreads();
    }
}
template <class Q>
DEVI void skinny_phase(LAS unsigned char* lds, const bf16_t* A, int lda, const bf16_t* Bt, int ldb, int N, int K, int diag, const Q& q, int nbuse = 0) {
    skinny_phase_t<8, Q>(lds, A, lda, Bt, ldb, N, K, diag, q, nbuse);
}
template <class Q>
DEVI void skinny_phase1(LAS unsigned char* lds, const bf16_t* A, int lda, const bf16_t* Bt, int ldb, int N, int K, int diag, const Q& q) {
    skinny_phase_t<1, Q>(lds, A, lda, Bt, ldb, N, K, diag, q);
}

struct QRetIn {
    static constexpr bool PERM = true;
    DEVI void oct(int row, int pn, int cl8, f32x4 a0, f32x4 a1, f32x4 b0, f32x4 b1, float rsc) const {
        a0 *= rsc; a1 *= rsc; b0 *= rsc; b1 *= rsc;
        const int b = row >> 11, t = row & 2047;
        bf16_t* nat = big + ((unsigned)row * 6144u + (unsigned)(pn * 256 + cl8));
        if (pn < 8) {
            const int h = pn & 3;
            const float* pc = rc + t * 128 + cl8; const float* ps = rs + t * 128 + cl8;
            const f32x4 c0 = *(const f32x4*)pc, c1 = *(const f32x4*)(pc + 4), s0 = *(const f32x4*)ps, s1 = *(const f32x4*)(ps + 4);
            const float sc = dec[pn * 128 + (t & 127)];
            const f32x4 o0 = (a0 * c0 - b0 * s0) * sc, o1 = (a1 * c1 - b1 * s1) * sc, o2 = (a0 * s0 + b0 * c0) * sc, o3 = (a1 * s1 + b1 * c1) * sc;
            const u32x2 p0 = pack4(o0), p1 = pack4(o1), p2 = pack4(o2), p3 = pack4(o3);
            *(u32x4*)nat = (u32x4){p0.x, p0.y, p1.x, p1.y}; *(u32x4*)(nat + 128) = (u32x4){p2.x, p2.y, p3.x, p3.y};
            if (pn >= 4) {
                bf16_t* q = kt + (((unsigned)(b * 4 + h) * 256u + (unsigned)cl8) * 2048u + (unsigned)t);
#pragma unroll
                for (int r = 0; r < 4; ++r) { q[(size_t)r * 2048] = f2bf(o0[r]); q[(size_t)(4 + r) * 2048] = f2bf(o1[r]); q[(size_t)(128 + r) * 2048] = f2bf(o2[r]); q[(size_t)(132 + r) * 2048] = f2bf(o3[r]); }
            }
        } else if (pn < 16) {
            const int c0i = (pn - 8) * 256 + cl8; const int head = c0i >> 9, e0 = c0i & 511;
            bf16_t* q = vt + (((unsigned)(b * 4 + head) * 512u + (unsigned)e0) * 2048u + (unsigned)t);
#pragma unroll
            for (int r = 0; r < 4; ++r) { q[(size_t)r * 2048] = f2bf(a0[r]); q[(size_t)(4 + r) * 2048] = f2bf(a1[r]); q[(size_t)(128 + r) * 2048] = f2bf(b0[r]); q[(size_t)(132 + r) * 2048] = f2bf(b1[r]); }
        } else {
            const u32x2 p0 = pack4(a0), p1 = pack4(a1), p2 = pack4(b0), p3 = pack4(b1);
            *(u32x4*)nat = (u32x4){p0.x, p0.y, p1.x, p1.y}; *(u32x4*)(nat + 128) = (u32x4){p2.x, p2.y, p3.x, p3.y};
        }
    }
    static constexpr bool NEEDS_RSTD = true;
    bf16_t* big; bf16_t* kt; bf16_t* vt; const float* rc; const float* rs; const float* dec; const float* ss;
    DEVI void quad(int row, int pn, int cl, f32x4 v0, f32x4 v1, float rsc) const {
        v0 *= rsc; v1 *= rsc;
        const bool smp = row >= PR; const int b = row >> 11, t = row & 2047;
        bf16_t* nat = big + ((unsigned)row * 6144u + (unsigned)(pn * 256 + cl));
        if (pn < 8) {
            const int h = pn & 3; const int pi = smp ? 2048 : t;
            const f32x4 c = *(const f32x4*)(rc + pi * 128 + cl), s = *(const f32x4*)(rs + pi * 128 + cl);
            f32x4 o0 = v0 * c - v1 * s, o1 = v0 * s + v1 * c;
            const float sc = dec[pn * 128 + (smp ? 0 : (t & 127))];
            o0 *= sc; o1 *= sc;
            *(u32x2*)nat = pack4(o0); *(u32x2*)(nat + 128) = pack4(o1);
            if (pn >= 4 && !smp) {
                bf16_t* q = kt + (((unsigned)(b * 4 + h) * 256u + (unsigned)cl) * 2048u + (unsigned)t);
#pragma unroll
                for (int r = 0; r < 4; ++r) { q[(size_t)r * 2048] = f2bf(o0[r]); q[(size_t)(128 + r) * 2048] = f2bf(o1[r]); }
            }
        } else if (pn < 16) {
            if (smp) { *(u32x2*)nat = pack4(v0); *(u32x2*)(nat + 128) = pack4(v1); }
            else {
                const int c0 = (pn - 8) * 256 + cl; const int head = c0 >> 9, e0 = c0 & 511;
                bf16_t* q = vt + (((unsigned)(b * 4 + head) * 512u + (unsigned)e0) * 2048u + (unsigned)t);
#pragma unroll
                for (int r = 0; r < 4; ++r) { q[(size_t)r * 2048] = f2bf(v0[r]); q[(size_t)(128 + r) * 2048] = f2bf(v1[r]); }
            }
        } else { *(u32x2*)nat = pack4(v0); *(u32x2*)(nat + 128) = pack4(v1); }
    }
};
struct QResid {
    static constexpr bool PERM = true;
    DEVI void oct(int row, int pn, int cl8, f32x4 a0, f32x4 a1, f32x4 b0, f32x4 b1, float rsc) const {
        (void)rsc;
        const float* r = (row < PR ? rinP + (size_t)row * 1024 : rinS + (size_t)(row - PR) * 1024) + pn * 256 + cl8;
        const unsigned off = (unsigned)row * 1024u + (unsigned)(pn * 256 + cl8);
        a0 += __builtin_nontemporal_load((const f32x4*)r); a1 += __builtin_nontemporal_load((const f32x4*)(r + 4)); b0 += __builtin_nontemporal_load((const f32x4*)(r + 128)); b1 += __builtin_nontemporal_load((const f32x4*)(r + 132));
        __builtin_nontemporal_store(a0, (f32x4*)(xout + off)); __builtin_nontemporal_store(a1, (f32x4*)(xout + off + 4)); __builtin_nontemporal_store(b0, (f32x4*)(xout + off + 128)); __builtin_nontemporal_store(b1, (f32x4*)(xout + off + 132));
        const u32x2 pa0 = pack4(a0), pa1 = pack4(a1), pb0 = pack4(b0), pb1 = pack4(b1);
        *(u32x4*)(xb + off) = (u32x4){pa0.x, pa0.y, pa1.x, pa1.y}; *(u32x4*)(xb + off + 128) = (u32x4){pb0.x, pb0.y, pb1.x, pb1.y};
        float sa = a0[0] * a0[0] + a0[1] * a0[1] + a0[2] * a0[2] + a0[3] * a0[3] + a1[0] * a1[0] + a1[1] * a1[1] + a1[2] * a1[2] + a1[3] * a1[3];
        float sb = b0[0] * b0[0] + b0[1] * b0[1] + b0[2] * b0[2] + b0[3] * b0[3] + b1[0] * b1[0] + b1[1] * b1[1] + b1[2] * b1[2] + b1[3] * b1[3];
        const int lane = (row & 15) | (((cl8 >> 3) & 3) << 4);
        sa += shx(sa, 16, lane); sa += shx(sa, 32, lane); sb += shx(sb, 16, lane); sb += shx(sb, 32, lane);
        if (lane < 16) { float* sp = ssout + ((unsigned)row * 32u + (unsigned)(pn * 8 + (cl8 >> 5))); sp[0] = sa; sp[4] = sb; }
    }
    static constexpr bool NEEDS_RSTD = false;
    const float* rinP; const float* rinS; float* xout; bf16_t* xb; float* ssout;
    DEVI void quad(int row, int pn, int cl, f32x4 v0, f32x4 v1, float rsc) const {
        (void)rsc;
        const float* r = (row < PR ? rinP + (size_t)row * 1024 : rinS + (size_t)(row - PR) * 1024) + pn * 256 + cl;
        const unsigned off = (unsigned)row * 1024u + (unsigned)(pn * 256 + cl);
        const f32x4 a = *(const f32x4*)r + v0, b = *(const f32x4*)(r + 128) + v1;
        *(f32x4*)(xout + off) = a; *(f32x4*)(xout + off + 128) = b;
        *(u32x2*)(xb + off) = pack4(a); *(u32x2*)(xb + off + 128) = pack4(b);
        float sq = a[0] * a[0] + a[1] * a[1] + a[2] * a[2] + a[3] * a[3] + b[0] * b[0] + b[1] * b[1] + b[2] * b[2] + b[3] * b[3];
        const int lane = (row & 15) | (((cl >> 2) & 3) << 4);
        sq += shx(sq, 16, lane); sq += shx(sq, 32, lane);
        if (lane < 16) ssout[(unsigned)row * 32u + (unsigned)(pn * 8 + (cl >> 4))] = sq;
    }
};
struct QBf16 {
    static constexpr bool NEEDS_RSTD = true;
    static constexpr bool PERM = true;
    bf16_t* out; int ld; const float* ss;
    DEVI void oct(int row, int pn, int cl8, f32x4 a0, f32x4 a1, f32x4 b0, f32x4 b1, float rsc) const {
        bf16_t* o = out + ((unsigned)row * (unsigned)ld + (unsigned)(pn * 256 + cl8));
        const u32x2 pa0 = pack4(a0 * rsc), pa1 = pack4(a1 * rsc), pb0 = pack4(b0 * rsc), pb1 = pack4(b1 * rsc);
        *(u32x4*)o = (u32x4){pa0.x, pa0.y, pa1.x, pa1.y}; *(u32x4*)(o + 128) = (u32x4){pb0.x, pb0.y, pb1.x, pb1.y};
    }
    DEVI void quad(int row, int pn, int cl, f32x4 v0, f32x4 v1, float rsc) const {
        v0 *= rsc; v1 *= rsc;
        bf16_t* o = out + ((unsigned)row * (unsigned)ld + (unsigned)(pn * 256 + cl));
        *(u32x2*)o = pack4(v0); *(u32x2*)(o + 128) = pack4(v1);
    }
};
DEVI float dpp_shr(float v, const int n) {
    const int x = __float_as_int(v);
    return __int_as_float(n == 1 ? __builtin_amdgcn_update_dpp(x, x, 0x111, 0xf, 0xf, false) : __builtin_amdgcn_update_dpp(x, x, 0x112, 0xf, 0xf, false));
}
struct QFfn {
    static constexpr bool NEEDS_RSTD = true;
    static constexpr bool PERM = true;
    bf16_t* y; bf16_t* big; const float* ss; const float* cw; const float* cb; const float* sbuf; float* outp; float* outs;
    DEVI void oct(int row, int pn, int cl8, f32x4 a0, f32x4 a1, f32x4 b0, f32x4 b1, float rsc) const {
        a0 *= rsc; a1 *= rsc; b0 *= rsc; b1 *= rsc;
        const int ch = pn * 128 + cl8, fr = row & 15;
        f32x4 p10, p11, p20, p21;
#pragma unroll
        for (int k = 0; k < 4; ++k) { p10[k] = dpp_shr(a0[k], 1); p11[k] = dpp_shr(a1[k], 1); p20[k] = dpp_shr(a0[k], 2); p21[k] = dpp_shr(a1[k], 2); }
        if (fr >= 2) {
            const f32x4 w00 = *(const f32x4*)(cw + ch), w01 = *(const f32x4*)(cw + ch + 4), w10 = *(const f32x4*)(cw + 3072 + ch), w11 = *(const f32x4*)(cw + 3072 + ch + 4);
            const f32x4 w20 = *(const f32x4*)(cw + 6144 + ch), w21 = *(const f32x4*)(cw + 6144 + ch + 4), c0 = *(const f32x4*)(cb + ch), c1 = *(const f32x4*)(cb + ch + 4);
            float o[8];
#pragma unroll
            for (int k = 0; k < 4; ++k) {
                o[k] = gelu_tanh(c0[k] + p20[k] * w00[k] + p10[k] * w10[k] + a0[k] * w20[k]) * b0[k];
                o[4 + k] = gelu_tanh(c1[k] + p21[k] * w01[k] + p11[k] * w11[k] + a1[k] * w21[k]) * b1[k];
            }
            u32x4 w; w.x = cvt_pk_bf16(o[0], o[1]); w.y = cvt_pk_bf16(o[2], o[3]); w.z = cvt_pk_bf16(o[4], o[5]); w.w = cvt_pk_bf16(o[6], o[7]);
            *(u32x4*)(y + ((unsigned)row * 3072u + (unsigned)ch)) = w;
        }
        if (fr < 2 || fr >= 14) {
            const u32x2 p0 = pack4(a0), p1 = pack4(a1);
            *(u32x4*)(big + ((unsigned)row * 6144u + (unsigned)ch)) = (u32x4){p0.x, p0.y, p1.x, p1.y};
            if (fr < 2) { const u32x2 g0 = pack4(b0), g1 = pack4(b1); *(u32x4*)(big + ((unsigned)row * 6144u + 3072u + (unsigned)ch)) = (u32x4){g0.x, g0.y, g1.x, g1.y}; }
            else if ((row & 2047) >= 2046) { float* q = outp + ((size_t)(row >> 11) * 2 + ((row & 2047) - 2046)) * 3072 + ch; *(f32x4*)q = a0; *(f32x4*)(q + 4) = a1; }
        }
    }
    DEVI void quad(int row, int pn, int cl, f32x4 v0, f32x4 v1, float rsc) const {
        v0 *= rsc; v1 *= rsc;
        const int ch = pn * 128 + cl, sb = row - PR;
        const float* b0 = sbuf + ((size_t)sb * 2) * 3072 + ch;
        const f32x4 h2 = *(const f32x4*)b0, h1 = *(const f32x4*)(b0 + 3072);
        const f32x4 w0 = *(const f32x4*)(cw + ch), w1 = *(const f32x4*)(cw + 3072 + ch), w2 = *(const f32x4*)(cw + 6144 + ch), c = *(const f32x4*)(cb + ch);
        float* q = outs + ((size_t)sb * 2) * 3072 + ch;
        *(f32x4*)q = h1; *(f32x4*)(q + 3072) = v0;
        f32x4 o;
#pragma unroll
        for (int k = 0; k < 4; ++k) o[k] = gelu_tanh(c[k] + h2[k] * w0[k] + h1[k] * w1[k] + v0[k] * w2[k]) * v1[k];
        *(u32x2*)(y + ((unsigned)row * 3072u + (unsigned)ch)) = pack4(o);
    }
};
struct QMemKV {
    static constexpr bool PERM = false;
    static constexpr bool NEEDS_RSTD = false;
    float* outk; float* outv; bf16_t* mk; bf16_t* mvt;
    DEVI void quad(int row, int pn, int cl, f32x4 v0, f32x4 v1, float rsc) const {
        if (pn < 4) {
            const size_t o = (size_t)row * 1024 + pn * 256 + cl;
            __builtin_nontemporal_store(v0, (f32x4*)(outk + o)); __builtin_nontemporal_store(v1, (f32x4*)(outk + o + 128));
            *(u32x2*)(mk + o) = pack4(v0); *(u32x2*)(mk + o + 128) = pack4(v1);
        } else {
            const int h = pn - 4; const size_t o = (size_t)row * 1024 + h * 256 + cl;
            __builtin_nontemporal_store(v0, (f32x4*)(outv + o)); __builtin_nontemporal_store(v1, (f32x4*)(outv + o + 128));
            const int b = row >> 8, m = row & 255;
            bf16_t* q = mvt + ((size_t)(b * 4 + h) * 256 + cl) * 256 + m;
#pragma unroll
            for (int r = 0; r < 4; ++r) { q[r * 256] = f2bf(v0[r]); q[(128 + r) * 256] = f2bf(v1[r]); }
        }
    }
};
struct QLru {
    static constexpr bool PERM = false;
    static constexpr bool NEEDS_RSTD = false;
    const float* ba; const float* bx; const float* lam; const bf16_t* xc; float* aa; float* uu;
    const float* h0; float* hout; const bf16_t* big; bf16_t* yl;
    DEVI void quad(int row, int pn, int cl, f32x4 v0, f32x4 v1, float rsc) const {
        const int ch = (pn >> 1) * 256 + (pn & 1) * 128 + cl;
        const f32x4 ba4 = *(const f32x4*)(ba + ch), bx4 = *(const f32x4*)(bx + ch), lm4 = *(const f32x4*)(lam + ch);
        const u32x2 xp = *(const u32x2*)(xc + (size_t)row * 1024 + ch);
        const float xv[4] = {bflo(xp.x), bfhi(xp.x), bflo(xp.y), bfhi(xp.y)};
        f32x4 a4, u4;
#pragma unroll
        for (int r = 0; r < 4; ++r) {
            const float rr = sigmoidf_(v0[r] + ba4[r]), ii = sigmoidf_(v1[r] + bx4[r]);
            const float la = 8.f * rr * lm4[r];
            const float av = exp_(la);
            a4[r] = av; u4[r] = __builtin_amdgcn_sqrtf(fmaxf(1.f - av * av, 0.f)) * (ii * xv[r]);
        }
        if (row < PR) { *(f32x4*)(aa + (size_t)row * 1024 + ch) = a4; *(f32x4*)(uu + (size_t)row * 1024 + ch) = u4; }
        else {
            const int sb = row - PR;
            const f32x4 hp = *(const f32x4*)(h0 + (size_t)sb * 1024 + ch);
            const f32x4 hn = a4 * hp + u4;
            *(f32x4*)(hout + (size_t)sb * 1024 + ch) = hn;
            const u32x2 gp = *(const u32x2*)(big + (size_t)row * 2048 + 1024 + ch);
            f32x4 y; y[0] = gelu_tanh(bflo(gp.x)) * hn[0]; y[1] = gelu_tanh(bfhi(gp.x)) * hn[1]; y[2] = gelu_tanh(bflo(gp.y)) * hn[2]; y[3] = gelu_tanh(bfhi(gp.y)) * hn[3];
            *(u32x2*)(yl + (size_t)row * 1024 + ch) = pack4(y);
        }
    }
};

template <bool F32OUT>
DEVI void norm_phase(const float* srcP, const float* srcS, const float* gain, bf16_t* dstb, float* dstP, float* dstS, int nrows) {
    const int tid = tid_(); const int lane = tid & 63, wave = bid_() * 8 + (tid >> 6), nw = nblk_() * 8;
    f32x4 g[4];
#pragma unroll
    for (int i = 0; i < 4; ++i) g[i] = *(const f32x4*)(gain + i * 256 + lane * 4);
    for (int r0 = wave; r0 < nrows; r0 += 2 * nw) {
        f32x4 v[2][4]; float ss[2];
#pragma unroll
        for (int u = 0; u < 2; ++u) {
            const int r = r0 + u * nw < nrows ? r0 + u * nw : r0;
            const float* s = r < PR ? srcP + (size_t)r * 1024 : srcS + (size_t)(r - PR) * 1024;
#pragma unroll
            for (int i = 0; i < 4; ++i) v[u][i] = *(const f32x4*)(s + i * 256 + lane * 4);
        }
#pragma unroll
        for (int u = 0; u < 2; ++u) {
            float q = 0.f;
#pragma unroll
            for (int i = 0; i < 4; ++i) q += v[u][i][0] * v[u][i][0] + v[u][i][1] * v[u][i][1] + v[u][i][2] * v[u][i][2] + v[u][i][3] * v[u][i][3];
            ss[u] = q;
        }
#pragma unroll
        for (int o = 32; o; o >>= 1) { ss[0] += shx(ss[0], o, lane); ss[1] += shx(ss[1], o, lane); }
#pragma unroll
        for (int u = 0; u < 2; ++u) {
            const int r = r0 + u * nw;
            if (r < nrows) {
                const float rs = __builtin_amdgcn_rsqf(__fadd_rn(__fmul_rn(ss[u], 1.f / 1024.f), 1e-6f));
                if (F32OUT) {
                    float* d = r < PR ? dstP + (size_t)r * 1024 : dstS + (size_t)(r - PR) * 1024;
#pragma unroll
                    for (int i = 0; i < 4; ++i) __builtin_nontemporal_store(v[u][i] * rs * g[i], (f32x4*)(d + i * 256 + lane * 4));
                } else {
                    bf16_t* d = dstb + (size_t)r * 1024;
#pragma unroll
                    for (int i = 0; i < 4; ++i) *(u32x2*)(d + i * 256 + lane * 4) = pack4(v[u][i] * rs * g[i]);
                }
            }
        }
    }
}

DEVI void cast_ss_phase(const float* srcP, const float* srcS, bf16_t* xb, float* ss) {
    const int tid = tid_(); const int lane = tid & 63, wave = bid_() * 8 + (tid >> 6), nw = nblk_() * 8;
    for (int r = wave; r < TR; r += nw) {
        const float* s = r < PR ? srcP + (size_t)r * 1024 : srcS + (size_t)(r - PR) * 1024;
        f32x4 v[4]; float q = 0.f;
#pragma unroll
        for (int i = 0; i < 4; ++i) { v[i] = *(const f32x4*)(s + i * 256 + lane * 4); q += v[i][0] * v[i][0] + v[i][1] * v[i][1] + v[i][2] * v[i][2] + v[i][3] * v[i][3]; }
        q = wave_sum(q, lane);
#pragma unroll
        for (int i = 0; i < 4; ++i) *(u32x2*)(xb + (size_t)r * 1024 + i * 256 + lane * 4) = pack4(v[i]);
        if (lane < 32) ss[(size_t)r * 32 + lane] = lane == 0 ? q : 0.f;
    }
}

DEVI void transpose_phase(LAS unsigned char* lds, const Params& p) {
    LAS float* tile = (LAS float*)lds;
    const int tid = tid_();
    for (int ti = bid_(); ti < p.ntiles; ti += nblk_()) {
        int j = 0;
        while (j + 1 < NJOBS && p.jobs[j + 1].tile0 <= ti) ++j;
        const TJob jb = p.jobs[j];
        const int lt = ti - jb.tile0, ntn = jb.N >> 6, tk = lt / ntn, tn = lt - tk * ntn, k0 = tk * 64, n0 = tn * 64;
        {
            const int kk = tid >> 4, nq = tid & 15;
#pragma unroll
            for (int i = 0; i < 2; ++i) {
                const f32x4 v = __builtin_nontemporal_load((const f32x4*)(jb.src + (size_t)(k0 + kk + 32 * i) * jb.ld + n0 + nq * 4));
                const float gk = jb.gain ? jb.gain[k0 + kk + 32 * i] : 1.f;
#pragma unroll
                for (int c = 0; c < 4; ++c) tile[(kk + 32 * i) * 65 + nq * 4 + c] = v[c] * gk;
            }
        }
        __syncthreads();
        {
            const int n = tid >> 3, kq = tid & 7;
            float f[8];
#pragma unroll
            for (int c = 0; c < 8; ++c) f[c] = tile[(kq * 8 + c) * 65 + n];
            u32x4 o; o.x = cvt_pk_bf16(f[0], f[1]); o.y = cvt_pk_bf16(f[2], f[3]); o.z = cvt_pk_bf16(f[4], f[5]); o.w = cvt_pk_bf16(f[6], f[7]);
            *(u32x4*)(jb.dst + (size_t)(n0 + n) * jb.K + k0 + kq * 8) = o;
        }
        __syncthreads();
    }
}

DEVI void rot_phase(float* rc, float* rs, double c1) {
    const int gt = bid_() * 512 + tid_(), ng = nblk_() * 512;
    for (int i = gt; i < 2049 * 128; i += ng) {
        const int pi = i >> 7, j = i & 127;
        double inv = 1.0, bb = c1; int e = j;
        while (e) { if (e & 1) inv *= bb; bb *= bb; e >>= 1; }
        const double pos = pi == 2048 ? 16384.0 : (double)pi;
        const double ang = pos * inv;
        const double rev = ang * 0.15915494309189534561;
        const float fr_ = (float)(rev - rint(rev));
        rs[i] = __builtin_amdgcn_sinf(fr_);
        rc[i] = __builtin_amdgcn_cosf(fr_);
    }
}

DEVI void dec_phase(float* dec) { for (int i = bid_() * 512 + tid_(); i < 1024; i += nblk_() * 512) { const int r = i >> 7, t = i & 127, h = r & 3; const float l2g = __builtin_amdgcn_logf(1.f - 1.f / (float)(32 << h)); dec[i] = r < 4 ? ex2_(l2g * (float)t) : 0.0625f * ex2_(-l2g * (float)t); } }
DEVI void lsg_phase(const float* lam, float* lsg) { for (int i = bid_() * 512 + tid_(); i < 1024; i += nblk_() * 512) { const float e = exp_(-lam[i]); const float ser = e * (1.f - e * (0.5f - e * (0.33333333f - e * (0.25f - e * 0.2f)))); lsg[i] = e < 0.03f ? -ser : -0.69314718056f * __builtin_amdgcn_logf(1.f + e); } }

DEVI void gate_phase(const bf16_t* o, const bf16_t* big, bf16_t* og) {
    const int tid = tid_(); const int lane = tid & 63, wave = bid_() * 8 + (tid >> 6), nw = nblk_() * 8;
    for (int it0 = wave; it0 < TR * 4; it0 += 4 * nw) {
        u32x4 ov[4], gv[4];
#pragma unroll
        for (int u = 0; u < 4; ++u) {
            const int it = it0 + u * nw < TR * 4 ? it0 + u * nw : it0;
            const int row = it >> 2, h = it & 3;
            ov[u] = *(const u32x4*)(o + (size_t)row * 2048 + h * 512 + lane * 8);
            gv[u] = *(const u32x4*)(big + (size_t)row * 6144 + 4096 + h * 512 + lane * 8);
        }
#pragma unroll
        for (int u = 0; u < 4; ++u) {
            const int it = it0 + u * nw;
            const int row = it >> 2, h = it & 3;
            float of[8], gf[8];
            of[0] = bflo(ov[u].x); of[1] = bfhi(ov[u].x); of[2] = bflo(ov[u].y); of[3] = bfhi(ov[u].y); of[4] = bflo(ov[u].z); of[5] = bfhi(ov[u].z); of[6] = bflo(ov[u].w); of[7] = bfhi(ov[u].w);
            gf[0] = bflo(gv[u].x); gf[1] = bfhi(gv[u].x); gf[2] = bflo(gv[u].y); gf[3] = bfhi(gv[u].y); gf[4] = bflo(gv[u].z); gf[5] = bfhi(gv[u].z); gf[6] = bflo(gv[u].w); gf[7] = bfhi(gv[u].w);
            float ss = 0.f;
#pragma unroll
            for (int c = 0; c < 8; ++c) ss += of[c] * of[c];
            ss = wave_sum(ss, lane);
            const float rs = __builtin_amdgcn_rsqf(__fadd_rn(__fmul_rn(ss, 1.f / 512.f), 1e-6f));
            float y[8];
#pragma unroll
            for (int c = 0; c < 8; ++c) y[c] = gf[c] * sigmoidf_(gf[c]) * of[c] * rs;
            u32x4 w; w.x = cvt_pk_bf16(y[0], y[1]); w.y = cvt_pk_bf16(y[2], y[3]); w.z = cvt_pk_bf16(y[4], y[5]); w.w = cvt_pk_bf16(y[6], y[7]);
            if (it < TR * 4) *(u32x4*)(og + (size_t)row * 2048 + h * 512 + lane * 8) = w;
        }
    }
}

DEVI void unpack8(u32x4 v, float* f) { f[0] = bflo(v.x); f[1] = bfhi(v.x); f[2] = bflo(v.y); f[3] = bfhi(v.y); f[4] = bflo(v.z); f[5] = bfhi(v.z); f[6] = bflo(v.w); f[7] = bfhi(v.w); }

DEVI void ffn_gate_phase(const bf16_t* big, bf16_t* y, const float* cw, const float* cb, const float* sbuf  , float* outp  , float* outs  ) {
    const int gt = bid_() * 512 + tid_(), ng = nblk_() * 512;
    for (int it = gt; it < 256 * 384 + SR * 384; it += ng) {
        const bool smp = it >= 256 * 384;
        const int li = smp ? it - 256 * 384 : it;
        const int seg = li / 384, c = (li - seg * 384) * 8;
        float w0[8], w1[8], w2[8], bb[8];
#pragma unroll
        for (int k = 0; k < 8; k += 4) {
            const f32x4 a0 = *(const f32x4*)(cw + c + k), a1 = *(const f32x4*)(cw + 3072 + c + k), a2 = *(const f32x4*)(cw + 6144 + c + k), a3 = *(const f32x4*)(cb + c + k);
#pragma unroll
            for (int j = 0; j < 4; ++j) { w0[k + j] = a0[j]; w1[k + j] = a1[j]; w2[k + j] = a2[j]; bb[k + j] = a3[j]; }
        }
        float u1[8], u2[8];
        if (!smp) {
            const int row0 = seg * 64, t0 = row0 & 2047;
            if (t0 > 0) { unpack8(*(const u32x4*)(big + (size_t)(row0 - 1) * 6144 + c), u1); unpack8(*(const u32x4*)(big + (size_t)(row0 - 2) * 6144 + c), u2); }
            else {
#pragma unroll
                for (int k = 0; k < 8; ++k) { u1[k] = 0.f; u2[k] = 0.f; }
            }
#pragma unroll 8
            for (int r = 0; r < 64; ++r) {
                const size_t row = (size_t)row0 + r;
                float u0[8], gg[8], o[8];
                unpack8(*(const u32x4*)(big + row * 6144 + c), u0);
                unpack8(*(const u32x4*)(big + row * 6144 + 3072 + c), gg);
#pragma unroll
                for (int k = 0; k < 8; ++k) { const float uc = bb[k] + u2[k] * w0[k] + u1[k] * w1[k] + u0[k] * w2[k]; o[k] = gelu_tanh(uc) * gg[k]; }
                u32x4 w; w.x = cvt_pk_bf16(o[0], o[1]); w.y = cvt_pk_bf16(o[2], o[3]); w.z = cvt_pk_bf16(o[4], o[5]); w.w = cvt_pk_bf16(o[6], o[7]);
                *(u32x4*)(y + row * 3072 + c) = w;
                if (t0 + r >= 2046) { float* q = outp + ((size_t)(row >> 11) * 2 + (t0 + r - 2046)) * 3072 + c; *(f32x4*)q = (f32x4){u0[0], u0[1], u0[2], u0[3]}; *(f32x4*)(q + 4) = (f32x4){u0[4], u0[5], u0[6], u0[7]}; }
#pragma unroll
                for (int k = 0; k < 8; ++k) { u2[k] = u1[k]; u1[k] = u0[k]; }
            }
        } else {
            const int sb = seg; const size_t row = (size_t)PR + sb;
            float u0[8], gg[8], o[8];
            unpack8(*(const u32x4*)(big + row * 6144 + c), u0);
            unpack8(*(const u32x4*)(big + row * 6144 + 3072 + c), gg);
            const float* b0 = sbuf + ((size_t)sb * 2 + 0) * 3072 + c; const float* b1 = b0 + 3072;
            const f32x4 p0 = *(const f32x4*)b0, p1 = *(const f32x4*)(b0 + 4), q0 = *(const f32x4*)b1, q1 = *(const f32x4*)(b1 + 4);
#pragma unroll
            for (int k = 0; k < 4; ++k) { u2[k] = p0[k]; u2[4 + k] = p1[k]; u1[k] = q0[k]; u1[4 + k] = q1[k]; }
            float* q = outs + ((size_t)sb * 2) * 3072 + c;
            *(f32x4*)q = q0; *(f32x4*)(q + 4) = q1;
            *(f32x4*)(q + 3072) = (f32x4){u0[0], u0[1], u0[2], u0[3]}; *(f32x4*)(q + 3072 + 4) = (f32x4){u0[4], u0[5], u0[6], u0[7]};
#pragma unroll
            for (int k = 0; k < 8; ++k) { const float uc = bb[k] + u2[k] * w0[k] + u1[k] * w1[k] + u0[k] * w2[k]; o[k] = gelu_tanh(uc) * gg[k]; }
            u32x4 w; w.x = cvt_pk_bf16(o[0], o[1]); w.y = cvt_pk_bf16(o[2], o[3]); w.z = cvt_pk_bf16(o[4], o[5]); w.w = cvt_pk_bf16(o[6], o[7]);
            *(u32x4*)(y + row * 3072 + c) = w;
        }
    }
}

DEVI void ffn_fix_phase(const bf16_t* big, bf16_t* y, const float* cw, const float* cb) {
    const int gt = bid_() * 512 + tid_(), ng = nblk_() * 512;
    for (int it = gt; it < 2048 * 384; it += ng) {
        const int ri = it / 384, c = (it - ri * 384) * 8;
        const int row = (ri >> 1) * 16 + (ri & 1), t = row & 2047;
        float u0[8], u1[8], u2[8], gg[8];
        unpack8(*(const u32x4*)(big + (size_t)row * 6144 + c), u0);
        unpack8(*(const u32x4*)(big + (size_t)row * 6144 + 3072 + c), gg);
        unpack8(*(const u32x4*)(big + (size_t)(t >= 1 ? row - 1 : row) * 6144 + c), u1);
        unpack8(*(const u32x4*)(big + (size_t)(t >= 2 ? row - 2 : row) * 6144 + c), u2);
#pragma unroll
        for (int k = 0; k < 8; ++k) { u1[k] = t >= 1 ? u1[k] : 0.f; u2[k] = t >= 2 ? u2[k] : 0.f; }
        float r[8];
#pragma unroll
        for (int k = 0; k < 8; ++k) {
            const float uc = cb[c + k] + u2[k] * cw[c + k] + u1[k] * cw[3072 + c + k] + u0[k] * cw[6144 + c + k];
            r[k] = gelu_tanh(uc) * gg[k];
        }
        u32x4 w; w.x = cvt_pk_bf16(r[0], r[1]); w.y = cvt_pk_bf16(r[2], r[3]); w.z = cvt_pk_bf16(r[4], r[5]); w.w = cvt_pk_bf16(r[6], r[7]);
        *(u32x4*)(y + (size_t)row * 3072 + c) = w;
    }
}

DEVI void lru_conv_phase(const bf16_t* big, bf16_t* xc, const float* cw, const float* cb, const float* sbuf  , float* outp  , float* outs  ) {
    const int gt = bid_() * 512 + tid_(), ng = nblk_() * 512;
    for (int it = gt; it < 1024 * 128 + SR * 128; it += ng) {
        const bool smp = it >= 1024 * 128;
        const int li = smp ? it - 1024 * 128 : it;
        const int seg = li >> 7, c = (li & 127) * 8;
        float w0[8], w1[8], w2[8], w3[8], bb[8];
#pragma unroll
        for (int k = 0; k < 8; k += 4) {
            const f32x4 a0 = *(const f32x4*)(cw + c + k), a1 = *(const f32x4*)(cw + 1024 + c + k), a2 = *(const f32x4*)(cw + 2048 + c + k), a3 = *(const f32x4*)(cw + 3072 + c + k), a4 = *(const f32x4*)(cb + c + k);
#pragma unroll
            for (int j = 0; j < 4; ++j) { w0[k + j] = a0[j]; w1[k + j] = a1[j]; w2[k + j] = a2[j]; w3[k + j] = a3[j]; bb[k + j] = a4[j]; }
        }
        if (!smp) {
            const int row0 = seg * 16, t0 = row0 & 2047;
            u32x4 raw[19];
#pragma unroll
            for (int r = 0; r < 19; ++r) {
                const int rr = (t0 == 0 && r < 3) ? row0 : row0 - 3 + r;
                raw[r] = *(const u32x4*)(big + (size_t)rr * 2048 + c);
            }
            float x1[8], x2[8], x3[8];
            if (t0 > 0) { unpack8(raw[0], x3); unpack8(raw[1], x2); unpack8(raw[2], x1); }
            else {
#pragma unroll
                for (int k = 0; k < 8; ++k) { x1[k] = 0.f; x2[k] = 0.f; x3[k] = 0.f; }
            }
#pragma unroll
            for (int r = 0; r < 16; ++r) {
                const size_t row = (size_t)row0 + r;
                float x0[8], o[8];
                unpack8(raw[3 + r], x0);
#pragma unroll
                for (int k = 0; k < 8; ++k) o[k] = bb[k] + x3[k] * w0[k] + x2[k] * w1[k] + x1[k] * w2[k] + x0[k] * w3[k];
                u32x4 w; w.x = cvt_pk_bf16(o[0], o[1]); w.y = cvt_pk_bf16(o[2], o[3]); w.z = cvt_pk_bf16(o[4], o[5]); w.w = cvt_pk_bf16(o[6], o[7]);
                *(u32x4*)(xc + row * 1024 + c) = w;
                if (t0 + r >= 2045) { float* q = outp + ((size_t)(row >> 11) * 3 + (t0 + r - 2045)) * 1024 + c; *(f32x4*)q = (f32x4){x0[0], x0[1], x0[2], x0[3]}; *(f32x4*)(q + 4) = (f32x4){x0[4], x0[5], x0[6], x0[7]}; }
#pragma unroll
                for (int k = 0; k < 8; ++k) { x3[k] = x2[k]; x2[k] = x1[k]; x1[k] = x0[k]; }
            }
        } else {
            const int sb = seg; const size_t row = (size_t)PR + sb;
            float x0[8], x1[8], x2[8], x3[8], o[8];
            unpack8(*(const u32x4*)(big + row * 2048 + c), x0);
            const float* b0 = sbuf + (size_t)sb * 3 * 1024 + c;
            float* q = outs + (size_t)sb * 3 * 1024 + c;
#pragma unroll
            for (int k = 0; k < 8; k += 4) {
                const f32x4 p3 = *(const f32x4*)(b0 + k), p2 = *(const f32x4*)(b0 + 1024 + k), p1 = *(const f32x4*)(b0 + 2048 + k);
#pragma unroll
                for (int j = 0; j < 4; ++j) { x3[k + j] = p3[j]; x2[k + j] = p2[j]; x1[k + j] = p1[j]; }
                *(f32x4*)(q + k) = p2; *(f32x4*)(q + 1024 + k) = p1; *(f32x4*)(q + 2048 + k) = (f32x4){x0[k], x0[k + 1], x0[k + 2], x0[k + 3]};
            }
#pragma unroll
            for (int k = 0; k < 8; ++k) o[k] = bb[k] + x3[k] * w0[k] + x2[k] * w1[k] + x1[k] * w2[k] + x0[k] * w3[k];
            u32x4 w; w.x = cvt_pk_bf16(o[0], o[1]); w.y = cvt_pk_bf16(o[2], o[3]); w.z = cvt_pk_bf16(o[4], o[5]); w.w = cvt_pk_bf16(o[6], o[7]);
            *(u32x4*)(xc + row * 1024 + c) = w;
        }
    }
}

DEVI void scan1_phase(const float* aa, const float* uu, float* chs  ) {
    const int gt = bid_() * 512 + tid_(), ng = nblk_() * 512;
    for (int it = gt; it < 8 * 64 * 256; it += ng) {
        const int c = (it & 255) * 4, ck = (it >> 8) & 63, b = it >> 14;
        const size_t base = ((size_t)b * 2048 + ck * 32) * 1024 + c;
        f32x4 ap = (f32x4){1.f, 1.f, 1.f, 1.f}, h = (f32x4){0.f, 0.f, 0.f, 0.f};
#pragma unroll 8
        for (int t = 0; t < 32; ++t) { const f32x4 a = *(const f32x4*)(aa + base + (size_t)t * 1024), u = *(const f32x4*)(uu + base + (size_t)t * 1024); h = a * h + u; ap *= a; }
        float* o = chs + ((size_t)(b * 64 + ck) * 1024 + c) * 2;
        *(f32x4*)o = (f32x4){ap[0], h[0], ap[1], h[1]}; *(f32x4*)(o + 4) = (f32x4){ap[2], h[2], ap[3], h[3]};
    }
}
DEVI void scan2_phase(const float* aa, const float* uu, const float* chs, const bf16_t* big, bf16_t* yl, float* hout  ) {
    const int gt = bid_() * 512 + tid_(), ng = nblk_() * 512;
    for (int it = gt; it < 8 * 64 * 256; it += ng) {
        const int c = (it & 255) * 4, ck = (it >> 8) & 63, b = it >> 14;
        f32x4 h = (f32x4){0.f, 0.f, 0.f, 0.f};
        for (int k = 0; k < ck; ++k) {
            const float* ci = chs + ((size_t)(b * 64 + k) * 1024 + c) * 2;
            const f32x4 p0 = *(const f32x4*)ci, p1 = *(const f32x4*)(ci + 4);
            h[0] = p0[0] * h[0] + p0[1]; h[1] = p0[2] * h[1] + p0[3]; h[2] = p1[0] * h[2] + p1[1]; h[3] = p1[2] * h[3] + p1[3];
        }
        const size_t row0 = (size_t)b * 2048 + ck * 32;
#pragma unroll 8
        for (int t = 0; t < 32; ++t) {
            const size_t row = row0 + t;
            h = *(const f32x4*)(aa + row * 1024 + c) * h + *(const f32x4*)(uu + row * 1024 + c);
            const u32x2 gp = *(const u32x2*)(big + row * 2048 + 1024 + c);
            f32x4 y; y[0] = gelu_tanh(bflo(gp.x)) * h[0]; y[1] = gelu_tanh(bfhi(gp.x)) * h[1]; y[2] = gelu_tanh(bflo(gp.y)) * h[2]; y[3] = gelu_tanh(bfhi(gp.y)) * h[3];
            *(u32x2*)(yl + row * 1024 + c) = pack4(y);
        }
        if (ck == 63) *(f32x4*)(hout + b * 1024 + c) = h;
    }
}

DEVI void retention_prompt_phase(LAS unsigned char* lds, const bf16_t* big, const bf16_t* ktg, const bf16_t* vtg, bf16_t* og, float* sout  , const float* dec,
                                 const bool fuse, const float* sin_, float* sout_s) {
    constexpr int KS_STR = 528, VT_STR = 272, ST_STR = 528, AT_STR = 272;
    constexpr int KS_OFF = 0, VT_OFF = 128 * KS_STR, ST_OFF = VT_OFF + 64 * VT_STR, AT_OFF = ST_OFF + 64 * ST_STR;
    const int tid = tid_(), w = tid >> 6, lane = tid & 63, fr = lane & 15, fq = lane >> 4;
    LAS unsigned char* att = lds + AT_OFF + w * (16 * AT_STR);
    for (int it = bid_(); it < 256; it += nblk_()) {
        const int b = it >> 5, h = (it >> 3) & 3, es = it & 7;
        const float gam = 1.f - 1.f / (float)(32 << h), gam127 = dec[h * 128 + 127];
        f32x4 sacc[2][4];
#pragma unroll
        for (int a = 0; a < 2; ++a)
#pragma unroll
            for (int e = 0; e < 4; ++e) sacc[a][e] = (f32x4){0.f, 0.f, 0.f, 0.f};
        __syncthreads();
        { const unsigned z = zv_(); for (int i = tid; i < 64 * ST_STR / 16; i += 512) *(LAS u32x4*)(lds + ST_OFF + i * 16) = (u32x4){z, z, z, z}; }
        f32x4 o4s = (f32x4){0.f, 0.f, 0.f, 0.f};
        u32x4 pk[8], pv[2];
        {   const bf16_t* src = big + ((size_t)b * 2048 + (tid >> 5)) * 6144 + 1024 + h * 256 + (tid & 31) * 8;
#pragma unroll
            for (int i = 0; i < 8; ++i) pk[i] = *(const u32x4*)(src + (size_t)i * 16 * 6144);
            const bf16_t* vsrc = vtg + ((size_t)(b * 4 + h) * 512 + es * 64 + (tid >> 4)) * 2048 + (tid & 15) * 8;
#pragma unroll
            for (int i = 0; i < 2; ++i) pv[i] = *(const u32x4*)(vsrc + (size_t)i * 32 * 2048);
        }
        for (int n = 0; n < 16; ++n) {
            const size_t row0 = (size_t)b * 2048 + n * 128;
            __syncthreads();
            f32x4 sv[8]; size_t s_base = 0; int s_sb = 0, s_h = 0, s_eq = 0;
            if (fuse) {
                const int sit = it * 8 + (n >> 1);
                s_sb = sit >> 4; s_h = (sit >> 2) & 3; s_eq = sit & 3;
                s_base = ((size_t)(s_sb * 4 + s_h) * 256) * 512 + s_eq * 128 + (tid & 31) * 4 + (size_t)(8 * (tid >> 5) + 128 * (n & 1)) * 512;
#pragma unroll
                for (int i = 0; i < 8; ++i) sv[i] = __builtin_nontemporal_load((const f32x4*)(sin_ + s_base + (size_t)i * 512));
            }
            {
                LAS unsigned char* dst = lds + KS_OFF + (tid >> 5) * KS_STR + (tid & 31) * 16;
#pragma unroll
                for (int i = 0; i < 8; ++i) *(LAS u32x4*)(dst + i * 16 * KS_STR) = pk[i];
                LAS unsigned char* vdst = lds + VT_OFF + (tid >> 4) * VT_STR + (tid & 15) * 16;
#pragma unroll
                for (int i = 0; i < 2; ++i) *(LAS u32x4*)(vdst + i * 32 * VT_STR) = pv[i];
            }
            bf16x8 qf[8];
#pragma unroll
            for (int ks = 0; ks < 8; ++ks) qf[ks] = *(const bf16x8*)(big + (row0 + 16 * w + fr) * 6144 + h * 256 + ks * 32 + fq * 8);
            __syncthreads();
            {   const int nn = n + 1 < 16 ? n + 1 : n;
                const bf16_t* src = big + ((size_t)b * 2048 + nn * 128 + (tid >> 5)) * 6144 + 1024 + h * 256 + (tid & 31) * 8;
#pragma unroll
                for (int i = 0; i < 8; ++i) pk[i] = *(const u32x4*)(src + (size_t)i * 16 * 6144);
                const bf16_t* vsrc = vtg + ((size_t)(b * 4 + h) * 512 + es * 64 + (tid >> 4)) * 2048 + nn * 128 + (tid & 15) * 8;
#pragma unroll
                for (int i = 0; i < 2; ++i) pv[i] = *(const u32x4*)(vsrc + (size_t)i * 32 * 2048);
            }
            for (int jt = 0; jt <= w; ++jt) {
                f32x4 acc = (f32x4){0.f, 0.f, 0.f, 0.f};
#pragma unroll
                for (int ks = 0; ks < 8; ++ks) {
                    const bf16x8 kf = *(const LAS bf16x8*)(lds + KS_OFF + (jt * 16 + fr) * KS_STR + ks * 64 + fq * 16);
                    acc = mfma16(kf, qf[ks], acc);
                }
                if (jt == w) {
#pragma unroll
                    for (int r = 0; r < 4; ++r) if (fq * 4 + r > fr) acc[r] = 0.f;
                }
                *(LAS u32x2*)(att + fr * AT_STR + (jt * 16 + fq * 4) * 2) = pack4(acc);
            }
            if ((w & 1) == 0) { const unsigned z = zv_(); *(LAS u32x2*)(att + fr * AT_STR + ((w + 1) * 16 + fq * 4) * 2) = (u32x2){z, z}; }
            __builtin_amdgcn_fence(__ATOMIC_SEQ_CST, "wavefront"); asm volatile("s_waitcnt lgkmcnt(0)" ::: "memory"); __builtin_amdgcn_wave_barrier();
#pragma unroll
            for (int et = 0; et < 4; ++et) {
                f32x4 ao = (f32x4){0.f, 0.f, 0.f, 0.f}, ac = (f32x4){0.f, 0.f, 0.f, 0.f};
                for (int js = 0; js <= (w >> 1); ++js) {
                    const bf16x8 af = *(const LAS bf16x8*)(att + fr * AT_STR + js * 64 + fq * 16);
                    const bf16x8 vf = *(const LAS bf16x8*)(lds + VT_OFF + (et * 16 + fr) * VT_STR + js * 64 + fq * 16);
                    ao = mfma16(vf, af, ao);
                }
#pragma unroll
                for (int ks = 0; ks < 8; ++ks) {
                    const bf16x8 sf = *(const LAS bf16x8*)(lds + ST_OFF + (et * 16 + fr) * ST_STR + ks * 64 + fq * 16);
                    ac = mfma16(sf, qf[ks], ac);
                }
                const f32x4 o = ao + ac * gam;
                *(u32x2*)(og + (row0 + 16 * w + fr) * 2048 + h * 512 + es * 64 + et * 16 + fq * 4) = pack4(o);
            }
#pragma unroll
            for (int a = 0; a < 2; ++a)
#pragma unroll
                for (int e = 0; e < 4; ++e) sacc[a][e] *= gam;
#pragma unroll
            for (int js = 0; js < 4; ++js) {
                bf16x8 kf[2];
#pragma unroll
                for (int a = 0; a < 2; ++a) kf[a] = *(const bf16x8*)(ktg + ((size_t)(b * 4 + h) * 256 + 32 * w + a * 16 + fr) * 2048 + n * 128 + js * 32 + fq * 8);
#pragma unroll
                for (int e = 0; e < 4; ++e) {
                    const bf16x8 vf = *(const LAS bf16x8*)(lds + VT_OFF + (e * 16 + fr) * VT_STR + js * 64 + fq * 16);
#pragma unroll
                    for (int a = 0; a < 2; ++a) sacc[a][e] = mfma16(kf[a], vf, sacc[a][e]);
                }
            }
#pragma unroll
            for (int a = 0; a < 2; ++a)
#pragma unroll
                for (int e = 0; e < 4; ++e) sacc[a][e] *= gam127;
            if (fuse) {
                const size_t srow = (size_t)PR + s_sb;
                const bf16_t* qp = big + srow * 6144 + s_h * 256 + 8 * (tid >> 5) + 128 * (n & 1);
                float qd8[8], kd8[8];
                unpack8(*(const u32x4*)qp, qd8); unpack8(*(const u32x4*)(qp + 1024), kd8);
                const u32x2 vp = *(const u32x2*)(big + srow * 6144 + 2048 + s_h * 512 + s_eq * 128 + (tid & 31) * 4);
                const f32x4 v4 = (f32x4){bflo(vp.x), bfhi(vp.x), bflo(vp.y), bfhi(vp.y)};
                const float sgam = 1.f - 1.f / (float)(32 << s_h);
                if ((n & 1) == 0) o4s = (f32x4){0.f, 0.f, 0.f, 0.f};
#pragma unroll
                for (int i = 0; i < 8; ++i) {
                    const f32x4 sn = sv[i] * sgam + v4 * kd8[i];
                    __builtin_nontemporal_store(sn, (f32x4*)(sout_s + s_base + (size_t)i * 512));
                    o4s += sn * qd8[i];
                }
                if (n & 1) *(LAS f32x4*)(lds + 153616 + tid * 16) = o4s;
            }
            __syncthreads();
            if (fuse && (n & 1) && tid < 32) {
                f32x4 sm = *(const LAS f32x4*)(lds + 153616 + tid * 16);
#pragma unroll
                for (int k = 1; k < 16; ++k) sm += *(const LAS f32x4*)(lds + 153616 + (k * 32 + tid) * 16);
                *(u32x2*)(og + ((size_t)PR + s_sb) * 2048 + s_h * 512 + s_eq * 128 + tid * 4) = pack4(sm);
            }
#pragma unroll
            for (int a = 0; a < 2; ++a)
#pragma unroll
                for (int e = 0; e < 4; ++e)
                    *(LAS u32x2*)(lds + ST_OFF + (e * 16 + fr) * ST_STR + (32 * w + a * 16 + fq * 4) * 2) = pack4(sacc[a][e]);
        }
#pragma unroll
        for (int a = 0; a < 2; ++a)
#pragma unroll
            for (int e = 0; e < 4; ++e)
#pragma unroll
                for (int r = 0; r < 4; ++r)
                    __builtin_nontemporal_store(sacc[a][e][r], sout + ((size_t)(b * 4 + h) * 256 + 32 * w + a * 16 + fq * 4 + r) * 512 + es * 64 + e * 16 + fr);
    }
}

DEVI void retention_sample_phase(LAS unsigned char* lds, const bf16_t* big, const float* sin_, float* sout, bf16_t* og) {
    const int tid = tid_(), ec = tid & 31, dr = tid >> 5;
    LAS float* red = (LAS float*)lds;
    for (int it = bid_(); it < 128 * 4 * 4; it += nblk_()) {
        const int sb = it >> 4, h = (it >> 2) & 3, eq = it & 3;
        const float gam = 1.f - 1.f / (float)(32 << h);
        const size_t row = (size_t)PR + sb;
        const bf16_t* qp = big + row * 6144 + h * 256;
        const bf16_t* kp = qp + 1024;
        const u32x2 vp = *(const u32x2*)(big + row * 6144 + 2048 + h * 512 + eq * 128 + ec * 4);
        const f32x4 v4 = (f32x4){bflo(vp.x), bfhi(vp.x), bflo(vp.y), bfhi(vp.y)};
        const size_t sbase = ((size_t)(sb * 4 + h) * 256) * 512 + eq * 128 + ec * 4;
        f32x4 o4 = (f32x4){0.f, 0.f, 0.f, 0.f};
#pragma unroll
        for (int i = 0; i < 16; ++i) {
            const int d = dr + 16 * i;
            const f32x4 s = *(const f32x4*)(sin_ + sbase + (size_t)d * 512);
            const float kd = bf2f(kp[d]), qd = bf2f(qp[d]);
            const f32x4 sn = s * gam + v4 * kd;
            *(f32x4*)(sout + sbase + (size_t)d * 512) = sn;
            o4 += sn * qd;
        }
        __syncthreads();
        *(LAS f32x4*)(red + (dr * 32 + ec) * 4) = o4;
        __syncthreads();
        if (tid < 32) {
            f32x4 s = (f32x4){0.f, 0.f, 0.f, 0.f};
#pragma unroll
            for (int k = 0; k < 16; ++k) s += *(const LAS f32x4*)(red + (k * 32 + tid) * 4);
            *(u32x2*)(og + row * 2048 + h * 512 + eq * 128 + tid * 4) = pack4(s);
        }
    }
}

DEVI void xattn_prompt_phase(LAS unsigned char* lds, const bf16_t* qx, const bf16_t* mk  , const bf16_t* mvt  , bf16_t* ao) {
    constexpr int STR = 528;
    const int tid = tid_(), w = tid >> 6, lane = tid & 63, fr = lane & 15, fq = lane >> 4;
    for (int it = bid_(); it < 512; it += nblk_()) {
        const int b = it >> 6, h = (it >> 4) & 3, qt = it & 15;
        const size_t row = (size_t)b * 2048 + qt * 128 + 16 * w + fr;
        __syncthreads();
        {   const int m0 = tid >> 5, dq = tid & 31;
            const bf16_t* src = mk + ((size_t)b * 256 + m0) * 1024 + h * 256 + dq * 8;
            LAS unsigned char* dst = lds + m0 * STR + dq * 16;
#pragma unroll
            for (int i = 0; i < 16; ++i) *(LAS u32x4*)(dst + i * 16 * STR) = *(const u32x4*)(src + (size_t)i * 16 * 1024);
        }
        bf16x8 qf[8];
#pragma unroll
        for (int ks = 0; ks < 8; ++ks) qf[ks] = *(const bf16x8*)(qx + row * 1024 + h * 256 + ks * 32 + fq * 8);
        __syncthreads();
        bf16x8 pf[8];
        float hmx[2], hsum[2];
        const float sc = 0.0625f * 1.4426950408889634f;
#pragma unroll
        for (int hf = 0; hf < 2; ++hf) {
            f32x4 s[8];
#pragma unroll
            for (int mt = 0; mt < 8; ++mt) {
                f32x4 acc = (f32x4){0.f, 0.f, 0.f, 0.f};
#pragma unroll
                for (int ks = 0; ks < 8; ++ks) {
                    const bf16x8 kf = *(const LAS bf16x8*)(lds + ((hf * 8 + mt) * 16 + fr) * STR + ks * 64 + fq * 16);
                    acc = mfma16(kf, qf[ks], acc);
                }
                s[mt] = acc;
                __builtin_amdgcn_sched_barrier(0);
            }
            float mx = -3.0e38f;
#pragma unroll
            for (int mt = 0; mt < 8; ++mt)
#pragma unroll
                for (int r = 0; r < 4; ++r) mx = fmaxf(mx, s[mt][r]);
            mx = fmaxf(mx, shx(mx, 16, lane)); mx = fmaxf(mx, shx(mx, 32, lane));
            float sum = 0.f;
#pragma unroll
            for (int mt = 0; mt < 8; ++mt)
#pragma unroll
                for (int r = 0; r < 4; ++r) { const float e = ex2_((s[mt][r] - mx) * sc); s[mt][r] = e; sum += e; }
            sum += shx(sum, 16, lane); sum += shx(sum, 32, lane);
            hmx[hf] = mx; hsum[hf] = sum;
#pragma unroll
            for (int ms = 0; ms < 4; ++ms) {
                u32x4 u; u.x = cvt_pk_bf16(s[2 * ms][0], s[2 * ms][1]); u.y = cvt_pk_bf16(s[2 * ms][2], s[2 * ms][3]);
                u.z = cvt_pk_bf16(s[2 * ms + 1][0], s[2 * ms + 1][1]); u.w = cvt_pk_bf16(s[2 * ms + 1][2], s[2 * ms + 1][3]);
                pf[hf * 4 + ms] = __builtin_bit_cast(bf16x8, u);
            }
        }
        const float mxa = fmaxf(hmx[0], hmx[1]);
        float al0 = ex2_((hmx[0] - mxa) * sc), al1 = ex2_((hmx[1] - mxa) * sc);
        const float inv = rcp_(hsum[0] * al0 + hsum[1] * al1);
        al0 *= inv; al1 *= inv;
        __syncthreads();
        {   const int d0 = tid >> 5, mq = tid & 31;
            const bf16_t* src = mvt + ((size_t)(b * 4 + h) * 256 + d0) * 256 + mq * 8;
            LAS unsigned char* dst = lds + d0 * STR + mq * 16;
#pragma unroll
            for (int i = 0; i < 16; ++i) *(LAS u32x4*)(dst + i * 16 * STR) = *(const u32x4*)(src + (size_t)i * 16 * 256);
        }
        __syncthreads();
#pragma unroll 2
        for (int dt = 0; dt < 16; ++dt) {
            f32x4 acc0 = (f32x4){0.f, 0.f, 0.f, 0.f}, acc1 = acc0;
#pragma unroll
            for (int ms = 0; ms < 8; ++ms) {
                const u32x2 lo = *(const LAS u32x2*)(lds + (dt * 16 + fr) * STR + (ms * 32 + fq * 4) * 2);
                const u32x2 hi = *(const LAS u32x2*)(lds + (dt * 16 + fr) * STR + (ms * 32 + 16 + fq * 4) * 2);
                u32x4 u; u.x = lo.x; u.y = lo.y; u.z = hi.x; u.w = hi.y;
                if (ms < 4) acc0 = mfma16(__builtin_bit_cast(bf16x8, u), pf[ms], acc0);
                else acc1 = mfma16(__builtin_bit_cast(bf16x8, u), pf[ms], acc1);
            }
            *(u32x2*)(ao + row * 1024 + h * 256 + dt * 16 + fq * 4) = pack4(acc0 * al0 + acc1 * al1);
        }
    }
}

DEVI void xattn_sample_phase(LAS unsigned char* lds, const bf16_t* qx, const float* ck, const float* cv, bf16_t* ao) {
    const int tid = tid_(), w = tid >> 6, lane = tid & 63;
    LAS float* sc = (LAS float*)lds;
    LAS float* red = (LAS float*)(lds + 2048);
    for (int it = bid_(); it < 512; it += nblk_()) {
        const int sb = it >> 2, h = it & 3;
        const size_t row = (size_t)PR + sb;
        const u32x2 qp = *(const u32x2*)(qx + row * 1024 + h * 256 + lane * 4);
        const f32x4 q4 = (f32x4){bflo(qp.x), bfhi(qp.x), bflo(qp.y), bfhi(qp.y)};
        const size_t base = ((size_t)sb * 256 * 4 + h) * 256 + lane * 4;
        __syncthreads();
#pragma unroll 16
        for (int i = 0; i < 32; ++i) {
            const int m = w + 8 * i;
            const f32x4 k4 = __builtin_nontemporal_load((const f32x4*)(ck + base + (size_t)m * 1024));
            float d = k4[0] * q4[0] + k4[1] * q4[1] + k4[2] * q4[2] + k4[3] * q4[3];
            d = wave_sum(d, lane);
            if (lane == 0) sc[m] = d * 0.0625f;
        }
        __syncthreads();
        float mx = -3.0e38f;
        for (int m = lane; m < 256; m += 64) mx = fmaxf(mx, sc[m]);
#pragma unroll
        for (int o = 32; o; o >>= 1) mx = fmaxf(mx, shx(mx, o, lane));
        float sum = 0.f;
        for (int m = lane; m < 256; m += 64) sum += exp_(sc[m] - mx);
        sum = wave_sum(sum, lane);
        const float inv = rcp_(sum);
        f32x4 o4 = (f32x4){0.f, 0.f, 0.f, 0.f};
#pragma unroll 16
        for (int i = 0; i < 32; ++i) {
            const int m = w + 8 * i;
            const float pm = exp_(sc[m] - mx) * inv;
            const f32x4 v4 = __builtin_nontemporal_load((const f32x4*)(cv + base + (size_t)m * 1024));
            o4 += v4 * pm;
        }
        *(LAS f32x4*)(red + (w * 64 + lane) * 4) = o4;
        __syncthreads();
        if (tid < 64) {
            f32x4 s = (f32x4){0.f, 0.f, 0.f, 0.f};
#pragma unroll
            for (int k = 0; k < 8; ++k) s += *(const LAS f32x4*)(red + (k * 64 + tid) * 4);
            *(u32x2*)(ao + row * 1024 + h * 256 + tid * 4) = pack4(s);
        }
    }
}

#define XB_TMO      128
#define XB_XCNT(j)  (256  + 64 * (j))
#define XB_XSUB(j)  (1280 + 64 * (j))
#define XB_XGEN(j)  (2304 + 64 * (j))
#define XB_TOP      3328
#define XB_TOPGEN   3392
#define XCD_BAR_WORDS 3456
#define XB_SPIN_CAP (1u << 18)
DEVI unsigned xb_ld(unsigned* p)              { return __hip_atomic_load(p, __ATOMIC_RELAXED, __HIP_MEMORY_SCOPE_AGENT); }
DEVI unsigned xb_add(unsigned* p, unsigned v) { return __hip_atomic_fetch_add(p, v, __ATOMIC_RELAXED, __HIP_MEMORY_SCOPE_AGENT); }
DEVI unsigned xb_xcc_id() { return (unsigned)__builtin_amdgcn_s_getreg((3 << 11) | 20) & 0xFu; }
#define XB_SPIN(cond, bar) do { unsigned _sp = 0; while (cond) { __builtin_amdgcn_s_sleep(1); \
    if ((++_sp & 255u) == 0u) { if (xb_ld(&(bar)[XB_TMO])) break; if (_sp > XB_SPIN_CAP) { atomicAdd(&(bar)[XB_TMO], 1u); break; } } } } while (0)
struct XcdBarrier { unsigned* bar; unsigned x; volatile LAS unsigned* st; };
DEVI XcdBarrier xcd_barrier_post(unsigned* bar, volatile LAS unsigned* st) {
    XcdBarrier b; b.bar = bar; b.x = xb_xcc_id(); b.st = st;
    if (threadIdx.x == 0) (void)xb_add(&bar[XB_XCNT(b.x)], 1u);
    return b;
}
DEVI void xcd_barrier_complete(unsigned* bar, unsigned x, unsigned& nloc, unsigned& nx) {
    const unsigned G = gridDim.x * gridDim.y * gridDim.z;
    unsigned sum, cnt, mine, sp = 0u;
    for (;;) {
        sum = 0u; cnt = 0u; mine = 0u;
#pragma unroll
        for (unsigned j = 0; j < 16; ++j) { const unsigned c = xb_ld(&bar[XB_XCNT(j)]); sum += c; cnt += (c > 0u) ? 1u : 0u; mine = (j == x) ? c : mine; }
        if (sum == G) break;
        __builtin_amdgcn_s_sleep(1);
        if ((++sp & 255u) == 0u) { if (xb_ld(&bar[XB_TMO])) break; if (sp > XB_SPIN_CAP) { atomicAdd(&bar[XB_TMO], 1u); break; } }
    }
    nloc = mine > 0u ? mine : 1u; nx = cnt > 0u ? cnt : 1u;
}
DEVI void xcd_barrier(const XcdBarrier& b) {
    asm volatile("s_waitcnt vmcnt(0)" ::: "memory");
    __syncthreads();
    if (threadIdx.x == 0) {
        unsigned* bar = b.bar;
        __builtin_amdgcn_s_waitcnt(0);
        unsigned nloc = b.st[0], nx = b.st[1];
        if (nloc == 0u) { xcd_barrier_complete(bar, b.x, nloc, nx); b.st[0] = nloc; b.st[1] = nx; }
        const unsigned old = xb_add(&bar[XB_XSUB(b.x)], 1u);
        const unsigned gen = old / nloc;
        if (old + 1u == (gen + 1u) * nloc) {
            __builtin_amdgcn_fence(__ATOMIC_RELEASE, "agent");
            asm volatile("s_waitcnt vmcnt(0)" ::: "memory");
            const unsigned og = xb_add(&bar[XB_TOP], 1u);
            const unsigned tg = og / nx;
            if (og + 1u == (tg + 1u) * nx) xb_add(&bar[XB_TOPGEN], 1u);
            else XB_SPIN(xb_ld(&bar[XB_TOPGEN]) == tg, bar);
            __builtin_amdgcn_fence(__ATOMIC_ACQUIRE, "agent");
            xb_add(&bar[XB_XGEN(b.x)], 1u);
            asm volatile("s_waitcnt vmcnt(0)" ::: "memory");
        } else {
            XB_SPIN(xb_ld(&bar[XB_XGEN(b.x)]) == gen, bar);
            __builtin_amdgcn_fence(__ATOMIC_ACQUIRE, "agent");
            asm volatile("s_waitcnt vmcnt(0)" ::: "memory");
        }
    }
    __syncthreads();
}

enum { K_PREP = 0, K_RETIN, K_RET, K_GATE, K_RESID, K_NORM, K_BF16, K_XATTN, K_FFNGATE, K_LRUCONV, K_LRU, K_SCAN1, K_SCAN2, K_NORMF };
constexpr int NPH = 24;
struct Step { int kind, L, lda, N, K, ldo, ssi; const bf16_t* A; const bf16_t* Bt; bf16_t* ob; const float* rinP; const float* rinS; };

template <int ONLY>
__global__ void __launch_bounds__(512) mega(Params p, int lo, int hi) {
    extern __shared__ __attribute__((aligned(16))) unsigned char shm[];
    LAS unsigned char* lds = (LAS unsigned char*)shm;
    cg::grid_group grid = cg::this_grid();
#define WS_ ((unsigned char*)p.in[33 + zero_()])
#define OUT_ ((float*)p.in[32 + zero_()])
#define x_prompt (p.in[0 + zero_()])
#define x_sample (p.in[1 + zero_()])
#define state_ret (p.in[2 + zero_()])
#define state_lru_h (p.in[3 + zero_()])
#define state_lru_conv (p.in[4 + zero_()])
#define state_ffn_conv (p.in[5 + zero_()])
#define cache_k (p.in[6 + zero_()])
#define cache_v (p.in[7 + zero_()])
#define mem_prompt (p.in[8 + zero_()])
#define norm_mix (p.in[9 + zero_()])
#define norm_xa (p.in[10 + zero_()])
#define norm_mem (p.in[11 + zero_()])
#define norm_ffn (p.in[12 + zero_()])
#define norm_final (p.in[13 + zero_()])
#define lru_conv_w (p.in[17 + zero_()])
#define lru_conv_b (p.in[18 + zero_()])
#define lru_ba (p.in[20 + zero_()])
#define lru_bx (p.in[22 + zero_()])
#define lru_lambda (p.in[23 + zero_()])
#define ffn_conv_w (p.in[29 + zero_()])
#define ffn_conv_b (p.in[30 + zero_()])
#define HN ((bf16_t*)(WS_ + W_HN))
#define MN ((bf16_t*)(WS_ + W_MN))
#define MK ((bf16_t*)(WS_ + W_MK))
#define MVT ((bf16_t*)(WS_ + W_MVT))
#define BIG ((bf16_t*)(WS_ + W_BIG))
#define X ((float*)(WS_ + W_X))
#define XS ((float*)(WS_ + W_X) + (size_t)PR * 1024)
#define QX ((bf16_t*)(WS_ + W_QX))
#define AO ((bf16_t*)(WS_ + W_AO))
#define Y ((bf16_t*)(WS_ + W_Y))
#define KT ((bf16_t*)(WS_ + W_KT))
#define VT ((bf16_t*)(WS_ + W_VT))
#define O ((bf16_t*)(WS_ + W_O))
#define OG ((bf16_t*)(WS_ + W_OG))
#define XC ((bf16_t*)(WS_ + W_XC))
#define AA ((float*)(WS_ + W_AA))
#define UU ((float*)(WS_ + W_UU))
#define CH ((float*)(WS_ + W_CH))
#define YL ((bf16_t*)(WS_ + W_YL))
#define ROTC ((float*)(WS_ + W_ROTC))
#define ROTS ((float*)(WS_ + W_ROTS))
#define LSG ((float*)(WS_ + W_LSG))
#define SS ((float*)(WS_ + W_SS))
#define DEC ((float*)(WS_ + W_DEC))
    volatile LAS unsigned* xst = (volatile LAS unsigned*)(lds + 153600);
    if (threadIdx.x < 4) xst[threadIdx.x] = 0u;
    __syncthreads();
    const XcdBarrier xbar = xcd_barrier_post((unsigned*)(WS_ + W_BAR), xst);
    const int hi2 = hi < NPH ? hi : NPH;
    for (int ph = lo; ph < hi2; ++ph) {
        Step st; st.kind = K_NORMF; st.L = ph >= 11 ? 1 : 0; st.lda = 1024; st.N = 1024; st.K = 1024; st.ldo = 1024; st.ssi = 0; st.A = HN; st.Bt = nullptr; st.ob = nullptr; st.rinP = X; st.rinS = XS;
        switch (ph) {
            case 0: st.kind = K_PREP; break;
            case 1: st.kind = K_RETIN; break;
            case 2: st.kind = K_RET; break;
            case 3: st.kind = K_GATE; break;
            case 4: st.kind = K_RESID; st.ssi = 1; st.A = OG; st.lda = 2048; st.K = 2048; st.Bt = (const bf16_t*)(WS_ + W_ROUT); st.rinP = x_prompt; st.rinS = x_sample; break;
            case 5: st.kind = K_BF16; st.ssi = 1; st.Bt = (const bf16_t*)(WS_ + W_XQ); st.ob = QX; break;
            case 6: st.kind = K_XATTN; break;
            case 7: st.kind = K_RESID; st.ssi = 2; st.A = AO; st.Bt = (const bf16_t*)(WS_ + W_XO); break;
            case 8: st.kind = K_BF16; st.ssi = 2; st.Bt = (const bf16_t*)(WS_ + W_UP); st.N = 6144; st.ob = BIG; st.ldo = 6144; break;
            case 9: st.kind = K_FFNGATE; break;
            case 10: st.kind = K_RESID; st.ssi = 3; st.A = Y; st.lda = 3072; st.K = 3072; st.Bt = (const bf16_t*)(WS_ + W_DN); break;
            case 11: st.kind = K_BF16; st.ssi = 3; st.Bt = (const bf16_t*)(WS_ + W_LIN); st.N = 2048; st.ob = BIG; st.ldo = 2048; break;
            case 12: st.kind = K_LRUCONV; break;
            case 13: st.kind = K_LRU; break;
            case 14: st.kind = K_SCAN1; break;
            case 15: st.kind = K_SCAN2; break;
            case 16: st.kind = K_RESID; st.ssi = 4; st.A = YL; st.Bt = (const bf16_t*)(WS_ + W_LOUT); break;
            case 17: st.kind = K_BF16; st.ssi = 4; st.Bt = (const bf16_t*)(WS_ + W_XQ + 2097152); st.ob = QX; break;
            case 18: st.kind = K_XATTN; break;
            case 19: st.kind = K_RESID; st.ssi = 5; st.A = AO; st.Bt = (const bf16_t*)(WS_ + W_XO + 2097152); break;
            case 20: st.kind = K_BF16; st.ssi = 5; st.Bt = (const bf16_t*)(WS_ + W_UP + 12582912); st.N = 6144; st.ob = BIG; st.ldo = 6144; break;
            case 21: st.kind = K_FFNGATE; break;
            case 22: st.kind = K_RESID; st.ssi = 6; st.A = Y; st.lda = 3072; st.K = 3072; st.Bt = (const bf16_t*)(WS_ + W_DN + 6291456); break;
            default: st.kind = K_NORMF; break;
        }
        const int L = st.L;
#ifndef DUP_MASK
#define DUP_MASK 0
#endif
        const int nrep = 1 + (int)(((unsigned)(DUP_MASK) >> st.kind) & 1u);
        for (int rep = 0; rep < nrep; ++rep) {
        if (rep) grid.sync();
        switch (st.kind) {
            case K_PREP: if constexpr (ONLY < 0 || ONLY == K_PREP) {
#if EN(0)
                transpose_phase(lds, p);
                rot_phase(ROTC, ROTS, p.rope_c1);
                lsg_phase(lru_lambda, LSG);
                dec_phase(DEC);
                cast_ss_phase(x_prompt, x_sample, HN, SS);
                for (int i = 0; i < 2; ++i) norm_phase<false>(mem_prompt, nullptr, norm_mem + i * 1024, MN + (size_t)i * 2097152, nullptr, nullptr, 2048);
#endif
            } break;
            case K_RETIN: if constexpr (ONLY < 0 || ONLY == K_RETIN) {
                QRetIn q; q.big = BIG; q.kt = KT; q.vt = VT; q.rc = ROTC; q.rs = ROTS; q.dec = DEC; q.ss = SS;
#if EN(1)
                run_gemm(lds, HN, 1024, (const bf16_t*)(WS_ + W_RIN), 1024, PR, 6144, 1024, 0, 0, q);
#endif
#if EN(13)
                skinny_phase(lds, HN + (size_t)PR * 1024, 1024, (const bf16_t*)(WS_ + W_RIN), 1024, 6144, 1024, 0, q, nblk_() == 256 ? 128 : 0);
#endif
#if EN(14)
                for (int i = 0; i < 2; ++i) {
                    QMemKV m; m.outk = OUT_ + O_MKP + (size_t)i * 2097152; m.outv = OUT_ + O_MVP + (size_t)i * 2097152; m.mk = MK + (size_t)i * 2097152; m.mvt = MVT + (size_t)i * 2097152;
                    run_gemm(lds, MN + (size_t)i * 2097152, 1024, (const bf16_t*)(WS_ + W_XKV + (size_t)i * 4194304), 1024, 2048, 2048, 1024, 0, 128 + 64 * i, m);
                }
#endif
            } break;
            case K_RET: if constexpr (ONLY < 0 || ONLY == K_RET) {
#if EN(2)
                retention_prompt_phase(lds, BIG, KT, VT, O, OUT_ + O_RETP, DEC, nblk_() == 256, state_ret, OUT_ + O_RETS);
#endif
#if EN(3)
                if (nblk_() != 256) retention_sample_phase(lds, BIG, state_ret, OUT_ + O_RETS, O);
#endif
            } break;
            case K_GATE: if constexpr (ONLY < 0 || ONLY == K_GATE) {
#if EN(4)
                gate_phase(O, BIG, OG);
#endif
            } break;
            case K_RESID: if constexpr (ONLY < 0 || ONLY == K_RESID) {
                QResid q; q.rinP = st.rinP; q.rinS = st.rinS; q.xout = X; q.xb = HN; q.ssout = SS + (size_t)st.ssi * TP * 32;
#if EN(5)
                run_gemm(lds, st.A, st.lda, st.Bt, st.K, PR, 1024, st.K, 0, 0, q);
#endif
#if EN(15)
                skinny_phase1(lds, st.A + (size_t)PR * st.lda, st.lda, st.Bt, st.K, 1024, st.K, 0, q);
#endif
            } break;
            case K_BF16: if constexpr (ONLY < 0 || ONLY == K_BF16) {
                if (st.N == 6144) {
                    unsigned char* wsb = WS_; float* ob = OUT_;
                    QFfn q; q.y = (bf16_t*)(wsb + W_Y); q.big = (bf16_t*)(wsb + W_BIG); q.ss = (const float*)(wsb + W_SS) + (size_t)st.ssi * TP * 32; q.cw = ffn_conv_w + (size_t)L * 9216; q.cb = ffn_conv_b + (size_t)L * 3072;
                    q.sbuf = state_ffn_conv + (size_t)L * 786432; q.outp = ob + O_FCP + (size_t)L * 49152; q.outs = ob + O_FCS + (size_t)L * 786432;
                    const bf16_t* hn = (const bf16_t*)(wsb + W_HN);
                    run_gemm(lds, hn, 1024, st.Bt, 1024, PR, 6144, 1024, 2, 0, q);
                    skinny_phase(lds, hn + (size_t)PR * 1024, 1024, st.Bt, 1024, 6144, 1024, 2, q);
                } else {
                QBf16 q; q.out = st.ob; q.ld = st.ldo; q.ss = SS + (size_t)st.ssi * TP * 32;
#if EN(6)
                run_gemm(lds, HN, 1024, st.Bt, 1024, PR, st.N, 1024, 0, 0, q);
#endif
#if EN(16)
                if (st.N == 1024) skinny_phase1(lds, HN + (size_t)PR * 1024, 1024, st.Bt, 1024, 1024, 1024, 0, q);
                else skinny_phase(lds, HN + (size_t)PR * 1024, 1024, st.Bt, 1024, st.N, 1024, 0, q);
#endif
                }
            } break;
            case K_XATTN: if constexpr (ONLY < 0 || ONLY == K_XATTN) {
#if EN(10)
                xattn_prompt_phase(lds, QX, MK + (size_t)L * 2097152, MVT + (size_t)L * 2097152, AO);
#endif
#if EN(11)
                xattn_sample_phase(lds, QX, cache_k + (size_t)L * 33554432, cache_v + (size_t)L * 33554432, AO);
#endif
            } break;
            case K_FFNGATE: if constexpr (ONLY < 0 || ONLY == K_FFNGATE) {
#if EN(12)
                ffn_fix_phase(BIG, Y, ffn_conv_w + (size_t)L * 9216, ffn_conv_b + (size_t)L * 3072);
#endif
            } break;
            case K_LRUCONV: if constexpr (ONLY < 0 || ONLY == K_LRUCONV) {
#if EN(7)
                lru_conv_phase(BIG, XC, lru_conv_w, lru_conv_b, state_lru_conv, OUT_ + O_LCP, OUT_ + O_LCS);
#endif
            } break;
            case K_LRU: if constexpr (ONLY < 0 || ONLY == K_LRU) {
                QLru q; q.ba = lru_ba; q.bx = lru_bx; q.lam = LSG; q.xc = XC; q.aa = AA; q.uu = UU; q.h0 = state_lru_h; q.hout = OUT_ + O_LHS; q.big = BIG; q.yl = YL;
#if EN(8)
                run_gemm(lds, XC, 1024, (const bf16_t*)(WS_ + W_AX), 256, PR, 2048, 256, 1, 0, q);
#endif
#if EN(18)
                skinny_phase(lds, XC + (size_t)PR * 1024, 1024, (const bf16_t*)(WS_ + W_AX), 256, 2048, 256, 1, q);
#endif
            } break;
            case K_SCAN1: if constexpr (ONLY < 0 || ONLY == K_SCAN1) {
#if EN(9)
                scan1_phase(AA, UU, CH);
#endif
            } break;
            case K_SCAN2: if constexpr (ONLY < 0 || ONLY == K_SCAN2) {
#if EN(9)
                scan2_phase(AA, UU, CH, BIG, YL, OUT_ + O_LHP);
#endif
            } break;
            default: if constexpr (ONLY < 0 || ONLY == K_NORMF) {
#if EN(0)
                norm_phase<true>(X, XS, norm_final, nullptr, OUT_ + O_YP, OUT_ + O_YS, TR);
#endif
            } break;
        }
        }
        if (ph + 1 < hi2) { if (lo < 0) grid.sync(); else xcd_barrier(xbar); }
    }
#ifdef EXTRA_SYNCS
    for (int i = 0; i < EXTRA_SYNCS; ++i) grid.sync();
#endif
}

#undef WS_
#undef OUT_
#undef x_prompt
#undef x_sample
#undef state_ret
#undef state_lru_h
#undef state_lru_conv
#undef state_ffn_conv
#undef cache_k
#undef cache_v
#undef mem_prompt
#undef norm_mix
#undef norm_xa
#undef norm_mem
#undef norm_ffn
#undef norm_final
#undef lru_conv_w
#undef lru_conv_b
#undef lru_ba
#undef lru_bx
#undef lru_lambda
#undef ffn_conv_w
#undef ffn_conv_b
#undef HN
#undef MN
#undef MK
#undef MVT
#undef BIG
#undef X
#undef XS
#undef QX
#undef AO
#undef Y
#undef KT
#undef VT
#undef O
#undef OG
#undef XC
#undef AA
#undef UU
#undef CH
#undef YL
#undef ROTC
#undef ROTS
#undef LSG
#undef SS
#undef DEC
__global__ void dump_k(const float* src, float* dst, size_t n) { for (size_t i = (size_t)bid_() * blockDim.x + threadIdx.x; i < n; i += (size_t)nblk_() * blockDim.x) dst[i] = src[i]; }
#ifndef MULTI
#define MULTI 0
#endif
static const int h_kinds[NPH] = {K_PREP, K_RETIN, K_RET, K_GATE, K_RESID, K_BF16, K_XATTN, K_RESID, K_BF16, K_FFNGATE, K_RESID, K_BF16, K_LRUCONV, K_LRU, K_SCAN1, K_SCAN2,
                                 K_RESID, K_BF16, K_XATTN, K_RESID, K_BF16, K_FFNGATE, K_RESID, K_NORMF};
typedef void (*mega_fn)(Params, int, int);
template <int K> static mega_fn get_fn() { return mega<K>; }
static mega_fn fn_of_kind(int k) {
    switch (k) {
        case 0: return get_fn<0>(); case 1: return get_fn<1>(); case 2: return get_fn<2>(); case 3: return get_fn<3>(); case 4: return get_fn<4>(); case 5: return get_fn<5>(); case 6: return get_fn<6>();
        case 7: return get_fn<7>(); case 8: return get_fn<8>(); case 9: return get_fn<9>(); case 10: return get_fn<10>(); case 11: return get_fn<11>(); case 12: return get_fn<12>(); default: return get_fn<13>();
    }
}

extern "C" void kernel_launch(void* const* d_in, const int* in_sizes, int n_in, void* d_out, int out_size, void* d_ws, size_t ws_size, hipStream_t stream) {
    (void)in_sizes; (void)n_in; (void)out_size;
    static int grid_blocks = 0;
    if (!grid_blocks) {
        int dev = 0, cus = 0;
        (void)hipGetDevice(&dev);
        (void)hipDeviceGetAttribute(&cus, hipDeviceAttributeMultiprocessorCount, dev);
#if MULTI
        for (int k = 0; k < 14; ++k) (void)hipFuncSetAttribute((const void*)fn_of_kind(k), hipFuncAttributeMaxDynamicSharedMemorySize, LDS_BYTES);
#else
        (void)hipFuncSetAttribute((const void*)mega<-1>, hipFuncAttributeMaxDynamicSharedMemorySize, LDS_BYTES);
#endif
        grid_blocks = cus;
        if (ws_size < W_TOTAL) fprintf(stderr, "workspace too small: %zu < %zu\n", ws_size, (size_t)W_TOTAL);
    }
    Params p; memset(&p, 0, sizeof(p));
    for (int i = 0; i < 32; ++i) p.in[i] = (const float*)d_in[i];
    p.in[32] = (const float*)d_out; p.in[33] = (const float*)d_ws;
    p.rope_c1 = pow(10000.0, -1.0 / 128.0);
    unsigned char* ws = (unsigned char*)d_ws;
    int nj = 0, tiles = 0;
    auto add = [&](const float* src, size_t dst_off, int ld, int K, int N, const float* gain = nullptr) {
        TJob& j = p.jobs[nj++]; j.gain = gain; j.src = src; j.dst = (bf16_t*)(ws + dst_off); j.ld = ld; j.K = K; j.N = N; j.tile0 = tiles; tiles += (K / 64) * (N / 64);
    };
    const float* ret_w_in = p.in[14]; const float* ret_w_out = p.in[15]; const float* lru_w_in = p.in[16]; const float* lru_wa = p.in[19]; const float* lru_wx = p.in[21];
    const float* lru_w_out = p.in[24]; const float* xa_w_q = p.in[25]; const float* xa_w_kv = p.in[26]; const float* xa_w_o = p.in[27]; const float* ffn_w_up = p.in[28]; const float* ffn_w_down = p.in[31];
    const float* g_mix = p.in[9]; const float* g_xa = p.in[10]; const float* g_ffn = p.in[12];
    add(ret_w_in, W_RIN, 6144, 1024, 6144, g_mix);
    add(ffn_w_up, W_UP, 6144, 1024, 6144, g_ffn);
    add(ffn_w_up + (size_t)1024 * 6144, W_UP + 12582912, 6144, 1024, 6144, g_ffn + 1024);
    add(ret_w_out, W_ROUT, 1024, 2048, 1024);
    add(lru_w_in, W_LIN, 2048, 1024, 2048, g_mix + 1024);
    for (int h = 0; h < 4; ++h)
        for (int s = 0; s < 2; ++s)
            for (int half = 0; half < 2; ++half)
                add((half ? lru_wx : lru_wa) + (size_t)h * 65536 + s * 128, W_AX + (size_t)(h * 512 + s * 256 + half * 128) * 256 * 2, 256, 256, 128);
    add(lru_w_out, W_LOUT, 1024, 1024, 1024);
    for (int i = 0; i < 2; ++i) add(xa_w_q + (size_t)i * 1048576, W_XQ + (size_t)i * 2097152, 1024, 1024, 1024, g_xa + i * 1024);
    for (int i = 0; i < 2; ++i) add(xa_w_kv + (size_t)i * 2097152, W_XKV + (size_t)i * 4194304, 2048, 1024, 2048);
    for (int i = 0; i < 2; ++i) add(xa_w_o + (size_t)i * 1048576, W_XO + (size_t)i * 2097152, 1024, 1024, 1024);
    for (int i = 0; i < 2; ++i) add(ffn_w_down + (size_t)i * 3145728, W_DN + (size_t)i * 6291456, 1024, 3072, 1024);
    p.ntiles = tiles;
    if (nj != NJOBS) fprintf(stderr, "job count mismatch %d\n", nj);
#if MULTI
#ifndef HI_LIMIT
#define HI_LIMIT NPH
#endif
    for (int ph0 = 0; ph0 < HI_LIMIT; ++ph0) {
        const int ph = ph0;
        int lo = ph, hi = ph + 1;
        void* args[] = {&p, &lo, &hi};
        hipError_t e = hipLaunchKernel((const void*)fn_of_kind(h_kinds[ph]), dim3(grid_blocks), dim3(512), args, LDS_BYTES, stream);
        if (e != hipSuccess) fprintf(stderr, "launch %d failed: %s\n", ph, hipGetErrorString(e));
    }
#ifdef DUMP_OFF
    dump_k<<<1024, 256, 0, stream>>>((const float*)((unsigned char*)d_ws + DUMP_OFF), (float*)d_out, (size_t)16000000);
#endif
#else
    (void)hipMemsetAsync((unsigned char*)d_ws + W_BAR, 0, 16384, stream);
    int lo = 0, hi = NPH;
    void* args[] = {&p, &lo, &hi};
    hipError_t e = hipLaunchCooperativeKernel((const void*)mega<-1>, dim3(grid_blocks), dim3(512), args, LDS_BYTES, stream);
    if (e != hipSuccess) fprintf(stderr, "cooperative launch failed: %s (grid %d)\n", hipGetErrorString(e), grid_blocks);
#endif
}
```

```cpp
#include <hip/hip_runtime.h>
#include <hip/hip_cooperative_groups.h>
#include <cstdio>
#include <cstring>
#include <cmath>
namespace cg = cooperative_groups;

#ifndef MASK
#define MASK 0xffffffffu
#endif
#define EN(k) (((MASK) >> (k)) & 1u)
#define LAS __attribute__((address_space(3)))
#define DEVI __device__ __forceinline__
typedef unsigned short bf16_t;
typedef short bf16x8 __attribute__((ext_vector_type(8)));
typedef float f32x4 __attribute__((ext_vector_type(4)));
typedef unsigned u32x2 __attribute__((ext_vector_type(2)));
typedef unsigned u32x4 __attribute__((ext_vector_type(4)));

constexpr int PR = 16384;
constexpr int SR = 128;
constexpr int TR = PR + SR;
constexpr int TP = 16640;
constexpr int LDS_BYTES = 153600 + 16 + 8192;

constexpr size_t O_YP = 0, O_YS = 16777216, O_RETP = 16908288, O_RETS = 21102592, O_LHP = 88211456, O_LHS = 88219648,
                 O_LCP = 88350720, O_LCS = 88375296, O_FCP = 88768512, O_FCS = 88866816, O_MKP = 90439680, O_MVP = 94633984;

constexpr size_t W_RIN = 0;
constexpr size_t W_ROUT = W_RIN + 12582912;
constexpr size_t W_LIN = W_ROUT + 4194304;
constexpr size_t W_AX = W_LIN + 4194304;
constexpr size_t W_LOUT = W_AX + 1048576;
constexpr size_t W_XQ = W_LOUT + 2097152;
constexpr size_t W_XKV = W_XQ + 2 * 2097152;
constexpr size_t W_XO = W_XKV + 2 * 4194304;
constexpr size_t W_UP = W_XO + 2 * 2097152;
constexpr size_t W_DN = W_UP + 2 * 12582912;
constexpr size_t W_ROTC = W_DN + 2 * 6291456;
constexpr size_t W_ROTS = W_ROTC + 1049088;
constexpr size_t W_LSG = W_ROTS + 1049088;
constexpr size_t W_DEC = W_LSG + 4096;
constexpr size_t W_SS = W_DEC + 4096;
constexpr size_t W_HN = W_SS + (size_t)7 * TP * 32 * 4;
constexpr size_t W_MN = W_HN + (size_t)TP * 2048;
constexpr size_t W_MK = W_MN + 8388608;
constexpr size_t W_MVT = W_MK + 8388608;
constexpr size_t W_BIG = W_MVT + 8388608;
constexpr size_t W_X = W_BIG + (size_t)TP * 12288;
constexpr size_t W_QX = W_X + (size_t)TP * 4096;
constexpr size_t W_AO = W_QX + (size_t)TP * 2048;
constexpr size_t W_Y = W_AO + (size_t)TP * 2048;
constexpr size_t W_L = W_Y + (size_t)TP * 6144;
constexpr size_t W_KT = W_L;
constexpr size_t W_VT = W_KT + 33554432;
constexpr size_t W_O = W_VT + 67108864;
constexpr size_t W_OG = W_O + (size_t)TP * 4096;
constexpr size_t W_END0 = W_OG + (size_t)TP * 4096;
constexpr size_t W_XC = W_L;
constexpr size_t W_AA = W_XC + (size_t)TP * 2048;
constexpr size_t W_UU = W_AA + (size_t)TP * 4096;
constexpr size_t W_CH = W_UU + (size_t)TP * 4096;
constexpr size_t W_YL = W_CH + 4194304;
constexpr size_t W_END1 = W_YL + (size_t)TP * 2048;
constexpr size_t W_BAR = (W_END0 > W_END1 ? W_END0 : W_END1);
constexpr size_t W_TOTAL = W_BAR + 256;

struct TJob { const float* src; bf16_t* dst; const float* gain; int ld, K, N, tile0; };
constexpr int NJOBS = 30;
struct Params {
    const float* in[34];
    double rope_c1;
    TJob jobs[NJOBS];
    int ntiles;
    int pad0;
};

typedef float f32x2 __attribute__((ext_vector_type(2)));
typedef __bf16 bf16x2_t __attribute__((ext_vector_type(2)));
DEVI unsigned cvt_pk_bf16(float lo, float hi) { f32x2 v = {lo, hi}; bf16x2_t r = __builtin_convertvector(v, bf16x2_t); return __builtin_bit_cast(unsigned, r); }
DEVI bf16_t f2bf(float f) { return (bf16_t)(cvt_pk_bf16(f, 0.f) & 0xffffu); }
DEVI float bflo(unsigned u) { return __uint_as_float(u << 16); }
DEVI float bfhi(unsigned u) { return __uint_as_float(u & 0xffff0000u); }
DEVI float bf2f(bf16_t b) { return __uint_as_float(((unsigned)b) << 16); }
DEVI u32x2 pack4(f32x4 v) { u32x2 r; r.x = cvt_pk_bf16(v[0], v[1]); r.y = cvt_pk_bf16(v[2], v[3]); return r; }
DEVI float shx(float v, int o, int lane) { return __int_as_float(__builtin_amdgcn_ds_bpermute((lane ^ o) << 2, __float_as_int(v))); }
DEVI float dpp_f(float v, const int ctrl_sel) {
    const int x = __float_as_int(v);
    int r;
    if (ctrl_sel == 0) r = __builtin_amdgcn_update_dpp(x, x, 0xB1, 0xf, 0xf, false);
    else if (ctrl_sel == 1) r = __builtin_amdgcn_update_dpp(x, x, 0x4E, 0xf, 0xf, false);
    else if (ctrl_sel == 2) r = __builtin_amdgcn_update_dpp(x, x, 0x141, 0xf, 0xf, false);
    else r = __builtin_amdgcn_update_dpp(x, x, 0x140, 0xf, 0xf, false);
    return __int_as_float(r);
}
DEVI float wave_sum(float v, int lane) {
    (void)lane;
    v += dpp_f(v, 0); v += dpp_f(v, 1); v += dpp_f(v, 2); v += dpp_f(v, 3);
    const int x = __float_as_int(v);
    const float s0 = __int_as_float(__builtin_amdgcn_readlane(x, 0)), s1 = __int_as_float(__builtin_amdgcn_readlane(x, 16));
    const float s2 = __int_as_float(__builtin_amdgcn_readlane(x, 32)), s3 = __int_as_float(__builtin_amdgcn_readlane(x, 48));
    return (s0 + s1) + (s2 + s3);
}
DEVI float rcp_(float x) { return __builtin_amdgcn_rcpf(x); }
DEVI float ex2_(float x) { return __builtin_amdgcn_exp2f(x); }
DEVI float exp_(float x) { return __builtin_amdgcn_exp2f(x * 1.4426950408889634f); }
DEVI float sigmoidf_(float x) { return rcp_(1.f + exp_(-x)); }
DEVI float gelu_tanh(float x) { const float z = 1.5957691216057308f * (x + 0.044715f * x * x * x); return x * rcp_(1.f + exp_(-z)); }
DEVI int zero_() { int z = 0; asm volatile("" : "+s"(z)); return z; }
DEVI int bid_() { int b = blockIdx.x; asm volatile("" : "+s"(b)); return b; }
DEVI int nblk_() { int b = gridDim.x; asm volatile("" : "+s"(b)); return b; }
DEVI unsigned zv_() { unsigned z = 0; asm volatile("" : "+v"(z)); return z; }
DEVI int tid_() { int t = threadIdx.x; asm volatile("" : "+v"(t)); return t; }
DEVI f32x4 mfma16(bf16x8 a, bf16x8 b, f32x4 c) { return __builtin_amdgcn_mfma_f32_16x16x32_bf16(a, b, c, 0, 0, 0); }

DEVI float rstd_of(const float* ss, int row) {
    const f32x4* p = (const f32x4*)(ss + (unsigned)row * 32u);
    f32x4 a = p[0];
#pragma unroll
    for (int i = 1; i < 8; ++i) a += p[i];
    return __builtin_amdgcn_rsqf(__fadd_rn(__fmul_rn((a[0] + a[1]) + (a[2] + a[3]), 1.f / 1024.f), 1e-6f));
}

namespace pg8 {
constexpr int BM = 256, BK = 64, HALF = 128, HTB = HALF * BK * 2, NXCD = 8, WGM = 8;
__host__ __device__ __forceinline__ int lds_byte(int r, int c) { const int st = (r >> 4) * 2 + (c >> 5), rr = r & 15, cc = c & 31, ob = rr * 64 + cc * 2; return st * 1024 + (ob ^ (((ob >> 9) & 1) << 5)); }
__host__ __device__ __forceinline__ void stage_rc(int b, int& R, int& C) { const int st = b / 1024, sb = b % 1024, swz = sb ^ (((sb >> 9) & 1) << 5); R = (st >> 1) * 16 + swz / 64; C = (st & 1) * 32 + (swz % 64) / 2; }
__host__ __device__ __forceinline__ int perm32(int rho) { const int n = rho >> 4, i = rho & 15; return 8 * (i >> 2) + 4 * n + (i & 3); }
struct Unit { int pm, pn; };
struct Gemm { const bf16_t* A; const bf16_t* Bt; int M, N, K, lda, ldb, diag; };
struct StaticOrder {
    int nM, nN, nwg, G, c;
    DEVI void init(int M, int N, int G_, int c_) { nM = M / BM; nN = N / BM; nwg = nM * nN; G = G_; c = c_; }
    DEVI bool next(int i, Unit& u) const {
        const long L = (long)i * G + c; if (L >= nwg) return false;
        int wgid = (int)L; { const int q = nwg / NXCD, r = nwg % NXCD, xcd = wgid % NXCD, off = wgid / NXCD; wgid = (xcd < r ? xcd * (q + 1) : r * (q + 1) + (xcd - r) * q) + off; }
        const int nig = WGM * nN, gid = wgid / nig, fm = gid * WGM, gsz = (nM - fm) < WGM ? (nM - fm) : WGM;
        u.pm = fm + ((wgid % nig) % gsz); u.pn = (wgid % nig) / gsz; return true;
    }
};

template <class Q>
DEVI void gemm_phase(LAS unsigned char* lds, const Gemm g, const StaticOrder& S, const Q& E) {
    const int tid = tid_(), wid = __builtin_amdgcn_readfirstlane(tid >> 6), lane = tid & 63, wr = wid >> 2, wc = wid & 3, fr = lane & 15, fq = lane >> 4;
    const int K = g.K, nt = K / BK;
    unsigned voffA, voffB;
    { int R, C; stage_rc(tid * 16, R, C); const int Rb = Q::PERM ? ((R & ~31) + perm32(R & 31)) : R; voffA = (unsigned)(R * g.lda + C) * 2u; voffB = (unsigned)(Rb * g.ldb + C) * 2u; }
    const size_t r64voffA = (size_t)64 * g.lda * 2, r64voffB = (size_t)64 * g.ldb * 2;
    const size_t kstep = (size_t)(BK * 2);
    const size_t hstepA = (size_t)HALF * g.lda * 2, hstepB = (g.diag == 2 ? (size_t)3072 : (size_t)HALF) * g.ldb * 2;
    const size_t tstepA = 2 * hstepA, tstepB = (g.diag == 2 ? (size_t)HALF : (size_t)2 * HALF) * g.ldb * 2;
    const unsigned ldsw = (unsigned)wid * 1024u;
    const int aoff = lds_byte(wr * 64 + fr, fq * 8), boff = lds_byte(wc * 32 + fr, fq * 8);
#define PG8_SA(b, h) (((b) * 2 + (h)) * HTB)
#define PG8_SB(b, h) ((4 + (b) * 2 + (h)) * HTB)
#define PG8_STAGE(bufoff, gbase, voff) do { _Pragma("unroll") for (int _i = 0; _i < 2; ++_i) \
        __builtin_amdgcn_global_load_lds((const unsigned*)((const char*)(gbase) + (size_t)_i * r64##voff + voff), (LAS unsigned*)(lds + (bufoff) + ldsw + _i * 8192), 16, 0, 0); } while (0)
#define PG8_LDA(dst, b, h) do { _Pragma("unroll") for (int m = 0; m < 4; ++m) _Pragma("unroll") for (int k = 0; k < 2; ++k) dst[m][k] = *(const LAS bf16x8*)(lds + PG8_SA(b, h) + aoff + m * 2048 + k * 1024); } while (0)
#define PG8_LDB(dst, b, h) do { _Pragma("unroll") for (int n = 0; n < 2; ++n) _Pragma("unroll") for (int k = 0; k < 2; ++k) dst[n][k] = *(const LAS bf16x8*)(lds + PG8_SB(b, h) + boff + n * 2048 + k * 1024); } while (0)
#define PG8_MMA(ai, bj, At, Bt) do { __builtin_amdgcn_s_setprio(1); _Pragma("unroll") for (int m = 0; m < 4; ++m) _Pragma("unroll") for (int n = 0; n < 2; ++n) _Pragma("unroll") for (int k = 0; k < 2; ++k) \
        acc[ai][bj][m][n] = __builtin_amdgcn_mfma_f32_16x16x32_bf16(Bt[n][k], At[m][k], acc[ai][bj][m][n], 0, 0, 0); __builtin_amdgcn_s_setprio(0); } while (0)
#define PG8_WAIT_V(n) asm volatile("s_waitcnt vmcnt(" #n ")" ::: "memory")
#define PG8_WAIT_L(n) asm volatile("s_waitcnt lgkmcnt(" #n ")" ::: "memory")
#define PG8_BAR __builtin_amdgcn_s_barrier()
#define PG8_SCHED __builtin_amdgcn_sched_barrier(0)
    Unit cur, nxt; int ui = 0;
    if (!S.next(0, cur)) return;
    f32x4 acc[2][2][4][2];
#pragma unroll
    for (int a = 0; a < 2; ++a)
#pragma unroll
        for (int b = 0; b < 2; ++b)
#pragma unroll
            for (int m = 0; m < 4; ++m)
#pragma unroll
                for (int n = 0; n < 2; ++n) acc[a][b][m][n] = (f32x4){0.f, 0.f, 0.f, 0.f};
    bf16x8 At[4][2], B0[2][2], B1[2][2];
    const char* cA = (const char*)g.A + (size_t)cur.pm * tstepA + (g.diag == 1 ? (size_t)(cur.pn >> 1) * 512 : 0); const char* cB = (const char*)g.Bt + (size_t)cur.pn * tstepB;
#define PG8_RSTD(unit, par) do { if constexpr (Q::NEEDS_RSTD) { \
        const int _rl = tid >> 1, _hf = tid & 1; \
        const f32x4* _p = (const f32x4*)(E.ss + ((size_t)((unit).pm * BM + _rl)) * 32 + _hf * 16); \
        const f32x4 _a = (_p[0] + _p[1]) + (_p[2] + _p[3]); \
        float _sm = (_a[0] + _a[1]) + (_a[2] + _a[3]); \
        _sm += shx(_sm, 1, lane); \
        if (!_hf) *(LAS float*)(lds + 131072 + (par) * 1024 + _rl * 4) = __builtin_amdgcn_rsqf(__fadd_rn(__fmul_rn(_sm, 1.f / 1024.f), 1e-6f)); } } while (0)
    PG8_RSTD(cur, 0);
    PG8_STAGE(PG8_SB(0, 0), cB, voffB); PG8_STAGE(PG8_SA(0, 0), cA, voffA); PG8_STAGE(PG8_SB(0, 1), cB + hstepB, voffB); PG8_STAGE(PG8_SA(0, 1), cA + hstepA, voffA);
    if (wr == 1) PG8_BAR;
    PG8_WAIT_V(4); PG8_BAR;
    PG8_STAGE(PG8_SB(1, 0), cB + kstep, voffB); PG8_STAGE(PG8_SA(1, 0), cA + kstep, voffA); PG8_STAGE(PG8_SB(1, 1), cB + hstepB + kstep, voffB);
    PG8_WAIT_V(6); PG8_BAR;
    for (;;) {
        const bool has_next = S.next(ui + 1, nxt);
        const char* nA = has_next ? (const char*)g.A + (size_t)nxt.pm * tstepA + (g.diag == 1 ? (size_t)(nxt.pn >> 1) * 512 : 0) : cA; const char* nB = has_next ? (const char*)g.Bt + (size_t)nxt.pn * tstepB : cB;
        for (int t = 0; t < nt; t += 2) {
            const bool last = (t == nt - 2);
            const char* a1 = cA + (size_t)(t + 1) * kstep;
            const char* a2 = last ? nA : cA + (size_t)(t + 2) * kstep; const char* b2 = last ? nB : cB + (size_t)(t + 2) * kstep;
            const char* a3 = a2 + kstep; const char* b3 = b2 + kstep;
            PG8_LDB(B0, 0, 0); PG8_SCHED; PG8_LDA(At, 0, 0); PG8_STAGE(PG8_SA(1, 1), a1 + hstepA, voffA);
            PG8_WAIT_L(8); PG8_BAR; PG8_WAIT_L(0); PG8_MMA(0, 0, At, B0); PG8_BAR; PG8_SCHED;
            PG8_LDB(B1, 0, 1); PG8_STAGE(PG8_SB(0, 0), b2, voffB);
            PG8_BAR; PG8_WAIT_L(0); PG8_MMA(0, 1, At, B1); PG8_BAR;
            PG8_LDA(At, 0, 1); PG8_STAGE(PG8_SA(0, 0), a2, voffA);
            PG8_BAR; PG8_WAIT_L(0); PG8_MMA(1, 0, At, B0); PG8_BAR; PG8_SCHED;
            PG8_STAGE(PG8_SB(0, 1), b2 + hstepB, voffB);
            PG8_WAIT_V(6); PG8_BAR; PG8_MMA(1, 1, At, B1); PG8_BAR;
            PG8_LDB(B0, 1, 0); PG8_SCHED; PG8_LDA(At, 1, 0); PG8_STAGE(PG8_SA(0, 1), a2 + hstepA, voffA);
            PG8_WAIT_L(8); PG8_BAR; PG8_WAIT_L(0); PG8_MMA(0, 0, At, B0); PG8_BAR; PG8_SCHED;
            PG8_LDB(B1, 1, 1); PG8_STAGE(PG8_SB(1, 0), b3, voffB);
            PG8_BAR; PG8_WAIT_L(0); PG8_MMA(0, 1, At, B1); PG8_BAR;
            PG8_LDA(At, 1, 1); PG8_STAGE(PG8_SA(1, 0), a3, voffA);
            PG8_BAR; PG8_WAIT_L(0); PG8_MMA(1, 0, At, B0); PG8_BAR; PG8_SCHED;
            PG8_STAGE(PG8_SB(1, 1), b3 + hstepB, voffB);
            PG8_WAIT_V(6); PG8_BAR; PG8_MMA(1, 1, At, B1); PG8_BAR;
        }
#pragma unroll
        for (int ai = 0; ai < 2; ++ai)
#pragma unroll
            for (int m = 0; m < 4; ++m) {
                int l2 = lane; asm volatile("" : "+v"(l2));
                const int rloc = ai * HALF + wr * 64 + m * 16 + (l2 & 15);
                float rsc = 1.f;
                if constexpr (Q::NEEDS_RSTD) rsc = *(const LAS float*)(lds + 131072 + (ui & 1) * 1024 + rloc * 4);
                if constexpr (Q::PERM) E.oct(cur.pm * BM + rloc, cur.pn, wc * 32 + (l2 >> 4) * 8, acc[ai][0][m][0], acc[ai][0][m][1], acc[ai][1][m][0], acc[ai][1][m][1], rsc);
                else {
#pragma unroll
                    for (int n = 0; n < 2; ++n)
                        E.quad(cur.pm * BM + rloc, cur.pn, wc * 32 + n * 16 + (l2 >> 4) * 4, acc[ai][0][m][n], acc[ai][1][m][n], rsc);
                }
            }
        if (!has_next) break;
        PG8_RSTD(nxt, (ui + 1) & 1);
#pragma unroll
        for (int a = 0; a < 2; ++a)
#pragma unroll
            for (int b = 0; b < 2; ++b)
#pragma unroll
                for (int m = 0; m < 4; ++m)
#pragma unroll
                    for (int n = 0; n < 2; ++n) acc[a][b][m][n] = (f32x4){0.f, 0.f, 0.f, 0.f};
        cur = nxt; cA = nA; cB = nB; ++ui;
    }
    PG8_WAIT_V(0);
    if (wr == 0) PG8_BAR;
    PG8_BAR;
#undef PG8_RSTD
#undef PG8_SA
#undef PG8_SB
#undef PG8_STAGE
#undef PG8_LDA
#undef PG8_LDB
#undef PG8_MMA
#undef PG8_WAIT_V
#undef PG8_WAIT_L
#undef PG8_BAR
#undef PG8_SCHED
}
}

template <class Q>
DEVI void run_gemm(LAS unsigned char* lds, const bf16_t* A, int lda, const bf16_t* Bt, int ldb, int M, int N, int K, int diag, int rot, const Q& q) {
    pg8::Gemm g; g.A = A; g.Bt = Bt; g.M = M; g.N = N; g.K = K; g.lda = lda; g.ldb = ldb; g.diag = diag;
    pg8::StaticOrder S; const int G_ = nblk_(); S.init(M, N, G_, (bid_() + G_ - (rot % G_)) % G_);
    pg8::gemm_phase<Q>(lds, g, S, q);
}

template <int RT, class Q>
DEVI void skinny_phase_t(LAS unsigned char* lds, const bf16_t* A, int lda, const bf16_t* Bt, int ldb, int N, int K, int diag, const Q& q, int nbuse = 0) {
    constexpr int RS = 8 / RT;
    const int tid = tid_(), w = tid >> 6, lane = tid & 63, fr = lane & 15, fq = lane >> 4;
    const int nitems = (N / 32) * RS, kw = K / 8;
    const int stride_ = nbuse > 0 ? nbuse : nblk_();
    for (int it = bid_() < stride_ ? bid_() : nitems; it < nitems; it += stride_) {
        const int ci = it / RS, rs = it - ci * RS, pn = ci >> 3, g = ci & 7;
        const bf16_t* a0 = A + (size_t)(rs * RT * 16 + fr) * lda + (diag == 1 ? (pn >> 1) * 256 : 0) + w * kw + fq * 8;
        const bf16_t* b0 = Bt + (size_t)((diag == 2 ? pn * 128 : pn * 256) + g * 16 + fr) * ldb + w * kw + fq * 8;
        const bf16_t* b1 = b0 + (size_t)(diag == 2 ? 3072 : 128) * ldb;
        f32x4 acc[RT][2];
#pragma unroll
        for (int rt = 0; rt < RT; ++rt) { acc[rt][0] = (f32x4){0.f, 0.f, 0.f, 0.f}; acc[rt][1] = (f32x4){0.f, 0.f, 0.f, 0.f}; }
        bf16x8 cb0 = *(const bf16x8*)(b0), cb1 = *(const bf16x8*)(b1), ca[RT];
#pragma unroll
        for (int rt = 0; rt < RT; ++rt) ca[rt] = *(const bf16x8*)(a0 + (size_t)rt * 16 * lda);
#pragma unroll 1
        for (int k = 32; k <= kw; k += 32) {
            const int kn = k < kw ? k : 0;
            const bf16x8 nb0 = *(const bf16x8*)(b0 + kn), nb1 = *(const bf16x8*)(b1 + kn);
            bf16x8 na[RT];
#pragma unroll
            for (int rt = 0; rt < RT; ++rt) na[rt] = *(const bf16x8*)(a0 + (size_t)rt * 16 * lda + kn);
#pragma unroll
            for (int rt = 0; rt < RT; ++rt) { acc[rt][0] = mfma16(cb0, ca[rt], acc[rt][0]); acc[rt][1] = mfma16(cb1, ca[rt], acc[rt][1]); }
            cb0 = nb0; cb1 = nb1;
#pragma unroll
            for (int rt = 0; rt < RT; ++rt) ca[rt] = na[rt];
        }
#pragma unroll
        for (int rt = 0; rt < RT; ++rt) {
            *(LAS f32x4*)(lds + (size_t)((((w * 8 + rt) * 2 + 0) * 64 + lane) * 16)) = acc[rt][0];
            *(LAS f32x4*)(lds + (size_t)((((w * 8 + rt) * 2 + 1) * 64 + lane) * 16)) = acc[rt][1];
        }
        __syncthreads();
        if (w < RT) {
            f32x4 v0 = *(const LAS f32x4*)(lds + (size_t)((((0 * 8 + w) * 2 + 0) * 64 + lane) * 16));
            f32x4 v1 = *(const LAS f32x4*)(lds + (size_t)((((0 * 8 + w) * 2 + 1) * 64 + lane) * 16));
#pragma unroll
            for (int ww = 1; ww < 8; ++ww) {
                v0 += *(const LAS f32x4*)(lds + (size_t)((((ww * 8 + w) * 2 + 0) * 64 + lane) * 16));
                v1 += *(const LAS f32x4*)(lds + (size_t)((((ww * 8 + w) * 2 + 1) * 64 + lane) * 16));
            }
            const int row = PR + (rs * RT + w) * 16 + fr;
            float rsc = 1.f;
            if constexpr (Q::NEEDS_RSTD) rsc = rstd_of(q.ss, row);
            q.quad(row, pn, g * 16 + fq * 4, v0, v1, rsc);
        }
        __syncthreads();
    }
}
template <class Q>
DEVI void skinny_phase(LAS unsigned char* lds, const bf16_t* A, int lda, const bf16_t* Bt, int ldb, int N, int K, int diag, const Q& q, int nbuse = 0) {
    skinny_phase_t<8, Q>(lds, A, lda, Bt, ldb, N, K, diag, q, nbuse);
}
template <class Q>
DEVI void skinny_phase1(LAS unsigned char* lds, const bf16_t* A, int lda, const bf16_t* Bt, int ldb, int N, int K, int diag, const Q& q) {
    skinny_phase_t<1, Q>(lds, A, lda, Bt, ldb, N, K, diag, q);
}

struct QRetIn {
    static constexpr bool PERM = true;
    DEVI void oct(int row, int pn, int cl8, f32x4 a0, f32x4 a1, f32x4 b0, f32x4 b1, float rsc) const {
        a0 *= rsc; a1 *= rsc; b0 *= rsc; b1 *= rsc;
        const int b = row >> 11, t = row & 2047;
        bf16_t* nat = big + ((unsigned)row * 6144u + (unsigned)(pn * 256 + cl8));
        if (pn < 8) {
            const int h = pn & 3;
            const float* pc = rc + t * 128 + cl8; const float* ps = rs + t * 128 + cl8;
            const f32x4 c0 = *(const f32x4*)pc, c1 = *(const f32x4*)(pc + 4), s0 = *(const f32x4*)ps, s1 = *(const f32x4*)(ps + 4);
            const float sc = dec[pn * 128 + (t & 127)];
            const f32x4 o0 = (a0 * c0 - b0 * s0) * sc, o1 = (a1 * c1 - b1 * s1) * sc, o2 = (a0 * s0 + b0 * c0) * sc, o3 = (a1 * s1 + b1 * c1) * sc;
            const u32x2 p0 = pack4(o0), p1 = pack4(o1), p2 = pack4(o2), p3 = pack4(o3);
            *(u32x4*)nat = (u32x4){p0.x, p0.y, p1.x, p1.y}; *(u32x4*)(nat + 128) = (u32x4){p2.x, p2.y, p3.x, p3.y};
            if (pn >= 4) {
                bf16_t* q = kt + (((unsigned)(b * 4 + h) * 256u + (unsigned)cl8) * 2048u + (unsigned)t);
#pragma unroll
                for (int r = 0; r < 4; ++r) { q[(size_t)r * 2048] = f2bf(o0[r]); q[(size_t)(4 + r) * 2048] = f2bf(o1[r]); q[(size_t)(128 + r) * 2048] = f2bf(o2[r]); q[(size_t)(132 + r) * 2048] = f2bf(o3[r]); }
            }
        } else if (pn < 16) {
            const int c0i = (pn - 8) * 256 + cl8; const int head = c0i >> 9, e0 = c0i & 511;
            bf16_t* q = vt + (((unsigned)(b * 4 + head) * 512u + (unsigned)e0) * 2048u + (unsigned)t);
#pragma unroll
            for (int r = 0; r < 4; ++r) { q[(size_t)r * 2048] = f2bf(a0[r]); q[(size_t)(4 + r) * 2048] = f2bf(a1[r]); q[(size_t)(128 + r) * 2048] = f2bf(b0[r]); q[(size_t)(132 + r) * 2048] = f2bf(b1[r]); }
        } else {
            const u32x2 p0 = pack4(a0), p1 = pack4(a1), p2 = pack4(b0), p3 = pack4(b1);
            *(u32x4*)nat = (u32x4){p0.x, p0.y, p1.x, p1.y}; *(u32x4*)(nat + 128) = (u32x4){p2.x, p2.y, p3.x, p3.y};
        }
    }
    static constexpr bool NEEDS_RSTD = true;
    bf16_t* big; bf16_t* kt; bf16_t* vt; const float* rc; const float* rs; const float* dec; const float* ss;
    DEVI void quad(int row, int pn, int cl, f32x4 v0, f32x4 v1, float rsc) const {
        v0 *= rsc; v1 *= rsc;
        const bool smp = row >= PR; const int b = row >> 11, t = row & 2047;
        bf16_t* nat = big + ((unsigned)row * 6144u + (unsigned)(pn * 256 + cl));
        if (pn < 8) {
            const int h = pn & 3; const int pi = smp ? 2048 : t;
            const f32x4 c = *(const f32x4*)(rc + pi * 128 + cl), s = *(const f32x4*)(rs + pi * 128 + cl);
            f32x4 o0 = v0 * c - v1 * s, o1 = v0 * s + v1 * c;
            const float sc = dec[pn * 128 + (smp ? 0 : (t & 127))];
            o0 *= sc; o1 *= sc;
            *(u32x2*)nat = pack4(o0); *(u32x2*)(nat + 128) = pack4(o1);
            if (pn >= 4 && !smp) {
                bf16_t* q = kt + (((unsigned)(b * 4 + h) * 256u + (unsigned)cl) * 2048u + (unsigned)t);
#pragma unroll
                for (int r = 0; r < 4; ++r) { q[(size_t)r * 2048] = f2bf(o0[r]); q[(size_t)(128 + r) * 2048] = f2bf(o1[r]); }
            }
        } else if (pn < 16) {
            if (smp) { *(u32x2*)nat = pack4(v0); *(u32x2*)(nat + 128) = pack4(v1); }
            else {
                const int c0 = (pn - 8) * 256 + cl; const int head = c0 >> 9, e0 = c0 & 511;
                bf16_t* q = vt + (((unsigned)(b * 4 + head) * 512u + (unsigned)e0) * 2048u + (unsigned)t);
#pragma unroll
                for (int r = 0; r < 4; ++r) { q[(size_t)r * 2048] = f2bf(v0[r]); q[(size_t)(128 + r) * 2048] = f2bf(v1[r]); }
            }
        } else { *(u32x2*)nat = pack4(v0); *(u32x2*)(nat + 128) = pack4(v1); }
    }
};
struct QResid {
    static constexpr bool PERM = true;
    DEVI void oct(int row, int pn, int cl8, f32x4 a0, f32x4 a1, f32x4 b0, f32x4 b1, float rsc) const {
        (void)rsc;
        const float* r = (row < PR ? rinP + (size_t)row * 1024 : rinS + (size_t)(row - PR) * 1024) + pn * 256 + cl8;
        const unsigned off = (unsigned)row * 1024u + (unsigned)(pn * 256 + cl8);
        a0 += __builtin_nontemporal_load((const f32x4*)r); a1 += __builtin_nontemporal_load((const f32x4*)(r + 4)); b0 += __builtin_nontemporal_load((const f32x4*)(r + 128)); b1 += __builtin_nontemporal_load((const f32x4*)(r + 132));
        __builtin_nontemporal_store(a0, (f32x4*)(xout + off)); __builtin_nontemporal_store(a1, (f32x4*)(xout + off + 4)); __builtin_nontemporal_store(b0, (f32x4*)(xout + off + 128)); __builtin_nontemporal_store(b1, (f32x4*)(xout + off + 132));
        const u32x2 pa0 = pack4(a0), pa1 = pack4(a1), pb0 = pack4(b0), pb1 = pack4(b1);
        *(u32x4*)(xb + off) = (u32x4){pa0.x, pa0.y, pa1.x, pa1.y}; *(u32x4*)(xb + off + 128) = (u32x4){pb0.x, pb0.y, pb1.x, pb1.y};
        float sa = a0[0] * a0[0] + a0[1] * a0[1] + a0[2] * a0[2] + a0[3] * a0[3] + a1[0] * a1[0] + a1[1] * a1[1] + a1[2] * a1[2] + a1[3] * a1[3];
        float sb = b0[0] * b0[0] + b0[1] * b0[1] + b0[2] * b0[2] + b0[3] * b0[3] + b1[0] * b1[0] + b1[1] * b1[1] + b1[2] * b1[2] + b1[3] * b1[3];
        const int lane = (row & 15) | (((cl8 >> 3) & 3) << 4);
        sa += shx(sa, 16, lane); sa += shx(sa, 32, lane); sb += shx(sb, 16, lane); sb += shx(sb, 32, lane);
        if (lane < 16) { float* sp = ssout + ((unsigned)row * 32u + (unsigned)(pn * 8 + (cl8 >> 5))); sp[0] = sa; sp[4] = sb; }
    }
    static constexpr bool NEEDS_RSTD = false;
    const float* rinP; const float* rinS; float* xout; bf16_t* xb; float* ssout;
    DEVI void quad(int row, int pn, int cl, f32x4 v0, f32x4 v1, float rsc) const {
        (void)rsc;
        const float* r = (row < PR ? rinP + (size_t)row * 1024 : rinS + (size_t)(row - PR) * 1024) + pn * 256 + cl;
        const unsigned off = (unsigned)row * 1024u + (unsigned)(pn * 256 + cl);
        const f32x4 a = *(const f32x4*)r + v0, b = *(const f32x4*)(r + 128) + v1;
        *(f32x4*)(xout + off) = a; *(f32x4*)(xout + off + 128) = b;
        *(u32x2*)(xb + off) = pack4(a); *(u32x2*)(xb + off + 128) = pack4(b);
        float sq = a[0] * a[0] + a[1] * a[1] + a[2] * a[2] + a[3] * a[3] + b[0] * b[0] + b[1] * b[1] + b[2] * b[2] + b[3] * b[3];
        const int lane = (row & 15) | (((cl >> 2) & 3) << 4);
        sq += shx(sq, 16, lane); sq += shx(sq, 32, lane);
        if (lane < 16) ssout[(unsigned)row * 32u + (unsigned)(pn * 8 + (cl >> 4))] = sq;
    }
};
struct QBf16 {
    static constexpr bool NEEDS_RSTD = true;
    static constexpr bool PERM = true;
    bf16_t* out; int ld; const float* ss;
    DEVI void oct(int row, int pn, int cl8, f32x4 a0, f32x4 a1, f32x4 b0, f32x4 b1, float rsc) const {
        bf16_t* o = out + ((unsigned)row * (unsigned)ld + (unsigned)(pn * 256 + cl8));
        const u32x2 pa0 = pack4(a0 * rsc), pa1 = pack4(a1 * rsc), pb0 = pack4(b0 * rsc), pb1 = pack4(b1 * rsc);
        *(u32x4*)o = (u32x4){pa0.x, pa0.y, pa1.x, pa1.y}; *(u32x4*)(o + 128) = (u32x4){pb0.x, pb0.y, pb1.x, pb1.y};
    }
    DEVI void quad(int row, int pn, int cl, f32x4 v0, f32x4 v1, float rsc) const {
        v0 *= rsc; v1 *= rsc;
        bf16_t* o = out + ((unsigned)row * (unsigned)ld + (unsigned)(pn * 256 + cl));
        *(u32x2*)o = pack4(v0); *(u32x2*)(o + 128) = pack4(v1);
    }
};
DEVI float dpp_shr(float v, const int n) {
    const int x = __float_as_int(v);
    return __int_as_float(n == 1 ? __builtin_amdgcn_update_dpp(x, x, 0x111, 0xf, 0xf, false) : __builtin_amdgcn_update_dpp(x, x, 0x112, 0xf, 0xf, false));
}
struct QFfn {
    static constexpr bool NEEDS_RSTD = true;
    static constexpr bool PERM = true;
    bf16_t* y; bf16_t* big; const float* ss; const float* cw; const float* cb; const float* sbuf; float* outp; float* outs;
    DEVI void oct(int row, int pn, int cl8, f32x4 a0, f32x4 a1, f32x4 b0, f32x4 b1, float rsc) const {
        a0 *= rsc; a1 *= rsc; b0 *= rsc; b1 *= rsc;
        const int ch = pn * 128 + cl8, fr = row & 15;
        f32x4 p10, p11, p20, p21;
#pragma unroll
        for (int k = 0; k < 4; ++k) { p10[k] = dpp_shr(a0[k], 1); p11[k] = dpp_shr(a1[k], 1); p20[k] = dpp_shr(a0[k], 2); p21[k] = dpp_shr(a1[k], 2); }
        if (fr >= 2) {
            const f32x4 w00 = *(const f32x4*)(cw + ch), w01 = *(const f32x4*)(cw + ch + 4), w10 = *(const f32x4*)(cw + 3072 + ch), w11 = *(const f32x4*)(cw + 3072 + ch + 4);
            const f32x4 w20 = *(const f32x4*)(cw + 6144 + ch), w21 = *(const f32x4*)(cw + 6144 + ch + 4), c0 = *(const f32x4*)(cb + ch), c1 = *(const f32x4*)(cb + ch + 4);
            float o[8];
#pragma unroll
            for (int k = 0; k < 4; ++k) {
                o[k] = gelu_tanh(c0[k] + p20[k] * w00[k] + p10[k] * w10[k] + a0[k] * w20[k]) * b0[k];
                o[4 + k] = gelu_tanh(c1[k] + p21[k] * w01[k] + p11[k] * w11[k] + a1[k] * w21[k]) * b1[k];
            }
            u32x4 w; w.x = cvt_pk_bf16(o[0], o[1]); w.y = cvt_pk_bf16(o[2], o[3]); w.z = cvt_pk_bf16(o[4], o[5]); w.w = cvt_pk_bf16(o[6], o[7]);
            *(u32x4*)(y + ((unsigned)row * 3072u + (unsigned)ch)) = w;
        }
        if (fr < 2 || fr >= 14) {
            const u32x2 p0 = pack4(a0), p1 = pack4(a1);
            *(u32x4*)(big + ((unsigned)row * 6144u + (unsigned)ch)) = (u32x4){p0.x, p0.y, p1.x, p1.y};
            if (fr < 2) { const u32x2 g0 = pack4(b0), g1 = pack4(b1); *(u32x4*)(big + ((unsigned)row * 6144u + 3072u + (unsigned)ch)) = (u32x4){g0.x, g0.y, g1.x, g1.y}; }
            else if ((row & 2047) >= 2046) { float* q = outp + ((size_t)(row >> 11) * 2 + ((row & 2047) - 2046)) * 3072 + ch; *(f32x4*)q = a0; *(f32x4*)(q + 4) = a1; }
        }
    }
    DEVI void quad(int row, int pn, int cl, f32x4 v0, f32x4 v1, float rsc) const {
        v0 *= rsc; v1 *= rsc;
        const int ch = pn * 128 + cl, sb = row - PR;
        const float* b0 = sbuf + ((size_t)sb * 2) * 3072 + ch;
        const f32x4 h2 = *(const f32x4*)b0, h1 = *(const f32x4*)(b0 + 3072);
        const f32x4 w0 = *(const f32x4*)(cw + ch), w1 = *(const f32x4*)(cw + 3072 + ch), w2 = *(const f32x4*)(cw + 6144 + ch), c = *(const f32x4*)(cb + ch);
        float* q = outs + ((size_t)sb * 2) * 3072 + ch;
        *(f32x4*)q = h1; *(f32x4*)(q + 3072) = v0;
        f32x4 o;
#pragma unroll
        for (int k = 0; k < 4; ++k) o[k] = gelu_tanh(c[k] + h2[k] * w0[k] + h1[k] * w1[k] + v0[k] * w2[k]) * v1[k];
        *(u32x2*)(y + ((unsigned)row * 3072u + (unsigned)ch)) = pack4(o);
    }
};
struct QMemKV {
    static constexpr bool PERM = false;
    static constexpr bool NEEDS_RSTD = false;
    float* outk; float* outv; bf16_t* mk; bf16_t* mvt;
    DEVI void quad(int row, int pn, int cl, f32x4 v0, f32x4 v1, float rsc) const {
        if (pn < 4) {
            const size_t o = (size_t)row * 1024 + pn * 256 + cl;
            __builtin_nontemporal_store(v0, (f32x4*)(outk + o)); __builtin_nontemporal_store(v1, (f32x4*)(outk + o + 128));
            *(u32x2*)(mk + o) = pack4(v0); *(u32x2*)(mk + o + 128) = pack4(v1);
        } else {
            const int h = pn - 4; const size_t o = (size_t)row * 1024 + h * 256 + cl;
            __builtin_nontemporal_store(v0, (f32x4*)(outv + o)); __builtin_nontemporal_store(v1, (f32x4*)(outv + o + 128));
            const int b = row >> 8, m = row & 255;
            bf16_t* q = mvt + ((size_t)(b * 4 + h) * 256 + cl) * 256 + m;
#pragma unroll
            for (int r = 0; r < 4; ++r) { q[r * 256] = f2bf(v0[r]); q[(128 + r) * 256] = f2bf(v1[r]); }
        }
    }
};
struct QLru {
    static constexpr bool PERM = false;
    static constexpr bool NEEDS_RSTD = false;
    const float* ba; const float* bx; const float* lam; const bf16_t* xc; float* aa; float* uu;
    const float* h0; float* hout; const bf16_t* big; bf16_t* yl;
    DEVI void quad(int row, int pn, int cl, f32x4 v0, f32x4 v1, float rsc) const {
        const int ch = (pn >> 1) * 256 + (pn & 1) * 128 + cl;
        const f32x4 ba4 = *(const f32x4*)(ba + ch), bx4 = *(const f32x4*)(bx + ch), lm4 = *(const f32x4*)(lam + ch);
        const u32x2 xp = *(const u32x2*)(xc + (size_t)row * 1024 + ch);
        const float xv[4] = {bflo(xp.x), bfhi(xp.x), bflo(xp.y), bfhi(xp.y)};
        f32x4 a4, u4;
#pragma unroll
        for (int r = 0; r < 4; ++r) {
            const float rr = sigmoidf_(v0[r] + ba4[r]), ii = sigmoidf_(v1[r] + bx4[r]);
            const float la = 8.f * rr * lm4[r];
            const float av = exp_(la);
            a4[r] = av; u4[r] = __builtin_amdgcn_sqrtf(fmaxf(1.f - av * av, 0.f)) * (ii * xv[r]);
        }
        if (row < PR) { *(f32x4*)(aa + (size_t)row * 1024 + ch) = a4; *(f32x4*)(uu + (size_t)row * 1024 + ch) = u4; }
        else {
            const int sb = row - PR;
            const f32x4 hp = *(const f32x4*)(h0 + (size_t)sb * 1024 + ch);
            const f32x4 hn = a4 * hp + u4;
            *(f32x4*)(hout + (size_t)sb * 1024 + ch) = hn;
            const u32x2 gp = *(const u32x2*)(big + (size_t)row * 2048 + 1024 + ch);
            f32x4 y; y[0] = gelu_tanh(bflo(gp.x)) * hn[0]; y[1] = gelu_tanh(bfhi(gp.x)) * hn[1]; y[2] = gelu_tanh(bflo(gp.y)) * hn[2]; y[3] = gelu_tanh(bfhi(gp.y)) * hn[3];
            *(u32x2*)(yl + (size_t)row * 1024 + ch) = pack4(y);
        }
    }
};

template <bool F32OUT>
DEVI void norm_phase(const float* srcP, const float* srcS, const float* gain, bf16_t* dstb, float* dstP, float* dstS, int nrows) {
    const int tid = tid_(); const int lane = tid & 63, wave = bid_() * 8 + (tid >> 6), nw = nblk_() * 8;
    f32x4 g[4];
#pragma unroll
    for (int i = 0; i < 4; ++i) g[i] = *(const f32x4*)(gain + i * 256 + lane * 4);
    for (int r0 = wave; r0 < nrows; r0 += 2 * nw) {
        f32x4 v[2][4]; float ss[2];
#pragma unroll
        for (int u = 0; u < 2; ++u) {
            const int r = r0 + u * nw < nrows ? r0 + u * nw : r0;
            const float* s = r < PR ? srcP + (size_t)r * 1024 : srcS + (size_t)(r - PR) * 1024;
#pragma unroll
            for (int i = 0; i < 4; ++i) v[u][i] = *(const f32x4*)(s + i * 256 + lane * 4);
        }
#pragma unroll
        for (int u = 0; u < 2; ++u) {
            float q = 0.f;
#pragma unroll
            for (int i = 0; i < 4; ++i) q += v[u][i][0] * v[u][i][0] + v[u][i][1] * v[u][i][1] + v[u][i][2] * v[u][i][2] + v[u][i][3] * v[u][i][3];
            ss[u] = q;
        }
#pragma unroll
        for (int o = 32; o; o >>= 1) { ss[0] += shx(ss[0], o, lane); ss[1] += shx(ss[1], o, lane); }
#pragma unroll
        for (int u = 0; u < 2; ++u) {
            const int r = r0 + u * nw;
            if (r < nrows) {
                const float rs = __builtin_amdgcn_rsqf(__fadd_rn(__fmul_rn(ss[u], 1.f / 1024.f), 1e-6f));
                if (F32OUT) {
                    float* d = r < PR ? dstP + (size_t)r * 1024 : dstS + (size_t)(r - PR) * 1024;
#pragma unroll
                    for (int i = 0; i < 4; ++i) __builtin_nontemporal_store(v[u][i] * rs * g[i], (f32x4*)(d + i * 256 + lane * 4));
                } else {
                    bf16_t* d = dstb + (size_t)r * 1024;
#pragma unroll
                    for (int i = 0; i < 4; ++i) *(u32x2*)(d + i * 256 + lane * 4) = pack4(v[u][i] * rs * g[i]);
                }
            }
        }
    }
}

DEVI void cast_ss_phase(const float* srcP, const float* srcS, bf16_t* xb, float* ss) {
    const int tid = tid_(); const int lane = tid & 63, wave = bid_() * 8 + (tid >> 6), nw = nblk_() * 8;
    for (int r = wave; r < TR; r += nw) {
        const float* s = r < PR ? srcP + (size_t)r * 1024 : srcS + (size_t)(r - PR) * 1024;
        f32x4 v[4]; float q = 0.f;
#pragma unroll
        for (int i = 0; i < 4; ++i) { v[i] = *(const f32x4*)(s + i * 256 + lane * 4); q += v[i][0] * v[i][0] + v[i][1] * v[i][1] + v[i][2] * v[i][2] + v[i][3] * v[i][3]; }
        q = wave_sum(q, lane);
#pragma unroll
        for (int i = 0; i < 4; ++i) *(u32x2*)(xb + (size_t)r * 1024 + i * 256 + lane * 4) = pack4(v[i]);
        if (lane < 32) ss[(size_t)r * 32 + lane] = lane == 0 ? q : 0.f;
    }
}

DEVI void transpose_phase(LAS unsigned char* lds, const Params& p) {
    LAS float* tile = (LAS float*)lds;
    const int tid = tid_();
    for (int ti = bid_(); ti < p.ntiles; ti += nblk_()) {
        int j = 0;
        while (j + 1 < NJOBS && p.jobs[j + 1].tile0 <= ti) ++j;
        const TJob jb = p.jobs[j];
        const int lt = ti - jb.tile0, ntn = jb.N >> 6, tk = lt / ntn, tn = lt - tk * ntn, k0 = tk * 64, n0 = tn * 64;
        {
            const int kk = tid >> 4, nq = tid & 15;
#pragma unroll
            for (int i = 0; i < 2; ++i) {
                const f32x4 v = __builtin_nontemporal_load((const f32x4*)(jb.src + (size_t)(k0 + kk + 32 * i) * jb.ld + n0 + nq * 4));
                const float gk = jb.gain ? jb.gain[k0 + kk + 32 * i] : 1.f;
#pragma unroll
                for (int c = 0; c < 4; ++c) tile[(kk + 32 * i) * 65 + nq * 4 + c] = v[c] * gk;
            }
        }
        __syncthreads();
        {
            const int n = tid >> 3, kq = tid & 7;
            float f[8];
#pragma unroll
            for (int c = 0; c < 8; ++c) f[c] = tile[(kq * 8 + c) * 65 + n];
            u32x4 o; o.x = cvt_pk_bf16(f[0], f[1]); o.y = cvt_pk_bf16(f[2], f[3]); o.z = cvt_pk_bf16(f[4], f[5]); o.w = cvt_pk_bf16(f[6], f[7]);
            *(u32x4*)(jb.dst + (size_t)(n0 + n) * jb.K + k0 + kq * 8) = o;
        }
        __syncthreads();
    }
}

DEVI void rot_phase(float* rc, float* rs, double c1) {
    const int gt = bid_() * 512 + tid_(), ng = nblk_() * 512;
    for (int i = gt; i < 2049 * 128; i += ng) {
        const int pi = i >> 7, j = i & 127;
        double inv = 1.0, bb = c1; int e = j;
        while (e) { if (e & 1) inv *= bb; bb *= bb; e >>= 1; }
        const double pos = pi == 2048 ? 16384.0 : (double)pi;
        const double ang = pos * inv;
        const double rev = ang * 0.15915494309189534561;
        const float fr_ = (float)(rev - rint(rev));
        rs[i] = __builtin_amdgcn_sinf(fr_);
        rc[i] = __builtin_amdgcn_cosf(fr_);
    }
}

DEVI void dec_phase(float* dec) { for (int i = bid_() * 512 + tid_(); i < 1024; i += nblk_() * 512) { const int r = i >> 7, t = i & 127, h = r & 3; const float l2g = __builtin_amdgcn_logf(1.f - 1.f / (float)(32 << h)); dec[i] = r < 4 ? ex2_(l2g * (float)t) : 0.0625f * ex2_(-l2g * (float)t); } }
DEVI void lsg_phase(const float* lam, float* lsg) { for (int i = bid_() * 512 + tid_(); i < 1024; i += nblk_() * 512) { const float e = exp_(-lam[i]); const float ser = e * (1.f - e * (0.5f - e * (0.33333333f - e * (0.25f - e * 0.2f)))); lsg[i] = e < 0.03f ? -ser : -0.69314718056f * __builtin_amdgcn_logf(1.f + e); } }

DEVI void gate_phase(const bf16_t* o, const bf16_t* big, bf16_t* og) {
    const int tid = tid_(); const int lane = tid & 63, wave = bid_() * 8 + (tid >> 6), nw = nblk_() * 8;
    for (int it0 = wave; it0 < TR * 4; it0 += 4 * nw) {
        u32x4 ov[4], gv[4];
#pragma unroll
        for (int u = 0; u < 4; ++u) {
            const int it = it0 + u * nw < TR * 4 ? it0 + u * nw : it0;
            const int row = it >> 2, h = it & 3;
            ov[u] = *(const u32x4*)(o + (size_t)row * 2048 + h * 512 + lane * 8);
            gv[u] = *(const u32x4*)(big + (size_t)row * 6144 + 4096 + h * 512 + lane * 8);
        }
#pragma unroll
        for (int u = 0; u < 4; ++u) {
            const int it = it0 + u * nw;
            const int row = it >> 2, h = it & 3;
            float of[8], gf[8];
            of[0] = bflo(ov[u].x); of[1] = bfhi(ov[u].x); of[2] = bflo(ov[u].y); of[3] = bfhi(ov[u].y); of[4] = bflo(ov[u].z); of[5] = bfhi(ov[u].z); of[6] = bflo(ov[u].w); of[7] = bfhi(ov[u].w);
            gf[0] = bflo(gv[u].x); gf[1] = bfhi(gv[u].x); gf[2] = bflo(gv[u].y); gf[3] = bfhi(gv[u].y); gf[4] = bflo(gv[u].z); gf[5] = bfhi(gv[u].z); gf[6] = bflo(gv[u].w); gf[7] = bfhi(gv[u].w);
            float ss = 0.f;
#pragma unroll
            for (int c = 0; c < 8; ++c) ss += of[c] * of[c];
            ss = wave_sum(ss, lane);
            const float rs = __builtin_amdgcn_rsqf(__fadd_rn(__fmul_rn(ss, 1.f / 512.f), 1e-6f));
            float y[8];
#pragma unroll
            for (int c = 0; c < 8; ++c) y[c] = gf[c] * sigmoidf_(gf[c]) * of[c] * rs;
            u32x4 w; w.x = cvt_pk_bf16(y[0], y[1]); w.y = cvt_pk_bf16(y[2], y[3]); w.z = cvt_pk_bf16(y[4], y[5]); w.w = cvt_pk_bf16(y[6], y[7]);
            if (it < TR * 4) *(u32x4*)(og + (size_t)row * 2048 + h * 512 + lane * 8) = w;
        }
    }
}

DEVI void unpack8(u32x4 v, float* f) { f[0] = bflo(v.x); f[1] = bfhi(v.x); f[2] = bflo(v.y); f[3] = bfhi(v.y); f[4] = bflo(v.z); f[5] = bfhi(v.z); f[6] = bflo(v.w); f[7] = bfhi(v.w); }

DEVI void ffn_gate_phase(const bf16_t* big, bf16_t* y, const float* cw, const float* cb, const float* sbuf  , float* outp  , float* outs  ) {
    const int gt = bid_() * 512 + tid_(), ng = nblk_() * 512;
    for (int it = gt; it < 256 * 384 + SR * 384; it += ng) {
        const bool smp = it >= 256 * 384;
        const int li = smp ? it - 256 * 384 : it;
        const int seg = li / 384, c = (li - seg * 384) * 8;
        float w0[8], w1[8], w2[8], bb[8];
#pragma unroll
        for (int k = 0; k < 8; k += 4) {
            const f32x4 a0 = *(const f32x4*)(cw + c + k), a1 = *(const f32x4*)(cw + 3072 + c + k), a2 = *(const f32x4*)(cw + 6144 + c + k), a3 = *(const f32x4*)(cb + c + k);
#pragma unroll
            for (int j = 0; j < 4; ++j) { w0[k + j] = a0[j]; w1[k + j] = a1[j]; w2[k + j] = a2[j]; bb[k + j] = a3[j]; }
        }
        float u1[8], u2[8];
        if (!smp) {
            const int row0 = seg * 64, t0 = row0 & 2047;
            if (t0 > 0) { unpack8(*(const u32x4*)(big + (size_t)(row0 - 1) * 6144 + c), u1); unpack8(*(const u32x4*)(big + (size_t)(row0 - 2) * 6144 + c), u2); }
            else {
#pragma unroll
                for (int k = 0; k < 8; ++k) { u1[k] = 0.f; u2[k] = 0.f; }
            }
#pragma unroll 8
            for (int r = 0; r < 64; ++r) {
                const size_t row = (size_t)row0 + r;
                float u0[8], gg[8], o[8];
                unpack8(*(const u32x4*)(big + row * 6144 + c), u0);
                unpack8(*(const u32x4*)(big + row * 6144 + 3072 + c), gg);
#pragma unroll
                for (int k = 0; k < 8; ++k) { const float uc = bb[k] + u2[k] * w0[k] + u1[k] * w1[k] + u0[k] * w2[k]; o[k] = gelu_tanh(uc) * gg[k]; }
                u32x4 w; w.x = cvt_pk_bf16(o[0], o[1]); w.y = cvt_pk_bf16(o[2], o[3]); w.z = cvt_pk_bf16(o[4], o[5]); w.w = cvt_pk_bf16(o[6], o[7]);
                *(u32x4*)(y + row * 3072 + c) = w;
                if (t0 + r >= 2046) { float* q = outp + ((size_t)(row >> 11) * 2 + (t0 + r - 2046)) * 3072 + c; *(f32x4*)q = (f32x4){u0[0], u0[1], u0[2], u0[3]}; *(f32x4*)(q + 4) = (f32x4){u0[4], u0[5], u0[6], u0[7]}; }
#pragma unroll
                for (int k = 0; k < 8; ++k) { u2[k] = u1[k]; u1[k] = u0[k]; }
            }
        } else {
            const int sb = seg; const size_t row = (size_t)PR + sb;
            float u0[8], gg[8], o[8];
            unpack8(*(const u32x4*)(big + row * 6144 + c), u0);
            unpack8(*(const u32x4*)(big + row * 6144 + 3072 + c), gg);
            const float* b0 = sbuf + ((size_t)sb * 2 + 0) * 3072 + c; const float* b1 = b0 + 3072;
            const f32x4 p0 = *(const f32x4*)b0, p1 = *(const f32x4*)(b0 + 4), q0 = *(const f32x4*)b1, q1 = *(const f32x4*)(b1 + 4);
#pragma unroll
            for (int k = 0; k < 4; ++k) { u2[k] = p0[k]; u2[4 + k] = p1[k]; u1[k] = q0[k]; u1[4 + k] = q1[k]; }
            float* q = outs + ((size_t)sb * 2) * 3072 + c;
            *(f32x4*)q = q0; *(f32x4*)(q + 4) = q1;
            *(f32x4*)(q + 3072) = (f32x4){u0[0], u0[1], u0[2], u0[3]}; *(f32x4*)(q + 3072 + 4) = (f32x4){u0[4], u0[5], u0[6], u0[7]};
#pragma unroll
            for (int k = 0; k < 8; ++k) { const float uc = bb[k] + u2[k] * w0[k] + u1[k] * w1[k] + u0[k] * w2[k]; o[k] = gelu_tanh(uc) * gg[k]; }
            u32x4 w; w.x = cvt_pk_bf16(o[0], o[1]); w.y = cvt_pk_bf16(o[2], o[3]); w.z = cvt_pk_bf16(o[4], o[5]); w.w = cvt_pk_bf16(o[6], o[7]);
            *(u32x4*)(y + row * 3072 + c) = w;
        }
    }
}

DEVI void ffn_fix_phase(const bf16_t* big, bf16_t* y, const float* cw, const float* cb) {
    const int gt = bid_() * 512 + tid_(), ng = nblk_() * 512;
    for (int it = gt; it < 2048 * 384; it += ng) {
        const int ri = it / 384, c = (it - ri * 384) * 8;
        const int row = (ri >> 1) * 16 + (ri & 1), t = row & 2047;
        float u0[8], u1[8], u2[8], gg[8];
        unpack8(*(const u32x4*)(big + (size_t)row * 6144 + c), u0);
        unpack8(*(const u32x4*)(big + (size_t)row * 6144 + 3072 + c), gg);
        unpack8(*(const u32x4*)(big + (size_t)(t >= 1 ? row - 1 : row) * 6144 + c), u1);
        unpack8(*(const u32x4*)(big + (size_t)(t >= 2 ? row - 2 : row) * 6144 + c), u2);
#pragma unroll
        for (int k = 0; k < 8; ++k) { u1[k] = t >= 1 ? u1[k] : 0.f; u2[k] = t >= 2 ? u2[k] : 0.f; }
        float r[8];
#pragma unroll
        for (int k = 0; k < 8; ++k) {
            const float uc = cb[c + k] + u2[k] * cw[c + k] + u1[k] * cw[3072 + c + k] + u0[k] * cw[6144 + c + k];
            r[k] = gelu_tanh(uc) * gg[k];
        }
        u32x4 w; w.x = cvt_pk_bf16(r[0], r[1]); w.y = cvt_pk_bf16(r[2], r[3]); w.z = cvt_pk_bf16(r[4], r[5]); w.w = cvt_pk_bf16(r[6], r[7]);
        *(u32x4*)(y + (size_t)row * 3072 + c) = w;
    }
}

DEVI void lru_conv_phase(const bf16_t* big, bf16_t* xc, const float* cw, const float* cb, const float* sbuf  , float* outp  , float* outs  ) {
    const int gt = bid_() * 512 + tid_(), ng = nblk_() * 512;
    for (int it = gt; it < 1024 * 128 + SR * 128; it += ng) {
        const bool smp = it >= 1024 * 128;
        const int li = smp ? it - 1024 * 128 : it;
        const int seg = li >> 7, c = (li & 127) * 8;
        float w0[8], w1[8], w2[8], w3[8], bb[8];
#pragma unroll
        for (int k = 0; k < 8; k += 4) {
            const f32x4 a0 = *(const f32x4*)(cw + c + k), a1 = *(const f32x4*)(cw + 1024 + c + k), a2 = *(const f32x4*)(cw + 2048 + c + k), a3 = *(const f32x4*)(cw + 3072 + c + k), a4 = *(const f32x4*)(cb + c + k);
#pragma unroll
            for (int j = 0; j < 4; ++j) { w0[k + j] = a0[j]; w1[k + j] = a1[j]; w2[k + j] = a2[j]; w3[k + j] = a3[j]; bb[k + j] = a4[j]; }
        }
        if (!smp) {
            const int row0 = seg * 16, t0 = row0 & 2047;
            u32x4 raw[19];
#pragma unroll
            for (int r = 0; r < 19; ++r) {
                const int rr = (t0 == 0 && r < 3) ? row0 : row0 - 3 + r;
                raw[r] = *(const u32x4*)(big + (size_t)rr * 2048 + c);
            }
            float x1[8], x2[8], x3[8];
            if (t0 > 0) { unpack8(raw[0], x3); unpack8(raw[1], x2); unpack8(raw[2], x1); }
            else {
#pragma unroll
                for (int k = 0; k < 8; ++k) { x1[k] = 0.f; x2[k] = 0.f; x3[k] = 0.f; }
            }
#pragma unroll
            for (int r = 0; r < 16; ++r) {
                const size_t row = (size_t)row0 + r;
                float x0[8], o[8];
                unpack8(raw[3 + r], x0);
#pragma unroll
                for (int k = 0; k < 8; ++k) o[k] = bb[k] + x3[k] * w0[k] + x2[k] * w1[k] + x1[k] * w2[k] + x0[k] * w3[k];
                u32x4 w; w.x = cvt_pk_bf16(o[0], o[1]); w.y = cvt_pk_bf16(o[2], o[3]); w.z = cvt_pk_bf16(o[4], o[5]); w.w = cvt_pk_bf16(o[6], o[7]);
                *(u32x4*)(xc + row * 1024 + c) = w;
                if (t0 + r >= 2045) { float* q = outp + ((size_t)(row >> 11) * 3 + (t0 + r - 2045)) * 1024 + c; *(f32x4*)q = (f32x4){x0[0], x0[1], x0[2], x0[3]}; *(f32x4*)(q + 4) = (f32x4){x0[4], x0[5], x0[6], x0[7]}; }
#pragma unroll
                for (int k = 0; k < 8; ++k) { x3[k] = x2[k]; x2[k] = x1[k]; x1[k] = x0[k]; }
            }
        } else {
            const int sb = seg; const size_t row = (size_t)PR + sb;
            float x0[8], x1[8], x2[8], x3[8], o[8];
            unpack8(*(const u32x4*)(big + row * 2048 + c), x0);
            const float* b0 = sbuf + (size_t)sb * 3 * 1024 + c;
            float* q = outs + (size_t)sb * 3 * 1024 + c;
#pragma unroll
            for (int k = 0; k < 8; k += 4) {
                const f32x4 p3 = *(const f32x4*)(b0 + k), p2 = *(const f32x4*)(b0 + 1024 + k), p1 = *(const f32x4*)(b0 + 2048 + k);
#pragma unroll
                for (int j = 0; j < 4; ++j) { x3[k + j] = p3[j]; x2[k + j] = p2[j]; x1[k + j] = p1[j]; }
                *(f32x4*)(q + k) = p2; *(f32x4*)(q + 1024 + k) = p1; *(f32x4*)(q + 2048 + k) = (f32x4){x0[k], x0[k + 1], x0[k + 2], x0[k + 3]};
            }
#pragma unroll
            for (int k = 0; k < 8; ++k) o[k] = bb[k] + x3[k] * w0[k] + x2[k] * w1[k] + x1[k] * w2[k] + x0[k] * w3[k];
            u32x4 w; w.x = cvt_pk_bf16(o[0], o[1]); w.y = cvt_pk_bf16(o[2], o[3]); w.z = cvt_pk_bf16(o[4], o[5]); w.w = cvt_pk_bf16(o[6], o[7]);
            *(u32x4*)(xc + row * 1024 + c) = w;
        }
    }
}

DEVI void scan1_phase(const float* aa, const float* uu, float* chs  ) {
    const int gt = bid_() * 512 + tid_(), ng = nblk_() * 512;
    for (int it = gt; it < 8 * 64 * 256; it += ng) {
        const int c = (it & 255) * 4, ck = (it >> 8) & 63, b = it >> 14;
        const size_t base = ((size_t)b * 2048 + ck * 32) * 1024 + c;
        f32x4 ap = (f32x4){1.f, 1.f, 1.f, 1.f}, h = (f32x4){0.f, 0.f, 0.f, 0.f};
#pragma unroll 8
        for (int t = 0; t < 32; ++t) { const f32x4 a = *(const f32x4*)(aa + base + (size_t)t * 1024), u = *(const f32x4*)(uu + base + (size_t)t * 1024); h = a * h + u; ap *= a; }
        float* o = chs + ((size_t)(b * 64 + ck) * 1024 + c) * 2;
        *(f32x4*)o = (f32x4){ap[0], h[0], ap[1], h[1]}; *(f32x4*)(o + 4) = (f32x4){ap[2], h[2], ap[3], h[3]};
    }
}
DEVI void scan2_phase(const float* aa, const float* uu, const float* chs, const bf16_t* big, bf16_t* yl, float* hout  ) {
    const int gt = bid_() * 512 + tid_(), ng = nblk_() * 512;
    for (int it = gt; it < 8 * 64 * 256; it += ng) {
        const int c = (it & 255) * 4, ck = (it >> 8) & 63, b = it >> 14;
        f32x4 h = (f32x4){0.f, 0.f, 0.f, 0.f};
        for (int k = 0; k < ck; ++k) {
            const float* ci = chs + ((size_t)(b * 64 + k) * 1024 + c) * 2;
            const f32x4 p0 = *(const f32x4*)ci, p1 = *(const f32x4*)(ci + 4);
            h[0] = p0[0] * h[0] + p0[1]; h[1] = p0[2] * h[1] + p0[3]; h[2] = p1[0] * h[2] + p1[1]; h[3] = p1[2] * h[3] + p1[3];
        }
        const size_t row0 = (size_t)b * 2048 + ck * 32;
#pragma unroll 8
        for (int t = 0; t < 32; ++t) {
            const size_t row = row0 + t;
            h = *(const f32x4*)(aa + row * 1024 + c) * h + *(const f32x4*)(uu + row * 1024 + c);
            const u32x2 gp = *(const u32x2*)(big + row * 2048 + 1024 + c);
            f32x4 y; y[0] = gelu_tanh(bflo(gp.x)) * h[0]; y[1] = gelu_tanh(bfhi(gp.x)) * h[1]; y[2] = gelu_tanh(bflo(gp.y)) * h[2]; y[3] = gelu_tanh(bfhi(gp.y)) * h[3];
            *(u32x2*)(yl + row * 1024 + c) = pack4(y);
        }
        if (ck == 63) *(f32x4*)(hout + b * 1024 + c) = h;
    }
}

DEVI void retention_prompt_phase(LAS unsigned char* lds, const bf16_t* big, const bf16_t* ktg, const bf16_t* vtg, bf16_t* og, float* sout  , const float* dec,
                                 const bool fuse, const float* sin_, float* sout_s) {
    constexpr int KS_STR = 528, VT_STR = 272, ST_STR = 528, AT_STR = 272;
    constexpr int KS_OFF = 0, VT_OFF = 128 * KS_STR, ST_OFF = VT_OFF + 64 * VT_STR, AT_OFF = ST_OFF + 64 * ST_STR;
    const int tid = tid_(), w = tid >> 6, lane = tid & 63, fr = lane & 15, fq = lane >> 4;
    LAS unsigned char* att = lds + AT_OFF + w * (16 * AT_STR);
    for (int it = bid_(); it < 256; it += nblk_()) {
        const int b = it >> 5, h = (it >> 3) & 3, es = it & 7;
        const float gam = 1.f - 1.f / (float)(32 << h), gam127 = dec[h * 128 + 127];
        f32x4 sacc[2][4];
#pragma unroll
        for (int a = 0; a < 2; ++a)
#pragma unroll
            for (int e = 0; e < 4; ++e) sacc[a][e] = (f32x4){0.f, 0.f, 0.f, 0.f};
        __syncthreads();
        { const unsigned z = zv_(); for (int i = tid; i < 64 * ST_STR / 16; i += 512) *(LAS u32x4*)(lds + ST_OFF + i * 16) = (u32x4){z, z, z, z}; }
        f32x4 o4s = (f32x4){0.f, 0.f, 0.f, 0.f};
        u32x4 pk[8], pv[2];
        {   const bf16_t* src = big + ((size_t)b * 2048 + (tid >> 5)) * 6144 + 1024 + h * 256 + (tid & 31) * 8;
#pragma unroll
            for (int i = 0; i < 8; ++i) pk[i] = *(const u32x4*)(src + (size_t)i * 16 * 6144);
            const bf16_t* vsrc = vtg + ((size_t)(b * 4 + h) * 512 + es * 64 + (tid >> 4)) * 2048 + (tid & 15) * 8;
#pragma unroll
            for (int i = 0; i < 2; ++i) pv[i] = *(const u32x4*)(vsrc + (size_t)i * 32 * 2048);
        }
        for (int n = 0; n < 16; ++n) {
            const size_t row0 = (size_t)b * 2048 + n * 128;
            __syncthreads();
            f32x4 sv[8]; size_t s_base = 0; int s_sb = 0, s_h = 0, s_eq = 0;
            if (fuse) {
                const int sit = it * 8 + (n >> 1);
                s_sb = sit >> 4; s_h = (sit >> 2) & 3; s_eq = sit & 3;
                s_base = ((size_t)(s_sb * 4 + s_h) * 256) * 512 + s_eq * 128 + (tid & 31) * 4 + (size_t)(8 * (tid >> 5) + 128 * (n & 1)) * 512;
#pragma unroll
                for (int i = 0; i < 8; ++i) sv[i] = __builtin_nontemporal_load((const f32x4*)(sin_ + s_base + (size_t)i * 512));
            }
            {
                LAS unsigned char* dst = lds + KS_OFF + (tid >> 5) * KS_STR + (tid & 31) * 16;
#pragma unroll
                for (int i = 0; i < 8; ++i) *(LAS u32x4*)(dst + i * 16 * KS_STR) = pk[i];
                LAS unsigned char* vdst = lds + VT_OFF + (tid >> 4) * VT_STR + (tid & 15) * 16;
#pragma unroll
                for (int i = 0; i < 2; ++i) *(LAS u32x4*)(vdst + i * 32 * VT_STR) = pv[i];
            }
            bf16x8 qf[8];
#pragma unroll
            for (int ks = 0; ks < 8; ++ks) qf[ks] = *(const bf16x8*)(big + (row0 + 16 * w + fr) * 6144 + h * 256 + ks * 32 + fq * 8);
            __syncthreads();
            {   const int nn = n + 1 < 16 ? n + 1 : n;
                const bf16_t* src = big + ((size_t)b * 2048 + nn * 128 + (tid >> 5)) * 6144 + 1024 + h * 256 + (tid & 31) * 8;
#pragma unroll
                for (int i = 0; i < 8; ++i) pk[i] = *(const u32x4*)(src + (size_t)i * 16 * 6144);
                const bf16_t* vsrc = vtg + ((size_t)(b * 4 + h) * 512 + es * 64 + (tid >> 4)) * 2048 + nn * 128 + (tid & 15) * 8;
#pragma unroll
                for (int i = 0; i < 2; ++i) pv[i] = *(const u32x4*)(vsrc + (size_t)i * 32 * 2048);
            }
            for (int jt = 0; jt <= w; ++jt) {
                f32x4 acc = (f32x4){0.f, 0.f, 0.f, 0.f};
#pragma unroll
                for (int ks = 0; ks < 8; ++ks) {
                    const bf16x8 kf = *(const LAS bf16x8*)(lds + KS_OFF + (jt * 16 + fr) * KS_STR + ks * 64 + fq * 16);
                    acc = mfma16(kf, qf[ks], acc);
                }
                if (jt == w) {
#pragma unroll
                    for (int r = 0; r < 4; ++r) if (fq * 4 + r > fr) acc[r] = 0.f;
                }
                *(LAS u32x2*)(att + fr * AT_STR + (jt * 16 + fq * 4) * 2) = pack4(acc);
            }
            if ((w & 1) == 0) { const unsigned z = zv_(); *(LAS u32x2*)(att + fr * AT_STR + ((w + 1) * 16 + fq * 4) * 2) = (u32x2){z, z}; }
            __builtin_amdgcn_fence(__ATOMIC_SEQ_CST, "wavefront"); asm volatile("s_waitcnt lgkmcnt(0)" ::: "memory"); __builtin_amdgcn_wave_barrier();
#pragma unroll
            for (int et = 0; et < 4; ++et) {
                f32x4 ao = (f32x4){0.f, 0.f, 0.f, 0.f}, ac = (f32x4){0.f, 0.f, 0.f, 0.f};
                for (int js = 0; js <= (w >> 1); ++js) {
                    const bf16x8 af = *(const LAS bf16x8*)(att + fr * AT_STR + js * 64 + fq * 16);
                    const bf16x8 vf = *(const LAS bf16x8*)(lds + VT_OFF + (et * 16 + fr) * VT_STR + js * 64 + fq * 16);
                    ao = mfma16(vf, af, ao);
                }
#pragma unroll
                for (int ks = 0; ks < 8; ++ks) {
                    const bf16x8 sf = *(const LAS bf16x8*)(lds + ST_OFF + (et * 16 + fr) * ST_STR + ks * 64 + fq * 16);
                    ac = mfma16(sf, qf[ks], ac);
                }
                const f32x4 o = ao + ac * gam;
                *(u32x2*)(og + (row0 + 16 * w + fr) * 2048 + h * 512 + es * 64 + et * 16 + fq * 4) = pack4(o);
            }
#pragma unroll
            for (int a = 0; a < 2; ++a)
#pragma unroll
                for (int e = 0; e < 4; ++e) sacc[a][e] *= gam;
#pragma unroll
            for (int js = 0; js < 4; ++js) {
                bf16x8 kf[2];
#pragma unroll
                for (int a = 0; a < 2; ++a) kf[a] = *(const bf16x8*)(ktg + ((size_t)(b * 4 + h) * 256 + 32 * w + a * 16 + fr) * 2048 + n * 128 + js * 32 + fq * 8);
#pragma unroll
                for (int e = 0; e < 4; ++e) {
                    const bf16x8 vf = *(const LAS bf16x8*)(lds + VT_OFF + (e * 16 + fr) * VT_STR + js * 64 + fq * 16);
#pragma unroll
                    for (int a = 0; a < 2; ++a) sacc[a][e] = mfma16(kf[a], vf, sacc[a][e]);
                }
            }
#pragma unroll
            for (int a = 0; a < 2; ++a)
#pragma unroll
                for (int e = 0; e < 4; ++e) sacc[a][e] *= gam127;
            if (fuse) {
                const size_t srow = (size_t)PR + s_sb;
                const bf16_t* qp = big + srow * 6144 + s_h * 256 + 8 * (tid >> 5) + 128 * (n & 1);
                float qd8[8], kd8[8];
                unpack8(*(const u32x4*)qp, qd8); unpack8(*(const u32x4*)(qp + 1024), kd8);
                const u32x2 vp = *(const u32x2*)(big + srow * 6144 + 2048 + s_h * 512 + s_eq * 128 + (tid & 31) * 4);
                const f32x4 v4 = (f32x4){bflo(vp.x), bfhi(vp.x), bflo(vp.y), bfhi(vp.y)};
                const float sgam = 1.f - 1.f / (float)(32 << s_h);
                if ((n & 1) == 0) o4s = (f32x4){0.f, 0.f, 0.f, 0.f};
#pragma unroll
                for (int i = 0; i < 8; ++i) {
                    const f32x4 sn = sv[i] * sgam + v4 * kd8[i];
                    __builtin_nontemporal_store(sn, (f32x4*)(sout_s + s_base + (size_t)i * 512));
                    o4s += sn * qd8[i];
                }
                if (n & 1) *(LAS f32x4*)(lds + 153616 + tid * 16) = o4s;
            }
            __syncthreads();
            if (fuse && (n & 1) && tid < 32) {
                f32x4 sm = *(const LAS f32x4*)(lds + 153616 + tid * 16);
#pragma unroll
                for (int k = 1; k < 16; ++k) sm += *(const LAS f32x4*)(lds + 153616 + (k * 32 + tid) * 16);
                *(u32x2*)(og + ((size_t)PR + s_sb) * 2048 + s_h * 512 + s_eq * 128 + tid * 4) = pack4(sm);
            }
#pragma unroll
            for (int a = 0; a < 2; ++a)
#pragma unroll
                for (int e = 0; e < 4; ++e)
                    *(LAS u32x2*)(lds + ST_OFF + (e * 16 + fr) * ST_STR + (32 * w + a * 16 + fq * 4) * 2) = pack4(sacc[a][e]);
        }
#pragma unroll
        for (int a = 0; a < 2; ++a)
#pragma unroll
            for (int e = 0; e < 4; ++e)
#pragma unroll
                for (int r = 0; r < 4; ++r)
                    __builtin_nontemporal_store(sacc[a][e][r], sout + ((size_t)(b * 4 + h) * 256 + 32 * w + a * 16 + fq * 4 + r) * 512 + es * 64 + e * 16 + fr);
    }
}

DEVI void retention_sample_phase(LAS unsigned char* lds, const bf16_t* big, const float* sin_, float* sout, bf16_t* og) {
    const int tid = tid_(), ec = tid & 31, dr = tid >> 5;
    LAS float* red = (LAS float*)lds;
    for (int it = bid_(); it < 128 * 4 * 4; it += nblk_()) {
        const int sb = it >> 4, h = (it >> 2) & 3, eq = it & 3;
        const float gam = 1.f - 1.f / (float)(32 << h);
        const size_t row = (size_t)PR + sb;
        const bf16_t* qp = big + row * 6144 + h * 256;
        const bf16_t* kp = qp + 1024;
        const u32x2 vp = *(const u32x2*)(big + row * 6144 + 2048 + h * 512 + eq * 128 + ec * 4);
        const f32x4 v4 = (f32x4){bflo(vp.x), bfhi(vp.x), bflo(vp.y), bfhi(vp.y)};
        const size_t sbase = ((size_t)(sb * 4 + h) * 256) * 512 + eq * 128 + ec * 4;
        f32x4 o4 = (f32x4){0.f, 0.f, 0.f, 0.f};
#pragma unroll
        for (int i = 0; i < 16; ++i) {
            const int d = dr + 16 * i;
            const f32x4 s = *(const f32x4*)(sin_ + sbase + (size_t)d * 512);
            const float kd = bf2f(kp[d]), qd = bf2f(qp[d]);
            const f32x4 sn = s * gam + v4 * kd;
            *(f32x4*)(sout + sbase + (size_t)d * 512) = sn;
            o4 += sn * qd;
        }
        __syncthreads();
        *(LAS f32x4*)(red + (dr * 32 + ec) * 4) = o4;
        __syncthreads();
        if (tid < 32) {
            f32x4 s = (f32x4){0.f, 0.f, 0.f, 0.f};
#pragma unroll
            for (int k = 0; k < 16; ++k) s += *(const LAS f32x4*)(red + (k * 32 + tid) * 4);
            *(u32x2*)(og + row * 2048 + h * 512 + eq * 128 + tid * 4) = pack4(s);
        }
    }
}

DEVI void xattn_prompt_phase(LAS unsigned char* lds, const bf16_t* qx, const bf16_t* mk  , const bf16_t* mvt  , bf16_t* ao) {
    constexpr int STR = 528;
    const int tid = tid_(), w = tid >> 6, lane = tid & 63, fr = lane & 15, fq = lane >> 4;
    for (int it = bid_(); it < 512; it += nblk_()) {
        const int b = it >> 6, h = (it >> 4) & 3, qt = it & 15;
        const size_t row = (size_t)b * 2048 + qt * 128 + 16 * w + fr;
        __syncthreads();
        {   const int m0 = tid >> 5, dq = tid & 31;
            const bf16_t* src = mk + ((size_t)b * 256 + m0) * 1024 + h * 256 + dq * 8;
            LAS unsigned char* dst = lds + m0 * STR + dq * 16;
#pragma unroll
            for (int i = 0; i < 16; ++i) *(LAS u32x4*)(dst + i * 16 * STR) = *(const u32x4*)(src + (size_t)i * 16 * 1024);
        }
        bf16x8 qf[8];
#pragma unroll
        for (int ks = 0; ks < 8; ++ks) qf[ks] = *(const bf16x8*)(qx + row * 1024 + h * 256 + ks * 32 + fq * 8);
        __syncthreads();
        bf16x8 pf[8];
        float hmx[2], hsum[2];
        const float sc = 0.0625f * 1.4426950408889634f;
#pragma unroll
        for (int hf = 0; hf < 2; ++hf) {
            f32x4 s[8];
#pragma unroll
            for (int mt = 0; mt < 8; ++mt) {
                f32x4 acc = (f32x4){0.f, 0.f, 0.f, 0.f};
#pragma unroll
                for (int ks = 0; ks < 8; ++ks) {
                    const bf16x8 kf = *(const LAS bf16x8*)(lds + ((hf * 8 + mt) * 16 + fr) * STR + ks * 64 + fq * 16);
                    acc = mfma16(kf, qf[ks], acc);
                }
                s[mt] = acc;
                __builtin_amdgcn_sched_barrier(0);
            }
            float mx = -3.0e38f;
#pragma unroll
            for (int mt = 0; mt < 8; ++mt)
#pragma unroll
                for (int r = 0; r < 4; ++r) mx = fmaxf(mx, s[mt][r]);
            mx = fmaxf(mx, shx(mx, 16, lane)); mx = fmaxf(mx, shx(mx, 32, lane));
            float sum = 0.f;
#pragma unroll
            for (int mt = 0; mt < 8; ++mt)
#pragma unroll
                for (int r = 0; r < 4; ++r) { const float e = ex2_((s[mt][r] - mx) * sc); s[mt][r] = e; sum += e; }
            sum += shx(sum, 16, lane); sum += shx(sum, 32, lane);
            hmx[hf] = mx; hsum[hf] = sum;
#pragma unroll
            for (int ms = 0; ms < 4; ++ms) {
                u32x4 u; u.x = cvt_pk_bf16(s[2 * ms][0], s[2 * ms][1]); u.y = cvt_pk_bf16(s[2 * ms][2], s[2 * ms][3]);
                u.z = cvt_pk_bf16(s[2 * ms + 1][0], s[2 * ms + 1][1]); u.w = cvt_pk_bf16(s[2 * ms + 1][2], s[2 * ms + 1][3]);
                pf[hf * 4 + ms] = __builtin_bit_cast(bf16x8, u);
            }
        }
        const float mxa = fmaxf(hmx[0], hmx[1]);
        float al0 = ex2_((hmx[0] - mxa) * sc), al1 = ex2_((hmx[1] - mxa) * sc);
        const float inv = rcp_(hsum[0] * al0 + hsum[1] * al1);
        al0 *= inv; al1 *= inv;
        __syncthreads();
        {   const int d0 = tid >> 5, mq = tid & 31;
            const bf16_t* src = mvt + ((size_t)(b * 4 + h) * 256 + d0) * 256 + mq * 8;
            LAS unsigned char* dst = lds + d0 * STR + mq * 16;
#pragma unroll
            for (int i = 0; i < 16; ++i) *(LAS u32x4*)(dst + i * 16 * STR) = *(const u32x4*)(src + (size_t)i * 16 * 256);
        }
        __syncthreads();
#pragma unroll 2
        for (int dt = 0; dt < 16; ++dt) {
            f32x4 acc0 = (f32x4){0.f, 0.f, 0.f, 0.f}, acc1 = acc0;
#pragma unroll
            for (int ms = 0; ms < 8; ++ms) {
                const u32x2 lo = *(const LAS u32x2*)(lds + (dt * 16 + fr) * STR + (ms * 32 + fq * 4) * 2);
                const u32x2 hi = *(const LAS u32x2*)(lds + (dt * 16 + fr) * STR + (ms * 32 + 16 + fq * 4) * 2);
                u32x4 u; u.x = lo.x; u.y = lo.y; u.z = hi.x; u.w = hi.y;
                if (ms < 4) acc0 = mfma16(__builtin_bit_cast(bf16x8, u), pf[ms], acc0);
                else acc1 = mfma16(__builtin_bit_cast(bf16x8, u), pf[ms], acc1);
            }
            *(u32x2*)(ao + row * 1024 + h * 256 + dt * 16 + fq * 4) = pack4(acc0 * al0 + acc1 * al1);
        }
    }
}

DEVI void xattn_sample_phase(LAS unsigned char* lds, const bf16_t* qx, const float* ck, const float* cv, bf16_t* ao) {
    const int tid = tid_(), w = tid >> 6, lane = tid & 63;
    LAS float* sc = (LAS float*)lds;
    LAS float* red = (LAS float*)(lds + 2048);
    for (int it = bid_(); it < 512; it += nblk_()) {
        const int sb = it >> 2, h = it & 3;
        const size_t row = (size_t)PR + sb;
        const u32x2 qp = *(const u32x2*)(qx + row * 1024 + h * 256 + lane * 4);
        const f32x4 q4 = (f32x4){bflo(qp.x), bfhi(qp.x), bflo(qp.y), bfhi(qp.y)};
        const size_t base = ((size_t)sb * 256 * 4 + h) * 256 + lane * 4;
        __syncthreads();
#pragma unroll 16
        for (int i = 0; i < 32; ++i) {
            const int m = w + 8 * i;
            const f32x4 k4 = __builtin_nontemporal_load((const f32x4*)(ck + base + (size_t)m * 1024));
            float d = k4[0] * q4[0] + k4[1] * q4[1] + k4[2] * q4[2] + k4[3] * q4[3];
            d = wave_sum(d, lane);
            if (lane == 0) sc[m] = d * 0.0625f;
        }
        __syncthreads();
        float mx = -3.0e38f;
        for (int m = lane; m < 256; m += 64) mx = fmaxf(mx, sc[m]);
#pragma unroll
        for (int o = 32; o; o >>= 1) mx = fmaxf(mx, shx(mx, o, lane));
        float sum = 0.f;
        for (int m = lane; m < 256; m += 64) sum += exp_(sc[m] - mx);
        sum = wave_sum(sum, lane);
        const float inv = rcp_(sum);
        f32x4 o4 = (f32x4){0.f, 0.f, 0.f, 0.f};
#pragma unroll 16
        for (int i = 0; i < 32; ++i) {
            const int m = w + 8 * i;
            const float pm = exp_(sc[m] - mx) * inv;
            const f32x4 v4 = __builtin_nontemporal_load((const f32x4*)(cv + base + (size_t)m * 1024));
            o4 += v4 * pm;
        }
        *(LAS f32x4*)(red + (w * 64 + lane) * 4) = o4;
        __syncthreads();
        if (tid < 64) {
            f32x4 s = (f32x4){0.f, 0.f, 0.f, 0.f};
#pragma unroll
            for (int k = 0; k < 8; ++k) s += *(const LAS f32x4*)(red + (k * 64 + tid) * 4);
            *(u32x2*)(ao + row * 1024 + h * 256 + tid * 4) = pack4(s);
        }
    }
}

#define XB_TMO      128
#define XB_XCNT(j)  (256  + 64 * (j))
#define XB_XSUB(j)  (1280 + 64 * (j))
#define XB_XGEN(j)  (2304 + 64 * (j))
#define XB_TOP      3328
#define XB_TOPGEN   3392
#define XCD_BAR_WORDS 3456
#define XB_SPIN_CAP (1u << 18)
DEVI unsigned xb_ld(unsigned* p)              { return __hip_atomic_load(p, __ATOMIC_RELAXED, __HIP_MEMORY_SCOPE_AGENT); }
DEVI unsigned xb_add(unsigned* p, unsigned v) { return __hip_atomic_fetch_add(p, v, __ATOMIC_RELAXED, __HIP_MEMORY_SCOPE_AGENT); }
DEVI unsigned xb_xcc_id() { return (unsigned)__builtin_amdgcn_s_getreg((3 << 11) | 20) & 0xFu; }
#define XB_SPIN(cond, bar) do { unsigned _sp = 0; while (cond) { __builtin_amdgcn_s_sleep(1); \
    if ((++_sp & 255u) == 0u) { if (xb_ld(&(bar)[XB_TMO])) break; if (_sp > XB_SPIN_CAP) { atomicAdd(&(bar)[XB_TMO], 1u); break; } } } } while (0)
struct XcdBarrier { unsigned* bar; unsigned x; volatile LAS unsigned* st; };
DEVI XcdBarrier xcd_barrier_post(unsigned* bar, volatile LAS unsigned* st) {
    XcdBarrier b; b.bar = bar; b.x = xb_xcc_id(); b.st = st;
    if (threadIdx.x == 0) (void)xb_add(&bar[XB_XCNT(b.x)], 1u);
    return b;
}
DEVI void xcd_barrier_complete(unsigned* bar, unsigned x, unsigned& nloc, unsigned& nx) {
    const unsigned G = gridDim.x * gridDim.y * gridDim.z;
    unsigned sum, cnt, mine, sp = 0u;
    for (;;) {
        sum = 0u; cnt = 0u; mine = 0u;
#pragma unroll
        for (unsigned j = 0; j < 16; ++j) { const unsigned c = xb_ld(&bar[XB_XCNT(j)]); sum += c; cnt += (c > 0u) ? 1u : 0u; mine = (j == x) ? c : mine; }
        if (sum == G) break;
        __builtin_amdgcn_s_sleep(1);
        if ((++sp & 255u) == 0u) { if (xb_ld(&bar[XB_TMO])) break; if (sp > XB_SPIN_CAP) { atomicAdd(&bar[XB_TMO], 1u); break; } }
    }
    nloc = mine > 0u ? mine : 1u; nx = cnt > 0u ? cnt : 1u;
}
DEVI void xcd_barrier(const XcdBarrier& b) {
    asm volatile("s_waitcnt vmcnt(0)" ::: "memory");
    __syncthreads();
    if (threadIdx.x == 0) {
        unsigned* bar = b.bar;
        __builtin_amdgcn_s_waitcnt(0);
        unsigned nloc = b.st[0], nx = b.st[1];
        if (nloc == 0u) { xcd_barrier_complete(bar, b.x, nloc, nx); b.st[0] = nloc; b.st[1] = nx; }
        const unsigned old = xb_add(&bar[XB_XSUB(b.x)], 1u);
        const unsigned gen = old / nloc;
        if (old + 1u == (gen + 1u) * nloc) {
            __builtin_amdgcn_fence(__ATOMIC_RELEASE, "agent");
            asm volatile("s_waitcnt vmcnt(0)" ::: "memory");
            const unsigned og = xb_add(&bar[XB_TOP], 1u);
            const unsigned tg = og / nx;
            if (og + 1u == (tg + 1u) * nx) xb_add(&bar[XB_TOPGEN], 1u);
            else XB_SPIN(xb_ld(&bar[XB_TOPGEN]) == tg, bar);
            __builtin_amdgcn_fence(__ATOMIC_ACQUIRE, "agent");
            xb_add(&bar[XB_XGEN(b.x)], 1u);
            asm volatile("s_waitcnt vmcnt(0)" ::: "memory");
        } else {
            XB_SPIN(xb_ld(&bar[XB_XGEN(b.x)]) == gen, bar);
            __builtin_amdgcn_fence(__ATOMIC_ACQUIRE, "agent");
            asm volatile("s_waitcnt vmcnt(0)" ::: "memory");
        }
    }
    __syncthreads();
}

enum { K_PREP = 0, K_RETIN, K_RET, K_GATE, K_RESID, K_NORM, K_BF16, K_XATTN, K_FFNGATE, K_LRUCONV, K_LRU, K_SCAN1, K_SCAN2, K_NORMF };
constexpr int NPH = 24;
struct Step { int kind, L, lda, N, K, ldo, ssi; const bf16_t* A; const bf16_t* Bt; bf16_t* ob; const float* rinP; const float* rinS; };

template <int ONLY>
__global__ void __launch_bounds__(512) mega(Params p, int lo, int hi) {
    extern __shared__ __attribute__((aligned(16))) unsigned char shm[];
    LAS unsigned char* lds = (LAS unsigned char*)shm;
    cg::grid_group grid = cg::this_grid();
#define WS_ ((unsigned char*)p.in[33 + zero_()])
#define OUT_ ((float*)p.in[32 + zero_()])
#define x_prompt (p.in[0 + zero_()])
#define x_sample (p.in[1 + zero_()])
#define state_ret (p.in[2 + zero_()])
#define state_lru_h (p.in[3 + zero_()])
#define state_lru_conv (p.in[4 + zero_()])
#define state_ffn_conv (p.in[5 + zero_()])
#define cache_k (p.in[6 + zero_()])
#define cache_v (p.in[7 + zero_()])
#define mem_prompt (p.in[8 + zero_()])
#define norm_mix (p.in[9 + zero_()])
#define norm_xa (p.in[10 + zero_()])
#define norm_mem (p.in[11 + zero_()])
#define norm_ffn (p.in[12 + zero_()])
#define norm_final (p.in[13 + zero_()])
#define lru_conv_w (p.in[17 + zero_()])
#define lru_conv_b (p.in[18 + zero_()])
#define lru_ba (p.in[20 + zero_()])
#define lru_bx (p.in[22 + zero_()])
#define lru_lambda (p.in[23 + zero_()])
#define ffn_conv_w (p.in[29 + zero_()])
#define ffn_conv_b (p.in[30 + zero_()])
#define HN ((bf16_t*)(WS_ + W_HN))
#define MN ((bf16_t*)(WS_ + W_MN))
#define MK ((bf16_t*)(WS_ + W_MK))
#define MVT ((bf16_t*)(WS_ + W_MVT))
#define BIG ((bf16_t*)(WS_ + W_BIG))
#define X ((float*)(WS_ + W_X))
#define XS ((float*)(WS_ + W_X) + (size_t)PR * 1024)
#define QX ((bf16_t*)(WS_ + W_QX))
#define AO ((bf16_t*)(WS_ + W_AO))
#define Y ((bf16_t*)(WS_ + W_Y))
#define KT ((bf16_t*)(WS_ + W_KT))
#define VT ((bf16_t*)(WS_ + W_VT))
#define O ((bf16_t*)(WS_ + W_O))
#define OG ((bf16_t*)(WS_ + W_OG))
#define XC ((bf16_t*)(WS_ + W_XC))
#define AA ((float*)(WS_ + W_AA))
#define UU ((float*)(WS_ + W_UU))
#define CH ((float*)(WS_ + W_CH))
#define YL ((bf16_t*)(WS_ + W_YL))
#define ROTC ((float*)(WS_ + W_ROTC))
#define ROTS ((float*)(WS_ + W_ROTS))
#define LSG ((float*)(WS_ + W_LSG))
#define SS ((float*)(WS_ + W_SS))
#define DEC ((float*)(WS_ + W_DEC))
    volatile LAS unsigned* xst = (volatile LAS unsigned*)(lds + 153600);
    if (threadIdx.x < 4) xst[threadIdx.x] = 0u;
    __syncthreads();
    const XcdBarrier xbar = xcd_barrier_post((unsigned*)(WS_ + W_BAR), xst);
    const int hi2 = hi < NPH ? hi : NPH;
    for (int ph = lo; ph < hi2; ++ph) {
        Step st; st.kind = K_NORMF; st.L = ph >= 11 ? 1 : 0; st.lda = 1024; st.N = 1024; st.K = 1024; st.ldo = 1024; st.ssi = 0; st.A = HN; st.Bt = nullptr; st.ob = nullptr; st.rinP = X; st.rinS = XS;
        switch (ph) {
            case 0: st.kind = K_PREP; break;
            case 1: st.kind = K_RETIN; break;
            case 2: st.kind = K_RET; break;
            case 3: st.kind = K_GATE; break;
            case 4: st.kind = K_RESID; st.ssi = 1; st.A = OG; st.lda = 2048; st.K = 2048; st.Bt = (const bf16_t*)(WS_ + W_ROUT); st.rinP = x_prompt; st.rinS = x_sample; break;
            case 5: st.kind = K_BF16; st.ssi = 1; st.Bt = (const bf16_t*)(WS_ + W_XQ); st.ob = QX; break;
            case 6: st.kind = K_XATTN; break;
            case 7: st.kind = K_RESID; st.ssi = 2; st.A = AO; st.Bt = (const bf16_t*)(WS_ + W_XO); break;
            case 8: st.kind = K_BF16; st.ssi = 2; st.Bt = (const bf16_t*)(WS_ + W_UP); st.N = 6144; st.ob = BIG; st.ldo = 6144; break;
            case 9: st.kind = K_FFNGATE; break;
            case 10: st.kind = K_RESID; st.ssi = 3; st.A = Y; st.lda = 3072; st.K = 3072; st.Bt = (const bf16_t*)(WS_ + W_DN); break;
            case 11: st.kind = K_BF16; st.ssi = 3; st.Bt = (const bf16_t*)(WS_ + W_LIN); st.N = 2048; st.ob = BIG; st.ldo = 2048; break;
            case 12: st.kind = K_LRUCONV; break;
            case 13: st.kind = K_LRU; break;
            case 14: st.kind = K_SCAN1; break;
            case 15: st.kind = K_SCAN2; break;
            case 16: st.kind = K_RESID; st.ssi = 4; st.A = YL; st.Bt = (const bf16_t*)(WS_ + W_LOUT); break;
            case 17: st.kind = K_BF16; st.ssi = 4; st.Bt = (const bf16_t*)(WS_ + W_XQ + 2097152); st.ob = QX; break;
            case 18: st.kind = K_XATTN; break;
            case 19: st.kind = K_RESID; st.ssi = 5; st.A = AO; st.Bt = (const bf16_t*)(WS_ + W_XO + 2097152); break;
            case 20: st.kind = K_BF16; st.ssi = 5; st.Bt = (const bf16_t*)(WS_ + W_UP + 12582912); st.N = 6144; st.ob = BIG; st.ldo = 6144; break;
            case 21: st.kind = K_FFNGATE; break;
            case 22: st.kind = K_RESID; st.ssi = 6; st.A = Y; st.lda = 3072; st.K = 3072; st.Bt = (const bf16_t*)(WS_ + W_DN + 6291456); break;
            default: st.kind = K_NORMF; break;
        }
        const int L = st.L;
#ifndef DUP_MASK
#define DUP_MASK 0
#endif
        const int nrep = 1 + (int)(((unsigned)(DUP_MASK) >> st.kind) & 1u);
        for (int rep = 0; rep < nrep; ++rep) {
        if (rep) grid.sync();
        switch (st.kind) {
            case K_PREP: if constexpr (ONLY < 0 || ONLY == K_PREP) {
#if EN(0)
                transpose_phase(lds, p);
                rot_phase(ROTC, ROTS, p.rope_c1);
                lsg_phase(lru_lambda, LSG);
                dec_phase(DEC);
                cast_ss_phase(x_prompt, x_sample, HN, SS);
                for (int i = 0; i < 2; ++i) norm_phase<false>(mem_prompt, nullptr, norm_mem + i * 1024, MN + (size_t)i * 2097152, nullptr, nullptr, 2048);
#endif
            } break;
            case K_RETIN: if constexpr (ONLY < 0 || ONLY == K_RETIN) {
                QRetIn q; q.big = BIG; q.kt = KT; q.vt = VT; q.rc = ROTC; q.rs = ROTS; q.dec = DEC; q.ss = SS;
#if EN(1)
                run_gemm(lds, HN, 1024, (const bf16_t*)(WS_ + W_RIN), 1024, PR, 6144, 1024, 0, 0, q);
#endif
#if EN(13)
                skinny_phase(lds, HN + (size_t)PR * 1024, 1024, (const bf16_t*)(WS_ + W_RIN), 1024, 6144, 1024, 0, q, nblk_() == 256 ? 128 : 0);
#endif
#if EN(14)
                for (int i = 0; i < 2; ++i) {
                    QMemKV m; m.outk = OUT_ + O_MKP + (size_t)i * 2097152; m.outv = OUT_ + O_MVP + (size_t)i * 2097152; m.mk = MK + (size_t)i * 2097152; m.mvt = MVT + (size_t)i * 2097152;
                    run_gemm(lds, MN + (size_t)i * 2097152, 1024, (const bf16_t*)(WS_ + W_XKV + (size_t)i * 4194304), 1024, 2048, 2048, 1024, 0, 128 + 64 * i, m);
                }
#endif
            } break;
            case K_RET: if constexpr (ONLY < 0 || ONLY == K_RET) {
#if EN(2)
                retention_prompt_phase(lds, BIG, KT, VT, O, OUT_ + O_RETP, DEC, nblk_() == 256, state_ret, OUT_ + O_RETS);
#endif
#if EN(3)
                if (nblk_() != 256) retention_sample_phase(lds, BIG, state_ret, OUT_ + O_RETS, O);
#endif
            } break;
            case K_GATE: if constexpr (ONLY < 0 || ONLY == K_GATE) {
#if EN(4)
                gate_phase(O, BIG, OG);
#endif
            } break;
            case K_RESID: if constexpr (ONLY < 0 || ONLY == K_RESID) {
                QResid q; q.rinP = st.rinP; q.rinS = st.rinS; q.xout = X; q.xb = HN; q.ssout = SS + (size_t)st.ssi * TP * 32;
#if EN(5)
                run_gemm(lds, st.A, st.lda, st.Bt, st.K, PR, 1024, st.K, 0, 0, q);
#endif
#if EN(15)
                skinny_phase1(lds, st.A + (size_t)PR * st.lda, st.lda, st.Bt, st.K, 1024, st.K, 0, q);
#endif
            } break;
            case K_BF16: if constexpr (ONLY < 0 || ONLY == K_BF16) {
                if (st.N == 6144) {
                    unsigned char* wsb = WS_; float* ob = OUT_;
                    QFfn q; q.y = (bf16_t*)(wsb + W_Y); q.big = (bf16_t*)(wsb + W_BIG); q.ss = (const float*)(wsb + W_SS) + (size_t)st.ssi * TP * 32; q.cw = ffn_conv_w + (size_t)L * 9216; q.cb = ffn_conv_b + (size_t)L * 3072;
                    q.sbuf = state_ffn_conv + (size_t)L * 786432; q.outp = ob + O_FCP + (size_t)L * 49152; q.outs = ob + O_FCS + (size_t)L * 786432;
                    const bf16_t* hn = (const bf16_t*)(wsb + W_HN);
                    run_gemm(lds, hn, 1024, st.Bt, 1024, PR, 6144, 1024, 2, 0, q);
                    skinny_phase(lds, hn + (size_t)PR * 1024, 1024, st.Bt, 1024, 6144, 1024, 2, q);
                } else {
                QBf16 q; q.out = st.ob; q.ld = st.ldo; q.ss = SS + (size_t)st.ssi * TP * 32;
#if EN(6)
                run_gemm(lds, HN, 1024, st.Bt, 1024, PR, st.N, 1024, 0, 0, q);
#endif
#if EN(16)
                if (st.N == 1024) skinny_phase1(lds, HN + (size_t)PR * 1024, 1024, st.Bt, 1024, 1024, 1024, 0, q);
                else skinny_phase_t<2>(lds, HN + (size_t)PR * 1024, 1024, st.Bt, 1024, st.N, 1024, 0, q);
#endif
                }
            } break;
            case K_XATTN: if constexpr (ONLY < 0 || ONLY == K_XATTN) {
#if EN(10)
                xattn_prompt_phase(lds, QX, MK + (size_t)L * 2097152, MVT + (size_t)L * 2097152, AO);
#endif
#if EN(11)
                xattn_sample_phase(lds, QX, cache_k + (size_t)L * 33554432, cache_v + (size_t)L * 33554432, AO);
#endif
            } break;
            case K_FFNGATE: if constexpr (ONLY < 0 || ONLY == K_FFNGATE) {
#if EN(12)
                ffn_fix_phase(BIG, Y, ffn_conv_w + (size_t)L * 9216, ffn_conv_b + (size_t)L * 3072);
#endif
            } break;
            case K_LRUCONV: if constexpr (ONLY < 0 || ONLY == K_LRUCONV) {
#if EN(7)
                lru_conv_phase(BIG, XC, lru_conv_w, lru_conv_b, state_lru_conv, OUT_ + O_LCP, OUT_ + O_LCS);
#endif
            } break;
            case K_LRU: if constexpr (ONLY < 0 || ONLY == K_LRU) {
                QLru q; q.ba = lru_ba; q.bx = lru_bx; q.lam = LSG; q.xc = XC; q.aa = AA; q.uu = UU; q.h0 = state_lru_h; q.hout = OUT_ + O_LHS; q.big = BIG; q.yl = YL;
#if EN(8)
                run_gemm(lds, XC, 1024, (const bf16_t*)(WS_ + W_AX), 256, PR, 2048, 256, 1, 0, q);
#endif
#if EN(18)
                skinny_phase_t<2>(lds, XC + (size_t)PR * 1024, 1024, (const bf16_t*)(WS_ + W_AX), 256, 2048, 256, 1, q);
#endif
            } break;
            case K_SCAN1: if constexpr (ONLY < 0 || ONLY == K_SCAN1) {
#if EN(9)
                scan1_phase(AA, UU, CH);
#endif
            } break;
            case K_SCAN2: if constexpr (ONLY < 0 || ONLY == K_SCAN2) {
#if EN(9)
                scan2_phase(AA, UU, CH, BIG, YL, OUT_ + O_LHP);
#endif
            } break;
            default: if constexpr (ONLY < 0 || ONLY == K_NORMF) {
#if EN(0)
                norm_phase<true>(X, XS, norm_final, nullptr, OUT_ + O_YP, OUT_ + O_YS, TR);
#endif
            } break;
        }
        }
        if (ph + 1 < hi2) { if (lo < 0) grid.sync(); else xcd_barrier(xbar); }
    }
#ifdef EXTRA_SYNCS
    for (int i = 0; i < EXTRA_SYNCS; ++i) grid.sync();
#endif
}

#undef WS_
#undef OUT_
#undef x_prompt
#undef x_sample
#undef state_ret
#undef state_lru_h
#undef state_lru_conv
#undef state_ffn_conv
#undef cache_k
#undef cache_v
#undef mem_prompt
#undef norm_mix
#undef norm_xa
#undef norm_mem
#undef norm_ffn
#undef norm_final
#undef lru_conv_w
#undef lru_conv_b
#undef lru_ba
#undef lru_bx
#undef lru_lambda
#undef ffn_conv_w
#undef ffn_conv_b
#undef HN
#undef MN
#undef MK
#undef MVT
#undef BIG
#undef X
#undef XS
#undef QX
#undef AO
#undef Y
#undef KT
#undef VT
#undef O
#undef OG
#undef XC
#undef AA
#undef UU
#undef CH
#undef YL
#undef ROTC
#undef ROTS
#undef LSG
#undef SS
#undef DEC
__global__ void dump_k(const float* src, float* dst, size_t n) { for (size_t i = (size_t)bid_() * blockDim.x + threadIdx.x; i < n; i += (size_t)nblk_() * blockDim.x) dst[i] = src[i]; }
#ifndef MULTI
#define MULTI 0
#endif
static const int h_kinds[NPH] = {K_PREP, K_RETIN, K_RET, K_GATE, K_RESID, K_BF16, K_XATTN, K_RESID, K_BF16, K_FFNGATE, K_RESID, K_BF16, K_LRUCONV, K_LRU, K_SCAN1, K_SCAN2,
                                 K_RESID, K_BF16, K_XATTN, K_RESID, K_BF16, K_FFNGATE, K_RESID, K_NORMF};
typedef void (*mega_fn)(Params, int, int);
template <int K> static mega_fn get_fn() { return mega<K>; }
static mega_fn fn_of_kind(int k) {
    switch (k) {
        case 0: return get_fn<0>(); case 1: return get_fn<1>(); case 2: return get_fn<2>(); case 3: return get_fn<3>(); case 4: return get_fn<4>(); case 5: return get_fn<5>(); case 6: return get_fn<6>();
        case 7: return get_fn<7>(); case 8: return get_fn<8>(); case 9: return get_fn<9>(); case 10: return get_fn<10>(); case 11: return get_fn<11>(); case 12: return get_fn<12>(); default: return get_fn<13>();
    }
}

extern "C" void kernel_launch(void* const* d_in, const int* in_sizes, int n_in, void* d_out, int out_size, void* d_ws, size_t ws_size, hipStream_t stream) {
    (void)in_sizes; (void)n_in; (void)out_size;
    static int grid_blocks = 0;
    if (!grid_blocks) {
        int dev = 0, cus = 0;
        (void)hipGetDevice(&dev);
        (void)hipDeviceGetAttribute(&cus, hipDeviceAttributeMultiprocessorCount, dev);
#if MULTI
        for (int k = 0; k < 14; ++k) (void)hipFuncSetAttribute((const void*)fn_of_kind(k), hipFuncAttributeMaxDynamicSharedMemorySize, LDS_BYTES);
#else
        (void)hipFuncSetAttribute((const void*)mega<-1>, hipFuncAttributeMaxDynamicSharedMemorySize, LDS_BYTES);
#endif
        grid_blocks = cus;
        if (ws_size < W_TOTAL) fprintf(stderr, "workspace too small: %zu < %zu\n", ws_size, (size_t)W_TOTAL);
    }
    Params p; memset(&p, 0, sizeof(p));
    for (int i = 0; i < 32; ++i) p.in[i] = (const float*)d_in[i];
    p.in[32] = (const float*)d_out; p.in[33] = (const float*)d_ws;
    p.rope_c1 = pow(10000.0, -1.0 / 128.0);
    unsigned char* ws = (unsigned char*)d_ws;
    int nj = 0, tiles = 0;
    auto add = [&](const float* src, size_t dst_off, int ld, int K, int N, const float* gain = nullptr) {
        TJob& j = p.jobs[nj++]; j.gain = gain; j.src = src; j.dst = (bf16_t*)(ws + dst_off); j.ld = ld; j.K = K; j.N = N; j.tile0 = tiles; tiles += (K / 64) * (N / 64);
    };
    const float* ret_w_in = p.in[14]; const float* ret_w_out = p.in[15]; const float* lru_w_in = p.in[16]; const float* lru_wa = p.in[19]; const float* lru_wx = p.in[21];
    const float* lru_w_out = p.in[24]; const float* xa_w_q = p.in[25]; const float* xa_w_kv = p.in[26]; const float* xa_w_o = p.in[27]; const float* ffn_w_up = p.in[28]; const float* ffn_w_down = p.in[31];
    const float* g_mix = p.in[9]; const float* g_xa = p.in[10]; const float* g_ffn = p.in[12];
    add(ret_w_in, W_RIN, 6144, 1024, 6144, g_mix);
    add(ffn_w_up, W_UP, 6144, 1024, 6144, g_ffn);
    add(ffn_w_up + (size_t)1024 * 6144, W_UP + 12582912, 6144, 1024, 6144, g_ffn + 1024);
    add(ret_w_out, W_ROUT, 1024, 2048, 1024);
    add(lru_w_in, W_LIN, 2048, 1024, 2048, g_mix + 1024);
    for (int h = 0; h < 4; ++h)
        for (int s = 0; s < 2; ++s)
            for (int half = 0; half < 2; ++half)
                add((half ? lru_wx : lru_wa) + (size_t)h * 65536 + s * 128, W_AX + (size_t)(h * 512 + s * 256 + half * 128) * 256 * 2, 256, 256, 128);
    add(lru_w_out, W_LOUT, 1024, 1024, 1024);
    for (int i = 0; i < 2; ++i) add(xa_w_q + (size_t)i * 1048576, W_XQ + (size_t)i * 2097152, 1024, 1024, 1024, g_xa + i * 1024);
    for (int i = 0; i < 2; ++i) add(xa_w_kv + (size_t)i * 2097152, W_XKV + (size_t)i * 4194304, 2048, 1024, 2048);
    for (int i = 0; i < 2; ++i) add(xa_w_o + (size_t)i * 1048576, W_XO + (size_t)i * 2097152, 1024, 1024, 1024);
    for (int i = 0; i < 2; ++i) add(ffn_w_down + (size_t)i * 3145728, W_DN + (size_t)i * 6291456, 1024, 3072, 1024);
    p.ntiles = tiles;
    if (nj != NJOBS) fprintf(stderr, "job count mismatch %d\n", nj);
#if MULTI
#ifndef HI_LIMIT
#define HI_LIMIT NPH
#endif
    for (int ph0 = 0; ph0 < HI_LIMIT; ++ph0) {
        const int ph = ph0;
        int lo = ph, hi = ph + 1;
        void* args[] = {&p, &lo, &hi};
        hipError_t e = hipLaunchKernel((const void*)fn_of_kind(h_kinds[ph]), dim3(grid_blocks), dim3(512), args, LDS_BYTES, stream);
        if (e != hipSuccess) fprintf(stderr, "launch %d failed: %s\n", ph, hipGetErrorString(e));
    }
#ifdef DUMP_OFF
    dump_k<<<1024, 256, 0, stream>>>((const float*)((unsigned char*)d_ws + DUMP_OFF), (float*)d_out, (size_t)16000000);
#endif
#else
    (void)hipMemsetAsync((unsigned char*)d_ws + W_BAR, 0, 16384, stream);
    int lo = 0, hi = NPH;
    void* args[] = {&p, &lo, &hi};
    hipError_t e = hipLaunchCooperativeKernel((const void*)mega<-1>, dim3(grid_blocks), dim3(512), args, LDS_BYTES, stream);
    if (e != hipSuccess) fprintf(stderr, "cooperative launch failed: %s (grid %d)\n", hipGetErrorString(e), grid_blocks);
#endif
}
```

```cpp
#include <hip/hip_runtime.h>
#include <hip/hip_cooperative_groups.h>
#include <cstdio>
#include <cstring>
#include <cmath>
namespace cg = cooperative_groups;

#ifndef MASK
#define MASK 0xffffffffu
#endif
#define EN(k) (((MASK) >> (k)) & 1u)
#define LAS __attribute__((address_space(3)))
#define DEVI __device__ __forceinline__
typedef unsigned short bf16_t;
typedef short bf16x8 __attribute__((ext_vector_type(8)));
typedef float f32x4 __attribute__((ext_vector_type(4)));
typedef unsigned u32x2 __attribute__((ext_vector_type(2)));
typedef unsigned u32x4 __attribute__((ext_vector_type(4)));

constexpr int PR = 16384;
constexpr int SR = 128;
constexpr int TR = PR + SR;
constexpr int TP = 16640;
constexpr int LDS_BYTES = 153600 + 16 + 8192;

constexpr size_t O_YP = 0, O_YS = 16777216, O_RETP = 16908288, O_RETS = 21102592, O_LHP = 88211456, O_LHS = 88219648,
                 O_LCP = 88350720, O_LCS = 88375296, O_FCP = 88768512, O_FCS = 88866816, O_MKP = 90439680, O_MVP = 94633984;

constexpr size_t W_RIN = 0;
constexpr size_t W_ROUT = W_RIN + 12582912;
constexpr size_t W_LIN = W_ROUT + 4194304;
constexpr size_t W_AX = W_LIN + 4194304;
constexpr size_t W_LOUT = W_AX + 1048576;
constexpr size_t W_XQ = W_LOUT + 2097152;
constexpr size_t W_XKV = W_XQ + 2 * 2097152;
constexpr size_t W_XO = W_XKV + 2 * 4194304;
constexpr size_t W_UP = W_XO + 2 * 2097152;
constexpr size_t W_DN = W_UP + 2 * 12582912;
constexpr size_t W_ROTC = W_DN + 2 * 6291456;
constexpr size_t W_ROTS = W_ROTC + 1049088;
constexpr size_t W_LSG = W_ROTS + 1049088;
constexpr size_t W_DEC = W_LSG + 4096;
constexpr size_t W_SS = W_DEC + 4096;
constexpr size_t W_HN = W_SS + (size_t)7 * TP * 32 * 4;
constexpr size_t W_MN = W_HN + (size_t)TP * 2048;
constexpr size_t W_MK = W_MN + 8388608;
constexpr size_t W_MVT = W_MK + 8388608;
constexpr size_t W_BIG = W_MVT + 8388608;
constexpr size_t W_X = W_BIG + (size_t)TP * 12288;
constexpr size_t W_QX = W_X + (size_t)TP * 4096;
constexpr size_t W_AO = W_QX + (size_t)TP * 2048;
constexpr size_t W_Y = W_AO + (size_t)TP * 2048;
constexpr size_t W_L = W_Y + (size_t)TP * 6144;
constexpr size_t W_KT = W_L;
constexpr size_t W_VT = W_KT + 33554432;
constexpr size_t W_O = W_VT + 67108864;
constexpr size_t W_OG = W_O + (size_t)TP * 4096;
constexpr size_t W_END0 = W_OG + (size_t)TP * 4096;
constexpr size_t W_XC = W_L;
constexpr size_t W_AA = W_XC + (size_t)TP * 2048;
constexpr size_t W_UU = W_AA + (size_t)TP * 4096;
constexpr size_t W_CH = W_UU + (size_t)TP * 4096;
constexpr size_t W_YL = W_CH + 4194304;
constexpr size_t W_END1 = W_YL + (size_t)TP * 2048;
constexpr size_t W_BAR = (W_END0 > W_END1 ? W_END0 : W_END1);
constexpr size_t W_TOTAL = W_BAR + 256;

struct TJob { const float* src; bf16_t* dst; const float* gain; int ld, K, N, tile0; };
constexpr int NJOBS = 30;
struct Params {
    const float* in[34];
    double rope_c1;
    TJob jobs[NJOBS];
    int ntiles;
    int pad0;
};

typedef float f32x2 __attribute__((ext_vector_type(2)));
typedef __bf16 bf16x2_t __attribute__((ext_vector_type(2)));
DEVI unsigned cvt_pk_bf16(float lo, float hi) { f32x2 v = {lo, hi}; bf16x2_t r = __builtin_convertvector(v, bf16x2_t); return __builtin_bit_cast(unsigned, r); }
DEVI bf16_t f2bf(float f) { return (bf16_t)(cvt_pk_bf16(f, 0.f) & 0xffffu); }
DEVI float bflo(unsigned u) { return __uint_as_float(u << 16); }
DEVI float bfhi(unsigned u) { return __uint_as_float(u & 0xffff0000u); }
DEVI float bf2f(bf16_t b) { return __uint_as_float(((unsigned)b) << 16); }
DEVI u32x2 pack4(f32x4 v) { u32x2 r; r.x = cvt_pk_bf16(v[0], v[1]); r.y = cvt_pk_bf16(v[2], v[3]); return r; }
DEVI float shx(float v, int o, int lane) { return __int_as_float(__builtin_amdgcn_ds_bpermute((lane ^ o) << 2, __float_as_int(v))); }
DEVI float dpp_f(float v, const int ctrl_sel) {
    const int x = __float_as_int(v);
    int r;
    if (ctrl_sel == 0) r = __builtin_amdgcn_update_dpp(x, x, 0xB1, 0xf, 0xf, false);
    else if (ctrl_sel == 1) r = __builtin_amdgcn_update_dpp(x, x, 0x4E, 0xf, 0xf, false);
    else if (ctrl_sel == 2) r = __builtin_amdgcn_update_dpp(x, x, 0x141, 0xf, 0xf, false);
    else r = __builtin_amdgcn_update_dpp(x, x, 0x140, 0xf, 0xf, false);
    return __int_as_float(r);
}
DEVI float wave_sum(float v, int lane) {
    (void)lane;
    v += dpp_f(v, 0); v += dpp_f(v, 1); v += dpp_f(v, 2); v += dpp_f(v, 3);
    const int x = __float_as_int(v);
    const float s0 = __int_as_float(__builtin_amdgcn_readlane(x, 0)), s1 = __int_as_float(__builtin_amdgcn_readlane(x, 16));
    const float s2 = __int_as_float(__builtin_amdgcn_readlane(x, 32)), s3 = __int_as_float(__builtin_amdgcn_readlane(x, 48));
    return (s0 + s1) + (s2 + s3);
}
DEVI float rcp_(float x) { return __builtin_amdgcn_rcpf(x); }
DEVI float ex2_(float x) { return __builtin_amdgcn_exp2f(x); }
DEVI float exp_(float x) { return __builtin_amdgcn_exp2f(x * 1.4426950408889634f); }
DEVI float sigmoidf_(float x) { return rcp_(1.f + exp_(-x)); }
DEVI float gelu_tanh(float x) { const float z = 1.5957691216057308f * (x + 0.044715f * x * x * x); return x * rcp_(1.f + exp_(-z)); }
DEVI int zero_() { int z = 0; asm volatile("" : "+s"(z)); return z; }
DEVI int bid_() { int b = blockIdx.x; asm volatile("" : "+s"(b)); return b; }
DEVI int nblk_() { int b = gridDim.x; asm volatile("" : "+s"(b)); return b; }
DEVI unsigned zv_() { unsigned z = 0; asm volatile("" : "+v"(z)); return z; }
DEVI int tid_() { int t = threadIdx.x; asm volatile("" : "+v"(t)); return t; }
DEVI f32x4 mfma16(bf16x8 a, bf16x8 b, f32x4 c) { return __builtin_amdgcn_mfma_f32_16x16x32_bf16(a, b, c, 0, 0, 0); }

DEVI float rstd_of(const float* ss, int row) {
    const f32x4* p = (const f32x4*)(ss + (unsigned)row * 32u);
    f32x4 a = p[0];
#pragma unroll
    for (int i = 1; i < 8; ++i) a += p[i];
    return __builtin_amdgcn_rsqf(__fadd_rn(__fmul_rn((a[0] + a[1]) + (a[2] + a[3]), 1.f / 1024.f), 1e-6f));
}

namespace pg8 {
constexpr int BM = 256, BK = 64, HALF = 128, HTB = HALF * BK * 2, NXCD = 8, WGM = 8;
__host__ __device__ __forceinline__ int lds_byte(int r, int c) { const int st = (r >> 4) * 2 + (c >> 5), rr = r & 15, cc = c & 31, ob = rr * 64 + cc * 2; return st * 1024 + (ob ^ (((ob >> 9) & 1) << 5)); }
__host__ __device__ __forceinline__ void stage_rc(int b, int& R, int& C) { const int st = b / 1024, sb = b % 1024, swz = sb ^ (((sb >> 9) & 1) << 5); R = (st >> 1) * 16 + swz / 64; C = (st & 1) * 32 + (swz % 64) / 2; }
__host__ __device__ __forceinline__ int perm32(int rho) { const int n = rho >> 4, i = rho & 15; return 8 * (i >> 2) + 4 * n + (i & 3); }
struct Unit { int pm, pn; };
struct Gemm { const bf16_t* A; const bf16_t* Bt; int M, N, K, lda, ldb, diag; };
struct StaticOrder {
    int nM, nN, nwg, G, c;
    DEVI void init(int M, int N, int G_, int c_) { nM = M / BM; nN = N / BM; nwg = nM * nN; G = G_; c = c_; }
    DEVI bool next(int i, Unit& u) const {
        const long L = (long)i * G + c; if (L >= nwg) return false;
        int wgid = (int)L; { const int q = nwg / NXCD, r = nwg % NXCD, xcd = wgid % NXCD, off = wgid / NXCD; wgid = (xcd < r ? xcd * (q + 1) : r * (q + 1) + (xcd - r) * q) + off; }
        const int nig = WGM * nN, gid = wgid / nig, fm = gid * WGM, gsz = (nM - fm) < WGM ? (nM - fm) : WGM;
        u.pm = fm + ((wgid % nig) % gsz); u.pn = (wgid % nig) / gsz; return true;
    }
};

template <class Q>
DEVI void gemm_phase(LAS unsigned char* lds, const Gemm g, const StaticOrder& S, const Q& E) {
    const int tid = tid_(), wid = __builtin_amdgcn_readfirstlane(tid >> 6), lane = tid & 63, wr = wid >> 2, wc = wid & 3, fr = lane & 15, fq = lane >> 4;
    const int K = g.K, nt = K / BK;
    unsigned voffA, voffB;
    { int R, C; stage_rc(tid * 16, R, C); const int Rb = Q::PERM ? ((R & ~31) + perm32(R & 31)) : R; voffA = (unsigned)(R * g.lda + C) * 2u; voffB = (unsigned)(Rb * g.ldb + C) * 2u; }
    const size_t r64voffA = (size_t)64 * g.lda * 2, r64voffB = (size_t)64 * g.ldb * 2;
    const size_t kstep = (size_t)(BK * 2);
    const size_t hstepA = (size_t)HALF * g.lda * 2, hstepB = (g.diag == 2 ? (size_t)3072 : (size_t)HALF) * g.ldb * 2;
    const size_t tstepA = 2 * hstepA, tstepB = (g.diag == 2 ? (size_t)HALF : (size_t)2 * HALF) * g.ldb * 2;
    const unsigned ldsw = (unsigned)wid * 1024u;
    const int aoff = lds_byte(wr * 64 + fr, fq * 8), boff = lds_byte(wc * 32 + fr, fq * 8);
#define PG8_SA(b, h) (((b) * 2 + (h)) * HTB)
#define PG8_SB(b, h) ((4 + (b) * 2 + (h)) * HTB)
#define PG8_STAGE(bufoff, gbase, voff) do { _Pragma("unroll") for (int _i = 0; _i < 2; ++_i) \
        __builtin_amdgcn_global_load_lds((const unsigned*)((const char*)(gbase) + (size_t)_i * r64##voff + voff), (LAS unsigned*)(lds + (bufoff) + ldsw + _i * 8192), 16, 0, 0); } while (0)
#define PG8_LDA(dst, b, h) do { _Pragma("unroll") for (int m = 0; m < 4; ++m) _Pragma("unroll") for (int k = 0; k < 2; ++k) dst[m][k] = *(const LAS bf16x8*)(lds + PG8_SA(b, h) + aoff + m * 2048 + k * 1024); } while (0)
#define PG8_LDB(dst, b, h) do { _Pragma("unroll") for (int n = 0; n < 2; ++n) _Pragma("unroll") for (int k = 0; k < 2; ++k) dst[n][k] = *(const LAS bf16x8*)(lds + PG8_SB(b, h) + boff + n * 2048 + k * 1024); } while (0)
#define PG8_MMA(ai, bj, At, Bt) do { __builtin_amdgcn_s_setprio(1); _Pragma("unroll") for (int m = 0; m < 4; ++m) _Pragma("unroll") for (int n = 0; n < 2; ++n) _Pragma("unroll") for (int k = 0; k < 2; ++k) \
        acc[ai][bj][m][n] = __builtin_amdgcn_mfma_f32_16x16x32_bf16(Bt[n][k], At[m][k], acc[ai][bj][m][n], 0, 0, 0); __builtin_amdgcn_s_setprio(0); } while (0)
#define PG8_WAIT_V(n) asm volatile("s_waitcnt vmcnt(" #n ")" ::: "memory")
#define PG8_WAIT_L(n) asm volatile("s_waitcnt lgkmcnt(" #n ")" ::: "memory")
#define PG8_BAR __builtin_amdgcn_s_barrier()
#define PG8_SCHED __builtin_amdgcn_sched_barrier(0)
    Unit cur, nxt; int ui = 0;
    if (!S.next(0, cur)) return;
    f32x4 acc[2][2][4][2];
#pragma unroll
    for (int a = 0; a < 2; ++a)
#pragma unroll
        for (int b = 0; b < 2; ++b)
#pragma unroll
            for (int m = 0; m < 4; ++m)
#pragma unroll
                for (int n = 0; n < 2; ++n) acc[a][b][m][n] = (f32x4){0.f, 0.f, 0.f, 0.f};
    bf16x8 At[4][2], B0[2][2], B1[2][2];
    const char* cA = (const char*)g.A + (size_t)cur.pm * tstepA + (g.diag == 1 ? (size_t)(cur.pn >> 1) * 512 : 0); const char* cB = (const char*)g.Bt + (size_t)cur.pn * tstepB;
#define PG8_RSTD(unit, par) do { if constexpr (Q::NEEDS_RSTD) { \
        const int _rl = tid >> 1, _hf = tid & 1; \
        const f32x4* _p = (const f32x4*)(E.ss + ((size_t)((unit).pm * BM + _rl)) * 32 + _hf * 16); \
        const f32x4 _a = (_p[0] + _p[1]) + (_p[2] + _p[3]); \
        float _sm = (_a[0] + _a[1]) + (_a[2] + _a[3]); \
        _sm += shx(_sm, 1, lane); \
        if (!_hf) *(LAS float*)(lds + 131072 + (par) * 1024 + _rl * 4) = __builtin_amdgcn_rsqf(__fadd_rn(__fmul_rn(_sm, 1.f / 1024.f), 1e-6f)); } } while (0)
    PG8_RSTD(cur, 0);
    PG8_STAGE(PG8_SB(0, 0), cB, voffB); PG8_STAGE(PG8_SA(0, 0), cA, voffA); PG8_STAGE(PG8_SB(0, 1), cB + hstepB, voffB); PG8_STAGE(PG8_SA(0, 1), cA + hstepA, voffA);
    if (wr == 1) PG8_BAR;
    PG8_WAIT_V(4); PG8_BAR;
    PG8_STAGE(PG8_SB(1, 0), cB + kstep, voffB); PG8_STAGE(PG8_SA(1, 0), cA + kstep, voffA); PG8_STAGE(PG8_SB(1, 1), cB + hstepB + kstep, voffB);
    PG8_WAIT_V(6); PG8_BAR;
    for (;;) {
        const bool has_next = S.next(ui + 1, nxt);
        const char* nA = has_next ? (const char*)g.A + (size_t)nxt.pm * tstepA + (g.diag == 1 ? (size_t)(nxt.pn >> 1) * 512 : 0) : cA; const char* nB = has_next ? (const char*)g.Bt + (size_t)nxt.pn * tstepB : cB;
        for (int t = 0; t < nt; t += 2) {
            const bool last = (t == nt - 2);
            const char* a1 = cA + (size_t)(t + 1) * kstep;
            const char* a2 = last ? nA : cA + (size_t)(t + 2) * kstep; const char* b2 = last ? nB : cB + (size_t)(t + 2) * kstep;
            const char* a3 = a2 + kstep; const char* b3 = b2 + kstep;
            PG8_LDB(B0, 0, 0); PG8_SCHED; PG8_LDA(At, 0, 0); PG8_STAGE(PG8_SA(1, 1), a1 + hstepA, voffA);
            PG8_WAIT_L(8); PG8_BAR; PG8_WAIT_L(0); PG8_MMA(0, 0, At, B0); PG8_BAR; PG8_SCHED;
            PG8_LDB(B1, 0, 1); PG8_STAGE(PG8_SB(0, 0), b2, voffB);
            PG8_BAR; PG8_WAIT_L(0); PG8_MMA(0, 1, At, B1); PG8_BAR;
            PG8_LDA(At, 0, 1); PG8_STAGE(PG8_SA(0, 0), a2, voffA);
            PG8_BAR; PG8_WAIT_L(0); PG8_MMA(1, 0, At, B0); PG8_BAR; PG8_SCHED;
            PG8_STAGE(PG8_SB(0, 1), b2 + hstepB, voffB);
            PG8_WAIT_V(6); PG8_BAR; PG8_MMA(1, 1, At, B1); PG8_BAR;
            PG8_LDB(B0, 1, 0); PG8_SCHED; PG8_LDA(At, 1, 0); PG8_STAGE(PG8_SA(0, 1), a2 + hstepA, voffA);
            PG8_WAIT_L(8); PG8_BAR; PG8_WAIT_L(0); PG8_MMA(0, 0, At, B0); PG8_BAR; PG8_SCHED;
            PG8_LDB(B1, 1, 1); PG8_STAGE(PG8_SB(1, 0), b3, voffB);
            PG8_BAR; PG8_WAIT_L(0); PG8_MMA(0, 1, At, B1); PG8_BAR;
            PG8_LDA(At, 1, 1); PG8_STAGE(PG8_SA(1, 0), a3, voffA);
            PG8_BAR; PG8_WAIT_L(0); PG8_MMA(1, 0, At, B0); PG8_BAR; PG8_SCHED;
            PG8_STAGE(PG8_SB(1, 1), b3 + hstepB, voffB);
            PG8_WAIT_V(6); PG8_BAR; PG8_MMA(1, 1, At, B1); PG8_BAR;
        }
#pragma unroll
        for (int ai = 0; ai < 2; ++ai)
#pragma unroll
            for (int m = 0; m < 4; ++m) {
                int l2 = lane; asm volatile("" : "+v"(l2));
                const int rloc = ai * HALF + wr * 64 + m * 16 + (l2 & 15);
                float rsc = 1.f;
                if constexpr (Q::NEEDS_RSTD) rsc = *(const LAS float*)(lds + 131072 + (ui & 1) * 1024 + rloc * 4);
                if constexpr (Q::PERM) E.oct(cur.pm * BM + rloc, cur.pn, wc * 32 + (l2 >> 4) * 8, acc[ai][0][m][0], acc[ai][0][m][1], acc[ai][1][m][0], acc[ai][1][m][1], rsc);
                else {
#pragma unroll
                    for (int n = 0; n < 2; ++n)
                        E.quad(cur.pm * BM + rloc, cur.pn, wc * 32 + n * 16 + (l2 >> 4) * 4, acc[ai][0][m][n], acc[ai][1][m][n], rsc);
                }
            }
        if (!has_next) break;
        PG8_RSTD(nxt, (ui + 1) & 1);
#pragma unroll
        for (int a = 0; a < 2; ++a)
#pragma unroll
            for (int b = 0; b < 2; ++b)
#pragma unroll
                for (int m = 0; m < 4; ++m)
#pragma unroll
                    for (int n = 0; n < 2; ++n) acc[a][b][m][n] = (f32x4){0.f, 0.f, 0.f, 0.f};
        cur = nxt; cA = nA; cB = nB; ++ui;
    }
    PG8_WAIT_V(0);
    if (wr == 0) PG8_BAR;
    PG8_BAR;
#undef PG8_RSTD
#undef PG8_SA
#undef PG8_SB
#undef PG8_STAGE
#undef PG8_LDA
#undef PG8_LDB
#undef PG8_MMA
#undef PG8_WAIT_V
#undef PG8_WAIT_L
#undef PG8_BAR
#undef PG8_SCHED
}
}

template <class Q>
DEVI void run_gemm(LAS unsigned char* lds, const bf16_t* A, int lda, const bf16_t* Bt, int ldb, int M, int N, int K, int diag, int rot, const Q& q) {
    pg8::Gemm g; g.A = A; g.Bt = Bt; g.M = M; g.N = N; g.K = K; g.lda = lda; g.ldb = ldb; g.diag = diag;
    pg8::StaticOrder S; const int G_ = nblk_(); S.init(M, N, G_, (bid_() + G_ - (rot % G_)) % G_);
    pg8::gemm_phase<Q>(lds, g, S, q);
}

template <int RT, class Q>
DEVI void skinny_phase_t(LAS unsigned char* lds, const bf16_t* A, int lda, const bf16_t* Bt, int ldb, int N, int K, int diag, const Q& q, int nbuse = 0) {
    constexpr int RS = 8 / RT;
    const int tid = tid_(), w = tid >> 6, lane = tid & 63, fr = lane & 15, fq = lane >> 4;
    const int nitems = (N / 32) * RS, kw = K / 8;
    const int stride_ = nbuse > 0 ? nbuse : nblk_();
    for (int it = bid_() < stride_ ? bid_() : nitems; it < nitems; it += stride_) {
        const int ci = it / RS, rs = it - ci * RS, pn = ci >> 3, g = ci & 7;
        const bf16_t* a0 = A + (size_t)(rs * RT * 16 + fr) * lda + (diag == 1 ? (pn >> 1) * 256 : 0) + w * kw + fq * 8;
        const bf16_t* b0 = Bt + (size_t)((diag == 2 ? pn * 128 : pn * 256) + g * 16 + fr) * ldb + w * kw + fq * 8;
        const bf16_t* b1 = b0 + (size_t)(diag == 2 ? 3072 : 128) * ldb;
        f32x4 acc[RT][2];
#pragma unroll
        for (int rt = 0; rt < RT; ++rt) { acc[rt][0] = (f32x4){0.f, 0.f, 0.f, 0.f}; acc[rt][1] = (f32x4){0.f, 0.f, 0.f, 0.f}; }
        bf16x8 cb0 = *(const bf16x8*)(b0), cb1 = *(const bf16x8*)(b1), ca[RT];
#pragma unroll
        for (int rt = 0; rt < RT; ++rt) ca[rt] = *(const bf16x8*)(a0 + (size_t)rt * 16 * lda);
#pragma unroll 1
        for (int k = 32; k <= kw; k += 32) {
            const int kn = k < kw ? k : 0;
            const bf16x8 nb0 = *(const bf16x8*)(b0 + kn), nb1 = *(const bf16x8*)(b1 + kn);
            bf16x8 na[RT];
#pragma unroll
            for (int rt = 0; rt < RT; ++rt) na[rt] = *(const bf16x8*)(a0 + (size_t)rt * 16 * lda + kn);
#pragma unroll
            for (int rt = 0; rt < RT; ++rt) { acc[rt][0] = mfma16(cb0, ca[rt], acc[rt][0]); acc[rt][1] = mfma16(cb1, ca[rt], acc[rt][1]); }
            cb0 = nb0; cb1 = nb1;
#pragma unroll
            for (int rt = 0; rt < RT; ++rt) ca[rt] = na[rt];
        }
#pragma unroll
        for (int rt = 0; rt < RT; ++rt) {
            *(LAS f32x4*)(lds + (size_t)((((w * 8 + rt) * 2 + 0) * 64 + lane) * 16)) = acc[rt][0];
            *(LAS f32x4*)(lds + (size_t)((((w * 8 + rt) * 2 + 1) * 64 + lane) * 16)) = acc[rt][1];
        }
        __syncthreads();
        if (w < RT) {
            f32x4 v0 = *(const LAS f32x4*)(lds + (size_t)((((0 * 8 + w) * 2 + 0) * 64 + lane) * 16));
            f32x4 v1 = *(const LAS f32x4*)(lds + (size_t)((((0 * 8 + w) * 2 + 1) * 64 + lane) * 16));
#pragma unroll
            for (int ww = 1; ww < 8; ++ww) {
                v0 += *(const LAS f32x4*)(lds + (size_t)((((ww * 8 + w) * 2 + 0) * 64 + lane) * 16));
                v1 += *(const LAS f32x4*)(lds + (size_t)((((ww * 8 + w) * 2 + 1) * 64 + lane) * 16));
            }
            const int row = PR + (rs * RT + w) * 16 + fr;
            float rsc = 1.f;
            if constexpr (Q::NEEDS_RSTD) rsc = rstd_of(q.ss, row);
            q.quad(row, pn, g * 16 + fq * 4, v0, v1, rsc);
        }
        __syncthreads();
    }
}
template <class Q>
DEVI void skinny_phase(LAS unsigned char* lds, const bf16_t* A, int lda, const bf16_t* Bt, int ldb, int N, int K, int diag, const Q& q, int nbuse = 0) {
    skinny_phase_t<8, Q>(lds, A, lda, Bt, ldb, N, K, diag, q, nbuse);
}
template <class Q>
DEVI void skinny_phase1(LAS unsigned char* lds, const bf16_t* A, int lda, const bf16_t* Bt, int ldb, int N, int K, int diag, const Q& q) {
    skinny_phase_t<1, Q>(lds, A, lda, Bt, ldb, N, K, diag, q);
}

struct QRetIn {
    static constexpr bool PERM = true;
    DEVI void oct(int row, int pn, int cl8, f32x4 a0, f32x4 a1, f32x4 b0, f32x4 b1, float rsc) const {
        a0 *= rsc; a1 *= rsc; b0 *= rsc; b1 *= rsc;
        const int b = row >> 11, t = row & 2047;
        bf16_t* nat = big + ((unsigned)row * 6144u + (unsigned)(pn * 256 + cl8));
        if (pn < 8) {
            const int h = pn & 3;
            const float* pc = rc + t * 128 + cl8; const float* ps = rs + t * 128 + cl8;
            const f32x4 c0 = *(const f32x4*)pc, c1 = *(const f32x4*)(pc + 4), s0 = *(const f32x4*)ps, s1 = *(const f32x4*)(ps + 4);
            const float sc = dec[pn * 128 + (t & 127)];
            const f32x4 o0 = (a0 * c0 - b0 * s0) * sc, o1 = (a1 * c1 - b1 * s1) * sc, o2 = (a0 * s0 + b0 * c0) * sc, o3 = (a1 * s1 + b1 * c1) * sc;
            const u32x2 p0 = pack4(o0), p1 = pack4(o1), p2 = pack4(o2), p3 = pack4(o3);
            *(u32x4*)nat = (u32x4){p0.x, p0.y, p1.x, p1.y}; *(u32x4*)(nat + 128) = (u32x4){p2.x, p2.y, p3.x, p3.y};
            if (pn >= 4) {
                bf16_t* q = kt + (((unsigned)(b * 4 + h) * 256u + (unsigned)cl8) * 2048u + (unsigned)t);
#pragma unroll
                for (int r = 0; r < 4; ++r) { q[(size_t)r * 2048] = f2bf(o0[r]); q[(size_t)(4 + r) * 2048] = f2bf(o1[r]); q[(size_t)(128 + r) * 2048] = f2bf(o2[r]); q[(size_t)(132 + r) * 2048] = f2bf(o3[r]); }
            }
        } else if (pn < 16) {
            const int c0i = (pn - 8) * 256 + cl8; const int head = c0i >> 9, e0 = c0i & 511;
            bf16_t* q = vt + (((unsigned)(b * 4 + head) * 512u + (unsigned)e0) * 2048u + (unsigned)t);
#pragma unroll
            for (int r = 0; r < 4; ++r) { q[(size_t)r * 2048] = f2bf(a0[r]); q[(size_t)(4 + r) * 2048] = f2bf(a1[r]); q[(size_t)(128 + r) * 2048] = f2bf(b0[r]); q[(size_t)(132 + r) * 2048] = f2bf(b1[r]); }
        } else {
            const u32x2 p0 = pack4(a0), p1 = pack4(a1), p2 = pack4(b0), p3 = pack4(b1);
            *(u32x4*)nat = (u32x4){p0.x, p0.y, p1.x, p1.y}; *(u32x4*)(nat + 128) = (u32x4){p2.x, p2.y, p3.x, p3.y};
        }
    }
    static constexpr bool NEEDS_RSTD = true;
    bf16_t* big; bf16_t* kt; bf16_t* vt; const float* rc; const float* rs; const float* dec; const float* ss;
    DEVI void quad(int row, int pn, int cl, f32x4 v0, f32x4 v1, float rsc) const {
        v0 *= rsc; v1 *= rsc;
        const bool smp = row >= PR; const int b = row >> 11, t = row & 2047;
        bf16_t* nat = big + ((unsigned)row * 6144u + (unsigned)(pn * 256 + cl));
        if (pn < 8) {
            const int h = pn & 3; const int pi = smp ? 2048 : t;
            const f32x4 c = *(const f32x4*)(rc + pi * 128 + cl), s = *(const f32x4*)(rs + pi * 128 + cl);
            f32x4 o0 = v0 * c - v1 * s, o1 = v0 * s + v1 * c;
            const float sc = dec[pn * 128 + (smp ? 0 : (t & 127))];
            o0 *= sc; o1 *= sc;
            *(u32x2*)nat = pack4(o0); *(u32x2*)(nat + 128) = pack4(o1);
            if (pn >= 4 && !smp) {
                bf16_t* q = kt + (((unsigned)(b * 4 + h) * 256u + (unsigned)cl) * 2048u + (unsigned)t);
#pragma unroll
                for (int r = 0; r < 4; ++r) { q[(size_t)r * 2048] = f2bf(o0[r]); q[(size_t)(128 + r) * 2048] = f2bf(o1[r]); }
            }
        } else if (pn < 16) {
            if (smp) { *(u32x2*)nat = pack4(v0); *(u32x2*)(nat + 128) = pack4(v1); }
            else {
                const int c0 = (pn - 8) * 256 + cl; const int head = c0 >> 9, e0 = c0 & 511;
                bf16_t* q = vt + (((unsigned)(b * 4 + head) * 512u + (unsigned)e0) * 2048u + (unsigned)t);
#pragma unroll
                for (int r = 0; r < 4; ++r) { q[(size_t)r * 2048] = f2bf(v0[r]); q[(size_t)(128 + r) * 2048] = f2bf(v1[r]); }
            }
        } else { *(u32x2*)nat = pack4(v0); *(u32x2*)(nat + 128) = pack4(v1); }
    }
};
struct QResid {
    static constexpr bool PERM = true;
    DEVI void oct(int row, int pn, int cl8, f32x4 a0, f32x4 a1, f32x4 b0, f32x4 b1, float rsc) const {
        (void)rsc;
        const float* r = (row < PR ? rinP + (size_t)row * 1024 : rinS + (size_t)(row - PR) * 1024) + pn * 256 + cl8;
        const unsigned off = (unsigned)row * 1024u + (unsigned)(pn * 256 + cl8);
        a0 += __builtin_nontemporal_load((const f32x4*)r); a1 += __builtin_nontemporal_load((const f32x4*)(r + 4)); b0 += __builtin_nontemporal_load((const f32x4*)(r + 128)); b1 += __builtin_nontemporal_load((const f32x4*)(r + 132));
        __builtin_nontemporal_store(a0, (f32x4*)(xout + off)); __builtin_nontemporal_store(a1, (f32x4*)(xout + off + 4)); __builtin_nontemporal_store(b0, (f32x4*)(xout + off + 128)); __builtin_nontemporal_store(b1, (f32x4*)(xout + off + 132));
        const u32x2 pa0 = pack4(a0), pa1 = pack4(a1), pb0 = pack4(b0), pb1 = pack4(b1);
        *(u32x4*)(xb + off) = (u32x4){pa0.x, pa0.y, pa1.x, pa1.y}; *(u32x4*)(xb + off + 128) = (u32x4){pb0.x, pb0.y, pb1.x, pb1.y};
        float sa = a0[0] * a0[0] + a0[1] * a0[1] + a0[2] * a0[2] + a0[3] * a0[3] + a1[0] * a1[0] + a1[1] * a1[1] + a1[2] * a1[2] + a1[3] * a1[3];
        float sb = b0[0] * b0[0] + b0[1] * b0[1] + b0[2] * b0[2] + b0[3] * b0[3] + b1[0] * b1[0] + b1[1] * b1[1] + b1[2] * b1[2] + b1[3] * b1[3];
        const int lane = (row & 15) | (((cl8 >> 3) & 3) << 4);
        sa += shx(sa, 16, lane); sa += shx(sa, 32, lane); sb += shx(sb, 16, lane); sb += shx(sb, 32, lane);
        if (lane < 16) { float* sp = ssout + ((unsigned)row * 32u + (unsigned)(pn * 8 + (cl8 >> 5))); sp[0] = sa; sp[4] = sb; }
    }
    static constexpr bool NEEDS_RSTD = false;
    const float* rinP; const float* rinS; float* xout; bf16_t* xb; float* ssout;
    DEVI void quad(int row, int pn, int cl, f32x4 v0, f32x4 v1, float rsc) const {
        (void)rsc;
        const float* r = (row < PR ? rinP + (size_t)row * 1024 : rinS + (size_t)(row - PR) * 1024) + pn * 256 + cl;
        const unsigned off = (unsigned)row * 1024u + (unsigned)(pn * 256 + cl);
        const f32x4 a = *(const f32x4*)r + v0, b = *(const f32x4*)(r + 128) + v1;
        *(f32x4*)(xout + off) = a; *(f32x4*)(xout + off + 128) = b;
        *(u32x2*)(xb + off) = pack4(a); *(u32x2*)(xb + off + 128) = pack4(b);
        float sq = a[0] * a[0] + a[1] * a[1] + a[2] * a[2] + a[3] * a[3] + b[0] * b[0] + b[1] * b[1] + b[2] * b[2] + b[3] * b[3];
        const int lane = (row & 15) | (((cl >> 2) & 3) << 4);
        sq += shx(sq, 16, lane); sq += shx(sq, 32, lane);
        if (lane < 16) ssout[(unsigned)row * 32u + (unsigned)(pn * 8 + (cl >> 4))] = sq;
    }
};
struct QBf16 {
    static constexpr bool NEEDS_RSTD = true;
    static constexpr bool PERM = true;
    bf16_t* out; int ld; const float* ss;
    DEVI void oct(int row, int pn, int cl8, f32x4 a0, f32x4 a1, f32x4 b0, f32x4 b1, float rsc) const {
        bf16_t* o = out + ((unsigned)row * (unsigned)ld + (unsigned)(pn * 256 + cl8));
        const u32x2 pa0 = pack4(a0 * rsc), pa1 = pack4(a1 * rsc), pb0 = pack4(b0 * rsc), pb1 = pack4(b1 * rsc);
        *(u32x4*)o = (u32x4){pa0.x, pa0.y, pa1.x, pa1.y}; *(u32x4*)(o + 128) = (u32x4){pb0.x, pb0.y, pb1.x, pb1.y};
    }
    DEVI void quad(int row, int pn, int cl, f32x4 v0, f32x4 v1, float rsc) const {
        v0 *= rsc; v1 *= rsc;
        bf16_t* o = out + ((unsigned)row * (unsigned)ld + (unsigned)(pn * 256 + cl));
        *(u32x2*)o = pack4(v0); *(u32x2*)(o + 128) = pack4(v1);
    }
};
DEVI float dpp_shr(float v, const int n) {
    const int x = __float_as_int(v);
    return __int_as_float(n == 1 ? __builtin_amdgcn_update_dpp(x, x, 0x111, 0xf, 0xf, false) : __builtin_amdgcn_update_dpp(x, x, 0x112, 0xf, 0xf, false));
}
struct QFfn {
    static constexpr bool NEEDS_RSTD = true;
    static constexpr bool PERM = true;
    bf16_t* y; bf16_t* big; const float* ss; const float* cw; const float* cb; const float* sbuf; float* outp; float* outs;
    DEVI void oct(int row, int pn, int cl8, f32x4 a0, f32x4 a1, f32x4 b0, f32x4 b1, float rsc) const {
        a0 *= rsc; a1 *= rsc; b0 *= rsc; b1 *= rsc;
        const int ch = pn * 128 + cl8, fr = row & 15;
        f32x4 p10, p11, p20, p21;
#pragma unroll
        for (int k = 0; k < 4; ++k) { p10[k] = dpp_shr(a0[k], 1); p11[k] = dpp_shr(a1[k], 1); p20[k] = dpp_shr(a0[k], 2); p21[k] = dpp_shr(a1[k], 2); }
        if (fr >= 2) {
            const f32x4 w00 = *(const f32x4*)(cw + ch), w01 = *(const f32x4*)(cw + ch + 4), w10 = *(const f32x4*)(cw + 3072 + ch), w11 = *(const f32x4*)(cw + 3072 + ch + 4);
            const f32x4 w20 = *(const f32x4*)(cw + 6144 + ch), w21 = *(const f32x4*)(cw + 6144 + ch + 4), c0 = *(const f32x4*)(cb + ch), c1 = *(const f32x4*)(cb + ch + 4);
            float o[8];
#pragma unroll
            for (int k = 0; k < 4; ++k) {
                o[k] = gelu_tanh(c0[k] + p20[k] * w00[k] + p10[k] * w10[k] + a0[k] * w20[k]) * b0[k];
                o[4 + k] = gelu_tanh(c1[k] + p21[k] * w01[k] + p11[k] * w11[k] + a1[k] * w21[k]) * b1[k];
            }
            u32x4 w; w.x = cvt_pk_bf16(o[0], o[1]); w.y = cvt_pk_bf16(o[2], o[3]); w.z = cvt_pk_bf16(o[4], o[5]); w.w = cvt_pk_bf16(o[6], o[7]);
            *(u32x4*)(y + ((unsigned)row * 3072u + (unsigned)ch)) = w;
        }
        if (fr < 2 || fr >= 14) {
            const u32x2 p0 = pack4(a0), p1 = pack4(a1);
            *(u32x4*)(big + ((unsigned)row * 6144u + (unsigned)ch)) = (u32x4){p0.x, p0.y, p1.x, p1.y};
            if (fr < 2) { const u32x2 g0 = pack4(b0), g1 = pack4(b1); *(u32x4*)(big + ((unsigned)row * 6144u + 3072u + (unsigned)ch)) = (u32x4){g0.x, g0.y, g1.x, g1.y}; }
            else if ((row & 2047) >= 2046) { float* q = outp + ((size_t)(row >> 11) * 2 + ((row & 2047) - 2046)) * 3072 + ch; *(f32x4*)q = a0; *(f32x4*)(q + 4) = a1; }
        }
    }
    DEVI void quad(int row, int pn, int cl, f32x4 v0, f32x4 v1, float rsc) const {
        v0 *= rsc; v1 *= rsc;
        const int ch = pn * 128 + cl, sb = row - PR;
        const float* b0 = sbuf + ((size_t)sb * 2) * 3072 + ch;
        const f32x4 h2 = *(const f32x4*)b0, h1 = *(const f32x4*)(b0 + 3072);
        const f32x4 w0 = *(const f32x4*)(cw + ch), w1 = *(const f32x4*)(cw + 3072 + ch), w2 = *(const f32x4*)(cw + 6144 + ch), c = *(const f32x4*)(cb + ch);
        float* q = outs + ((size_t)sb * 2) * 3072 + ch;
        *(f32x4*)q = h1; *(f32x4*)(q + 3072) = v0;
        f32x4 o;
#pragma unroll
        for (int k = 0; k < 4; ++k) o[k] = gelu_tanh(c[k] + h2[k] * w0[k] + h1[k] * w1[k] + v0[k] * w2[k]) * v1[k];
        *(u32x2*)(y + ((unsigned)row * 3072u + (unsigned)ch)) = pack4(o);
    }
};
struct QMemKV {
    static constexpr bool PERM = false;
    static constexpr bool NEEDS_RSTD = false;
    float* outk; float* outv; bf16_t* mk; bf16_t* mvt;
    DEVI void quad(int row, int pn, int cl, f32x4 v0, f32x4 v1, float rsc) const {
        if (pn < 4) {
            const size_t o = (size_t)row * 1024 + pn * 256 + cl;
            __builtin_nontemporal_store(v0, (f32x4*)(outk + o)); __builtin_nontemporal_store(v1, (f32x4*)(outk + o + 128));
            *(u32x2*)(mk + o) = pack4(v0); *(u32x2*)(mk + o + 128) = pack4(v1);
        } else {
            const int h = pn - 4; const size_t o = (size_t)row * 1024 + h * 256 + cl;
            __builtin_nontemporal_store(v0, (f32x4*)(outv + o)); __builtin_nontemporal_store(v1, (f32x4*)(outv + o + 128));
            const int b = row >> 8, m = row & 255;
            bf16_t* q = mvt + ((size_t)(b * 4 + h) * 256 + cl) * 256 + m;
#pragma unroll
            for (int r = 0; r < 4; ++r) { q[r * 256] = f2bf(v0[r]); q[(128 + r) * 256] = f2bf(v1[r]); }
        }
    }
};
struct QLru {
    static constexpr bool PERM = false;
    static constexpr bool NEEDS_RSTD = false;
    const float* ba; const float* bx; const float* lam; const bf16_t* xc; float* aa; float* uu;
    const float* h0; float* hout; const bf16_t* big; bf16_t* yl;
    DEVI void quad(int row, int pn, int cl, f32x4 v0, f32x4 v1, float rsc) const {
        const int ch = (pn >> 1) * 256 + (pn & 1) * 128 + cl;
        const f32x4 ba4 = *(const f32x4*)(ba + ch), bx4 = *(const f32x4*)(bx + ch), lm4 = *(const f32x4*)(lam + ch);
        const u32x2 xp = *(const u32x2*)(xc + (size_t)row * 1024 + ch);
        const float xv[4] = {bflo(xp.x), bfhi(xp.x), bflo(xp.y), bfhi(xp.y)};
        f32x4 a4, u4;
#pragma unroll
        for (int r = 0; r < 4; ++r) {
            const float rr = sigmoidf_(v0[r] + ba4[r]), ii = sigmoidf_(v1[r] + bx4[r]);
            const float la = 8.f * rr * lm4[r];
            const float av = exp_(la);
            a4[r] = av; u4[r] = __builtin_amdgcn_sqrtf(fmaxf(1.f - av * av, 0.f)) * (ii * xv[r]);
        }
        if (row < PR) { *(f32x4*)(aa + (size_t)row * 1024 + ch) = a4; *(f32x4*)(uu + (size_t)row * 1024 + ch) = u4; }
        else {
            const int sb = row - PR;
            const f32x4 hp = *(const f32x4*)(h0 + (size_t)sb * 1024 + ch);
            const f32x4 hn = a4 * hp + u4;
            *(f32x4*)(hout + (size_t)sb * 1024 + ch) = hn;
            const u32x2 gp = *(const u32x2*)(big + (size_t)row * 2048 + 1024 + ch);
            f32x4 y; y[0] = gelu_tanh(bflo(gp.x)) * hn[0]; y[1] = gelu_tanh(bfhi(gp.x)) * hn[1]; y[2] = gelu_tanh(bflo(gp.y)) * hn[2]; y[3] = gelu_tanh(bfhi(gp.y)) * hn[3];
            *(u32x2*)(yl + (size_t)row * 1024 + ch) = pack4(y);
        }
    }
};

template <bool F32OUT>
DEVI void norm_phase(const float* srcP, const float* srcS, const float* gain, bf16_t* dstb, float* dstP, float* dstS, int nrows) {
    const int tid = tid_(); const int lane = tid & 63, wave = bid_() * 8 + (tid >> 6), nw = nblk_() * 8;
    f32x4 g[4];
#pragma unroll
    for (int i = 0; i < 4; ++i) g[i] = *(const f32x4*)(gain + i * 256 + lane * 4);
    for (int r0 = wave; r0 < nrows; r0 += 2 * nw) {
        f32x4 v[2][4]; float ss[2];
#pragma unroll
        for (int u = 0; u < 2; ++u) {
            const int r = r0 + u * nw < nrows ? r0 + u * nw : r0;
            const float* s = r < PR ? srcP + (size_t)r * 1024 : srcS + (size_t)(r - PR) * 1024;
#pragma unroll
            for (int i = 0; i < 4; ++i) v[u][i] = *(const f32x4*)(s + i * 256 + lane * 4);
        }
#pragma unroll
        for (int u = 0; u < 2; ++u) {
            float q = 0.f;
#pragma unroll
            for (int i = 0; i < 4; ++i) q += v[u][i][0] * v[u][i][0] + v[u][i][1] * v[u][i][1] + v[u][i][2] * v[u][i][2] + v[u][i][3] * v[u][i][3];
            ss[u] = q;
        }
#pragma unroll
        for (int o = 32; o; o >>= 1) { ss[0] += shx(ss[0], o, lane); ss[1] += shx(ss[1], o, lane); }
#pragma unroll
        for (int u = 0; u < 2; ++u) {
            const int r = r0 + u * nw;
            if (r < nrows) {
                const float rs = __builtin_amdgcn_rsqf(__fadd_rn(__fmul_rn(ss[u], 1.f / 1024.f), 1e-6f));
                if (F32OUT) {
                    float* d = r < PR ? dstP + (size_t)r * 1024 : dstS + (size_t)(r - PR) * 1024;
#pragma unroll
                    for (int i = 0; i < 4; ++i) __builtin_nontemporal_store(v[u][i] * rs * g[i], (f32x4*)(d + i * 256 + lane * 4));
                } else {
                    bf16_t* d = dstb + (size_t)r * 1024;
#pragma unroll
                    for (int i = 0; i < 4; ++i) *(u32x2*)(d + i * 256 + lane * 4) = pack4(v[u][i] * rs * g[i]);
                }
            }
        }
    }
}

DEVI void cast_ss_phase(const float* srcP, const float* srcS, bf16_t* xb, float* ss) {
    const int tid = tid_(); const int lane = tid & 63, wave = bid_() * 8 + (tid >> 6), nw = nblk_() * 8;
    for (int r = wave; r < TR; r += nw) {
        const float* s = r < PR ? srcP + (size_t)r * 1024 : srcS + (size_t)(r - PR) * 1024;
        f32x4 v[4]; float q = 0.f;
#pragma unroll
        for (int i = 0; i < 4; ++i) { v[i] = *(const f32x4*)(s + i * 256 + lane * 4); q += v[i][0] * v[i][0] + v[i][1] * v[i][1] + v[i][2] * v[i][2] + v[i][3] * v[i][3]; }
        q = wave_sum(q, lane);
#pragma unroll
        for (int i = 0; i < 4; ++i) *(u32x2*)(xb + (size_t)r * 1024 + i * 256 + lane * 4) = pack4(v[i]);
        if (lane < 32) ss[(size_t)r * 32 + lane] = lane == 0 ? q : 0.f;
    }
}

DEVI void transpose_phase(LAS unsigned char* lds, const Params& p) {
    LAS float* tile = (LAS float*)lds;
    const int tid = tid_();
    const int kk = tid >> 4, nq = tid & 15, n = tid >> 3, kq = tid & 7;
    const int nb = nblk_(), b0 = bid_();
    f32x4 v[2]; float gk[2]; bf16_t* cdst = nullptr; int cK = 0;
    bool have = false;
    int j = 0;
    for (int step = 0;; ++step) {
        const int tl = b0 + step * nb;
        const bool doload = tl < p.ntiles;
        if (have) {
#pragma unroll
            for (int i = 0; i < 2; ++i)
#pragma unroll
                for (int c = 0; c < 4; ++c) tile[(kk + 32 * i) * 65 + nq * 4 + c] = v[i][c] * gk[i];
            __syncthreads();
        }
        f32x4 nv[2] = {v[0], v[1]}; float ngk[2] = {1.f, 1.f}; bf16_t* ndst = nullptr; int nK = 0;
        if (doload) {
            while (j + 1 < NJOBS && p.jobs[j + 1].tile0 <= tl) ++j;
            const TJob jb = p.jobs[j];
            const int lt = tl - jb.tile0, ntn = jb.N >> 6, tk = lt / ntn, tn = lt - tk * ntn, k0 = tk * 64, n0 = tn * 64;
#pragma unroll
            for (int i = 0; i < 2; ++i) {
                nv[i] = __builtin_nontemporal_load((const f32x4*)(jb.src + (size_t)(k0 + kk + 32 * i) * jb.ld + n0 + nq * 4));
                ngk[i] = jb.gain ? jb.gain[k0 + kk + 32 * i] : 1.f;
            }
            ndst = jb.dst + (size_t)n0 * jb.K + k0; nK = jb.K;
        }
        if (have) {
            float f[8];
#pragma unroll
            for (int c = 0; c < 8; ++c) f[c] = tile[(kq * 8 + c) * 65 + n];
            u32x4 o; o.x = cvt_pk_bf16(f[0], f[1]); o.y = cvt_pk_bf16(f[2], f[3]); o.z = cvt_pk_bf16(f[4], f[5]); o.w = cvt_pk_bf16(f[6], f[7]);
            *(u32x4*)(cdst + (size_t)n * cK + kq * 8) = o;
            __syncthreads();
        }
        if (!doload) break;
        v[0] = nv[0]; v[1] = nv[1]; gk[0] = ngk[0]; gk[1] = ngk[1]; cdst = ndst; cK = nK; have = true;
    }
}

DEVI void rot_phase(float* rc, float* rs, double c1) {
    const int gt = bid_() * 512 + tid_(), ng = nblk_() * 512;
    for (int i = gt; i < 2049 * 128; i += ng) {
        const int pi = i >> 7, j = i & 127;
        double inv = 1.0, bb = c1; int e = j;
        while (e) { if (e & 1) inv *= bb; bb *= bb; e >>= 1; }
        const double pos = pi == 2048 ? 16384.0 : (double)pi;
        const double ang = pos * inv;
        const double rev = ang * 0.15915494309189534561;
        const float fr_ = (float)(rev - rint(rev));
        rs[i] = __builtin_amdgcn_sinf(fr_);
        rc[i] = __builtin_amdgcn_cosf(fr_);
    }
}

DEVI void dec_phase(float* dec) { for (int i = bid_() * 512 + tid_(); i < 1024; i += nblk_() * 512) { const int r = i >> 7, t = i & 127, h = r & 3; const float l2g = __builtin_amdgcn_logf(1.f - 1.f / (float)(32 << h)); dec[i] = r < 4 ? ex2_(l2g * (float)t) : 0.0625f * ex2_(-l2g * (float)t); } }
DEVI void lsg_phase(const float* lam, float* lsg) { for (int i = bid_() * 512 + tid_(); i < 1024; i += nblk_() * 512) { const float e = exp_(-lam[i]); const float ser = e * (1.f - e * (0.5f - e * (0.33333333f - e * (0.25f - e * 0.2f)))); lsg[i] = e < 0.03f ? -ser : -0.69314718056f * __builtin_amdgcn_logf(1.f + e); } }

DEVI void gate_phase(const bf16_t* o, const bf16_t* big, bf16_t* og) {
    const int tid = tid_(); const int lane = tid & 63, wave = bid_() * 8 + (tid >> 6), nw = nblk_() * 8;
    for (int it0 = wave; it0 < TR * 4; it0 += 4 * nw) {
        u32x4 ov[4], gv[4];
#pragma unroll
        for (int u = 0; u < 4; ++u) {
            const int it = it0 + u * nw < TR * 4 ? it0 + u * nw : it0;
            const int row = it >> 2, h = it & 3;
            ov[u] = *(const u32x4*)(o + (size_t)row * 2048 + h * 512 + lane * 8);
            gv[u] = *(const u32x4*)(big + (size_t)row * 6144 + 4096 + h * 512 + lane * 8);
        }
#pragma unroll
        for (int u = 0; u < 4; ++u) {
            const int it = it0 + u * nw;
            const int row = it >> 2, h = it & 3;
            float of[8], gf[8];
            of[0] = bflo(ov[u].x); of[1] = bfhi(ov[u].x); of[2] = bflo(ov[u].y); of[3] = bfhi(ov[u].y); of[4] = bflo(ov[u].z); of[5] = bfhi(ov[u].z); of[6] = bflo(ov[u].w); of[7] = bfhi(ov[u].w);
            gf[0] = bflo(gv[u].x); gf[1] = bfhi(gv[u].x); gf[2] = bflo(gv[u].y); gf[3] = bfhi(gv[u].y); gf[4] = bflo(gv[u].z); gf[5] = bfhi(gv[u].z); gf[6] = bflo(gv[u].w); gf[7] = bfhi(gv[u].w);
            float ss = 0.f;
#pragma unroll
            for (int c = 0; c < 8; ++c) ss += of[c] * of[c];
            ss = wave_sum(ss, lane);
            const float rs = __builtin_amdgcn_rsqf(__fadd_rn(__fmul_rn(ss, 1.f / 512.f), 1e-6f));
            float y[8];
#pragma unroll
            for (int c = 0; c < 8; ++c) y[c] = gf[c] * sigmoidf_(gf[c]) * of[c] * rs;
            u32x4 w; w.x = cvt_pk_bf16(y[0], y[1]); w.y = cvt_pk_bf16(y[2], y[3]); w.z = cvt_pk_bf16(y[4], y[5]); w.w = cvt_pk_bf16(y[6], y[7]);
            if (it < TR * 4) *(u32x4*)(og + (size_t)row * 2048 + h * 512 + lane * 8) = w;
        }
    }
}

DEVI void unpack8(u32x4 v, float* f) { f[0] = bflo(v.x); f[1] = bfhi(v.x); f[2] = bflo(v.y); f[3] = bfhi(v.y); f[4] = bflo(v.z); f[5] = bfhi(v.z); f[6] = bflo(v.w); f[7] = bfhi(v.w); }

DEVI void ffn_gate_phase(const bf16_t* big, bf16_t* y, const float* cw, const float* cb, const float* sbuf  , float* outp  , float* outs  ) {
    const int gt = bid_() * 512 + tid_(), ng = nblk_() * 512;
    for (int it = gt; it < 256 * 384 + SR * 384; it += ng) {
        const bool smp = it >= 256 * 384;
        const int li = smp ? it - 256 * 384 : it;
        const int seg = li / 384, c = (li - seg * 384) * 8;
        float w0[8], w1[8], w2[8], bb[8];
#pragma unroll
        for (int k = 0; k < 8; k += 4) {
            const f32x4 a0 = *(const f32x4*)(cw + c + k), a1 = *(const f32x4*)(cw + 3072 + c + k), a2 = *(const f32x4*)(cw + 6144 + c + k), a3 = *(const f32x4*)(cb + c + k);
#pragma unroll
            for (int j = 0; j < 4; ++j) { w0[k + j] = a0[j]; w1[k + j] = a1[j]; w2[k + j] = a2[j]; bb[k + j] = a3[j]; }
        }
        float u1[8], u2[8];
        if (!smp) {
            const int row0 = seg * 64, t0 = row0 & 2047;
            if (t0 > 0) { unpack8(*(const u32x4*)(big + (size_t)(row0 - 1) * 6144 + c), u1); unpack8(*(const u32x4*)(big + (size_t)(row0 - 2) * 6144 + c), u2); }
            else {
#pragma unroll
                for (int k = 0; k < 8; ++k) { u1[k] = 0.f; u2[k] = 0.f; }
            }
#pragma unroll 8
            for (int r = 0; r < 64; ++r) {
                const size_t row = (size_t)row0 + r;
                float u0[8], gg[8], o[8];
                unpack8(*(const u32x4*)(big + row * 6144 + c), u0);
                unpack8(*(const u32x4*)(big + row * 6144 + 3072 + c), gg);
#pragma unroll
                for (int k = 0; k < 8; ++k) { const float uc = bb[k] + u2[k] * w0[k] + u1[k] * w1[k] + u0[k] * w2[k]; o[k] = gelu_tanh(uc) * gg[k]; }
                u32x4 w; w.x = cvt_pk_bf16(o[0], o[1]); w.y = cvt_pk_bf16(o[2], o[3]); w.z = cvt_pk_bf16(o[4], o[5]); w.w = cvt_pk_bf16(o[6], o[7]);
                *(u32x4*)(y + row * 3072 + c) = w;
                if (t0 + r >= 2046) { float* q = outp + ((size_t)(row >> 11) * 2 + (t0 + r - 2046)) * 3072 + c; *(f32x4*)q = (f32x4){u0[0], u0[1], u0[2], u0[3]}; *(f32x4*)(q + 4) = (f32x4){u0[4], u0[5], u0[6], u0[7]}; }
#pragma unroll
                for (int k = 0; k < 8; ++k) { u2[k] = u1[k]; u1[k] = u0[k]; }
            }
        } else {
            const int sb = seg; const size_t row = (size_t)PR + sb;
            float u0[8], gg[8], o[8];
            unpack8(*(const u32x4*)(big + row * 6144 + c), u0);
            unpack8(*(const u32x4*)(big + row * 6144 + 3072 + c), gg);
            const float* b0 = sbuf + ((size_t)sb * 2 + 0) * 3072 + c; const float* b1 = b0 + 3072;
            const f32x4 p0 = *(const f32x4*)b0, p1 = *(const f32x4*)(b0 + 4), q0 = *(const f32x4*)b1, q1 = *(const f32x4*)(b1 + 4);
#pragma unroll
            for (int k = 0; k < 4; ++k) { u2[k] = p0[k]; u2[4 + k] = p1[k]; u1[k] = q0[k]; u1[4 + k] = q1[k]; }
            float* q = outs + ((size_t)sb * 2) * 3072 + c;
            *(f32x4*)q = q0; *(f32x4*)(q + 4) = q1;
            *(f32x4*)(q + 3072) = (f32x4){u0[0], u0[1], u0[2], u0[3]}; *(f32x4*)(q + 3072 + 4) = (f32x4){u0[4], u0[5], u0[6], u0[7]};
#pragma unroll
            for (int k = 0; k < 8; ++k) { const float uc = bb[k] + u2[k] * w0[k] + u1[k] * w1[k] + u0[k] * w2[k]; o[k] = gelu_tanh(uc) * gg[k]; }
            u32x4 w; w.x = cvt_pk_bf16(o[0], o[1]); w.y = cvt_pk_bf16(o[2], o[3]); w.z = cvt_pk_bf16(o[4], o[5]); w.w = cvt_pk_bf16(o[6], o[7]);
            *(u32x4*)(y + row * 3072 + c) = w;
        }
    }
}

DEVI void ffn_fix_phase(const bf16_t* big, bf16_t* y, const float* cw, const float* cb) {
    const int gt = bid_() * 512 + tid_(), ng = nblk_() * 512;
    for (int it = gt; it < 2048 * 384; it += ng) {
        const int ri = it / 384, c = (it - ri * 384) * 8;
        const int row = (ri >> 1) * 16 + (ri & 1), t = row & 2047;
        float u0[8], u1[8], u2[8], gg[8];
        unpack8(*(const u32x4*)(big + (size_t)row * 6144 + c), u0);
        unpack8(*(const u32x4*)(big + (size_t)row * 6144 + 3072 + c), gg);
        unpack8(*(const u32x4*)(big + (size_t)(t >= 1 ? row - 1 : row) * 6144 + c), u1);
        unpack8(*(const u32x4*)(big + (size_t)(t >= 2 ? row - 2 : row) * 6144 + c), u2);
#pragma unroll
        for (int k = 0; k < 8; ++k) { u1[k] = t >= 1 ? u1[k] : 0.f; u2[k] = t >= 2 ? u2[k] : 0.f; }
        float r[8];
#pragma unroll
        for (int k = 0; k < 8; ++k) {
            const float uc = cb[c + k] + u2[k] * cw[c + k] + u1[k] * cw[3072 + c + k] + u0[k] * cw[6144 + c + k];
            r[k] = gelu_tanh(uc) * gg[k];
        }
        u32x4 w; w.x = cvt_pk_bf16(r[0], r[1]); w.y = cvt_pk_bf16(r[2], r[3]); w.z = cvt_pk_bf16(r[4], r[5]); w.w = cvt_pk_bf16(r[6], r[7]);
        *(u32x4*)(y + (size_t)row * 3072 + c) = w;
    }
}

DEVI void lru_conv_phase(const bf16_t* big, bf16_t* xc, const float* cw, const float* cb, const float* sbuf  , float* outp  , float* outs  ) {
    const int gt = bid_() * 512 + tid_(), ng = nblk_() * 512;
    for (int it = gt; it < 1024 * 128 + SR * 128; it += ng) {
        const bool smp = it >= 1024 * 128;
        const int li = smp ? it - 1024 * 128 : it;
        const int seg = li >> 7, c = (li & 127) * 8;
        float w0[8], w1[8], w2[8], w3[8], bb[8];
#pragma unroll
        for (int k = 0; k < 8; k += 4) {
            const f32x4 a0 = *(const f32x4*)(cw + c + k), a1 = *(const f32x4*)(cw + 1024 + c + k), a2 = *(const f32x4*)(cw + 2048 + c + k), a3 = *(const f32x4*)(cw + 3072 + c + k), a4 = *(const f32x4*)(cb + c + k);
#pragma unroll
            for (int j = 0; j < 4; ++j) { w0[k + j] = a0[j]; w1[k + j] = a1[j]; w2[k + j] = a2[j]; w3[k + j] = a3[j]; bb[k + j] = a4[j]; }
        }
        if (!smp) {
            const int row0 = seg * 16, t0 = row0 & 2047;
            u32x4 raw[19];
#pragma unroll
            for (int r = 0; r < 19; ++r) {
                const int rr = (t0 == 0 && r < 3) ? row0 : row0 - 3 + r;
                raw[r] = *(const u32x4*)(big + (size_t)rr * 2048 + c);
            }
            float x1[8], x2[8], x3[8];
            if (t0 > 0) { unpack8(raw[0], x3); unpack8(raw[1], x2); unpack8(raw[2], x1); }
            else {
#pragma unroll
                for (int k = 0; k < 8; ++k) { x1[k] = 0.f; x2[k] = 0.f; x3[k] = 0.f; }
            }
#pragma unroll
            for (int r = 0; r < 16; ++r) {
                const size_t row = (size_t)row0 + r;
                float x0[8], o[8];
                unpack8(raw[3 + r], x0);
#pragma unroll
                for (int k = 0; k < 8; ++k) o[k] = bb[k] + x3[k] * w0[k] + x2[k] * w1[k] + x1[k] * w2[k] + x0[k] * w3[k];
                u32x4 w; w.x = cvt_pk_bf16(o[0], o[1]); w.y = cvt_pk_bf16(o[2], o[3]); w.z = cvt_pk_bf16(o[4], o[5]); w.w = cvt_pk_bf16(o[6], o[7]);
                *(u32x4*)(xc + row * 1024 + c) = w;
                if (t0 + r >= 2045) { float* q = outp + ((size_t)(row >> 11) * 3 + (t0 + r - 2045)) * 1024 + c; *(f32x4*)q = (f32x4){x0[0], x0[1], x0[2], x0[3]}; *(f32x4*)(q + 4) = (f32x4){x0[4], x0[5], x0[6], x0[7]}; }
#pragma unroll
                for (int k = 0; k < 8; ++k) { x3[k] = x2[k]; x2[k] = x1[k]; x1[k] = x0[k]; }
            }
        } else {
            const int sb = seg; const size_t row = (size_t)PR + sb;
            float x0[8], x1[8], x2[8], x3[8], o[8];
            unpack8(*(const u32x4*)(big + row * 2048 + c), x0);
            const float* b0 = sbuf + (size_t)sb * 3 * 1024 + c;
            float* q = outs + (size_t)sb * 3 * 1024 + c;
#pragma unroll
            for (int k = 0; k < 8; k += 4) {
                const f32x4 p3 = *(const f32x4*)(b0 + k), p2 = *(const f32x4*)(b0 + 1024 + k), p1 = *(const f32x4*)(b0 + 2048 + k);
#pragma unroll
                for (int j = 0; j < 4; ++j) { x3[k + j] = p3[j]; x2[k + j] = p2[j]; x1[k + j] = p1[j]; }
                *(f32x4*)(q + k) = p2; *(f32x4*)(q + 1024 + k) = p1; *(f32x4*)(q + 2048 + k) = (f32x4){x0[k], x0[k + 1], x0[k + 2], x0[k + 3]};
            }
#pragma unroll
            for (int k = 0; k < 8; ++k) o[k] = bb[k] + x3[k] * w0[k] + x2[k] * w1[k] + x1[k] * w2[k] + x0[k] * w3[k];
            u32x4 w; w.x = cvt_pk_bf16(o[0], o[1]); w.y = cvt_pk_bf16(o[2], o[3]); w.z = cvt_pk_bf16(o[4], o[5]); w.w = cvt_pk_bf16(o[6], o[7]);
            *(u32x4*)(xc + row * 1024 + c) = w;
        }
    }
}

DEVI void scan1_phase(const float* aa, const float* uu, float* chs  ) {
    const int gt = bid_() * 512 + tid_(), ng = nblk_() * 512;
    for (int it = gt; it < 8 * 64 * 256; it += ng) {
        const int c = (it & 255) * 4, ck = (it >> 8) & 63, b = it >> 14;
        const size_t base = ((size_t)b * 2048 + ck * 32) * 1024 + c;
        f32x4 ap = (f32x4){1.f, 1.f, 1.f, 1.f}, h = (f32x4){0.f, 0.f, 0.f, 0.f};
#pragma unroll 8
        for (int t = 0; t < 32; ++t) { const f32x4 a = *(const f32x4*)(aa + base + (size_t)t * 1024), u = *(const f32x4*)(uu + base + (size_t)t * 1024); h = a * h + u; ap *= a; }
        float* o = chs + ((size_t)(b * 64 + ck) * 1024 + c) * 2;
        *(f32x4*)o = (f32x4){ap[0], h[0], ap[1], h[1]}; *(f32x4*)(o + 4) = (f32x4){ap[2], h[2], ap[3], h[3]};
    }
}
DEVI void scan2_phase(const float* aa, const float* uu, const float* chs, const bf16_t* big, bf16_t* yl, float* hout  ) {
    const int gt = bid_() * 512 + tid_(), ng = nblk_() * 512;
    for (int it = gt; it < 8 * 64 * 256; it += ng) {
        const int c = (it & 255) * 4, ck = (it >> 8) & 63, b = it >> 14;
        f32x4 h = (f32x4){0.f, 0.f, 0.f, 0.f};
        for (int k = 0; k < ck; ++k) {
            const float* ci = chs + ((size_t)(b * 64 + k) * 1024 + c) * 2;
            const f32x4 p0 = *(const f32x4*)ci, p1 = *(const f32x4*)(ci + 4);
            h[0] = p0[0] * h[0] + p0[1]; h[1] = p0[2] * h[1] + p0[3]; h[2] = p1[0] * h[2] + p1[1]; h[3] = p1[2] * h[3] + p1[3];
        }
        const size_t row0 = (size_t)b * 2048 + ck * 32;
#pragma unroll 8
        for (int t = 0; t < 32; ++t) {
            const size_t row = row0 + t;
            h = *(const f32x4*)(aa + row * 1024 + c) * h + *(const f32x4*)(uu + row * 1024 + c);
            const u32x2 gp = *(const u32x2*)(big + row * 2048 + 1024 + c);
            f32x4 y; y[0] = gelu_tanh(bflo(gp.x)) * h[0]; y[1] = gelu_tanh(bfhi(gp.x)) * h[1]; y[2] = gelu_tanh(bflo(gp.y)) * h[2]; y[3] = gelu_tanh(bfhi(gp.y)) * h[3];
            *(u32x2*)(yl + row * 1024 + c) = pack4(y);
        }
        if (ck == 63) *(f32x4*)(hout + b * 1024 + c) = h;
    }
}

DEVI void retention_prompt_phase(LAS unsigned char* lds, const bf16_t* big, const bf16_t* ktg, const bf16_t* vtg, bf16_t* og, float* sout  , const float* dec,
                                 const bool fuse, const float* sin_, float* sout_s) {
    constexpr int KS_STR = 528, VT_STR = 272, ST_STR = 528, AT_STR = 272;
    constexpr int KS_OFF = 0, VT_OFF = 128 * KS_STR, ST_OFF = VT_OFF + 64 * VT_STR, AT_OFF = ST_OFF + 64 * ST_STR;
    const int tid = tid_(), w = tid >> 6, lane = tid & 63, fr = lane & 15, fq = lane >> 4;
    LAS unsigned char* att = lds + AT_OFF + w * (16 * AT_STR);
    for (int it = bid_(); it < 256; it += nblk_()) {
        const int b = it >> 5, h = (it >> 3) & 3, es = it & 7;
        const float gam = 1.f - 1.f / (float)(32 << h), gam127 = dec[h * 128 + 127];
        f32x4 sacc[2][4];
#pragma unroll
        for (int a = 0; a < 2; ++a)
#pragma unroll
            for (int e = 0; e < 4; ++e) sacc[a][e] = (f32x4){0.f, 0.f, 0.f, 0.f};
        __syncthreads();
        { const unsigned z = zv_(); for (int i = tid; i < 64 * ST_STR / 16; i += 512) *(LAS u32x4*)(lds + ST_OFF + i * 16) = (u32x4){z, z, z, z}; }
        f32x4 o4s = (f32x4){0.f, 0.f, 0.f, 0.f};
        u32x4 pk[8], pv[2];
        {   const bf16_t* src = big + ((size_t)b * 2048 + (tid >> 5)) * 6144 + 1024 + h * 256 + (tid & 31) * 8;
#pragma unroll
            for (int i = 0; i < 8; ++i) pk[i] = *(const u32x4*)(src + (size_t)i * 16 * 6144);
            const bf16_t* vsrc = vtg + ((size_t)(b * 4 + h) * 512 + es * 64 + (tid >> 4)) * 2048 + (tid & 15) * 8;
#pragma unroll
            for (int i = 0; i < 2; ++i) pv[i] = *(const u32x4*)(vsrc + (size_t)i * 32 * 2048);
        }
        for (int n = 0; n < 16; ++n) {
            const size_t row0 = (size_t)b * 2048 + n * 128;
            __syncthreads();
            f32x4 sv[8]; size_t s_base = 0; int s_sb = 0, s_h = 0, s_eq = 0;
            if (fuse) {
                const int sit = it * 8 + (n >> 1);
                s_sb = sit >> 4; s_h = (sit >> 2) & 3; s_eq = sit & 3;
                s_base = ((size_t)(s_sb * 4 + s_h) * 256) * 512 + s_eq * 128 + (tid & 31) * 4 + (size_t)(8 * (tid >> 5) + 128 * (n & 1)) * 512;
#pragma unroll
                for (int i = 0; i < 8; ++i) sv[i] = __builtin_nontemporal_load((const f32x4*)(sin_ + s_base + (size_t)i * 512));
            }
            {
                LAS unsigned char* dst = lds + KS_OFF + (tid >> 5) * KS_STR + (tid & 31) * 16;
#pragma unroll
                for (int i = 0; i < 8; ++i) *(LAS u32x4*)(dst + i * 16 * KS_STR) = pk[i];
                LAS unsigned char* vdst = lds + VT_OFF + (tid >> 4) * VT_STR + (tid & 15) * 16;
#pragma unroll
                for (int i = 0; i < 2; ++i) *(LAS u32x4*)(vdst + i * 32 * VT_STR) = pv[i];
            }
            bf16x8 qf[8];
#pragma unroll
            for (int ks = 0; ks < 8; ++ks) qf[ks] = *(const bf16x8*)(big + (row0 + 16 * w + fr) * 6144 + h * 256 + ks * 32 + fq * 8);
            __syncthreads();
            {   const int nn = n + 1 < 16 ? n + 1 : n;
                const bf16_t* src = big + ((size_t)b * 2048 + nn * 128 + (tid >> 5)) * 6144 + 1024 + h * 256 + (tid & 31) * 8;
#pragma unroll
                for (int i = 0; i < 8; ++i) pk[i] = *(const u32x4*)(src + (size_t)i * 16 * 6144);
                const bf16_t* vsrc = vtg + ((size_t)(b * 4 + h) * 512 + es * 64 + (tid >> 4)) * 2048 + nn * 128 + (tid & 15) * 8;
#pragma unroll
                for (int i = 0; i < 2; ++i) pv[i] = *(const u32x4*)(vsrc + (size_t)i * 32 * 2048);
            }
            for (int jt = 0; jt <= w; ++jt) {
                f32x4 acc = (f32x4){0.f, 0.f, 0.f, 0.f};
#pragma unroll
                for (int ks = 0; ks < 8; ++ks) {
                    const bf16x8 kf = *(const LAS bf16x8*)(lds + KS_OFF + (jt * 16 + fr) * KS_STR + ks * 64 + fq * 16);
                    acc = mfma16(kf, qf[ks], acc);
                }
                if (jt == w) {
#pragma unroll
                    for (int r = 0; r < 4; ++r) if (fq * 4 + r > fr) acc[r] = 0.f;
                }
                *(LAS u32x2*)(att + fr * AT_STR + (jt * 16 + fq * 4) * 2) = pack4(acc);
            }
            if ((w & 1) == 0) { const unsigned z = zv_(); *(LAS u32x2*)(att + fr * AT_STR + ((w + 1) * 16 + fq * 4) * 2) = (u32x2){z, z}; }
            __builtin_amdgcn_fence(__ATOMIC_SEQ_CST, "wavefront"); asm volatile("s_waitcnt lgkmcnt(0)" ::: "memory"); __builtin_amdgcn_wave_barrier();
#pragma unroll
            for (int et = 0; et < 4; ++et) {
                f32x4 ao = (f32x4){0.f, 0.f, 0.f, 0.f}, ac = (f32x4){0.f, 0.f, 0.f, 0.f};
                for (int js = 0; js <= (w >> 1); ++js) {
                    const bf16x8 af = *(const LAS bf16x8*)(att + fr * AT_STR + js * 64 + fq * 16);
                    const bf16x8 vf = *(const LAS bf16x8*)(lds + VT_OFF + (et * 16 + fr) * VT_STR + js * 64 + fq * 16);
                    ao = mfma16(vf, af, ao);
                }
#pragma unroll
                for (int ks = 0; ks < 8; ++ks) {
                    const bf16x8 sf = *(const LAS bf16x8*)(lds + ST_OFF + (et * 16 + fr) * ST_STR + ks * 64 + fq * 16);
                    ac = mfma16(sf, qf[ks], ac);
                }
                const f32x4 o = ao + ac * gam;
                *(u32x2*)(og + (row0 + 16 * w + fr) * 2048 + h * 512 + es * 64 + et * 16 + fq * 4) = pack4(o);
            }
#pragma unroll
            for (int a = 0; a < 2; ++a)
#pragma unroll
                for (int e = 0; e < 4; ++e) sacc[a][e] *= gam;
#pragma unroll
            for (int js = 0; js < 4; ++js) {
                bf16x8 kf[2];
#pragma unroll
                for (int a = 0; a < 2; ++a) kf[a] = *(const bf16x8*)(ktg + ((size_t)(b * 4 + h) * 256 + 32 * w + a * 16 + fr) * 2048 + n * 128 + js * 32 + fq * 8);
#pragma unroll
                for (int e = 0; e < 4; ++e) {
                    const bf16x8 vf = *(const LAS bf16x8*)(lds + VT_OFF + (e * 16 + fr) * VT_STR + js * 64 + fq * 16);
#pragma unroll
                    for (int a = 0; a < 2; ++a) sacc[a][e] = mfma16(kf[a], vf, sacc[a][e]);
                }
            }
#pragma unroll
            for (int a = 0; a < 2; ++a)
#pragma unroll
                for (int e = 0; e < 4; ++e) sacc[a][e] *= gam127;
            if (fuse) {
                const size_t srow = (size_t)PR + s_sb;
                const bf16_t* qp = big + srow * 6144 + s_h * 256 + 8 * (tid >> 5) + 128 * (n & 1);
                float qd8[8], kd8[8];
                unpack8(*(const u32x4*)qp, qd8); unpack8(*(const u32x4*)(qp + 1024), kd8);
                const u32x2 vp = *(const u32x2*)(big + srow * 6144 + 2048 + s_h * 512 + s_eq * 128 + (tid & 31) * 4);
                const f32x4 v4 = (f32x4){bflo(vp.x), bfhi(vp.x), bflo(vp.y), bfhi(vp.y)};
                const float sgam = 1.f - 1.f / (float)(32 << s_h);
                if ((n & 1) == 0) o4s = (f32x4){0.f, 0.f, 0.f, 0.f};
#pragma unroll
                for (int i = 0; i < 8; ++i) {
                    const f32x4 sn = sv[i] * sgam + v4 * kd8[i];
                    __builtin_nontemporal_store(sn, (f32x4*)(sout_s + s_base + (size_t)i * 512));
                    o4s += sn * qd8[i];
                }
                if (n & 1) *(LAS f32x4*)(lds + 153616 + tid * 16) = o4s;
            }
            __syncthreads();
            if (fuse && (n & 1) && tid < 32) {
                f32x4 sm = *(const LAS f32x4*)(lds + 153616 + tid * 16);
#pragma unroll
                for (int k = 1; k < 16; ++k) sm += *(const LAS f32x4*)(lds + 153616 + (k * 32 + tid) * 16);
                *(u32x2*)(og + ((size_t)PR + s_sb) * 2048 + s_h * 512 + s_eq * 128 + tid * 4) = pack4(sm);
            }
#pragma unroll
            for (int a = 0; a < 2; ++a)
#pragma unroll
                for (int e = 0; e < 4; ++e)
                    *(LAS u32x2*)(lds + ST_OFF + (e * 16 + fr) * ST_STR + (32 * w + a * 16 + fq * 4) * 2) = pack4(sacc[a][e]);
        }
#pragma unroll
        for (int a = 0; a < 2; ++a)
#pragma unroll
            for (int e = 0; e < 4; ++e)
#pragma unroll
                for (int r = 0; r < 4; ++r)
                    __builtin_nontemporal_store(sacc[a][e][r], sout + ((size_t)(b * 4 + h) * 256 + 32 * w + a * 16 + fq * 4 + r) * 512 + es * 64 + e * 16 + fr);
    }
}

DEVI void retention_sample_phase(LAS unsigned char* lds, const bf16_t* big, const float* sin_, float* sout, bf16_t* og) {
    const int tid = tid_(), ec = tid & 31, dr = tid >> 5;
    LAS float* red = (LAS float*)lds;
    for (int it = bid_(); it < 128 * 4 * 4; it += nblk_()) {
        const int sb = it >> 4, h = (it >> 2) & 3, eq = it & 3;
        const float gam = 1.f - 1.f / (float)(32 << h);
        const size_t row = (size_t)PR + sb;
        const bf16_t* qp = big + row * 6144 + h * 256;
        const bf16_t* kp = qp + 1024;
        const u32x2 vp = *(const u32x2*)(big + row * 6144 + 2048 + h * 512 + eq * 128 + ec * 4);
        const f32x4 v4 = (f32x4){bflo(vp.x), bfhi(vp.x), bflo(vp.y), bfhi(vp.y)};
        const size_t sbase = ((size_t)(sb * 4 + h) * 256) * 512 + eq * 128 + ec * 4;
        f32x4 o4 = (f32x4){0.f, 0.f, 0.f, 0.f};
#pragma unroll
        for (int i = 0; i < 16; ++i) {
            const int d = dr + 16 * i;
            const f32x4 s = *(const f32x4*)(sin_ + sbase + (size_t)d * 512);
            const float kd = bf2f(kp[d]), qd = bf2f(qp[d]);
            const f32x4 sn = s * gam + v4 * kd;
            *(f32x4*)(sout + sbase + (size_t)d * 512) = sn;
            o4 += sn * qd;
        }
        __syncthreads();
        *(LAS f32x4*)(red + (dr * 32 + ec) * 4) = o4;
        __syncthreads();
        if (tid < 32) {
            f32x4 s = (f32x4){0.f, 0.f, 0.f, 0.f};
#pragma unroll
            for (int k = 0; k < 16; ++k) s += *(const LAS f32x4*)(red + (k * 32 + tid) * 4);
            *(u32x2*)(og + row * 2048 + h * 512 + eq * 128 + tid * 4) = pack4(s);
        }
    }
}

DEVI void xattn_prompt_phase(LAS unsigned char* lds, const bf16_t* qx, const bf16_t* mk  , const bf16_t* mvt  , bf16_t* ao) {
    constexpr int STR = 528;
    const int tid = tid_(), w = tid >> 6, lane = tid & 63, fr = lane & 15, fq = lane >> 4;
    for (int it = bid_(); it < 512; it += nblk_()) {
        const int b = it >> 6, h = (it >> 4) & 3, qt = it & 15;
        const size_t row = (size_t)b * 2048 + qt * 128 + 16 * w + fr;
        __syncthreads();
        {   const int m0 = tid >> 5, dq = tid & 31;
            const bf16_t* src = mk + ((size_t)b * 256 + m0) * 1024 + h * 256 + dq * 8;
            LAS unsigned char* dst = lds + m0 * STR + dq * 16;
#pragma unroll
            for (int i = 0; i < 16; ++i) *(LAS u32x4*)(dst + i * 16 * STR) = *(const u32x4*)(src + (size_t)i * 16 * 1024);
        }
        bf16x8 qf[8];
#pragma unroll
        for (int ks = 0; ks < 8; ++ks) qf[ks] = *(const bf16x8*)(qx + row * 1024 + h * 256 + ks * 32 + fq * 8);
        __syncthreads();
        bf16x8 pf[8];
        float hmx[2], hsum[2];
        const float sc = 0.0625f * 1.4426950408889634f;
#pragma unroll
        for (int hf = 0; hf < 2; ++hf) {
            f32x4 s[8];
#pragma unroll
            for (int mt = 0; mt < 8; ++mt) {
                f32x4 acc = (f32x4){0.f, 0.f, 0.f, 0.f};
#pragma unroll
                for (int ks = 0; ks < 8; ++ks) {
                    const bf16x8 kf = *(const LAS bf16x8*)(lds + ((hf * 8 + mt) * 16 + fr) * STR + ks * 64 + fq * 16);
                    acc = mfma16(kf, qf[ks], acc);
                }
                s[mt] = acc;
                __builtin_amdgcn_sched_barrier(0);
            }
            float mx = -3.0e38f;
#pragma unroll
            for (int mt = 0; mt < 8; ++mt)
#pragma unroll
                for (int r = 0; r < 4; ++r) mx = fmaxf(mx, s[mt][r]);
            mx = fmaxf(mx, shx(mx, 16, lane)); mx = fmaxf(mx, shx(mx, 32, lane));
            float sum = 0.f;
#pragma unroll
            for (int mt = 0; mt < 8; ++mt)
#pragma unroll
                for (int r = 0; r < 4; ++r) { const float e = ex2_((s[mt][r] - mx) * sc); s[mt][r] = e; sum += e; }
            sum += shx(sum, 16, lane); sum += shx(sum, 32, lane);
            hmx[hf] = mx; hsum[hf] = sum;
#pragma unroll
            for (int ms = 0; ms < 4; ++ms) {
                u32x4 u; u.x = cvt_pk_bf16(s[2 * ms][0], s[2 * ms][1]); u.y = cvt_pk_bf16(s[2 * ms][2], s[2 * ms][3]);
                u.z = cvt_pk_bf16(s[2 * ms + 1][0], s[2 * ms + 1][1]); u.w = cvt_pk_bf16(s[2 * ms + 1][2], s[2 * ms + 1][3]);
                pf[hf * 4 + ms] = __builtin_bit_cast(bf16x8, u);
            }
        }
        const float mxa = fmaxf(hmx[0], hmx[1]);
        float al0 = ex2_((hmx[0] - mxa) * sc), al1 = ex2_((hmx[1] - mxa) * sc);
        const float inv = rcp_(hsum[0] * al0 + hsum[1] * al1);
        al0 *= inv; al1 *= inv;
        __syncthreads();
        {   const int d0 = tid >> 5, mq = tid & 31;
            const bf16_t* src = mvt + ((size_t)(b * 4 + h) * 256 + d0) * 256 + mq * 8;
            LAS unsigned char* dst = lds + d0 * STR + mq * 16;
#pragma unroll
            for (int i = 0; i < 16; ++i) *(LAS u32x4*)(dst + i * 16 * STR) = *(const u32x4*)(src + (size_t)i * 16 * 256);
        }
        __syncthreads();
#pragma unroll 2
        for (int dt = 0; dt < 16; ++dt) {
            f32x4 acc0 = (f32x4){0.f, 0.f, 0.f, 0.f}, acc1 = acc0;
#pragma unroll
            for (int ms = 0; ms < 8; ++ms) {
                const u32x2 lo = *(const LAS u32x2*)(lds + (dt * 16 + fr) * STR + (ms * 32 + fq * 4) * 2);
                const u32x2 hi = *(const LAS u32x2*)(lds + (dt * 16 + fr) * STR + (ms * 32 + 16 + fq * 4) * 2);
                u32x4 u; u.x = lo.x; u.y = lo.y; u.z = hi.x; u.w = hi.y;
                if (ms < 4) acc0 = mfma16(__builtin_bit_cast(bf16x8, u), pf[ms], acc0);
                else acc1 = mfma16(__builtin_bit_cast(bf16x8, u), pf[ms], acc1);
            }
            *(u32x2*)(ao + row * 1024 + h * 256 + dt * 16 + fq * 4) = pack4(acc0 * al0 + acc1 * al1);
        }
    }
}

DEVI void xattn_sample_phase(LAS unsigned char* lds, const bf16_t* qx, const float* ck, const float* cv, bf16_t* ao) {
    const int tid = tid_(), w = tid >> 6, lane = tid & 63;
    LAS float* sc = (LAS float*)lds;
    LAS float* red = (LAS float*)(lds + 2048);
    for (int it = bid_(); it < 512; it += nblk_()) {
        const int sb = it >> 2, h = it & 3;
        const size_t row = (size_t)PR + sb;
        const u32x2 qp = *(const u32x2*)(qx + row * 1024 + h * 256 + lane * 4);
        const f32x4 q4 = (f32x4){bflo(qp.x), bfhi(qp.x), bflo(qp.y), bfhi(qp.y)};
        const size_t base = ((size_t)sb * 256 * 4 + h) * 256 + lane * 4;
        __syncthreads();
#pragma unroll 16
        for (int i = 0; i < 32; ++i) {
            const int m = w + 8 * i;
            const f32x4 k4 = __builtin_nontemporal_load((const f32x4*)(ck + base + (size_t)m * 1024));
            float d = k4[0] * q4[0] + k4[1] * q4[1] + k4[2] * q4[2] + k4[3] * q4[3];
            d = wave_sum(d, lane);
            if (lane == 0) sc[m] = d * 0.0625f;
        }
        __syncthreads();
        float mx = -3.0e38f;
        for (int m = lane; m < 256; m += 64) mx = fmaxf(mx, sc[m]);
#pragma unroll
        for (int o = 32; o; o >>= 1) mx = fmaxf(mx, shx(mx, o, lane));
        float sum = 0.f;
        for (int m = lane; m < 256; m += 64) sum += exp_(sc[m] - mx);
        sum = wave_sum(sum, lane);
        const float inv = rcp_(sum);
        f32x4 o4 = (f32x4){0.f, 0.f, 0.f, 0.f};
#pragma unroll 16
        for (int i = 0; i < 32; ++i) {
            const int m = w + 8 * i;
            const float pm = exp_(sc[m] - mx) * inv;
            const f32x4 v4 = __builtin_nontemporal_load((const f32x4*)(cv + base + (size_t)m * 1024));
            o4 += v4 * pm;
        }
        *(LAS f32x4*)(red + (w * 64 + lane) * 4) = o4;
        __syncthreads();
        if (tid < 64) {
            f32x4 s = (f32x4){0.f, 0.f, 0.f, 0.f};
#pragma unroll
            for (int k = 0; k < 8; ++k) s += *(const LAS f32x4*)(red + (k * 64 + tid) * 4);
            *(u32x2*)(ao + row * 1024 + h * 256 + tid * 4) = pack4(s);
        }
    }
}

#define XB_TMO      128
#define XB_XCNT(j)  (256  + 64 * (j))
#define XB_XSUB(j)  (1280 + 64 * (j))
#define XB_XGEN(j)  (2304 + 64 * (j))
#define XB_TOP      3328
#define XB_TOPGEN   3392
#define XCD_BAR_WORDS 3456
#define XB_SPIN_CAP (1u << 18)
DEVI unsigned xb_ld(unsigned* p)              { return __hip_atomic_load(p, __ATOMIC_RELAXED, __HIP_MEMORY_SCOPE_AGENT); }
DEVI unsigned xb_add(unsigned* p, unsigned v) { return __hip_atomic_fetch_add(p, v, __ATOMIC_RELAXED, __HIP_MEMORY_SCOPE_AGENT); }
DEVI unsigned xb_xcc_id() { return (unsigned)__builtin_amdgcn_s_getreg((3 << 11) | 20) & 0xFu; }
#define XB_SPIN(cond, bar) do { unsigned _sp = 0; while (cond) { __builtin_amdgcn_s_sleep(1); \
    if ((++_sp & 255u) == 0u) { if (xb_ld(&(bar)[XB_TMO])) break; if (_sp > XB_SPIN_CAP) { atomicAdd(&(bar)[XB_TMO], 1u); break; } } } } while (0)
struct XcdBarrier { unsigned* bar; unsigned x; volatile LAS unsigned* st; };
DEVI XcdBarrier xcd_barrier_post(unsigned* bar, volatile LAS unsigned* st) {
    XcdBarrier b; b.bar = bar; b.x = xb_xcc_id(); b.st = st;
    if (threadIdx.x == 0) (void)xb_add(&bar[XB_XCNT(b.x)], 1u);
    return b;
}
DEVI void xcd_barrier_complete(unsigned* bar, unsigned x, unsigned& nloc, unsigned& nx) {
    const unsigned G = gridDim.x * gridDim.y * gridDim.z;
    unsigned sum, cnt, mine, sp = 0u;
    for (;;) {
        sum = 0u; cnt = 0u; mine = 0u;
#pragma unroll
        for (unsigned j = 0; j < 16; ++j) { const unsigned c = xb_ld(&bar[XB_XCNT(j)]); sum += c; cnt += (c > 0u) ? 1u : 0u; mine = (j == x) ? c : mine; }
        if (sum == G) break;
        __builtin_amdgcn_s_sleep(1);
        if ((++sp & 255u) == 0u) { if (xb_ld(&bar[XB_TMO])) break; if (sp > XB_SPIN_CAP) { atomicAdd(&bar[XB_TMO], 1u); break; } }
    }
    nloc = mine > 0u ? mine : 1u; nx = cnt > 0u ? cnt : 1u;
}
DEVI void xcd_barrier(const XcdBarrier& b) {
    asm volatile("s_waitcnt vmcnt(0)" ::: "memory");
    __syncthreads();
    if (threadIdx.x == 0) {
        unsigned* bar = b.bar;
        __builtin_amdgcn_s_waitcnt(0);
        unsigned nloc = b.st[0], nx = b.st[1];
        if (nloc == 0u) { xcd_barrier_complete(bar, b.x, nloc, nx); b.st[0] = nloc; b.st[1] = nx; }
        const unsigned old = xb_add(&bar[XB_XSUB(b.x)], 1u);
        const unsigned gen = old / nloc;
        if (old + 1u == (gen + 1u) * nloc) {
            __builtin_amdgcn_fence(__ATOMIC_RELEASE, "agent");
            asm volatile("s_waitcnt vmcnt(0)" ::: "memory");
            const unsigned og = xb_add(&bar[XB_TOP], 1u);
            const unsigned tg = og / nx;
            if (og + 1u == (tg + 1u) * nx) xb_add(&bar[XB_TOPGEN], 1u);
            else XB_SPIN(xb_ld(&bar[XB_TOPGEN]) == tg, bar);
            __builtin_amdgcn_fence(__ATOMIC_ACQUIRE, "agent");
            xb_add(&bar[XB_XGEN(b.x)], 1u);
            asm volatile("s_waitcnt vmcnt(0)" ::: "memory");
        } else {
            XB_SPIN(xb_ld(&bar[XB_XGEN(b.x)]) == gen, bar);
            __builtin_amdgcn_fence(__ATOMIC_ACQUIRE, "agent");
            asm volatile("s_waitcnt vmcnt(0)" ::: "memory");
        }
    }
    __syncthreads();
}

enum { K_PREP = 0, K_RETIN, K_RET, K_GATE, K_RESID, K_NORM, K_BF16, K_XATTN, K_FFNGATE, K_LRUCONV, K_LRU, K_SCAN1, K_SCAN2, K_NORMF };
constexpr int NPH = 24;
struct Step { int kind, L, lda, N, K, ldo, ssi; const bf16_t* A; const bf16_t* Bt; bf16_t* ob; const float* rinP; const float* rinS; };

template <int ONLY>
__global__ void __launch_bounds__(512) mega(Params p, int lo, int hi) {
    extern __shared__ __attribute__((aligned(16))) unsigned char shm[];
    LAS unsigned char* lds = (LAS unsigned char*)shm;
    cg::grid_group grid = cg::this_grid();
#define WS_ ((unsigned char*)p.in[33 + zero_()])
#define OUT_ ((float*)p.in[32 + zero_()])
#define x_prompt (p.in[0 + zero_()])
#define x_sample (p.in[1 + zero_()])
#define state_ret (p.in[2 + zero_()])
#define state_lru_h (p.in[3 + zero_()])
#define state_lru_conv (p.in[4 + zero_()])
#define state_ffn_conv (p.in[5 + zero_()])
#define cache_k (p.in[6 + zero_()])
#define cache_v (p.in[7 + zero_()])
#define mem_prompt (p.in[8 + zero_()])
#define norm_mix (p.in[9 + zero_()])
#define norm_xa (p.in[10 + zero_()])
#define norm_mem (p.in[11 + zero_()])
#define norm_ffn (p.in[12 + zero_()])
#define norm_final (p.in[13 + zero_()])
#define lru_conv_w (p.in[17 + zero_()])
#define lru_conv_b (p.in[18 + zero_()])
#define lru_ba (p.in[20 + zero_()])
#define lru_bx (p.in[22 + zero_()])
#define lru_lambda (p.in[23 + zero_()])
#define ffn_conv_w (p.in[29 + zero_()])
#define ffn_conv_b (p.in[30 + zero_()])
#define HN ((bf16_t*)(WS_ + W_HN))
#define MN ((bf16_t*)(WS_ + W_MN))
#define MK ((bf16_t*)(WS_ + W_MK))
#define MVT ((bf16_t*)(WS_ + W_MVT))
#define BIG ((bf16_t*)(WS_ + W_BIG))
#define X ((float*)(WS_ + W_X))
#define XS ((float*)(WS_ + W_X) + (size_t)PR * 1024)
#define QX ((bf16_t*)(WS_ + W_QX))
#define AO ((bf16_t*)(WS_ + W_AO))
#define Y ((bf16_t*)(WS_ + W_Y))
#define KT ((bf16_t*)(WS_ + W_KT))
#define VT ((bf16_t*)(WS_ + W_VT))
#define O ((bf16_t*)(WS_ + W_O))
#define OG ((bf16_t*)(WS_ + W_OG))
#define XC ((bf16_t*)(WS_ + W_XC))
#define AA ((float*)(WS_ + W_AA))
#define UU ((float*)(WS_ + W_UU))
#define CH ((float*)(WS_ + W_CH))
#define YL ((bf16_t*)(WS_ + W_YL))
#define ROTC ((float*)(WS_ + W_ROTC))
#define ROTS ((float*)(WS_ + W_ROTS))
#define LSG ((float*)(WS_ + W_LSG))
#define SS ((float*)(WS_ + W_SS))
#define DEC ((float*)(WS_ + W_DEC))
    volatile LAS unsigned* xst = (volatile LAS unsigned*)(lds + 153600);
    if (threadIdx.x < 4) xst[threadIdx.x] = 0u;
    __syncthreads();
    const XcdBarrier xbar = xcd_barrier_post((unsigned*)(WS_ + W_BAR), xst);
    const int hi2 = hi < NPH ? hi : NPH;
    for (int ph = lo; ph < hi2; ++ph) {
        Step st; st.kind = K_NORMF; st.L = ph >= 11 ? 1 : 0; st.lda = 1024; st.N = 1024; st.K = 1024; st.ldo = 1024; st.ssi = 0; st.A = HN; st.Bt = nullptr; st.ob = nullptr; st.rinP = X; st.rinS = XS;
        switch (ph) {
            case 0: st.kind = K_PREP; break;
            case 1: st.kind = K_RETIN; break;
            case 2: st.kind = K_RET; break;
            case 3: st.kind = K_GATE; break;
            case 4: st.kind = K_RESID; st.ssi = 1; st.A = OG; st.lda = 2048; st.K = 2048; st.Bt = (const bf16_t*)(WS_ + W_ROUT); st.rinP = x_prompt; st.rinS = x_sample; break;
            case 5: st.kind = K_BF16; st.ssi = 1; st.Bt = (const bf16_t*)(WS_ + W_XQ); st.ob = QX; break;
            case 6: st.kind = K_XATTN; break;
            case 7: st.kind = K_RESID; st.ssi = 2; st.A = AO; st.Bt = (const bf16_t*)(WS_ + W_XO); break;
            case 8: st.kind = K_BF16; st.ssi = 2; st.Bt = (const bf16_t*)(WS_ + W_UP); st.N = 6144; st.ob = BIG; st.ldo = 6144; break;
            case 9: st.kind = K_FFNGATE; break;
            case 10: st.kind = K_RESID; st.ssi = 3; st.A = Y; st.lda = 3072; st.K = 3072; st.Bt = (const bf16_t*)(WS_ + W_DN); break;
            case 11: st.kind = K_BF16; st.ssi = 3; st.Bt = (const bf16_t*)(WS_ + W_LIN); st.N = 2048; st.ob = BIG; st.ldo = 2048; break;
            case 12: st.kind = K_LRUCONV; break;
            case 13: st.kind = K_LRU; break;
            case 14: st.kind = K_SCAN1; break;
            case 15: st.kind = K_SCAN2; break;
            case 16: st.kind = K_RESID; st.ssi = 4; st.A = YL; st.Bt = (const bf16_t*)(WS_ + W_LOUT); break;
            case 17: st.kind = K_BF16; st.ssi = 4; st.Bt = (const bf16_t*)(WS_ + W_XQ + 2097152); st.ob = QX; break;
            case 18: st.kind = K_XATTN; break;
            case 19: st.kind = K_RESID; st.ssi = 5; st.A = AO; st.Bt = (const bf16_t*)(WS_ + W_XO + 2097152); break;
            case 20: st.kind = K_BF16; st.ssi = 5; st.Bt = (const bf16_t*)(WS_ + W_UP + 12582912); st.N = 6144; st.ob = BIG; st.ldo = 6144; break;
            case 21: st.kind = K_FFNGATE; break;
            case 22: st.kind = K_RESID; st.ssi = 6; st.A = Y; st.lda = 3072; st.K = 3072; st.Bt = (const bf16_t*)(WS_ + W_DN + 6291456); break;
            default: st.kind = K_NORMF; break;
        }
        const int L = st.L;
#ifndef DUP_MASK
#define DUP_MASK 0
#endif
        const int nrep = 1 + (int)(((unsigned)(DUP_MASK) >> st.kind) & 1u);
        for (int rep = 0; rep < nrep; ++rep) {
        if (rep) grid.sync();
        switch (st.kind) {
            case K_PREP: if constexpr (ONLY < 0 || ONLY == K_PREP) {
#if EN(0)
                transpose_phase(lds, p);
                rot_phase(ROTC, ROTS, p.rope_c1);
                lsg_phase(lru_lambda, LSG);
                dec_phase(DEC);
                cast_ss_phase(x_prompt, x_sample, HN, SS);
                for (int i = 0; i < 2; ++i) norm_phase<false>(mem_prompt, nullptr, norm_mem + i * 1024, MN + (size_t)i * 2097152, nullptr, nullptr, 2048);
#endif
            } break;
            case K_RETIN: if constexpr (ONLY < 0 || ONLY == K_RETIN) {
                QRetIn q; q.big = BIG; q.kt = KT; q.vt = VT; q.rc = ROTC; q.rs = ROTS; q.dec = DEC; q.ss = SS;
#if EN(1)
                run_gemm(lds, HN, 1024, (const bf16_t*)(WS_ + W_RIN), 1024, PR, 6144, 1024, 0, 0, q);
#endif
#if EN(13)
                skinny_phase(lds, HN + (size_t)PR * 1024, 1024, (const bf16_t*)(WS_ + W_RIN), 1024, 6144, 1024, 0, q, nblk_() == 256 ? 128 : 0);
#endif
#if EN(14)
                for (int i = 0; i < 2; ++i) {
                    QMemKV m; m.outk = OUT_ + O_MKP + (size_t)i * 2097152; m.outv = OUT_ + O_MVP + (size_t)i * 2097152; m.mk = MK + (size_t)i * 2097152; m.mvt = MVT + (size_t)i * 2097152;
                    run_gemm(lds, MN + (size_t)i * 2097152, 1024, (const bf16_t*)(WS_ + W_XKV + (size_t)i * 4194304), 1024, 2048, 2048, 1024, 0, 128 + 64 * i, m);
                }
#endif
            } break;
            case K_RET: if constexpr (ONLY < 0 || ONLY == K_RET) {
#if EN(2)
                retention_prompt_phase(lds, BIG, KT, VT, O, OUT_ + O_RETP, DEC, nblk_() == 256, state_ret, OUT_ + O_RETS);
#endif
#if EN(3)
                if (nblk_() != 256) retention_sample_phase(lds, BIG, state_ret, OUT_ + O_RETS, O);
#endif
            } break;
            case K_GATE: if constexpr (ONLY < 0 || ONLY == K_GATE) {
#if EN(4)
                gate_phase(O, BIG, OG);
#endif
            } break;
            case K_RESID: if constexpr (ONLY < 0 || ONLY == K_RESID) {
                QResid q; q.rinP = st.rinP; q.rinS = st.rinS; q.xout = X; q.xb = HN; q.ssout = SS + (size_t)st.ssi * TP * 32;
#if EN(5)
                run_gemm(lds, st.A, st.lda, st.Bt, st.K, PR, 1024, st.K, 0, 0, q);
#endif
#if EN(15)
                skinny_phase1(lds, st.A + (size_t)PR * st.lda, st.lda, st.Bt, st.K, 1024, st.K, 0, q);
#endif
            } break;
            case K_BF16: if constexpr (ONLY < 0 || ONLY == K_BF16) {
                if (st.N == 6144) {
                    unsigned char* wsb = WS_; float* ob = OUT_;
                    QFfn q; q.y = (bf16_t*)(wsb + W_Y); q.big = (bf16_t*)(wsb + W_BIG); q.ss = (const float*)(wsb + W_SS) + (size_t)st.ssi * TP * 32; q.cw = ffn_conv_w + (size_t)L * 9216; q.cb = ffn_conv_b + (size_t)L * 3072;
                    q.sbuf = state_ffn_conv + (size_t)L * 786432; q.outp = ob + O_FCP + (size_t)L * 49152; q.outs = ob + O_FCS + (size_t)L * 786432;
                    const bf16_t* hn = (const bf16_t*)(wsb + W_HN);
                    run_gemm(lds, hn, 1024, st.Bt, 1024, PR, 6144, 1024, 2, 0, q);
                    skinny_phase(lds, hn + (size_t)PR * 1024, 1024, st.Bt, 1024, 6144, 1024, 2, q);
                } else {
                QBf16 q; q.out = st.ob; q.ld = st.ldo; q.ss = SS + (size_t)st.ssi * TP * 32;
#if EN(6)
                run_gemm(lds, HN, 1024, st.Bt, 1024, PR, st.N, 1024, 0, 0, q);
#endif
#if EN(16)
                if (st.N == 1024) skinny_phase1(lds, HN + (size_t)PR * 1024, 1024, st.Bt, 1024, 1024, 1024, 0, q);
                else skinny_phase_t<2>(lds, HN + (size_t)PR * 1024, 1024, st.Bt, 1024, st.N, 1024, 0, q);
#endif
                }
            } break;
            case K_XATTN: if constexpr (ONLY < 0 || ONLY == K_XATTN) {
#if EN(10)
                xattn_prompt_phase(lds, QX, MK + (size_t)L * 2097152, MVT + (size_t)L * 2097152, AO);
#endif
#if EN(11)
                xattn_sample_phase(lds, QX, cache_k + (size_t)L * 33554432, cache_v + (size_t)L * 33554432, AO);
#endif
            } break;
            case K_FFNGATE: if constexpr (ONLY < 0 || ONLY == K_FFNGATE) {
#if EN(12)
                ffn_fix_phase(BIG, Y, ffn_conv_w + (size_t)L * 9216, ffn_conv_b + (size_t)L * 3072);
#endif
            } break;
            case K_LRUCONV: if constexpr (ONLY < 0 || ONLY == K_LRUCONV) {
#if EN(7)
                lru_conv_phase(BIG, XC, lru_conv_w, lru_conv_b, state_lru_conv, OUT_ + O_LCP, OUT_ + O_LCS);
#endif
            } break;
            case K_LRU: if constexpr (ONLY < 0 || ONLY == K_LRU) {
                QLru q; q.ba = lru_ba; q.bx = lru_bx; q.lam = LSG; q.xc = XC; q.aa = AA; q.uu = UU; q.h0 = state_lru_h; q.hout = OUT_ + O_LHS; q.big = BIG; q.yl = YL;
#if EN(8)
                run_gemm(lds, XC, 1024, (const bf16_t*)(WS_ + W_AX), 256, PR, 2048, 256, 1, 0, q);
#endif
#if EN(18)
                skinny_phase_t<2>(lds, XC + (size_t)PR * 1024, 1024, (const bf16_t*)(WS_ + W_AX), 256, 2048, 256, 1, q);
#endif
            } break;
            case K_SCAN1: if constexpr (ONLY < 0 || ONLY == K_SCAN1) {
#if EN(9)
                scan1_phase(AA, UU, CH);
#endif
            } break;
            case K_SCAN2: if constexpr (ONLY < 0 || ONLY == K_SCAN2) {
#if EN(9)
                scan2_phase(AA, UU, CH, BIG, YL, OUT_ + O_LHP);
#endif
            } break;
            default: if constexpr (ONLY < 0 || ONLY == K_NORMF) {
#if EN(0)
                norm_phase<true>(X, XS, norm_final, nullptr, OUT_ + O_YP, OUT_ + O_YS, TR);
#endif
            } break;
        }
        }
        if (ph + 1 < hi2) { if (lo < 0) grid.sync(); else xcd_barrier(xbar); }
    }
#ifdef EXTRA_SYNCS
    for (int i = 0; i < EXTRA_SYNCS; ++i) grid.sync();
#endif
}

#undef WS_
#undef OUT_
#undef x_prompt
#undef x_sample
#undef state_ret
#undef state_lru_h
#undef state_lru_conv
#undef state_ffn_conv
#undef cache_k
#undef cache_v
#undef mem_prompt
#undef norm_mix
#undef norm_xa
#undef norm_mem
#undef norm_ffn
#undef norm_final
#undef lru_conv_w
#undef lru_conv_b
#undef lru_ba
#undef lru_bx
#undef lru_lambda
#undef ffn_conv_w
#undef ffn_conv_b
#undef HN
#undef MN
#undef MK
#undef MVT
#undef BIG
#undef X
#undef XS
#undef QX
#undef AO
#undef Y
#undef KT
#undef VT
#undef O
#undef OG
#undef XC
#undef AA
#undef UU
#undef CH
#undef YL
#undef ROTC
#undef ROTS
#undef LSG
#undef SS
#undef DEC
__global__ void dump_k(const float* src, float* dst, size_t n) { for (size_t i = (size_t)bid_() * blockDim.x + threadIdx.x; i < n; i += (size_t)nblk_() * blockDim.x) dst[i] = src[i]; }
#ifndef MULTI
#define MULTI 0
#endif
static const int h_kinds[NPH] = {K_PREP, K_RETIN, K_RET, K_GATE, K_RESID, K_BF16, K_XATTN, K_RESID, K_BF16, K_FFNGATE, K_RESID, K_BF16, K_LRUCONV, K_LRU, K_SCAN1, K_SCAN2,
                                 K_RESID, K_BF16, K_XATTN, K_RESID, K_BF16, K_FFNGATE, K_RESID, K_NORMF};
typedef void (*mega_fn)(Params, int, int);
template <int K> static mega_fn get_fn() { return mega<K>; }
static mega_fn fn_of_kind(int k) {
    switch (k) {
        case 0: return get_fn<0>(); case 1: return get_fn<1>(); case 2: return get_fn<2>(); case 3: return get_fn<3>(); case 4: return get_fn<4>(); case 5: return get_fn<5>(); case 6: return get_fn<6>();
        case 7: return get_fn<7>(); case 8: return get_fn<8>(); case 9: return get_fn<9>(); case 10: return get_fn<10>(); case 11: return get_fn<11>(); case 12: return get_fn<12>(); default: return get_fn<13>();
    }
}

extern "C" void kernel_launch(void* const* d_in, const int* in_sizes, int n_in, void* d_out, int out_size, void* d_ws, size_t ws_size, hipStream_t stream) {
    (void)in_sizes; (void)n_in; (void)out_size;
    static int grid_blocks = 0;
    if (!grid_blocks) {
        int dev = 0, cus = 0;
        (void)hipGetDevice(&dev);
        (void)hipDeviceGetAttribute(&cus, hipDeviceAttributeMultiprocessorCount, dev);
#if MULTI
        for (int k = 0; k < 14; ++k) (void)hipFuncSetAttribute((const void*)fn_of_kind(k), hipFuncAttributeMaxDynamicSharedMemorySize, LDS_BYTES);
#else
        (void)hipFuncSetAttribute((const void*)mega<-1>, hipFuncAttributeMaxDynamicSharedMemorySize, LDS_BYTES);
#endif
        grid_blocks = cus;
        if (ws_size < W_TOTAL) fprintf(stderr, "workspace too small: %zu < %zu\n", ws_size, (size_t)W_TOTAL);
    }
    Params p; memset(&p, 0, sizeof(p));
    for (int i = 0; i < 32; ++i) p.in[i] = (const float*)d_in[i];
    p.in[32] = (const float*)d_out; p.in[33] = (const float*)d_ws;
    p.rope_c1 = pow(10000.0, -1.0 / 128.0);
    unsigned char* ws = (unsigned char*)d_ws;
    int nj = 0, tiles = 0;
    auto add = [&](const float* src, size_t dst_off, int ld, int K, int N, const float* gain = nullptr) {
        TJob& j = p.jobs[nj++]; j.gain = gain; j.src = src; j.dst = (bf16_t*)(ws + dst_off); j.ld = ld; j.K = K; j.N = N; j.tile0 = tiles; tiles += (K / 64) * (N / 64);
    };
    const float* ret_w_in = p.in[14]; const float* ret_w_out = p.in[15]; const float* lru_w_in = p.in[16]; const float* lru_wa = p.in[19]; const float* lru_wx = p.in[21];
    const float* lru_w_out = p.in[24]; const float* xa_w_q = p.in[25]; const float* xa_w_kv = p.in[26]; const float* xa_w_o = p.in[27]; const float* ffn_w_up = p.in[28]; const float* ffn_w_down = p.in[31];
    const float* g_mix = p.in[9]; const float* g_xa = p.in[10]; const float* g_ffn = p.in[12];
    add(ret_w_in, W_RIN, 6144, 1024, 6144, g_mix);
    add(ffn_w_up, W_UP, 6144, 1024, 6144, g_ffn);
    add(ffn_w_up + (size_t)1024 * 6144, W_UP + 12582912, 6144, 1024, 6144, g_ffn + 1024);
    add(ret_w_out, W_ROUT, 1024, 2048, 1024);
    add(lru_w_in, W_LIN, 2048, 1024, 2048, g_mix + 1024);
    for (int h = 0; h < 4; ++h)
        for (int s = 0; s < 2; ++s)
            for (int half = 0; half < 2; ++half)
                add((half ? lru_wx : lru_wa) + (size_t)h * 65536 + s * 128, W_AX + (size_t)(h * 512 + s * 256 + half * 128) * 256 * 2, 256, 256, 128);
    add(lru_w_out, W_LOUT, 1024, 1024, 1024);
    for (int i = 0; i < 2; ++i) add(xa_w_q + (size_t)i * 1048576, W_XQ + (size_t)i * 2097152, 1024, 1024, 1024, g_xa + i * 1024);
    for (int i = 0; i < 2; ++i) add(xa_w_kv + (size_t)i * 2097152, W_XKV + (size_t)i * 4194304, 2048, 1024, 2048);
    for (int i = 0; i < 2; ++i) add(xa_w_o + (size_t)i * 1048576, W_XO + (size_t)i * 2097152, 1024, 1024, 1024);
    for (int i = 0; i < 2; ++i) add(ffn_w_down + (size_t)i * 3145728, W_DN + (size_t)i * 6291456, 1024, 3072, 1024);
    p.ntiles = tiles;
    if (nj != NJOBS) fprintf(stderr, "job count mismatch %d\n", nj);
#if MULTI
#ifndef HI_LIMIT
#define HI_LIMIT NPH
#endif
    for (int ph0 = 0; ph0 < HI_LIMIT; ++ph0) {
        const int ph = ph0;
        int lo = ph, hi = ph + 1;
        void* args[] = {&p, &lo, &hi};
        hipError_t e = hipLaunchKernel((const void*)fn_of_kind(h_kinds[ph]), dim3(grid_blocks), dim3(512), args, LDS_BYTES, stream);
        if (e != hipSuccess) fprintf(stderr, "launch %d failed: %s\n", ph, hipGetErrorString(e));
    }
#ifdef DUMP_OFF
    dump_k<<<1024, 256, 0, stream>>>((const float*)((unsigned char*)d_ws + DUMP_OFF), (float*)d_out, (size_t)16000000);
#endif
#else
    (void)hipMemsetAsync((unsigned char*)d_ws + W_BAR, 0, 16384, stream);
    int lo = 0, hi = NPH;
    void* args[] = {&p, &lo, &hi};
    hipError_t e = hipLaunchCooperativeKernel((const void*)mega<-1>, dim3(grid_blocks), dim3(512), args, LDS_BYTES, stream);
    if (e != hipSuccess) fprintf(stderr, "cooperative launch failed: %s (grid %d)\n", hipGetErrorString(e), grid_blocks);
#endif
}
```

```cpp
#include <hip/hip_runtime.h>
#include <hip/hip_cooperative_groups.h>
#include <cstdio>
#include <cstring>
#include <cmath>
namespace cg = cooperative_groups;

#ifndef MASK
#define MASK 0xffffffffu
#endif
#define EN(k) (((MASK) >> (k)) & 1u)
#define LAS __attribute__((address_space(3)))
#define DEVI __device__ __forceinline__
typedef unsigned short bf16_t;
typedef short bf16x8 __attribute__((ext_vector_type(8)));
typedef float f32x4 __attribute__((ext_vector_type(4)));
typedef unsigned u32x2 __attribute__((ext_vector_type(2)));
typedef unsigned u32x4 __attribute__((ext_vector_type(4)));

constexpr int PR = 16384;
constexpr int SR = 128;
constexpr int TR = PR + SR;
constexpr int TP = 16640;
constexpr int LDS_BYTES = 153600 + 16 + 8192;

constexpr size_t O_YP = 0, O_YS = 16777216, O_RETP = 16908288, O_RETS = 21102592, O_LHP = 88211456, O_LHS = 88219648,
                 O_LCP = 88350720, O_LCS = 88375296, O_FCP = 88768512, O_FCS = 88866816, O_MKP = 90439680, O_MVP = 94633984;

constexpr size_t W_RIN = 0;
constexpr size_t W_ROUT = W_RIN + 12582912;
constexpr size_t W_LIN = W_ROUT + 4194304;
constexpr size_t W_AX = W_LIN + 4194304;
constexpr size_t W_LOUT = W_AX + 1048576;
constexpr size_t W_XQ = W_LOUT + 2097152;
constexpr size_t W_XKV = W_XQ + 2 * 2097152;
constexpr size_t W_XO = W_XKV + 2 * 4194304;
constexpr size_t W_UP = W_XO + 2 * 2097152;
constexpr size_t W_DN = W_UP + 2 * 12582912;
constexpr size_t W_ROTC = W_DN + 2 * 6291456;
constexpr size_t W_ROTS = W_ROTC + 1049088;
constexpr size_t W_LSG = W_ROTS + 1049088;
constexpr size_t W_DEC = W_LSG + 4096;
constexpr size_t W_SS = W_DEC + 4096;
constexpr size_t W_HN = W_SS + (size_t)7 * TP * 32 * 4;
constexpr size_t W_MN = W_HN + (size_t)TP * 2048;
constexpr size_t W_MK = W_MN + 8388608;
constexpr size_t W_MVT = W_MK + 8388608;
constexpr size_t W_BIG = W_MVT + 8388608;
constexpr size_t W_X = W_BIG + (size_t)TP * 12288;
constexpr size_t W_QX = W_X + (size_t)TP * 4096;
constexpr size_t W_AO = W_QX + (size_t)TP * 2048;
constexpr size_t W_Y = W_AO + (size_t)TP * 2048;
constexpr size_t W_L = W_Y + (size_t)TP * 6144;
constexpr size_t W_KT = W_L;
constexpr size_t W_VT = W_KT + 33554432;
constexpr size_t W_O = W_VT + 67108864;
constexpr size_t W_OG = W_O + (size_t)TP * 4096;
constexpr size_t W_END0 = W_OG + (size_t)TP * 4096;
constexpr size_t W_XC = W_L;
constexpr size_t W_AA = W_XC + (size_t)TP * 2048;
constexpr size_t W_UU = W_AA + (size_t)TP * 4096;
constexpr size_t W_CH = W_UU + (size_t)TP * 4096;
constexpr size_t W_YL = W_CH + 4194304;
constexpr size_t W_END1 = W_YL + (size_t)TP * 2048;
constexpr size_t W_BAR = (W_END0 > W_END1 ? W_END0 : W_END1);
constexpr size_t W_TOTAL = W_BAR + 256;

struct TJob { const float* src; bf16_t* dst; const float* gain; int ld, K, N, tile0; };
constexpr int NJOBS = 30;
struct Params {
    const float* in[34];
    double rope_c1;
    TJob jobs[NJOBS];
    int ntiles;
    int pad0;
};

typedef float f32x2 __attribute__((ext_vector_type(2)));
typedef __bf16 bf16x2_t __attribute__((ext_vector_type(2)));
DEVI unsigned cvt_pk_bf16(float lo, float hi) { f32x2 v = {lo, hi}; bf16x2_t r = __builtin_convertvector(v, bf16x2_t); return __builtin_bit_cast(unsigned, r); }
DEVI bf16_t f2bf(float f) { return (bf16_t)(cvt_pk_bf16(f, 0.f) & 0xffffu); }
DEVI float bflo(unsigned u) { return __uint_as_float(u << 16); }
DEVI float bfhi(unsigned u) { return __uint_as_float(u & 0xffff0000u); }
DEVI float bf2f(bf16_t b) { return __uint_as_float(((unsigned)b) << 16); }
DEVI u32x2 pack4(f32x4 v) { u32x2 r; r.x = cvt_pk_bf16(v[0], v[1]); r.y = cvt_pk_bf16(v[2], v[3]); return r; }
DEVI float shx(float v, int o, int lane) { return __int_as_float(__builtin_amdgcn_ds_bpermute((lane ^ o) << 2, __float_as_int(v))); }
DEVI float dpp_f(float v, const int ctrl_sel) {
    const int x = __float_as_int(v);
    int r;
    if (ctrl_sel == 0) r = __builtin_amdgcn_update_dpp(x, x, 0xB1, 0xf, 0xf, false);
    else if (ctrl_sel == 1) r = __builtin_amdgcn_update_dpp(x, x, 0x4E, 0xf, 0xf, false);
    else if (ctrl_sel == 2) r = __builtin_amdgcn_update_dpp(x, x, 0x141, 0xf, 0xf, false);
    else r = __builtin_amdgcn_update_dpp(x, x, 0x140, 0xf, 0xf, false);
    return __int_as_float(r);
}
DEVI float wave_sum(float v, int lane) {
    (void)lane;
    v += dpp_f(v, 0); v += dpp_f(v, 1); v += dpp_f(v, 2); v += dpp_f(v, 3);
    const int x = __float_as_int(v);
    const float s0 = __int_as_float(__builtin_amdgcn_readlane(x, 0)), s1 = __int_as_float(__builtin_amdgcn_readlane(x, 16));
    const float s2 = __int_as_float(__builtin_amdgcn_readlane(x, 32)), s3 = __int_as_float(__builtin_amdgcn_readlane(x, 48));
    return (s0 + s1) + (s2 + s3);
}
DEVI float rcp_(float x) { return __builtin_amdgcn_rcpf(x); }
DEVI float ex2_(float x) { return __builtin_amdgcn_exp2f(x); }
DEVI float exp_(float x) { return __builtin_amdgcn_exp2f(x * 1.4426950408889634f); }
DEVI float sigmoidf_(float x) { return rcp_(1.f + exp_(-x)); }
DEVI float gelu_tanh(float x) { const float z = 1.5957691216057308f * (x + 0.044715f * x * x * x); return x * rcp_(1.f + exp_(-z)); }
DEVI int zero_() { int z = 0; asm volatile("" : "+s"(z)); return z; }
DEVI int bid_() { int b = blockIdx.x; asm volatile("" : "+s"(b)); return b; }
DEVI int nblk_() { int b = gridDim.x; asm volatile("" : "+s"(b)); return b; }
DEVI unsigned zv_() { unsigned z = 0; asm volatile("" : "+v"(z)); return z; }
DEVI int tid_() { int t = threadIdx.x; asm volatile("" : "+v"(t)); return t; }
DEVI f32x4 mfma16(bf16x8 a, bf16x8 b, f32x4 c) { return __builtin_amdgcn_mfma_f32_16x16x32_bf16(a, b, c, 0, 0, 0); }

DEVI float rstd_of(const float* ss, int row) {
    const f32x4* p = (const f32x4*)(ss + (unsigned)row * 32u);
    f32x4 a = p[0];
#pragma unroll
    for (int i = 1; i < 8; ++i) a += p[i];
    return __builtin_amdgcn_rsqf(__fadd_rn(__fmul_rn((a[0] + a[1]) + (a[2] + a[3]), 1.f / 1024.f), 1e-6f));
}

namespace pg8 {
constexpr int BM = 256, BK = 64, HALF = 128, HTB = HALF * BK * 2, NXCD = 8, WGM = 8;
__host__ __device__ __forceinline__ int lds_byte(int r, int c) { const int st = (r >> 4) * 2 + (c >> 5), rr = r & 15, cc = c & 31, ob = rr * 64 + cc * 2; return st * 1024 + (ob ^ (((ob >> 9) & 1) << 5)); }
__host__ __device__ __forceinline__ void stage_rc(int b, int& R, int& C) { const int st = b / 1024, sb = b % 1024, swz = sb ^ (((sb >> 9) & 1) << 5); R = (st >> 1) * 16 + swz / 64; C = (st & 1) * 32 + (swz % 64) / 2; }
__host__ __device__ __forceinline__ int perm32(int rho) { const int n = rho >> 4, i = rho & 15; return 8 * (i >> 2) + 4 * n + (i & 3); }
struct Unit { int pm, pn; };
struct Gemm { const bf16_t* A; const bf16_t* Bt; int M, N, K, lda, ldb, diag; };
struct StaticOrder {
    int nM, nN, nwg, G, c;
    DEVI void init(int M, int N, int G_, int c_) { nM = M / BM; nN = N / BM; nwg = nM * nN; G = G_; c = c_; }
    DEVI bool next(int i, Unit& u) const {
        const long L = (long)i * G + c; if (L >= nwg) return false;
        int wgid = (int)L; { const int q = nwg / NXCD, r = nwg % NXCD, xcd = wgid % NXCD, off = wgid / NXCD; wgid = (xcd < r ? xcd * (q + 1) : r * (q + 1) + (xcd - r) * q) + off; }
        const int nig = WGM * nN, gid = wgid / nig, fm = gid * WGM, gsz = (nM - fm) < WGM ? (nM - fm) : WGM;
        u.pm = fm + ((wgid % nig) % gsz); u.pn = (wgid % nig) / gsz; return true;
    }
};

template <class Q>
DEVI void gemm_phase(LAS unsigned char* lds, const Gemm g, const StaticOrder& S, const Q& E) {
    const int tid = tid_(), wid = __builtin_amdgcn_readfirstlane(tid >> 6), lane = tid & 63, wr = wid >> 2, wc = wid & 3, fr = lane & 15, fq = lane >> 4;
    const int K = g.K, nt = K / BK;
    unsigned voffA, voffB;
    { int R, C; stage_rc(tid * 16, R, C); const int Rb = Q::PERM ? ((R & ~31) + perm32(R & 31)) : R; voffA = (unsigned)(R * g.lda + C) * 2u; voffB = (unsigned)(Rb * g.ldb + C) * 2u; }
    const size_t r64voffA = (size_t)64 * g.lda * 2, r64voffB = (size_t)64 * g.ldb * 2;
    const size_t kstep = (size_t)(BK * 2);
    const size_t hstepA = (size_t)HALF * g.lda * 2, hstepB = (g.diag == 2 ? (size_t)3072 : (size_t)HALF) * g.ldb * 2;
    const size_t tstepA = 2 * hstepA, tstepB = (g.diag == 2 ? (size_t)HALF : (size_t)2 * HALF) * g.ldb * 2;
    const unsigned ldsw = (unsigned)wid * 1024u;
    const int aoff = lds_byte(wr * 64 + fr, fq * 8), boff = lds_byte(wc * 32 + fr, fq * 8);
#define PG8_SA(b, h) (((b) * 2 + (h)) * HTB)
#define PG8_SB(b, h) ((4 + (b) * 2 + (h)) * HTB)
#define PG8_STAGE(bufoff, gbase, voff) do { _Pragma("unroll") for (int _i = 0; _i < 2; ++_i) \
        __builtin_amdgcn_global_load_lds((const unsigned*)((const char*)(gbase) + (size_t)_i * r64##voff + voff), (LAS unsigned*)(lds + (bufoff) + ldsw + _i * 8192), 16, 0, 0); } while (0)
#define PG8_LDA(dst, b, h) do { _Pragma("unroll") for (int m = 0; m < 4; ++m) _Pragma("unroll") for (int k = 0; k < 2; ++k) dst[m][k] = *(const LAS bf16x8*)(lds + PG8_SA(b, h) + aoff + m * 2048 + k * 1024); } while (0)
#define PG8_LDB(dst, b, h) do { _Pragma("unroll") for (int n = 0; n < 2; ++n) _Pragma("unroll") for (int k = 0; k < 2; ++k) dst[n][k] = *(const LAS bf16x8*)(lds + PG8_SB(b, h) + boff + n * 2048 + k * 1024); } while (0)
#define PG8_MMA(ai, bj, At, Bt) do { __builtin_amdgcn_s_setprio(1); _Pragma("unroll") for (int m = 0; m < 4; ++m) _Pragma("unroll") for (int n = 0; n < 2; ++n) _Pragma("unroll") for (int k = 0; k < 2; ++k) \
        acc[ai][bj][m][n] = __builtin_amdgcn_mfma_f32_16x16x32_bf16(Bt[n][k], At[m][k], acc[ai][bj][m][n], 0, 0, 0); __builtin_amdgcn_s_setprio(0); } while (0)
#define PG8_WAIT_V(n) asm volatile("s_waitcnt vmcnt(" #n ")" ::: "memory")
#define PG8_WAIT_L(n) asm volatile("s_waitcnt lgkmcnt(" #n ")" ::: "memory")
#define PG8_BAR __builtin_amdgcn_s_barrier()
#define PG8_SCHED __builtin_amdgcn_sched_barrier(0)
    Unit cur, nxt; int ui = 0;
    if (!S.next(0, cur)) return;
    f32x4 acc[2][2][4][2];
#pragma unroll
    for (int a = 0; a < 2; ++a)
#pragma unroll
        for (int b = 0; b < 2; ++b)
#pragma unroll
            for (int m = 0; m < 4; ++m)
#pragma unroll
                for (int n = 0; n < 2; ++n) acc[a][b][m][n] = (f32x4){0.f, 0.f, 0.f, 0.f};
    bf16x8 At[4][2], B0[2][2], B1[2][2];
    const char* cA = (const char*)g.A + (size_t)cur.pm * tstepA + (g.diag == 1 ? (size_t)(cur.pn >> 1) * 512 : 0); const char* cB = (const char*)g.Bt + (size_t)cur.pn * tstepB;
#define PG8_RSTD(unit, par) do { if constexpr (Q::NEEDS_RSTD) { \
        const int _rl = tid >> 1, _hf = tid & 1; \
        const f32x4* _p = (const f32x4*)(E.ss + ((size_t)((unit).pm * BM + _rl)) * 32 + _hf * 16); \
        const f32x4 _a = (_p[0] + _p[1]) + (_p[2] + _p[3]); \
        float _sm = (_a[0] + _a[1]) + (_a[2] + _a[3]); \
        _sm += shx(_sm, 1, lane); \
        if (!_hf) *(LAS float*)(lds + 131072 + (par) * 1024 + _rl * 4) = __builtin_amdgcn_rsqf(__fadd_rn(__fmul_rn(_sm, 1.f / 1024.f), 1e-6f)); } } while (0)
    PG8_RSTD(cur, 0);
    PG8_STAGE(PG8_SB(0, 0), cB, voffB); PG8_STAGE(PG8_SA(0, 0), cA, voffA); PG8_STAGE(PG8_SB(0, 1), cB + hstepB, voffB); PG8_STAGE(PG8_SA(0, 1), cA + hstepA, voffA);
    if (wr == 1) PG8_BAR;
    PG8_WAIT_V(4); PG8_BAR;
    PG8_STAGE(PG8_SB(1, 0), cB + kstep, voffB); PG8_STAGE(PG8_SA(1, 0), cA + kstep, voffA); PG8_STAGE(PG8_SB(1, 1), cB + hstepB + kstep, voffB);
    PG8_WAIT_V(6); PG8_BAR;
    for (;;) {
        const bool has_next = S.next(ui + 1, nxt);
        const char* nA = has_next ? (const char*)g.A + (size_t)nxt.pm * tstepA + (g.diag == 1 ? (size_t)(nxt.pn >> 1) * 512 : 0) : cA; const char* nB = has_next ? (const char*)g.Bt + (size_t)nxt.pn * tstepB : cB;
        for (int t = 0; t < nt; t += 2) {
            const bool last = (t == nt - 2);
            const char* a1 = cA + (size_t)(t + 1) * kstep;
            const char* a2 = last ? nA : cA + (size_t)(t + 2) * kstep; const char* b2 = last ? nB : cB + (size_t)(t + 2) * kstep;
            const char* a3 = a2 + kstep; const char* b3 = b2 + kstep;
            PG8_LDB(B0, 0, 0); PG8_SCHED; PG8_LDA(At, 0, 0); PG8_STAGE(PG8_SA(1, 1), a1 + hstepA, voffA);
            PG8_WAIT_L(8); PG8_BAR; PG8_WAIT_L(0); PG8_MMA(0, 0, At, B0); PG8_BAR; PG8_SCHED;
            PG8_LDB(B1, 0, 1); PG8_STAGE(PG8_SB(0, 0), b2, voffB);
            PG8_BAR; PG8_WAIT_L(0); PG8_MMA(0, 1, At, B1); PG8_BAR;
            PG8_LDA(At, 0, 1); PG8_STAGE(PG8_SA(0, 0), a2, voffA);
            PG8_BAR; PG8_WAIT_L(0); PG8_MMA(1, 0, At, B0); PG8_BAR; PG8_SCHED;
            PG8_STAGE(PG8_SB(0, 1), b2 + hstepB, voffB);
            PG8_WAIT_V(6); PG8_BAR; PG8_MMA(1, 1, At, B1); PG8_BAR;
            PG8_LDB(B0, 1, 0); PG8_SCHED; PG8_LDA(At, 1, 0); PG8_STAGE(PG8_SA(0, 1), a2 + hstepA, voffA);
            PG8_WAIT_L(8); PG8_BAR; PG8_WAIT_L(0); PG8_MMA(0, 0, At, B0); PG8_BAR; PG8_SCHED;
            PG8_LDB(B1, 1, 1); PG8_STAGE(PG8_SB(1, 0), b3, voffB);
            PG8_BAR; PG8_WAIT_L(0); PG8_MMA(0, 1, At, B1); PG8_BAR;
            PG8_LDA(At, 1, 1); PG8_STAGE(PG8_SA(1, 0), a3, voffA);
            PG8_BAR; PG8_WAIT_L(0); PG8_MMA(1, 0, At, B0); PG8_BAR; PG8_SCHED;
            PG8_STAGE(PG8_SB(1, 1), b3 + hstepB, voffB);
            PG8_WAIT_V(6); PG8_BAR; PG8_MMA(1, 1, At, B1); PG8_BAR;
        }
#pragma unroll
        for (int ai = 0; ai < 2; ++ai)
#pragma unroll
            for (int m = 0; m < 4; ++m) {
                int l2 = lane; asm volatile("" : "+v"(l2));
                const int rloc = ai * HALF + wr * 64 + m * 16 + (l2 & 15);
                float rsc = 1.f;
                if constexpr (Q::NEEDS_RSTD) rsc = *(const LAS float*)(lds + 131072 + (ui & 1) * 1024 + rloc * 4);
                if constexpr (Q::PERM) E.oct(cur.pm * BM + rloc, cur.pn, wc * 32 + (l2 >> 4) * 8, acc[ai][0][m][0], acc[ai][0][m][1], acc[ai][1][m][0], acc[ai][1][m][1], rsc);
                else {
#pragma unroll
                    for (int n = 0; n < 2; ++n)
                        E.quad(cur.pm * BM + rloc, cur.pn, wc * 32 + n * 16 + (l2 >> 4) * 4, acc[ai][0][m][n], acc[ai][1][m][n], rsc);
                }
            }
        if (!has_next) break;
        PG8_RSTD(nxt, (ui + 1) & 1);
#pragma unroll
        for (int a = 0; a < 2; ++a)
#pragma unroll
            for (int b = 0; b < 2; ++b)
#pragma unroll
                for (int m = 0; m < 4; ++m)
#pragma unroll
                    for (int n = 0; n < 2; ++n) acc[a][b][m][n] = (f32x4){0.f, 0.f, 0.f, 0.f};
        cur = nxt; cA = nA; cB = nB; ++ui;
    }
    PG8_WAIT_V(0);
    if (wr == 0) PG8_BAR;
    PG8_BAR;
#undef PG8_RSTD
#undef PG8_SA
#undef PG8_SB
#undef PG8_STAGE
#undef PG8_LDA
#undef PG8_LDB
#undef PG8_MMA
#undef PG8_WAIT_V
#undef PG8_WAIT_L
#undef PG8_BAR
#undef PG8_SCHED
}
}

template <class Q>
DEVI void run_gemm(LAS unsigned char* lds, const bf16_t* A, int lda, const bf16_t* Bt, int ldb, int M, int N, int K, int diag, int rot, const Q& q) {
    pg8::Gemm g; g.A = A; g.Bt = Bt; g.M = M; g.N = N; g.K = K; g.lda = lda; g.ldb = ldb; g.diag = diag;
    pg8::StaticOrder S; const int G_ = nblk_(); S.init(M, N, G_, (bid_() + G_ - (rot % G_)) % G_);
    pg8::gemm_phase<Q>(lds, g, S, q);
}

template <int RT, class Q>
DEVI void skinny_phase_t(LAS unsigned char* lds, const bf16_t* A, int lda, const bf16_t* Bt, int ldb, int N, int K, int diag, const Q& q, int nbuse = 0) {
    constexpr int RS = 8 / RT;
    const int tid = tid_(), w = tid >> 6, lane = tid & 63, fr = lane & 15, fq = lane >> 4;
    const int nitems = (N / 32) * RS, kw = K / 8;
    const int stride_ = nbuse > 0 ? nbuse : nblk_();
    for (int it = bid_() < stride_ ? bid_() : nitems; it < nitems; it += stride_) {
        const int ci = it / RS, rs = it - ci * RS, pn = ci >> 3, g = ci & 7;
        const bf16_t* a0 = A + (size_t)(rs * RT * 16 + fr) * lda + (diag == 1 ? (pn >> 1) * 256 : 0) + w * kw + fq * 8;
        const bf16_t* b0 = Bt + (size_t)((diag == 2 ? pn * 128 : pn * 256) + g * 16 + fr) * ldb + w * kw + fq * 8;
        const bf16_t* b1 = b0 + (size_t)(diag == 2 ? 3072 : 128) * ldb;
        f32x4 acc[RT][2];
#pragma unroll
        for (int rt = 0; rt < RT; ++rt) { acc[rt][0] = (f32x4){0.f, 0.f, 0.f, 0.f}; acc[rt][1] = (f32x4){0.f, 0.f, 0.f, 0.f}; }
        bf16x8 cb0 = *(const bf16x8*)(b0), cb1 = *(const bf16x8*)(b1), ca[RT];
#pragma unroll
        for (int rt = 0; rt < RT; ++rt) ca[rt] = *(const bf16x8*)(a0 + (size_t)rt * 16 * lda);
#pragma unroll 1
        for (int k = 32; k <= kw; k += 32) {
            const int kn = k < kw ? k : 0;
            const bf16x8 nb0 = *(const bf16x8*)(b0 + kn), nb1 = *(const bf16x8*)(b1 + kn);
            bf16x8 na[RT];
#pragma unroll
            for (int rt = 0; rt < RT; ++rt) na[rt] = *(const bf16x8*)(a0 + (size_t)rt * 16 * lda + kn);
#pragma unroll
            for (int rt = 0; rt < RT; ++rt) { acc[rt][0] = mfma16(cb0, ca[rt], acc[rt][0]); acc[rt][1] = mfma16(cb1, ca[rt], acc[rt][1]); }
            cb0 = nb0; cb1 = nb1;
#pragma unroll
            for (int rt = 0; rt < RT; ++rt) ca[rt] = na[rt];
        }
#pragma unroll
        for (int rt = 0; rt < RT; ++rt) {
            *(LAS f32x4*)(lds + (size_t)((((w * 8 + rt) * 2 + 0) * 64 + lane) * 16)) = acc[rt][0];
            *(LAS f32x4*)(lds + (size_t)((((w * 8 + rt) * 2 + 1) * 64 + lane) * 16)) = acc[rt][1];
        }
        __syncthreads();
        if (w < RT) {
            f32x4 v0 = *(const LAS f32x4*)(lds + (size_t)((((0 * 8 + w) * 2 + 0) * 64 + lane) * 16));
            f32x4 v1 = *(const LAS f32x4*)(lds + (size_t)((((0 * 8 + w) * 2 + 1) * 64 + lane) * 16));
#pragma unroll
            for (int ww = 1; ww < 8; ++ww) {
                v0 += *(const LAS f32x4*)(lds + (size_t)((((ww * 8 + w) * 2 + 0) * 64 + lane) * 16));
                v1 += *(const LAS f32x4*)(lds + (size_t)((((ww * 8 + w) * 2 + 1) * 64 + lane) * 16));
            }
            const int row = PR + (rs * RT + w) * 16 + fr;
            float rsc = 1.f;
            if constexpr (Q::NEEDS_RSTD) rsc = rstd_of(q.ss, row);
            q.quad(row, pn, g * 16 + fq * 4, v0, v1, rsc);
        }
        __syncthreads();
    }
}
template <class Q>
DEVI void skinny_phase(LAS unsigned char* lds, const bf16_t* A, int lda, const bf16_t* Bt, int ldb, int N, int K, int diag, const Q& q, int nbuse = 0) {
    skinny_phase_t<8, Q>(lds, A, lda, Bt, ldb, N, K, diag, q, nbuse);
}
template <class Q>
DEVI void skinny_phase1(LAS unsigned char* lds, const bf16_t* A, int lda, const bf16_t* Bt, int ldb, int N, int K, int diag, const Q& q) {
    skinny_phase_t<1, Q>(lds, A, lda, Bt, ldb, N, K, diag, q);
}

struct QRetIn {
    static constexpr bool PERM = true;
    DEVI void oct(int row, int pn, int cl8, f32x4 a0, f32x4 a1, f32x4 b0, f32x4 b1, float rsc) const {
        a0 *= rsc; a1 *= rsc; b0 *= rsc; b1 *= rsc;
        const int b = row >> 11, t = row & 2047;
        bf16_t* nat = big + ((unsigned)row * 6144u + (unsigned)(pn * 256 + cl8));
        if (pn < 8) {
            const int h = pn & 3;
            const float* pc = rc + t * 128 + cl8; const float* ps = rs + t * 128 + cl8;
            const f32x4 c0 = *(const f32x4*)pc, c1 = *(const f32x4*)(pc + 4), s0 = *(const f32x4*)ps, s1 = *(const f32x4*)(ps + 4);
            const float sc = dec[pn * 128 + (t & 127)];
            const f32x4 o0 = (a0 * c0 - b0 * s0) * sc, o1 = (a1 * c1 - b1 * s1) * sc, o2 = (a0 * s0 + b0 * c0) * sc, o3 = (a1 * s1 + b1 * c1) * sc;
            const u32x2 p0 = pack4(o0), p1 = pack4(o1), p2 = pack4(o2), p3 = pack4(o3);
            *(u32x4*)nat = (u32x4){p0.x, p0.y, p1.x, p1.y}; *(u32x4*)(nat + 128) = (u32x4){p2.x, p2.y, p3.x, p3.y};
            if (pn >= 4) {
                bf16_t* q = kt + (((unsigned)(b * 4 + h) * 256u + (unsigned)cl8) * 2048u + (unsigned)t);
#pragma unroll
                for (int r = 0; r < 4; ++r) { q[(size_t)r * 2048] = f2bf(o0[r]); q[(size_t)(4 + r) * 2048] = f2bf(o1[r]); q[(size_t)(128 + r) * 2048] = f2bf(o2[r]); q[(size_t)(132 + r) * 2048] = f2bf(o3[r]); }
            }
        } else if (pn < 16) {
            const int c0i = (pn - 8) * 256 + cl8; const int head = c0i >> 9, e0 = c0i & 511;
            bf16_t* q = vt + (((unsigned)(b * 4 + head) * 512u + (unsigned)e0) * 2048u + (unsigned)t);
#pragma unroll
            for (int r = 0; r < 4; ++r) { q[(size_t)r * 2048] = f2bf(a0[r]); q[(size_t)(4 + r) * 2048] = f2bf(a1[r]); q[(size_t)(128 + r) * 2048] = f2bf(b0[r]); q[(size_t)(132 + r) * 2048] = f2bf(b1[r]); }
        } else {
            const u32x2 p0 = pack4(a0), p1 = pack4(a1), p2 = pack4(b0), p3 = pack4(b1);
            *(u32x4*)nat = (u32x4){p0.x, p0.y, p1.x, p1.y}; *(u32x4*)(nat + 128) = (u32x4){p2.x, p2.y, p3.x, p3.y};
        }
    }
    static constexpr bool NEEDS_RSTD = true;
    bf16_t* big; bf16_t* kt; bf16_t* vt; const float* rc; const float* rs; const float* dec; const float* ss;
    DEVI void quad(int row, int pn, int cl, f32x4 v0, f32x4 v1, float rsc) const {
        v0 *= rsc; v1 *= rsc;
        const bool smp = row >= PR; const int b = row >> 11, t = row & 2047;
        bf16_t* nat = big + ((unsigned)row * 6144u + (unsigned)(pn * 256 + cl));
        if (pn < 8) {
            const int h = pn & 3; const int pi = smp ? 2048 : t;
            const f32x4 c = *(const f32x4*)(rc + pi * 128 + cl), s = *(const f32x4*)(rs + pi * 128 + cl);
            f32x4 o0 = v0 * c - v1 * s, o1 = v0 * s + v1 * c;
            const float sc = dec[pn * 128 + (smp ? 0 : (t & 127))];
            o0 *= sc; o1 *= sc;
            *(u32x2*)nat = pack4(o0); *(u32x2*)(nat + 128) = pack4(o1);
            if (pn >= 4 && !smp) {
                bf16_t* q = kt + (((unsigned)(b * 4 + h) * 256u + (unsigned)cl) * 2048u + (unsigned)t);
#pragma unroll
                for (int r = 0; r < 4; ++r) { q[(size_t)r * 2048] = f2bf(o0[r]); q[(size_t)(128 + r) * 2048] = f2bf(o1[r]); }
            }
        } else if (pn < 16) {
            if (smp) { *(u32x2*)nat = pack4(v0); *(u32x2*)(nat + 128) = pack4(v1); }
            else {
                const int c0 = (pn - 8) * 256 + cl; const int head = c0 >> 9, e0 = c0 & 511;
                bf16_t* q = vt + (((unsigned)(b * 4 + head) * 512u + (unsigned)e0) * 2048u + (unsigned)t);
#pragma unroll
                for (int r = 0; r < 4; ++r) { q[(size_t)r * 2048] = f2bf(v0[r]); q[(size_t)(128 + r) * 2048] = f2bf(v1[r]); }
            }
        } else { *(u32x2*)nat = pack4(v0); *(u32x2*)(nat + 128) = pack4(v1); }
    }
};
struct QResid {
    static constexpr bool PERM = true;
    DEVI void oct(int row, int pn, int cl8, f32x4 a0, f32x4 a1, f32x4 b0, f32x4 b1, float rsc) const {
        (void)rsc;
        const float* r = (row < PR ? rinP + (size_t)row * 1024 : rinS + (size_t)(row - PR) * 1024) + pn * 256 + cl8;
        const unsigned off = (unsigned)row * 1024u + (unsigned)(pn * 256 + cl8);
        a0 += __builtin_nontemporal_load((const f32x4*)r); a1 += __builtin_nontemporal_load((const f32x4*)(r + 4)); b0 += __builtin_nontemporal_load((const f32x4*)(r + 128)); b1 += __builtin_nontemporal_load((const f32x4*)(r + 132));
        __builtin_nontemporal_store(a0, (f32x4*)(xout + off)); __builtin_nontemporal_store(a1, (f32x4*)(xout + off + 4)); __builtin_nontemporal_store(b0, (f32x4*)(xout + off + 128)); __builtin_nontemporal_store(b1, (f32x4*)(xout + off + 132));
        const u32x2 pa0 = pack4(a0), pa1 = pack4(a1), pb0 = pack4(b0), pb1 = pack4(b1);
        *(u32x4*)(xb + off) = (u32x4){pa0.x, pa0.y, pa1.x, pa1.y}; *(u32x4*)(xb + off + 128) = (u32x4){pb0.x, pb0.y, pb1.x, pb1.y};
        float sa = a0[0] * a0[0] + a0[1] * a0[1] + a0[2] * a0[2] + a0[3] * a0[3] + a1[0] * a1[0] + a1[1] * a1[1] + a1[2] * a1[2] + a1[3] * a1[3];
        float sb = b0[0] * b0[0] + b0[1] * b0[1] + b0[2] * b0[2] + b0[3] * b0[3] + b1[0] * b1[0] + b1[1] * b1[1] + b1[2] * b1[2] + b1[3] * b1[3];
        const int lane = (row & 15) | (((cl8 >> 3) & 3) << 4);
        sa += shx(sa, 16, lane); sa += shx(sa, 32, lane); sb += shx(sb, 16, lane); sb += shx(sb, 32, lane);
        if (lane < 16) { float* sp = ssout + ((unsigned)row * 32u + (unsigned)(pn * 8 + (cl8 >> 5))); sp[0] = sa; sp[4] = sb; }
    }
    static constexpr bool NEEDS_RSTD = false;
    const float* rinP; const float* rinS; float* xout; bf16_t* xb; float* ssout;
    DEVI void quad(int row, int pn, int cl, f32x4 v0, f32x4 v1, float rsc) const {
        (void)rsc;
        const float* r = (row < PR ? rinP + (size_t)row * 1024 : rinS + (size_t)(row - PR) * 1024) + pn * 256 + cl;
        const unsigned off = (unsigned)row * 1024u + (unsigned)(pn * 256 + cl);
        const f32x4 a = *(const f32x4*)r + v0, b = *(const f32x4*)(r + 128) + v1;
        *(f32x4*)(xout + off) = a; *(f32x4*)(xout + off + 128) = b;
        *(u32x2*)(xb + off) = pack4(a); *(u32x2*)(xb + off + 128) = pack4(b);
        float sq = a[0] * a[0] + a[1] * a[1] + a[2] * a[2] + a[3] * a[3] + b[0] * b[0] + b[1] * b[1] + b[2] * b[2] + b[3] * b[3];
        const int lane = (row & 15) | (((cl >> 2) & 3) << 4);
        sq += shx(sq, 16, lane); sq += shx(sq, 32, lane);
        if (lane < 16) ssout[(unsigned)row * 32u + (unsigned)(pn * 8 + (cl >> 4))] = sq;
    }
};
struct QBf16 {
    static constexpr bool NEEDS_RSTD = true;
    static constexpr bool PERM = true;
    bf16_t* out; int ld; const float* ss;
    DEVI void oct(int row, int pn, int cl8, f32x4 a0, f32x4 a1, f32x4 b0, f32x4 b1, float rsc) const {
        bf16_t* o = out + ((unsigned)row * (unsigned)ld + (unsigned)(pn * 256 + cl8));
        const u32x2 pa0 = pack4(a0 * rsc), pa1 = pack4(a1 * rsc), pb0 = pack4(b0 * rsc), pb1 = pack4(b1 * rsc);
        *(u32x4*)o = (u32x4){pa0.x, pa0.y, pa1.x, pa1.y}; *(u32x4*)(o + 128) = (u32x4){pb0.x, pb0.y, pb1.x, pb1.y};
    }
    DEVI void quad(int row, int pn, int cl, f32x4 v0, f32x4 v1, float rsc) const {
        v0 *= rsc; v1 *= rsc;
        bf16_t* o = out + ((unsigned)row * (unsigned)ld + (unsigned)(pn * 256 + cl));
        *(u32x2*)o = pack4(v0); *(u32x2*)(o + 128) = pack4(v1);
    }
};
DEVI float dpp_shr(float v, const int n) {
    const int x = __float_as_int(v);
    return __int_as_float(n == 1 ? __builtin_amdgcn_update_dpp(x, x, 0x111, 0xf, 0xf, false) : __builtin_amdgcn_update_dpp(x, x, 0x112, 0xf, 0xf, false));
}
struct QFfn {
    static constexpr bool NEEDS_RSTD = true;
    static constexpr bool PERM = true;
    bf16_t* y; bf16_t* big; const float* ss; const float* cw; const float* cb; const float* sbuf; float* outp; float* outs;
    DEVI void oct(int row, int pn, int cl8, f32x4 a0, f32x4 a1, f32x4 b0, f32x4 b1, float rsc) const {
        a0 *= rsc; a1 *= rsc; b0 *= rsc; b1 *= rsc;
        const int ch = pn * 128 + cl8, fr = row & 15;
        f32x4 p10, p11, p20, p21;
#pragma unroll
        for (int k = 0; k < 4; ++k) { p10[k] = dpp_shr(a0[k], 1); p11[k] = dpp_shr(a1[k], 1); p20[k] = dpp_shr(a0[k], 2); p21[k] = dpp_shr(a1[k], 2); }
        if (fr >= 2) {
            const f32x4 w00 = *(const f32x4*)(cw + ch), w01 = *(const f32x4*)(cw + ch + 4), w10 = *(const f32x4*)(cw + 3072 + ch), w11 = *(const f32x4*)(cw + 3072 + ch + 4);
            const f32x4 w20 = *(const f32x4*)(cw + 6144 + ch), w21 = *(const f32x4*)(cw + 6144 + ch + 4), c0 = *(const f32x4*)(cb + ch), c1 = *(const f32x4*)(cb + ch + 4);
            float o[8];
#pragma unroll
            for (int k = 0; k < 4; ++k) {
                o[k] = gelu_tanh(c0[k] + p20[k] * w00[k] + p10[k] * w10[k] + a0[k] * w20[k]) * b0[k];
                o[4 + k] = gelu_tanh(c1[k] + p21[k] * w01[k] + p11[k] * w11[k] + a1[k] * w21[k]) * b1[k];
            }
            u32x4 w; w.x = cvt_pk_bf16(o[0], o[1]); w.y = cvt_pk_bf16(o[2], o[3]); w.z = cvt_pk_bf16(o[4], o[5]); w.w = cvt_pk_bf16(o[6], o[7]);
            *(u32x4*)(y + ((unsigned)row * 3072u + (unsigned)ch)) = w;
        }
        if (fr < 2 || fr >= 14) {
            const u32x2 p0 = pack4(a0), p1 = pack4(a1);
            *(u32x4*)(big + ((unsigned)row * 6144u + (unsigned)ch)) = (u32x4){p0.x, p0.y, p1.x, p1.y};
            if (fr < 2) { const u32x2 g0 = pack4(b0), g1 = pack4(b1); *(u32x4*)(big + ((unsigned)row * 6144u + 3072u + (unsigned)ch)) = (u32x4){g0.x, g0.y, g1.x, g1.y}; }
            else if ((row & 2047) >= 2046) { float* q = outp + ((size_t)(row >> 11) * 2 + ((row & 2047) - 2046)) * 3072 + ch; *(f32x4*)q = a0; *(f32x4*)(q + 4) = a1; }
        }
    }
    DEVI void quad(int row, int pn, int cl, f32x4 v0, f32x4 v1, float rsc) const {
        v0 *= rsc; v1 *= rsc;
        const int ch = pn * 128 + cl, sb = row - PR;
        const float* b0 = sbuf + ((size_t)sb * 2) * 3072 + ch;
        const f32x4 h2 = *(const f32x4*)b0, h1 = *(const f32x4*)(b0 + 3072);
        const f32x4 w0 = *(const f32x4*)(cw + ch), w1 = *(const f32x4*)(cw + 3072 + ch), w2 = *(const f32x4*)(cw + 6144 + ch), c = *(const f32x4*)(cb + ch);
        float* q = outs + ((size_t)sb * 2) * 3072 + ch;
        *(f32x4*)q = h1; *(f32x4*)(q + 3072) = v0;
        f32x4 o;
#pragma unroll
        for (int k = 0; k < 4; ++k) o[k] = gelu_tanh(c[k] + h2[k] * w0[k] + h1[k] * w1[k] + v0[k] * w2[k]) * v1[k];
        *(u32x2*)(y + ((unsigned)row * 3072u + (unsigned)ch)) = pack4(o);
    }
};
struct QMemKV {
    static constexpr bool PERM = false;
    static constexpr bool NEEDS_RSTD = false;
    float* outk; float* outv; bf16_t* mk; bf16_t* mvt;
    DEVI void quad(int row, int pn, int cl, f32x4 v0, f32x4 v1, float rsc) const {
        if (pn < 4) {
            const size_t o = (size_t)row * 1024 + pn * 256 + cl;
            __builtin_nontemporal_store(v0, (f32x4*)(outk + o)); __builtin_nontemporal_store(v1, (f32x4*)(outk + o + 128));
            *(u32x2*)(mk + o) = pack4(v0); *(u32x2*)(mk + o + 128) = pack4(v1);
        } else {
            const int h = pn - 4; const size_t o = (size_t)row * 1024 + h * 256 + cl;
            __builtin_nontemporal_store(v0, (f32x4*)(outv + o)); __builtin_nontemporal_store(v1, (f32x4*)(outv + o + 128));
            const int b = row >> 8, m = row & 255;
            bf16_t* q = mvt + ((size_t)(b * 4 + h) * 256 + cl) * 256 + m;
#pragma unroll
            for (int r = 0; r < 4; ++r) { q[r * 256] = f2bf(v0[r]); q[(128 + r) * 256] = f2bf(v1[r]); }
        }
    }
};
struct QLru {
    static constexpr bool PERM = false;
    static constexpr bool NEEDS_RSTD = false;
    const float* ba; const float* bx; const float* lam; const bf16_t* xc; float* aa; float* uu;
    const float* h0; float* hout; const bf16_t* big; bf16_t* yl;
    DEVI void quad(int row, int pn, int cl, f32x4 v0, f32x4 v1, float rsc) const {
        const int ch = (pn >> 1) * 256 + (pn & 1) * 128 + cl;
        const f32x4 ba4 = *(const f32x4*)(ba + ch), bx4 = *(const f32x4*)(bx + ch), lm4 = *(const f32x4*)(lam + ch);
        const u32x2 xp = *(const u32x2*)(xc + (size_t)row * 1024 + ch);
        const float xv[4] = {bflo(xp.x), bfhi(xp.x), bflo(xp.y), bfhi(xp.y)};
        f32x4 a4, u4;
#pragma unroll
        for (int r = 0; r < 4; ++r) {
            const float rr = sigmoidf_(v0[r] + ba4[r]), ii = sigmoidf_(v1[r] + bx4[r]);
            const float la = 8.f * rr * lm4[r];
            const float av = exp_(la);
            a4[r] = av; u4[r] = __builtin_amdgcn_sqrtf(fmaxf(1.f - av * av, 0.f)) * (ii * xv[r]);
        }
        if (row < PR) { *(f32x4*)(aa + (size_t)row * 1024 + ch) = a4; *(f32x4*)(uu + (size_t)row * 1024 + ch) = u4; }
        else {
            const int sb = row - PR;
            const f32x4 hp = *(const f32x4*)(h0 + (size_t)sb * 1024 + ch);
            const f32x4 hn = a4 * hp + u4;
            *(f32x4*)(hout + (size_t)sb * 1024 + ch) = hn;
            const u32x2 gp = *(const u32x2*)(big + (size_t)row * 2048 + 1024 + ch);
            f32x4 y; y[0] = gelu_tanh(bflo(gp.x)) * hn[0]; y[1] = gelu_tanh(bfhi(gp.x)) * hn[1]; y[2] = gelu_tanh(bflo(gp.y)) * hn[2]; y[3] = gelu_tanh(bfhi(gp.y)) * hn[3];
            *(u32x2*)(yl + (size_t)row * 1024 + ch) = pack4(y);
        }
    }
};

template <bool F32OUT>
DEVI void norm_phase(const float* srcP, const float* srcS, const float* gain, bf16_t* dstb, float* dstP, float* dstS, int nrows) {
    const int tid = tid_(); const int lane = tid & 63, wave = bid_() * 8 + (tid >> 6), nw = nblk_() * 8;
    f32x4 g[4];
#pragma unroll
    for (int i = 0; i < 4; ++i) g[i] = *(const f32x4*)(gain + i * 256 + lane * 4);
    for (int r0 = wave; r0 < nrows; r0 += 2 * nw) {
        f32x4 v[2][4]; float ss[2];
#pragma unroll
        for (int u = 0; u < 2; ++u) {
            const int r = r0 + u * nw < nrows ? r0 + u * nw : r0;
            const float* s = r < PR ? srcP + (size_t)r * 1024 : srcS + (size_t)(r - PR) * 1024;
#pragma unroll
            for (int i = 0; i < 4; ++i) v[u][i] = *(const f32x4*)(s + i * 256 + lane * 4);
        }
#pragma unroll
        for (int u = 0; u < 2; ++u) {
            float q = 0.f;
#pragma unroll
            for (int i = 0; i < 4; ++i) q += v[u][i][0] * v[u][i][0] + v[u][i][1] * v[u][i][1] + v[u][i][2] * v[u][i][2] + v[u][i][3] * v[u][i][3];
            ss[u] = q;
        }
#pragma unroll
        for (int o = 32; o; o >>= 1) { ss[0] += shx(ss[0], o, lane); ss[1] += shx(ss[1], o, lane); }
#pragma unroll
        for (int u = 0; u < 2; ++u) {
            const int r = r0 + u * nw;
            if (r < nrows) {
                const float rs = __builtin_amdgcn_rsqf(__fadd_rn(__fmul_rn(ss[u], 1.f / 1024.f), 1e-6f));
                if (F32OUT) {
                    float* d = r < PR ? dstP + (size_t)r * 1024 : dstS + (size_t)(r - PR) * 1024;
#pragma unroll
                    for (int i = 0; i < 4; ++i) __builtin_nontemporal_store(v[u][i] * rs * g[i], (f32x4*)(d + i * 256 + lane * 4));
                } else {
                    bf16_t* d = dstb + (size_t)r * 1024;
#pragma unroll
                    for (int i = 0; i < 4; ++i) *(u32x2*)(d + i * 256 + lane * 4) = pack4(v[u][i] * rs * g[i]);
                }
            }
        }
    }
}

DEVI void cast_ss_phase(const float* srcP, const float* srcS, bf16_t* xb, float* ss) {
    const int tid = tid_(); const int lane = tid & 63, wave = bid_() * 8 + (tid >> 6), nw = nblk_() * 8;
    for (int r = wave; r < TR; r += nw) {
        const float* s = r < PR ? srcP + (size_t)r * 1024 : srcS + (size_t)(r - PR) * 1024;
        f32x4 v[4]; float q = 0.f;
#pragma unroll
        for (int i = 0; i < 4; ++i) { v[i] = *(const f32x4*)(s + i * 256 + lane * 4); q += v[i][0] * v[i][0] + v[i][1] * v[i][1] + v[i][2] * v[i][2] + v[i][3] * v[i][3]; }
        q = wave_sum(q, lane);
#pragma unroll
        for (int i = 0; i < 4; ++i) *(u32x2*)(xb + (size_t)r * 1024 + i * 256 + lane * 4) = pack4(v[i]);
        if (lane < 32) ss[(size_t)r * 32 + lane] = lane == 0 ? q : 0.f;
    }
}

DEVI void transpose_phase(LAS unsigned char* lds, const Params& p) {
    LAS float* tile = (LAS float*)lds;
    const int tid = tid_();
    const int kk = tid >> 4, nq = tid & 15, n = tid >> 3, kq = tid & 7;
    const int nb = nblk_(), b0 = bid_();
    f32x4 v[2]; float gk[2]; bf16_t* cdst = nullptr; int cK = 0;
    bool have = false;
    int j = 0;
    for (int step = 0;; ++step) {
        const int tl = b0 + step * nb;
        const bool doload = tl < p.ntiles;
        if (have) {
#pragma unroll
            for (int i = 0; i < 2; ++i)
#pragma unroll
                for (int c = 0; c < 4; ++c) tile[(kk + 32 * i) * 65 + nq * 4 + c] = v[i][c] * gk[i];
            __syncthreads();
        }
        f32x4 nv[2] = {v[0], v[1]}; float ngk[2] = {1.f, 1.f}; bf16_t* ndst = nullptr; int nK = 0;
        if (doload) {
            while (j + 1 < NJOBS && p.jobs[j + 1].tile0 <= tl) ++j;
            const TJob jb = p.jobs[j];
            const int lt = tl - jb.tile0, ntn = jb.N >> 6, tk = lt / ntn, tn = lt - tk * ntn, k0 = tk * 64, n0 = tn * 64;
#pragma unroll
            for (int i = 0; i < 2; ++i) {
                nv[i] = __builtin_nontemporal_load((const f32x4*)(jb.src + (size_t)(k0 + kk + 32 * i) * jb.ld + n0 + nq * 4));
                ngk[i] = jb.gain ? jb.gain[k0 + kk + 32 * i] : 1.f;
            }
            ndst = jb.dst + (size_t)n0 * jb.K + k0; nK = jb.K;
        }
        if (have) {
            float f[8];
#pragma unroll
            for (int c = 0; c < 8; ++c) f[c] = tile[(kq * 8 + c) * 65 + n];
            u32x4 o; o.x = cvt_pk_bf16(f[0], f[1]); o.y = cvt_pk_bf16(f[2], f[3]); o.z = cvt_pk_bf16(f[4], f[5]); o.w = cvt_pk_bf16(f[6], f[7]);
            *(u32x4*)(cdst + (size_t)n * cK + kq * 8) = o;
            __syncthreads();
        }
        if (!doload) break;
        v[0] = nv[0]; v[1] = nv[1]; gk[0] = ngk[0]; gk[1] = ngk[1]; cdst = ndst; cK = nK; have = true;
    }
}

DEVI void rot_phase(float* rc, float* rs, double c1) {
    const int gt = bid_() * 512 + tid_(), ng = nblk_() * 512;
    for (int i = gt; i < 2049 * 128; i += ng) {
        const int pi = i >> 7, j = i & 127;
        double inv = 1.0, bb = c1; int e = j;
        while (e) { if (e & 1) inv *= bb; bb *= bb; e >>= 1; }
        const double pos = pi == 2048 ? 16384.0 : (double)pi;
        const double ang = pos * inv;
        const double rev = ang * 0.15915494309189534561;
        const float fr_ = (float)(rev - rint(rev));
        rs[i] = __builtin_amdgcn_sinf(fr_);
        rc[i] = __builtin_amdgcn_cosf(fr_);
    }
}

DEVI void dec_phase(float* dec) { for (int i = bid_() * 512 + tid_(); i < 1024; i += nblk_() * 512) { const int r = i >> 7, t = i & 127, h = r & 3; const float l2g = __builtin_amdgcn_logf(1.f - 1.f / (float)(32 << h)); dec[i] = r < 4 ? ex2_(l2g * (float)t) : 0.0625f * ex2_(-l2g * (float)t); } }
DEVI void lsg_phase(const float* lam, float* lsg) { for (int i = bid_() * 512 + tid_(); i < 1024; i += nblk_() * 512) { const float e = exp_(-lam[i]); const float ser = e * (1.f - e * (0.5f - e * (0.33333333f - e * (0.25f - e * 0.2f)))); lsg[i] = e < 0.03f ? -ser : -0.69314718056f * __builtin_amdgcn_logf(1.f + e); } }

DEVI void gate_phase(const bf16_t* o, const bf16_t* big, bf16_t* og) {
    const int tid = tid_(); const int lane = tid & 63, wave = bid_() * 8 + (tid >> 6), nw = nblk_() * 8;
    for (int it0 = wave; it0 < TR * 4; it0 += 4 * nw) {
        u32x4 ov[4], gv[4];
#pragma unroll
        for (int u = 0; u < 4; ++u) {
            const int it = it0 + u * nw < TR * 4 ? it0 + u * nw : it0;
            const int row = it >> 2, h = it & 3;
            ov[u] = *(const u32x4*)(o + (size_t)row * 2048 + h * 512 + lane * 8);
            gv[u] = *(const u32x4*)(big + (size_t)row * 6144 + 4096 + h * 512 + lane * 8);
        }
#pragma unroll
        for (int u = 0; u < 4; ++u) {
            const int it = it0 + u * nw;
            const int row = it >> 2, h = it & 3;
            float of[8], gf[8];
            of[0] = bflo(ov[u].x); of[1] = bfhi(ov[u].x); of[2] = bflo(ov[u].y); of[3] = bfhi(ov[u].y); of[4] = bflo(ov[u].z); of[5] = bfhi(ov[u].z); of[6] = bflo(ov[u].w); of[7] = bfhi(ov[u].w);
            gf[0] = bflo(gv[u].x); gf[1] = bfhi(gv[u].x); gf[2] = bflo(gv[u].y); gf[3] = bfhi(gv[u].y); gf[4] = bflo(gv[u].z); gf[5] = bfhi(gv[u].z); gf[6] = bflo(gv[u].w); gf[7] = bfhi(gv[u].w);
            float ss = 0.f;
#pragma unroll
            for (int c = 0; c < 8; ++c) ss += of[c] * of[c];
            ss = wave_sum(ss, lane);
            const float rs = __builtin_amdgcn_rsqf(__fadd_rn(__fmul_rn(ss, 1.f / 512.f), 1e-6f));
            float y[8];
#pragma unroll
            for (int c = 0; c < 8; ++c) y[c] = gf[c] * sigmoidf_(gf[c]) * of[c] * rs;
            u32x4 w; w.x = cvt_pk_bf16(y[0], y[1]); w.y = cvt_pk_bf16(y[2], y[3]); w.z = cvt_pk_bf16(y[4], y[5]); w.w = cvt_pk_bf16(y[6], y[7]);
            if (it < TR * 4) *(u32x4*)(og + (size_t)row * 2048 + h * 512 + lane * 8) = w;
        }
    }
}

DEVI void unpack8(u32x4 v, float* f) { f[0] = bflo(v.x); f[1] = bfhi(v.x); f[2] = bflo(v.y); f[3] = bfhi(v.y); f[4] = bflo(v.z); f[5] = bfhi(v.z); f[6] = bflo(v.w); f[7] = bfhi(v.w); }

DEVI void ffn_gate_phase(const bf16_t* big, bf16_t* y, const float* cw, const float* cb, const float* sbuf  , float* outp  , float* outs  ) {
    const int gt = bid_() * 512 + tid_(), ng = nblk_() * 512;
    for (int it = gt; it < 256 * 384 + SR * 384; it += ng) {
        const bool smp = it >= 256 * 384;
        const int li = smp ? it - 256 * 384 : it;
        const int seg = li / 384, c = (li - seg * 384) * 8;
        float w0[8], w1[8], w2[8], bb[8];
#pragma unroll
        for (int k = 0; k < 8; k += 4) {
            const f32x4 a0 = *(const f32x4*)(cw + c + k), a1 = *(const f32x4*)(cw + 3072 + c + k), a2 = *(const f32x4*)(cw + 6144 + c + k), a3 = *(const f32x4*)(cb + c + k);
#pragma unroll
            for (int j = 0; j < 4; ++j) { w0[k + j] = a0[j]; w1[k + j] = a1[j]; w2[k + j] = a2[j]; bb[k + j] = a3[j]; }
        }
        float u1[8], u2[8];
        if (!smp) {
            const int row0 = seg * 64, t0 = row0 & 2047;
            if (t0 > 0) { unpack8(*(const u32x4*)(big + (size_t)(row0 - 1) * 6144 + c), u1); unpack8(*(const u32x4*)(big + (size_t)(row0 - 2) * 6144 + c), u2); }
            else {
#pragma unroll
                for (int k = 0; k < 8; ++k) { u1[k] = 0.f; u2[k] = 0.f; }
            }
#pragma unroll 8
            for (int r = 0; r < 64; ++r) {
                const size_t row = (size_t)row0 + r;
                float u0[8], gg[8], o[8];
                unpack8(*(const u32x4*)(big + row * 6144 + c), u0);
                unpack8(*(const u32x4*)(big + row * 6144 + 3072 + c), gg);
#pragma unroll
                for (int k = 0; k < 8; ++k) { const float uc = bb[k] + u2[k] * w0[k] + u1[k] * w1[k] + u0[k] * w2[k]; o[k] = gelu_tanh(uc) * gg[k]; }
                u32x4 w; w.x = cvt_pk_bf16(o[0], o[1]); w.y = cvt_pk_bf16(o[2], o[3]); w.z = cvt_pk_bf16(o[4], o[5]); w.w = cvt_pk_bf16(o[6], o[7]);
                *(u32x4*)(y + row * 3072 + c) = w;
                if (t0 + r >= 2046) { float* q = outp + ((size_t)(row >> 11) * 2 + (t0 + r - 2046)) * 3072 + c; *(f32x4*)q = (f32x4){u0[0], u0[1], u0[2], u0[3]}; *(f32x4*)(q + 4) = (f32x4){u0[4], u0[5], u0[6], u0[7]}; }
#pragma unroll
                for (int k = 0; k < 8; ++k) { u2[k] = u1[k]; u1[k] = u0[k]; }
            }
        } else {
            const int sb = seg; const size_t row = (size_t)PR + sb;
            float u0[8], gg[8], o[8];
            unpack8(*(const u32x4*)(big + row * 6144 + c), u0);
            unpack8(*(const u32x4*)(big + row * 6144 + 3072 + c), gg);
            const float* b0 = sbuf + ((size_t)sb * 2 + 0) * 3072 + c; const float* b1 = b0 + 3072;
            const f32x4 p0 = *(const f32x4*)b0, p1 = *(const f32x4*)(b0 + 4), q0 = *(const f32x4*)b1, q1 = *(const f32x4*)(b1 + 4);
#pragma unroll
            for (int k = 0; k < 4; ++k) { u2[k] = p0[k]; u2[4 + k] = p1[k]; u1[k] = q0[k]; u1[4 + k] = q1[k]; }
            float* q = outs + ((size_t)sb * 2) * 3072 + c;
            *(f32x4*)q = q0; *(f32x4*)(q + 4) = q1;
            *(f32x4*)(q + 3072) = (f32x4){u0[0], u0[1], u0[2], u0[3]}; *(f32x4*)(q + 3072 + 4) = (f32x4){u0[4], u0[5], u0[6], u0[7]};
#pragma unroll
            for (int k = 0; k < 8; ++k) { const float uc = bb[k] + u2[k] * w0[k] + u1[k] * w1[k] + u0[k] * w2[k]; o[k] = gelu_tanh(uc) * gg[k]; }
            u32x4 w; w.x = cvt_pk_bf16(o[0], o[1]); w.y = cvt_pk_bf16(o[2], o[3]); w.z = cvt_pk_bf16(o[4], o[5]); w.w = cvt_pk_bf16(o[6], o[7]);
            *(u32x4*)(y + row * 3072 + c) = w;
        }
    }
}

DEVI void ffn_fix_phase(const bf16_t* big, bf16_t* y, const float* cw, const float* cb) {
    const int gt = bid_() * 512 + tid_(), ng = nblk_() * 512;
    for (int it = gt; it < 2048 * 384; it += ng) {
        const int ri = it / 384, c = (it - ri * 384) * 8;
        const int row = (ri >> 1) * 16 + (ri & 1), t = row & 2047;
        float u0[8], u1[8], u2[8], gg[8];
        unpack8(*(const u32x4*)(big + (size_t)row * 6144 + c), u0);
        unpack8(*(const u32x4*)(big + (size_t)row * 6144 + 3072 + c), gg);
        unpack8(*(const u32x4*)(big + (size_t)(t >= 1 ? row - 1 : row) * 6144 + c), u1);
        unpack8(*(const u32x4*)(big + (size_t)(t >= 2 ? row - 2 : row) * 6144 + c), u2);
#pragma unroll
        for (int k = 0; k < 8; ++k) { u1[k] = t >= 1 ? u1[k] : 0.f; u2[k] = t >= 2 ? u2[k] : 0.f; }
        float r[8];
#pragma unroll
        for (int k = 0; k < 8; ++k) {
            const float uc = cb[c + k] + u2[k] * cw[c + k] + u1[k] * cw[3072 + c + k] + u0[k] * cw[6144 + c + k];
            r[k] = gelu_tanh(uc) * gg[k];
        }
        u32x4 w; w.x = cvt_pk_bf16(r[0], r[1]); w.y = cvt_pk_bf16(r[2], r[3]); w.z = cvt_pk_bf16(r[4], r[5]); w.w = cvt_pk_bf16(r[6], r[7]);
        *(u32x4*)(y + (size_t)row * 3072 + c) = w;
    }
}

DEVI void lru_conv_phase(const bf16_t* big, bf16_t* xc, const float* cw, const float* cb, const float* sbuf  , float* outp  , float* outs  ) {
    const int gt = bid_() * 512 + tid_(), ng = nblk_() * 512;
    for (int it = gt; it < 1024 * 128 + SR * 128; it += ng) {
        const bool smp = it >= 1024 * 128;
        const int li = smp ? it - 1024 * 128 : it;
        const int seg = li >> 7, c = (li & 127) * 8;
        float w0[8], w1[8], w2[8], w3[8], bb[8];
#pragma unroll
        for (int k = 0; k < 8; k += 4) {
            const f32x4 a0 = *(const f32x4*)(cw + c + k), a1 = *(const f32x4*)(cw + 1024 + c + k), a2 = *(const f32x4*)(cw + 2048 + c + k), a3 = *(const f32x4*)(cw + 3072 + c + k), a4 = *(const f32x4*)(cb + c + k);
#pragma unroll
            for (int j = 0; j < 4; ++j) { w0[k + j] = a0[j]; w1[k + j] = a1[j]; w2[k + j] = a2[j]; w3[k + j] = a3[j]; bb[k + j] = a4[j]; }
        }
        if (!smp) {
            const int row0 = seg * 16, t0 = row0 & 2047;
            u32x4 raw[19];
#pragma unroll
            for (int r = 0; r < 19; ++r) {
                const int rr = (t0 == 0 && r < 3) ? row0 : row0 - 3 + r;
                raw[r] = *(const u32x4*)(big + (size_t)rr * 2048 + c);
            }
            float x1[8], x2[8], x3[8];
            if (t0 > 0) { unpack8(raw[0], x3); unpack8(raw[1], x2); unpack8(raw[2], x1); }
            else {
#pragma unroll
                for (int k = 0; k < 8; ++k) { x1[k] = 0.f; x2[k] = 0.f; x3[k] = 0.f; }
            }
#pragma unroll
            for (int r = 0; r < 16; ++r) {
                const size_t row = (size_t)row0 + r;
                float x0[8], o[8];
                unpack8(raw[3 + r], x0);
#pragma unroll
                for (int k = 0; k < 8; ++k) o[k] = bb[k] + x3[k] * w0[k] + x2[k] * w1[k] + x1[k] * w2[k] + x0[k] * w3[k];
                u32x4 w; w.x = cvt_pk_bf16(o[0], o[1]); w.y = cvt_pk_bf16(o[2], o[3]); w.z = cvt_pk_bf16(o[4], o[5]); w.w = cvt_pk_bf16(o[6], o[7]);
                *(u32x4*)(xc + row * 1024 + c) = w;
                if (t0 + r >= 2045) { float* q = outp + ((size_t)(row >> 11) * 3 + (t0 + r - 2045)) * 1024 + c; *(f32x4*)q = (f32x4){x0[0], x0[1], x0[2], x0[3]}; *(f32x4*)(q + 4) = (f32x4){x0[4], x0[5], x0[6], x0[7]}; }
#pragma unroll
                for (int k = 0; k < 8; ++k) { x3[k] = x2[k]; x2[k] = x1[k]; x1[k] = x0[k]; }
            }
        } else {
            const int sb = seg; const size_t row = (size_t)PR + sb;
            float x0[8], x1[8], x2[8], x3[8], o[8];
            unpack8(*(const u32x4*)(big + row * 2048 + c), x0);
            const float* b0 = sbuf + (size_t)sb * 3 * 1024 + c;
            float* q = outs + (size_t)sb * 3 * 1024 + c;
#pragma unroll
            for (int k = 0; k < 8; k += 4) {
                const f32x4 p3 = *(const f32x4*)(b0 + k), p2 = *(const f32x4*)(b0 + 1024 + k), p1 = *(const f32x4*)(b0 + 2048 + k);
#pragma unroll
                for (int j = 0; j < 4; ++j) { x3[k + j] = p3[j]; x2[k + j] = p2[j]; x1[k + j] = p1[j]; }
                *(f32x4*)(q + k) = p2; *(f32x4*)(q + 1024 + k) = p1; *(f32x4*)(q + 2048 + k) = (f32x4){x0[k], x0[k + 1], x0[k + 2], x0[k + 3]};
            }
#pragma unroll
            for (int k = 0; k < 8; ++k) o[k] = bb[k] + x3[k] * w0[k] + x2[k] * w1[k] + x1[k] * w2[k] + x0[k] * w3[k];
            u32x4 w; w.x = cvt_pk_bf16(o[0], o[1]); w.y = cvt_pk_bf16(o[2], o[3]); w.z = cvt_pk_bf16(o[4], o[5]); w.w = cvt_pk_bf16(o[6], o[7]);
            *(u32x4*)(xc + row * 1024 + c) = w;
        }
    }
}

DEVI void scan1_phase(const float* aa, const float* uu, float* chs  ) {
    const int gt = bid_() * 512 + tid_(), ng = nblk_() * 512;
    for (int it = gt; it < 8 * 64 * 256; it += ng) {
        const int c = (it & 255) * 4, ck = (it >> 8) & 63, b = it >> 14;
        const size_t base = ((size_t)b * 2048 + ck * 32) * 1024 + c;
        f32x4 ap = (f32x4){1.f, 1.f, 1.f, 1.f}, h = (f32x4){0.f, 0.f, 0.f, 0.f};
#pragma unroll 8
        for (int t = 0; t < 32; ++t) { const f32x4 a = *(const f32x4*)(aa + base + (size_t)t * 1024), u = *(const f32x4*)(uu + base + (size_t)t * 1024); h = a * h + u; ap *= a; }
        float* o = chs + ((size_t)(b * 64 + ck) * 1024 + c) * 2;
        *(f32x4*)o = (f32x4){ap[0], h[0], ap[1], h[1]}; *(f32x4*)(o + 4) = (f32x4){ap[2], h[2], ap[3], h[3]};
    }
}
DEVI void scan2_phase(const float* aa, const float* uu, const float* chs, const bf16_t* big, bf16_t* yl, float* hout  ) {
    const int gt = bid_() * 512 + tid_(), ng = nblk_() * 512;
    for (int it = gt; it < 8 * 64 * 256; it += ng) {
        const int c = (it & 255) * 4, ck = (it >> 8) & 63, b = it >> 14;
        f32x4 h = (f32x4){0.f, 0.f, 0.f, 0.f};
        for (int k = 0; k < ck; ++k) {
            const float* ci = chs + ((size_t)(b * 64 + k) * 1024 + c) * 2;
            const f32x4 p0 = *(const f32x4*)ci, p1 = *(const f32x4*)(ci + 4);
            h[0] = p0[0] * h[0] + p0[1]; h[1] = p0[2] * h[1] + p0[3]; h[2] = p1[0] * h[2] + p1[1]; h[3] = p1[2] * h[3] + p1[3];
        }
        const size_t row0 = (size_t)b * 2048 + ck * 32;
#pragma unroll 8
        for (int t = 0; t < 32; ++t) {
            const size_t row = row0 + t;
            h = *(const f32x4*)(aa + row * 1024 + c) * h + *(const f32x4*)(uu + row * 1024 + c);
            const u32x2 gp = *(const u32x2*)(big + row * 2048 + 1024 + c);
            f32x4 y; y[0] = gelu_tanh(bflo(gp.x)) * h[0]; y[1] = gelu_tanh(bfhi(gp.x)) * h[1]; y[2] = gelu_tanh(bflo(gp.y)) * h[2]; y[3] = gelu_tanh(bfhi(gp.y)) * h[3];
            *(u32x2*)(yl + row * 1024 + c) = pack4(y);
        }
        if (ck == 63) *(f32x4*)(hout + b * 1024 + c) = h;
    }
}

DEVI void retention_prompt_phase(LAS unsigned char* lds, const bf16_t* big, const bf16_t* ktg, const bf16_t* vtg, bf16_t* og, float* sout  , const float* dec,
                                 const bool fuse, const float* sin_, float* sout_s) {
    constexpr int KS_STR = 528, VT_STR = 272, ST_STR = 528, AT_STR = 272;
    constexpr int KS_OFF = 0, VT_OFF = 128 * KS_STR, ST_OFF = VT_OFF + 64 * VT_STR, AT_OFF = ST_OFF + 64 * ST_STR;
    const int tid = tid_(), w = tid >> 6, lane = tid & 63, fr = lane & 15, fq = lane >> 4;
    LAS unsigned char* att = lds + AT_OFF + w * (16 * AT_STR);
    for (int it = bid_(); it < 256; it += nblk_()) {
        const int b = it >> 5, h = (it >> 3) & 3, es = it & 7;
        const float gam = 1.f - 1.f / (float)(32 << h), gam127 = dec[h * 128 + 127];
        f32x4 sacc[2][4];
#pragma unroll
        for (int a = 0; a < 2; ++a)
#pragma unroll
            for (int e = 0; e < 4; ++e) sacc[a][e] = (f32x4){0.f, 0.f, 0.f, 0.f};
        __syncthreads();
        { const unsigned z = zv_(); for (int i = tid; i < 64 * ST_STR / 16; i += 512) *(LAS u32x4*)(lds + ST_OFF + i * 16) = (u32x4){z, z, z, z}; }
        f32x4 o4s = (f32x4){0.f, 0.f, 0.f, 0.f};
        u32x4 pk[8], pv[2];
        {   const bf16_t* src = big + ((size_t)b * 2048 + (tid >> 5)) * 6144 + 1024 + h * 256 + (tid & 31) * 8;
#pragma unroll
            for (int i = 0; i < 8; ++i) pk[i] = *(const u32x4*)(src + (size_t)i * 16 * 6144);
            const bf16_t* vsrc = vtg + ((size_t)(b * 4 + h) * 512 + es * 64 + (tid >> 4)) * 2048 + (tid & 15) * 8;
#pragma unroll
            for (int i = 0; i < 2; ++i) pv[i] = *(const u32x4*)(vsrc + (size_t)i * 32 * 2048);
        }
        for (int n = 0; n < 16; ++n) {
            const size_t row0 = (size_t)b * 2048 + n * 128;
            __syncthreads();
            f32x4 sv[8]; size_t s_base = 0; int s_sb = 0, s_h = 0, s_eq = 0;
            if (fuse) {
                const int sit = it * 8 + (n >> 1);
                s_sb = sit >> 4; s_h = (sit >> 2) & 3; s_eq = sit & 3;
                s_base = ((size_t)(s_sb * 4 + s_h) * 256) * 512 + s_eq * 128 + (tid & 31) * 4 + (size_t)(8 * (tid >> 5) + 128 * (n & 1)) * 512;
#pragma unroll
                for (int i = 0; i < 8; ++i) sv[i] = __builtin_nontemporal_load((const f32x4*)(sin_ + s_base + (size_t)i * 512));
            }
            {
                LAS unsigned char* dst = lds + KS_OFF + (tid >> 5) * KS_STR + (tid & 31) * 16;
#pragma unroll
                for (int i = 0; i < 8; ++i) *(LAS u32x4*)(dst + i * 16 * KS_STR) = pk[i];
                LAS unsigned char* vdst = lds + VT_OFF + (tid >> 4) * VT_STR + (tid & 15) * 16;
#pragma unroll
                for (int i = 0; i < 2; ++i) *(LAS u32x4*)(vdst + i * 32 * VT_STR) = pv[i];
            }
            bf16x8 qf[8];
#pragma unroll
            for (int ks = 0; ks < 8; ++ks) qf[ks] = *(const bf16x8*)(big + (row0 + 16 * w + fr) * 6144 + h * 256 + ks * 32 + fq * 8);
            __syncthreads();
            {   const int nn = n + 1 < 16 ? n + 1 : n;
                const bf16_t* src = big + ((size_t)b * 2048 + nn * 128 + (tid >> 5)) * 6144 + 1024 + h * 256 + (tid & 31) * 8;
#pragma unroll
                for (int i = 0; i < 8; ++i) pk[i] = *(const u32x4*)(src + (size_t)i * 16 * 6144);
                const bf16_t* vsrc = vtg + ((size_t)(b * 4 + h) * 512 + es * 64 + (tid >> 4)) * 2048 + nn * 128 + (tid & 15) * 8;
#pragma unroll
                for (int i = 0; i < 2; ++i) pv[i] = *(const u32x4*)(vsrc + (size_t)i * 32 * 2048);
            }
            for (int jt = 0; jt <= w; ++jt) {
                f32x4 acc = (f32x4){0.f, 0.f, 0.f, 0.f};
#pragma unroll
                for (int ks = 0; ks < 8; ++ks) {
                    const bf16x8 kf = *(const LAS bf16x8*)(lds + KS_OFF + (jt * 16 + fr) * KS_STR + ks * 64 + fq * 16);
                    acc = mfma16(kf, qf[ks], acc);
                }
                if (jt == w) {
#pragma unroll
                    for (int r = 0; r < 4; ++r) if (fq * 4 + r > fr) acc[r] = 0.f;
                }
                *(LAS u32x2*)(att + fr * AT_STR + (jt * 16 + fq * 4) * 2) = pack4(acc);
            }
            if ((w & 1) == 0) { const unsigned z = zv_(); *(LAS u32x2*)(att + fr * AT_STR + ((w + 1) * 16 + fq * 4) * 2) = (u32x2){z, z}; }
            __builtin_amdgcn_fence(__ATOMIC_SEQ_CST, "wavefront"); asm volatile("s_waitcnt lgkmcnt(0)" ::: "memory"); __builtin_amdgcn_wave_barrier();
#pragma unroll
            for (int et = 0; et < 4; ++et) {
                f32x4 ao = (f32x4){0.f, 0.f, 0.f, 0.f}, ac = (f32x4){0.f, 0.f, 0.f, 0.f};
                for (int js = 0; js <= (w >> 1); ++js) {
                    const bf16x8 af = *(const LAS bf16x8*)(att + fr * AT_STR + js * 64 + fq * 16);
                    const bf16x8 vf = *(const LAS bf16x8*)(lds + VT_OFF + (et * 16 + fr) * VT_STR + js * 64 + fq * 16);
                    ao = mfma16(vf, af, ao);
                }
#pragma unroll
                for (int ks = 0; ks < 8; ++ks) {
                    const bf16x8 sf = *(const LAS bf16x8*)(lds + ST_OFF + (et * 16 + fr) * ST_STR + ks * 64 + fq * 16);
                    ac = mfma16(sf, qf[ks], ac);
                }
                const f32x4 o = ao + ac * gam;
                *(u32x2*)(og + (row0 + 16 * w + fr) * 2048 + h * 512 + es * 64 + et * 16 + fq * 4) = pack4(o);
            }
#pragma unroll
            for (int a = 0; a < 2; ++a)
#pragma unroll
                for (int e = 0; e < 4; ++e) sacc[a][e] *= gam;
#pragma unroll
            for (int js = 0; js < 4; ++js) {
                bf16x8 kf[2];
#pragma unroll
                for (int a = 0; a < 2; ++a) kf[a] = *(const bf16x8*)(ktg + ((size_t)(b * 4 + h) * 256 + 32 * w + a * 16 + fr) * 2048 + n * 128 + js * 32 + fq * 8);
#pragma unroll
                for (int e = 0; e < 4; ++e) {
                    const bf16x8 vf = *(const LAS bf16x8*)(lds + VT_OFF + (e * 16 + fr) * VT_STR + js * 64 + fq * 16);
#pragma unroll
                    for (int a = 0; a < 2; ++a) sacc[a][e] = mfma16(kf[a], vf, sacc[a][e]);
                }
            }
#pragma unroll
            for (int a = 0; a < 2; ++a)
#pragma unroll
                for (int e = 0; e < 4; ++e) sacc[a][e] *= gam127;
            if (fuse) {
                const size_t srow = (size_t)PR + s_sb;
                const bf16_t* qp = big + srow * 6144 + s_h * 256 + 8 * (tid >> 5) + 128 * (n & 1);
                float qd8[8], kd8[8];
                unpack8(*(const u32x4*)qp, qd8); unpack8(*(const u32x4*)(qp + 1024), kd8);
                const u32x2 vp = *(const u32x2*)(big + srow * 6144 + 2048 + s_h * 512 + s_eq * 128 + (tid & 31) * 4);
                const f32x4 v4 = (f32x4){bflo(vp.x), bfhi(vp.x), bflo(vp.y), bfhi(vp.y)};
                const float sgam = 1.f - 1.f / (float)(32 << s_h);
                if ((n & 1) == 0) o4s = (f32x4){0.f, 0.f, 0.f, 0.f};
#pragma unroll
                for (int i = 0; i < 8; ++i) {
                    const f32x4 sn = sv[i] * sgam + v4 * kd8[i];
                    __builtin_nontemporal_store(sn, (f32x4*)(sout_s + s_base + (size_t)i * 512));
                    o4s += sn * qd8[i];
                }
                if (n & 1) *(LAS f32x4*)(lds + 153616 + tid * 16) = o4s;
            }
            __syncthreads();
            if (fuse && (n & 1) && tid < 32) {
                f32x4 sm = *(const LAS f32x4*)(lds + 153616 + tid * 16);
#pragma unroll
                for (int k = 1; k < 16; ++k) sm += *(const LAS f32x4*)(lds + 153616 + (k * 32 + tid) * 16);
                *(u32x2*)(og + ((size_t)PR + s_sb) * 2048 + s_h * 512 + s_eq * 128 + tid * 4) = pack4(sm);
            }
#pragma unroll
            for (int a = 0; a < 2; ++a)
#pragma unroll
                for (int e = 0; e < 4; ++e)
                    *(LAS u32x2*)(lds + ST_OFF + (e * 16 + fr) * ST_STR + (32 * w + a * 16 + fq * 4) * 2) = pack4(sacc[a][e]);
        }
#pragma unroll
        for (int a = 0; a < 2; ++a)
#pragma unroll
            for (int e = 0; e < 4; ++e)
#pragma unroll
                for (int r = 0; r < 4; ++r)
                    __builtin_nontemporal_store(sacc[a][e][r], sout + ((size_t)(b * 4 + h) * 256 + 32 * w + a * 16 + fq * 4 + r) * 512 + es * 64 + e * 16 + fr);
    }
}

DEVI void retention_sample_phase(LAS unsigned char* lds, const bf16_t* big, const float* sin_, float* sout, bf16_t* og) {
    const int tid = tid_(), ec = tid & 31, dr = tid >> 5;
    LAS float* red = (LAS float*)lds;
    for (int it = bid_(); it < 128 * 4 * 4; it += nblk_()) {
        const int sb = it >> 4, h = (it >> 2) & 3, eq = it & 3;
        const float gam = 1.f - 1.f / (float)(32 << h);
        const size_t row = (size_t)PR + sb;
        const bf16_t* qp = big + row * 6144 + h * 256;
        const bf16_t* kp = qp + 1024;
        const u32x2 vp = *(const u32x2*)(big + row * 6144 + 2048 + h * 512 + eq * 128 + ec * 4);
        const f32x4 v4 = (f32x4){bflo(vp.x), bfhi(vp.x), bflo(vp.y), bfhi(vp.y)};
        const size_t sbase = ((size_t)(sb * 4 + h) * 256) * 512 + eq * 128 + ec * 4;
        f32x4 o4 = (f32x4){0.f, 0.f, 0.f, 0.f};
#pragma unroll
        for (int i = 0; i < 16; ++i) {
            const int d = dr + 16 * i;
            const f32x4 s = *(const f32x4*)(sin_ + sbase + (size_t)d * 512);
            const float kd = bf2f(kp[d]), qd = bf2f(qp[d]);
            const f32x4 sn = s * gam + v4 * kd;
            *(f32x4*)(sout + sbase + (size_t)d * 512) = sn;
            o4 += sn * qd;
        }
        __syncthreads();
        *(LAS f32x4*)(red + (dr * 32 + ec) * 4) = o4;
        __syncthreads();
        if (tid < 32) {
            f32x4 s = (f32x4){0.f, 0.f, 0.f, 0.f};
#pragma unroll
            for (int k = 0; k < 16; ++k) s += *(const LAS f32x4*)(red + (k * 32 + tid) * 4);
            *(u32x2*)(og + row * 2048 + h * 512 + eq * 128 + tid * 4) = pack4(s);
        }
    }
}

DEVI void xattn_prompt_phase(LAS unsigned char* lds, const bf16_t* qx, const bf16_t* mk  , const bf16_t* mvt  , bf16_t* ao) {
    constexpr int STR = 528;
    const int tid = tid_(), w = tid >> 6, lane = tid & 63, fr = lane & 15, fq = lane >> 4;
    for (int it = bid_(); it < 512; it += nblk_()) {
        const int b = it >> 6, h = (it >> 4) & 3, qt = it & 15;
        const size_t row = (size_t)b * 2048 + qt * 128 + 16 * w + fr;
        __syncthreads();
        {   const int m0 = tid >> 5, dq = tid & 31;
            const bf16_t* src = mk + ((size_t)b * 256 + m0) * 1024 + h * 256 + dq * 8;
            LAS unsigned char* dst = lds + m0 * STR + dq * 16;
#pragma unroll
            for (int i = 0; i < 16; ++i) *(LAS u32x4*)(dst + i * 16 * STR) = *(const u32x4*)(src + (size_t)i * 16 * 1024);
        }
        bf16x8 qf[8];
#pragma unroll
        for (int ks = 0; ks < 8; ++ks) qf[ks] = *(const bf16x8*)(qx + row * 1024 + h * 256 + ks * 32 + fq * 8);
        __syncthreads();
        bf16x8 pf[8];
        float hmx[2], hsum[2];
        const float sc = 0.0625f * 1.4426950408889634f;
#pragma unroll
        for (int hf = 0; hf < 2; ++hf) {
            f32x4 s[8];
#pragma unroll
            for (int mt = 0; mt < 8; ++mt) {
                f32x4 acc = (f32x4){0.f, 0.f, 0.f, 0.f};
#pragma unroll
                for (int ks = 0; ks < 8; ++ks) {
                    const bf16x8 kf = *(const LAS bf16x8*)(lds + ((hf * 8 + mt) * 16 + fr) * STR + ks * 64 + fq * 16);
                    acc = mfma16(kf, qf[ks], acc);
                }
                s[mt] = acc;
                __builtin_amdgcn_sched_barrier(0);
            }
            float mx = -3.0e38f;
#pragma unroll
            for (int mt = 0; mt < 8; ++mt)
#pragma unroll
                for (int r = 0; r < 4; ++r) mx = fmaxf(mx, s[mt][r]);
            mx = fmaxf(mx, shx(mx, 16, lane)); mx = fmaxf(mx, shx(mx, 32, lane));
            float sum = 0.f;
#pragma unroll
            for (int mt = 0; mt < 8; ++mt)
#pragma unroll
                for (int r = 0; r < 4; ++r) { const float e = ex2_((s[mt][r] - mx) * sc); s[mt][r] = e; sum += e; }
            sum += shx(sum, 16, lane); sum += shx(sum, 32, lane);
            hmx[hf] = mx; hsum[hf] = sum;
#pragma unroll
            for (int ms = 0; ms < 4; ++ms) {
                u32x4 u; u.x = cvt_pk_bf16(s[2 * ms][0], s[2 * ms][1]); u.y = cvt_pk_bf16(s[2 * ms][2], s[2 * ms][3]);
                u.z = cvt_pk_bf16(s[2 * ms + 1][0], s[2 * ms + 1][1]); u.w = cvt_pk_bf16(s[2 * ms + 1][2], s[2 * ms + 1][3]);
                pf[hf * 4 + ms] = __builtin_bit_cast(bf16x8, u);
            }
        }
        const float mxa = fmaxf(hmx[0], hmx[1]);
        float al0 = ex2_((hmx[0] - mxa) * sc), al1 = ex2_((hmx[1] - mxa) * sc);
        const float inv = rcp_(hsum[0] * al0 + hsum[1] * al1);
        al0 *= inv; al1 *= inv;
        __syncthreads();
        {   const int d0 = tid >> 5, mq = tid & 31;
            const bf16_t* src = mvt + ((size_t)(b * 4 + h) * 256 + d0) * 256 + mq * 8;
            LAS unsigned char* dst = lds + d0 * STR + mq * 16;
#pragma unroll
            for (int i = 0; i < 16; ++i) *(LAS u32x4*)(dst + i * 16 * STR) = *(const u32x4*)(src + (size_t)i * 16 * 256);
        }
        __syncthreads();
#pragma unroll 2
        for (int dt = 0; dt < 16; ++dt) {
            f32x4 acc0 = (f32x4){0.f, 0.f, 0.f, 0.f}, acc1 = acc0;
#pragma unroll
            for (int ms = 0; ms < 8; ++ms) {
                const u32x2 lo = *(const LAS u32x2*)(lds + (dt * 16 + fr) * STR + (ms * 32 + fq * 4) * 2);
                const u32x2 hi = *(const LAS u32x2*)(lds + (dt * 16 + fr) * STR + (ms * 32 + 16 + fq * 4) * 2);
                u32x4 u; u.x = lo.x; u.y = lo.y; u.z = hi.x; u.w = hi.y;
                if (ms < 4) acc0 = mfma16(__builtin_bit_cast(bf16x8, u), pf[ms], acc0);
                else acc1 = mfma16(__builtin_bit_cast(bf16x8, u), pf[ms], acc1);
            }
            *(u32x2*)(ao + row * 1024 + h * 256 + dt * 16 + fq * 4) = pack4(acc0 * al0 + acc1 * al1);
        }
    }
}

DEVI void xattn_sample_phase(LAS unsigned char* lds, const bf16_t* qx, const float* ck, const float* cv, bf16_t* ao) {
    const int tid = tid_(), w = tid >> 6, lane = tid & 63;
    LAS float* sc = (LAS float*)lds;
    LAS float* red = (LAS float*)(lds + 2048);
    for (int it = bid_(); it < 512; it += nblk_()) {
        const int sb = it >> 2, h = it & 3;
        const size_t row = (size_t)PR + sb;
        const u32x2 qp = *(const u32x2*)(qx + row * 1024 + h * 256 + lane * 4);
        const f32x4 q4 = (f32x4){bflo(qp.x), bfhi(qp.x), bflo(qp.y), bfhi(qp.y)};
        const size_t base = ((size_t)sb * 256 * 4 + h) * 256 + lane * 4;
        __syncthreads();
#pragma unroll 16
        for (int i = 0; i < 32; ++i) {
            const int m = w + 8 * i;
            const f32x4 k4 = __builtin_nontemporal_load((const f32x4*)(ck + base + (size_t)m * 1024));
            float d = k4[0] * q4[0] + k4[1] * q4[1] + k4[2] * q4[2] + k4[3] * q4[3];
            d = wave_sum(d, lane);
            if (lane == 0) sc[m] = d * 0.0625f;
        }
        __syncthreads();
        float mx = -3.0e38f;
        for (int m = lane; m < 256; m += 64) mx = fmaxf(mx, sc[m]);
#pragma unroll
        for (int o = 32; o; o >>= 1) mx = fmaxf(mx, shx(mx, o, lane));
        float sum = 0.f;
        for (int m = lane; m < 256; m += 64) sum += exp_(sc[m] - mx);
        sum = wave_sum(sum, lane);
        const float inv = rcp_(sum);
        f32x4 o4 = (f32x4){0.f, 0.f, 0.f, 0.f};
#pragma unroll 16
        for (int i = 0; i < 32; ++i) {
            const int m = w + 8 * i;
            const float pm = exp_(sc[m] - mx) * inv;
            const f32x4 v4 = __builtin_nontemporal_load((const f32x4*)(cv + base + (size_t)m * 1024));
            o4 += v4 * pm;
        }
        *(LAS f32x4*)(red + (w * 64 + lane) * 4) = o4;
        __syncthreads();
        if (tid < 64) {
            f32x4 s = (f32x4){0.f, 0.f, 0.f, 0.f};
#pragma unroll
            for (int k = 0; k < 8; ++k) s += *(const LAS f32x4*)(red + (k * 64 + tid) * 4);
            *(u32x2*)(ao + row * 1024 + h * 256 + tid * 4) = pack4(s);
        }
    }
}

#define XB_TMO      128
#define XB_XCNT(j)  (256  + 64 * (j))
#define XB_XSUB(j)  (1280 + 64 * (j))
#define XB_XGEN(j)  (2304 + 64 * (j))
#define XB_TOP      3328
#define XB_TOPGEN   3392
#define XCD_BAR_WORDS 3456
#define XB_SPIN_CAP (1u << 18)
DEVI unsigned xb_ld(unsigned* p)              { return __hip_atomic_load(p, __ATOMIC_RELAXED, __HIP_MEMORY_SCOPE_AGENT); }
DEVI unsigned xb_add(unsigned* p, unsigned v) { return __hip_atomic_fetch_add(p, v, __ATOMIC_RELAXED, __HIP_MEMORY_SCOPE_AGENT); }
DEVI unsigned xb_xcc_id() { return (unsigned)__builtin_amdgcn_s_getreg((3 << 11) | 20) & 0xFu; }
#define XB_SPIN(cond, bar) do { unsigned _sp = 0; while (cond) { __builtin_amdgcn_s_sleep(1); \
    if ((++_sp & 255u) == 0u) { if (xb_ld(&(bar)[XB_TMO])) break; if (_sp > XB_SPIN_CAP) { atomicAdd(&(bar)[XB_TMO], 1u); break; } } } } while (0)
struct XcdBarrier { unsigned* bar; unsigned x; volatile LAS unsigned* st; };
DEVI XcdBarrier xcd_barrier_post(unsigned* bar, volatile LAS unsigned* st) {
    XcdBarrier b; b.bar = bar; b.x = xb_xcc_id(); b.st = st;
    if (threadIdx.x == 0) (void)xb_add(&bar[XB_XCNT(b.x)], 1u);
    return b;
}
DEVI void xcd_barrier_complete(unsigned* bar, unsigned x, unsigned& nloc, unsigned& nx) {
    const unsigned G = gridDim.x * gridDim.y * gridDim.z;
    unsigned sum, cnt, mine, sp = 0u;
    for (;;) {
        sum = 0u; cnt = 0u; mine = 0u;
#pragma unroll
        for (unsigned j = 0; j < 16; ++j) { const unsigned c = xb_ld(&bar[XB_XCNT(j)]); sum += c; cnt += (c > 0u) ? 1u : 0u; mine = (j == x) ? c : mine; }
        if (sum == G) break;
        __builtin_amdgcn_s_sleep(1);
        if ((++sp & 255u) == 0u) { if (xb_ld(&bar[XB_TMO])) break; if (sp > XB_SPIN_CAP) { atomicAdd(&bar[XB_TMO], 1u); break; } }
    }
    nloc = mine > 0u ? mine : 1u; nx = cnt > 0u ? cnt : 1u;
}
DEVI void xcd_barrier(const XcdBarrier& b) {
    asm volatile("s_waitcnt vmcnt(0)" ::: "memory");
    __syncthreads();
    if (threadIdx.x == 0) {
        unsigned* bar = b.bar;
        __builtin_amdgcn_s_waitcnt(0);
        unsigned nloc = b.st[0], nx = b.st[1];
        if (nloc == 0u) { xcd_barrier_complete(bar, b.x, nloc, nx); b.st[0] = nloc; b.st[1] = nx; }
        const unsigned old = xb_add(&bar[XB_XSUB(b.x)], 1u);
        const unsigned gen = old / nloc;
        if (old + 1u == (gen + 1u) * nloc) {
            __builtin_amdgcn_fence(__ATOMIC_RELEASE, "agent");
            asm volatile("s_waitcnt vmcnt(0)" ::: "memory");
            const unsigned og = xb_add(&bar[XB_TOP], 1u);
            const unsigned tg = og / nx;
            if (og + 1u == (tg + 1u) * nx) xb_add(&bar[XB_TOPGEN], 1u);
            else XB_SPIN(xb_ld(&bar[XB_TOPGEN]) == tg, bar);
            __builtin_amdgcn_fence(__ATOMIC_ACQUIRE, "agent");
            xb_add(&bar[XB_XGEN(b.x)], 1u);
            asm volatile("s_waitcnt vmcnt(0)" ::: "memory");
        } else {
            XB_SPIN(xb_ld(&bar[XB_XGEN(b.x)]) == gen, bar);
            __builtin_amdgcn_fence(__ATOMIC_ACQUIRE, "agent");
            asm volatile("s_waitcnt vmcnt(0)" ::: "memory");
        }
    }
    __syncthreads();
}

enum { K_PREP = 0, K_RETIN, K_RET, K_GATE, K_RESID, K_NORM, K_BF16, K_XATTN, K_FFNGATE, K_LRUCONV, K_LRU, K_SCAN1, K_SCAN2, K_NORMF };
constexpr int NPH = 24;
struct Step { int kind, L, lda, N, K, ldo, ssi; const bf16_t* A; const bf16_t* Bt; bf16_t* ob; const float* rinP; const float* rinS; };

template <int ONLY>
__global__ void __launch_bounds__(512) mega(Params p, int lo, int hi) {
    extern __shared__ __attribute__((aligned(16))) unsigned char shm[];
    LAS unsigned char* lds = (LAS unsigned char*)shm;
    cg::grid_group grid = cg::this_grid();
#define WS_ ((unsigned char*)p.in[33 + zero_()])
#define OUT_ ((float*)p.in[32 + zero_()])
#define x_prompt (p.in[0 + zero_()])
#define x_sample (p.in[1 + zero_()])
#define state_ret (p.in[2 + zero_()])
#define state_lru_h (p.in[3 + zero_()])
#define state_lru_conv (p.in[4 + zero_()])
#define state_ffn_conv (p.in[5 + zero_()])
#define cache_k (p.in[6 + zero_()])
#define cache_v (p.in[7 + zero_()])
#define mem_prompt (p.in[8 + zero_()])
#define norm_mix (p.in[9 + zero_()])
#define norm_xa (p.in[10 + zero_()])
#define norm_mem (p.in[11 + zero_()])
#define norm_ffn (p.in[12 + zero_()])
#define norm_final (p.in[13 + zero_()])
#define lru_conv_w (p.in[17 + zero_()])
#define lru_conv_b (p.in[18 + zero_()])
#define lru_ba (p.in[20 + zero_()])
#define lru_bx (p.in[22 + zero_()])
#define lru_lambda (p.in[23 + zero_()])
#define ffn_conv_w (p.in[29 + zero_()])
#define ffn_conv_b (p.in[30 + zero_()])
#define HN ((bf16_t*)(WS_ + W_HN))
#define MN ((bf16_t*)(WS_ + W_MN))
#define MK ((bf16_t*)(WS_ + W_MK))
#define MVT ((bf16_t*)(WS_ + W_MVT))
#define BIG ((bf16_t*)(WS_ + W_BIG))
#define X ((float*)(WS_ + W_X))
#define XS ((float*)(WS_ + W_X) + (size_t)PR * 1024)
#define QX ((bf16_t*)(WS_ + W_QX))
#define AO ((bf16_t*)(WS_ + W_AO))
#define Y ((bf16_t*)(WS_ + W_Y))
#define KT ((bf16_t*)(WS_ + W_KT))
#define VT ((bf16_t*)(WS_ + W_VT))
#define O ((bf16_t*)(WS_ + W_O))
#define OG ((bf16_t*)(WS_ + W_OG))
#define XC ((bf16_t*)(WS_ + W_XC))
#define AA ((float*)(WS_ + W_AA))
#define UU ((float*)(WS_ + W_UU))
#define CH ((float*)(WS_ + W_CH))
#define YL ((bf16_t*)(WS_ + W_YL))
#define ROTC ((float*)(WS_ + W_ROTC))
#define ROTS ((float*)(WS_ + W_ROTS))
#define LSG ((float*)(WS_ + W_LSG))
#define SS ((float*)(WS_ + W_SS))
#define DEC ((float*)(WS_ + W_DEC))
    volatile LAS unsigned* xst = (volatile LAS unsigned*)(lds + 153600);
    if (threadIdx.x < 4) xst[threadIdx.x] = 0u;
    __syncthreads();
    const XcdBarrier xbar = xcd_barrier_post((unsigned*)(WS_ + W_BAR), xst);
    const int hi2 = hi < NPH ? hi : NPH;
    for (int ph = lo; ph < hi2; ++ph) {
        Step st; st.kind = K_NORMF; st.L = ph >= 11 ? 1 : 0; st.lda = 1024; st.N = 1024; st.K = 1024; st.ldo = 1024; st.ssi = 0; st.A = HN; st.Bt = nullptr; st.ob = nullptr; st.rinP = X; st.rinS = XS;
        switch (ph) {
            case 0: st.kind = K_PREP; break;
            case 1: st.kind = K_RETIN; break;
            case 2: st.kind = K_RET; break;
            case 3: st.kind = K_GATE; break;
            case 4: st.kind = K_RESID; st.ssi = 1; st.A = OG; st.lda = 2048; st.K = 2048; st.Bt = (const bf16_t*)(WS_ + W_ROUT); st.rinP = x_prompt; st.rinS = x_sample; break;
            case 5: st.kind = K_BF16; st.ssi = 1; st.Bt = (const bf16_t*)(WS_ + W_XQ); st.ob = QX; break;
            case 6: st.kind = K_XATTN; break;
            case 7: st.kind = K_RESID; st.ssi = 2; st.A = AO; st.Bt = (const bf16_t*)(WS_ + W_XO); break;
            case 8: st.kind = K_BF16; st.ssi = 2; st.Bt = (const bf16_t*)(WS_ + W_UP); st.N = 6144; st.ob = BIG; st.ldo = 6144; break;
            case 9: st.kind = K_FFNGATE; break;
            case 10: st.kind = K_RESID; st.ssi = 3; st.A = Y; st.lda = 3072; st.K = 3072; st.Bt = (const bf16_t*)(WS_ + W_DN); break;
            case 11: st.kind = K_BF16; st.ssi = 3; st.Bt = (const bf16_t*)(WS_ + W_LIN); st.N = 2048; st.ob = BIG; st.ldo = 2048; break;
            case 12: st.kind = K_LRUCONV; break;
            case 13: st.kind = K_LRU; break;
            case 14: st.kind = K_SCAN1; break;
            case 15: st.kind = K_SCAN2; break;
            case 16: st.kind = K_RESID; st.ssi = 4; st.A = YL; st.Bt = (const bf16_t*)(WS_ + W_LOUT); break;
            case 17: st.kind = K_BF16; st.ssi = 4; st.Bt = (const bf16_t*)(WS_ + W_XQ + 2097152); st.ob = QX; break;
            case 18: st.kind = K_XATTN; break;
            case 19: st.kind = K_RESID; st.ssi = 5; st.A = AO; st.Bt = (const bf16_t*)(WS_ + W_XO + 2097152); break;
            case 20: st.kind = K_BF16; st.ssi = 5; st.Bt = (const bf16_t*)(WS_ + W_UP + 12582912); st.N = 6144; st.ob = BIG; st.ldo = 6144; break;
            case 21: st.kind = K_FFNGATE; break;
            case 22: st.kind = K_RESID; st.ssi = 6; st.A = Y; st.lda = 3072; st.K = 3072; st.Bt = (const bf16_t*)(WS_ + W_DN + 6291456); break;
            default: st.kind = K_NORMF; break;
        }
        const int L = st.L;
#ifndef DUP_MASK
#define DUP_MASK 0
#endif
        const int nrep = 1 + (int)(((unsigned)(DUP_MASK) >> st.kind) & 1u);
        for (int rep = 0; rep < nrep; ++rep) {
        if (rep) grid.sync();
        switch (st.kind) {
            case K_PREP: if constexpr (ONLY < 0 || ONLY == K_PREP) {
#if EN(0)
                transpose_phase(lds, p);
                rot_phase(ROTC, ROTS, p.rope_c1);
                lsg_phase(lru_lambda, LSG);
                dec_phase(DEC);
                cast_ss_phase(x_prompt, x_sample, HN, SS);
                for (int i = 0; i < 2; ++i) norm_phase<false>(mem_prompt, nullptr, norm_mem + i * 1024, MN + (size_t)i * 2097152, nullptr, nullptr, 2048);
#endif
            } break;
            case K_RETIN: if constexpr (ONLY < 0 || ONLY == K_RETIN) {
                QRetIn q; q.big = BIG; q.kt = KT; q.vt = VT; q.rc = ROTC; q.rs = ROTS; q.dec = DEC; q.ss = SS;
#if EN(1)
                run_gemm(lds, HN, 1024, (const bf16_t*)(WS_ + W_RIN), 1024, PR, 6144, 1024, 0, 0, q);
#endif
#if EN(13)
                skinny_phase_t<4>(lds, HN + (size_t)PR * 1024, 1024, (const bf16_t*)(WS_ + W_RIN), 1024, 6144, 1024, 0, q, nblk_() == 256 ? 128 : 0);
#endif
#if EN(14)
                for (int i = 0; i < 2; ++i) {
                    QMemKV m; m.outk = OUT_ + O_MKP + (size_t)i * 2097152; m.outv = OUT_ + O_MVP + (size_t)i * 2097152; m.mk = MK + (size_t)i * 2097152; m.mvt = MVT + (size_t)i * 2097152;
                    run_gemm(lds, MN + (size_t)i * 2097152, 1024, (const bf16_t*)(WS_ + W_XKV + (size_t)i * 4194304), 1024, 2048, 2048, 1024, 0, 128 + 64 * i, m);
                }
#endif
            } break;
            case K_RET: if constexpr (ONLY < 0 || ONLY == K_RET) {
#if EN(2)
                retention_prompt_phase(lds, BIG, KT, VT, O, OUT_ + O_RETP, DEC, nblk_() == 256, state_ret, OUT_ + O_RETS);
#endif
#if EN(3)
                if (nblk_() != 256) retention_sample_phase(lds, BIG, state_ret, OUT_ + O_RETS, O);
#endif
            } break;
            case K_GATE: if constexpr (ONLY < 0 || ONLY == K_GATE) {
#if EN(4)
                gate_phase(O, BIG, OG);
#endif
            } break;
            case K_RESID: if constexpr (ONLY < 0 || ONLY == K_RESID) {
                QResid q; q.rinP = st.rinP; q.rinS = st.rinS; q.xout = X; q.xb = HN; q.ssout = SS + (size_t)st.ssi * TP * 32;
#if EN(5)
                run_gemm(lds, st.A, st.lda, st.Bt, st.K, PR, 1024, st.K, 0, 0, q);
#endif
#if EN(15)
                skinny_phase1(lds, st.A + (size_t)PR * st.lda, st.lda, st.Bt, st.K, 1024, st.K, 0, q);
#endif
            } break;
            case K_BF16: if constexpr (ONLY < 0 || ONLY == K_BF16) {
                if (st.N == 6144) {
                    unsigned char* wsb = WS_; float* ob = OUT_;
                    QFfn q; q.y = (bf16_t*)(wsb + W_Y); q.big = (bf16_t*)(wsb + W_BIG); q.ss = (const float*)(wsb + W_SS) + (size_t)st.ssi * TP * 32; q.cw = ffn_conv_w + (size_t)L * 9216; q.cb = ffn_conv_b + (size_t)L * 3072;
                    q.sbuf = state_ffn_conv + (size_t)L * 786432; q.outp = ob + O_FCP + (size_t)L * 49152; q.outs = ob + O_FCS + (size_t)L * 786432;
                    const bf16_t* hn = (const bf16_t*)(wsb + W_HN);
                    run_gemm(lds, hn, 1024, st.Bt, 1024, PR, 6144, 1024, 2, 0, q);
                    skinny_phase(lds, hn + (size_t)PR * 1024, 1024, st.Bt, 1024, 6144, 1024, 2, q);
                } else {
                QBf16 q; q.out = st.ob; q.ld = st.ldo; q.ss = SS + (size_t)st.ssi * TP * 32;
#if EN(6)
                run_gemm(lds, HN, 1024, st.Bt, 1024, PR, st.N, 1024, 0, 0, q);
#endif
#if EN(16)
                if (st.N == 1024) skinny_phase1(lds, HN + (size_t)PR * 1024, 1024, st.Bt, 1024, 1024, 1024, 0, q);
                else skinny_phase_t<2>(lds, HN + (size_t)PR * 1024, 1024, st.Bt, 1024, st.N, 1024, 0, q);
#endif
                }
            } break;
            case K_XATTN: if constexpr (ONLY < 0 || ONLY == K_XATTN) {
#if EN(10)
                xattn_prompt_phase(lds, QX, MK + (size_t)L * 2097152, MVT + (size_t)L * 2097152, AO);
#endif
#if EN(11)
                xattn_sample_phase(lds, QX, cache_k + (size_t)L * 33554432, cache_v + (size_t)L * 33554432, AO);
#endif
            } break;
            case K_FFNGATE: if constexpr (ONLY < 0 || ONLY == K_FFNGATE) {
#if EN(12)
                ffn_fix_phase(BIG, Y, ffn_conv_w + (size_t)L * 9216, ffn_conv_b + (size_t)L * 3072);
#endif
            } break;
            case K_LRUCONV: if constexpr (ONLY < 0 || ONLY == K_LRUCONV) {
#if EN(7)
                lru_conv_phase(BIG, XC, lru_conv_w, lru_conv_b, state_lru_conv, OUT_ + O_LCP, OUT_ + O_LCS);
#endif
            } break;
            case K_LRU: if constexpr (ONLY < 0 || ONLY == K_LRU) {
                QLru q; q.ba = lru_ba; q.bx = lru_bx; q.lam = LSG; q.xc = XC; q.aa = AA; q.uu = UU; q.h0 = state_lru_h; q.hout = OUT_ + O_LHS; q.big = BIG; q.yl = YL;
#if EN(8)
                run_gemm(lds, XC, 1024, (const bf16_t*)(WS_ + W_AX), 256, PR, 2048, 256, 1, 0, q);
#endif
#if EN(18)
                skinny_phase_t<2>(lds, XC + (size_t)PR * 1024, 1024, (const bf16_t*)(WS_ + W_AX), 256, 2048, 256, 1, q);
#endif
            } break;
            case K_SCAN1: if constexpr (ONLY < 0 || ONLY == K_SCAN1) {
#if EN(9)
                scan1_phase(AA, UU, CH);
#endif
            } break;
            case K_SCAN2: if constexpr (ONLY < 0 || ONLY == K_SCAN2) {
#if EN(9)
                scan2_phase(AA, UU, CH, BIG, YL, OUT_ + O_LHP);
#endif
            } break;
            default: if constexpr (ONLY < 0 || ONLY == K_NORMF) {
#if EN(0)
                norm_phase<true>(X, XS, norm_final, nullptr, OUT_ + O_YP, OUT_ + O_YS, TR);
#endif
            } break;
        }
        }
        if (ph + 1 < hi2) { if (lo < 0) grid.sync(); else xcd_barrier(xbar); }
    }
#ifdef EXTRA_SYNCS
    for (int i = 0; i < EXTRA_SYNCS; ++i) grid.sync();
#endif
}

#undef WS_
#undef OUT_
#undef x_prompt
#undef x_sample
#undef state_ret
#undef state_lru_h
#undef state_lru_conv
#undef state_ffn_conv
#undef cache_k
#undef cache_v
#undef mem_prompt
#undef norm_mix
#undef norm_xa
#undef norm_mem
#undef norm_ffn
#undef norm_final
#undef lru_conv_w
#undef lru_conv_b
#undef lru_ba
#undef lru_bx
#undef lru_lambda
#undef ffn_conv_w
#undef ffn_conv_b
#undef HN
#undef MN
#undef MK
#undef MVT
#undef BIG
#undef X
#undef XS
#undef QX
#undef AO
#undef Y
#undef KT
#undef VT
#undef O
#undef OG
#undef XC
#undef AA
#undef UU
#undef CH
#undef YL
#undef ROTC
#undef ROTS
#undef LSG
#undef SS
#undef DEC
__global__ void dump_k(const float* src, float* dst, size_t n) { for (size_t i = (size_t)bid_() * blockDim.x + threadIdx.x; i < n; i += (size_t)nblk_() * blockDim.x) dst[i] = src[i]; }
#ifndef MULTI
#define MULTI 0
#endif
static const int h_kinds[NPH] = {K_PREP, K_RETIN, K_RET, K_GATE, K_RESID, K_BF16, K_XATTN, K_RESID, K_BF16, K_FFNGATE, K_RESID, K_BF16, K_LRUCONV, K_LRU, K_SCAN1, K_SCAN2,
                                 K_RESID, K_BF16, K_XATTN, K_RESID, K_BF16, K_FFNGATE, K_RESID, K_NORMF};
typedef void (*mega_fn)(Params, int, int);
template <int K> static mega_fn get_fn() { return mega<K>; }
static mega_fn fn_of_kind(int k) {
    switch (k) {
        case 0: return get_fn<0>(); case 1: return get_fn<1>(); case 2: return get_fn<2>(); case 3: return get_fn<3>(); case 4: return get_fn<4>(); case 5: return get_fn<5>(); case 6: return get_fn<6>();
        case 7: return get_fn<7>(); case 8: return get_fn<8>(); case 9: return get_fn<9>(); case 10: return get_fn<10>(); case 11: return get_fn<11>(); case 12: return get_fn<12>(); default: return get_fn<13>();
    }
}

extern "C" void kernel_launch(void* const* d_in, const int* in_sizes, int n_in, void* d_out, int out_size, void* d_ws, size_t ws_size, hipStream_t stream) {
    (void)in_sizes; (void)n_in; (void)out_size;
    static int grid_blocks = 0;
    if (!grid_blocks) {
        int dev = 0, cus = 0;
        (void)hipGetDevice(&dev);
        (void)hipDeviceGetAttribute(&cus, hipDeviceAttributeMultiprocessorCount, dev);
#if MULTI
        for (int k = 0; k < 14; ++k) (void)hipFuncSetAttribute((const void*)fn_of_kind(k), hipFuncAttributeMaxDynamicSharedMemorySize, LDS_BYTES);
#else
        (void)hipFuncSetAttribute((const void*)mega<-1>, hipFuncAttributeMaxDynamicSharedMemorySize, LDS_BYTES);
#endif
        grid_blocks = cus;
        if (ws_size < W_TOTAL) fprintf(stderr, "workspace too small: %zu < %zu\n", ws_size, (size_t)W_TOTAL);
    }
    Params p; memset(&p, 0, sizeof(p));
    for (int i = 0; i < 32; ++i) p.in[i] = (const float*)d_in[i];
    p.in[32] = (const float*)d_out; p.in[33] = (const float*)d_ws;
    p.rope_c1 = pow(10000.0, -1.0 / 128.0);
    unsigned char* ws = (unsigned char*)d_ws;
    int nj = 0, tiles = 0;
    auto add = [&](const float* src, size_t dst_off, int ld, int K, int N, const float* gain = nullptr) {
        TJob& j = p.jobs[nj++]; j.gain = gain; j.src = src; j.dst = (bf16_t*)(ws + dst_off); j.ld = ld; j.K = K; j.N = N; j.tile0 = tiles; tiles += (K / 64) * (N / 64);
    };
    const float* ret_w_in = p.in[14]; const float* ret_w_out = p.in[15]; const float* lru_w_in = p.in[16]; const float* lru_wa = p.in[19]; const float* lru_wx = p.in[21];
    const float* lru_w_out = p.in[24]; const float* xa_w_q = p.in[25]; const float* xa_w_kv = p.in[26]; const float* xa_w_o = p.in[27]; const float* ffn_w_up = p.in[28]; const float* ffn_w_down = p.in[31];
    const float* g_mix = p.in[9]; const float* g_xa = p.in[10]; const float* g_ffn = p.in[12];
    add(ret_w_in, W_RIN, 6144, 1024, 6144, g_mix);
    add(ffn_w_up, W_UP, 6144, 1024, 6144, g_ffn);
    add(ffn_w_up + (size_t)1024 * 6144, W_UP + 12582912, 6144, 1024, 6144, g_ffn + 1024);
    add(ret_w_out, W_ROUT, 1024, 2048, 1024);
    add(lru_w_in, W_LIN, 2048, 1024, 2048, g_mix + 1024);
    for (int h = 0; h < 4; ++h)
        for (int s = 0; s < 2; ++s)
            for (int half = 0; half < 2; ++half)
                add((half ? lru_wx : lru_wa) + (size_t)h * 65536 + s * 128, W_AX + (size_t)(h * 512 + s * 256 + half * 128) * 256 * 2, 256, 256, 128);
    add(lru_w_out, W_LOUT, 1024, 1024, 1024);
    for (int i = 0; i < 2; ++i) add(xa_w_q + (size_t)i * 1048576, W_XQ + (size_t)i * 2097152, 1024, 1024, 1024, g_xa + i * 1024);
    for (int i = 0; i < 2; ++i) add(xa_w_kv + (size_t)i * 2097152, W_XKV + (size_t)i * 4194304, 2048, 1024, 2048);
    for (int i = 0; i < 2; ++i) add(xa_w_o + (size_t)i * 1048576, W_XO + (size_t)i * 2097152, 1024, 1024, 1024);
    for (int i = 0; i < 2; ++i) add(ffn_w_down + (size_t)i * 3145728, W_DN + (size_t)i * 6291456, 1024, 3072, 1024);
    p.ntiles = tiles;
    if (nj != NJOBS) fprintf(stderr, "job count mismatch %d\n", nj);
#if MULTI
#ifndef HI_LIMIT
#define HI_LIMIT NPH
#endif
    for (int ph0 = 0; ph0 < HI_LIMIT; ++ph0) {
        const int ph = ph0;
        int lo = ph, hi = ph + 1;
        void* args[] = {&p, &lo, &hi};
        hipError_t e = hipLaunchKernel((const void*)fn_of_kind(h_kinds[ph]), dim3(grid_blocks), dim3(512), args, LDS_BYTES, stream);
        if (e != hipSuccess) fprintf(stderr, "launch %d failed: %s\n", ph, hipGetErrorString(e));
    }
#ifdef DUMP_OFF
    dump_k<<<1024, 256, 0, stream>>>((const float*)((unsigned char*)d_ws + DUMP_OFF), (float*)d_out, (size_t)16000000);
#endif
#else
    (void)hipMemsetAsync((unsigned char*)d_ws + W_BAR, 0, 16384, stream);
    int lo = 0, hi = NPH;
    void* args[] = {&p, &lo, &hi};
    hipError_t e = hipLaunchCooperativeKernel((const void*)mega<-1>, dim3(grid_blocks), dim3(512), args, LDS_BYTES, stream);
    if (e != hipSuccess) fprintf(stderr, "cooperative launch failed: %s (grid %d)\n", hipGetErrorString(e), grid_blocks);
#endif
}
```

```cpp
#include <hip/hip_runtime.h>
#include <hip/hip_cooperative_groups.h>
#include <cstdio>
#include <cstring>
#include <cmath>
namespace cg = cooperative_groups;

#ifndef MASK
#define MASK 0xffffffffu
#endif
#define EN(k) (((MASK) >> (k)) & 1u)
#define LAS __attribute__((address_space(3)))
#define DEVI __device__ __forceinline__
typedef unsigned short bf16_t;
typedef short bf16x8 __attribute__((ext_vector_type(8)));
typedef float f32x4 __attribute__((ext_vector_type(4)));
typedef unsigned u32x2 __attribute__((ext_vector_type(2)));
typedef unsigned u32x4 __attribute__((ext_vector_type(4)));

constexpr int PR = 16384;
constexpr int SR = 128;
constexpr int TR = PR + SR;
constexpr int TP = 16640;
constexpr int LDS_BYTES = 153600 + 16 + 8192;

constexpr size_t O_YP = 0, O_YS = 16777216, O_RETP = 16908288, O_RETS = 21102592, O_LHP = 88211456, O_LHS = 88219648,
                 O_LCP = 88350720, O_LCS = 88375296, O_FCP = 88768512, O_FCS = 88866816, O_MKP = 90439680, O_MVP = 94633984;

constexpr size_t W_RIN = 0;
constexpr size_t W_ROUT = W_RIN + 12582912;
constexpr size_t W_LIN = W_ROUT + 4194304;
constexpr size_t W_AX = W_LIN + 4194304;
constexpr size_t W_LOUT = W_AX + 1048576;
constexpr size_t W_XQ = W_LOUT + 2097152;
constexpr size_t W_XKV = W_XQ + 2 * 2097152;
constexpr size_t W_XO = W_XKV + 2 * 4194304;
constexpr size_t W_UP = W_XO + 2 * 2097152;
constexpr size_t W_DN = W_UP + 2 * 12582912;
constexpr size_t W_ROTC = W_DN + 2 * 6291456;
constexpr size_t W_ROTS = W_ROTC + 1049088;
constexpr size_t W_LSG = W_ROTS + 1049088;
constexpr size_t W_DEC = W_LSG + 4096;
constexpr size_t W_SS = W_DEC + 4096;
constexpr size_t W_HN = W_SS + (size_t)7 * TP * 32 * 4;
constexpr size_t W_MN = W_HN + (size_t)TP * 2048;
constexpr size_t W_MK = W_MN + 8388608;
constexpr size_t W_MVT = W_MK + 8388608;
constexpr size_t W_BIG = W_MVT + 8388608;
constexpr size_t W_X = W_BIG + (size_t)TP * 12288;
constexpr size_t W_QX = W_X + (size_t)TP * 4096;
constexpr size_t W_AO = W_QX + (size_t)TP * 2048;
constexpr size_t W_Y = W_AO + (size_t)TP * 2048;
constexpr size_t W_L = W_Y + (size_t)TP * 6144;
constexpr size_t W_KT = W_L;
constexpr size_t W_VT = W_KT + 33554432;
constexpr size_t W_O = W_VT + 67108864;
constexpr size_t W_OG = W_O + (size_t)TP * 4096;
constexpr size_t W_END0 = W_OG + (size_t)TP * 4096;
constexpr size_t W_XC = W_L;
constexpr size_t W_AA = W_XC + (size_t)TP * 2048;
constexpr size_t W_UU = W_AA + (size_t)TP * 4096;
constexpr size_t W_CH = W_UU + (size_t)TP * 4096;
constexpr size_t W_YL = W_CH + 4194304;
constexpr size_t W_END1 = W_YL + (size_t)TP * 2048;
constexpr size_t W_BAR = (W_END0 > W_END1 ? W_END0 : W_END1);
constexpr size_t W_TOTAL = W_BAR + 256;

struct TJob { const float* src; bf16_t* dst; const float* gain; int ld, K, N, tile0; };
constexpr int NJOBS = 30;
struct Params {
    const float* in[34];
    double rope_c1;
    TJob jobs[NJOBS];
    int ntiles;
    int pad0;
};

typedef float f32x2 __attribute__((ext_vector_type(2)));
typedef __bf16 bf16x2_t __attribute__((ext_vector_type(2)));
DEVI unsigned cvt_pk_bf16(float lo, float hi) { f32x2 v = {lo, hi}; bf16x2_t r = __builtin_convertvector(v, bf16x2_t); return __builtin_bit_cast(unsigned, r); }
DEVI bf16_t f2bf(float f) { return (bf16_t)(cvt_pk_bf16(f, 0.f) & 0xffffu); }
DEVI float bflo(unsigned u) { return __uint_as_float(u << 16); }
DEVI float bfhi(unsigned u) { return __uint_as_float(u & 0xffff0000u); }
DEVI float bf2f(bf16_t b) { return __uint_as_float(((unsigned)b) << 16); }
DEVI u32x2 pack4(f32x4 v) { u32x2 r; r.x = cvt_pk_bf16(v[0], v[1]); r.y = cvt_pk_bf16(v[2], v[3]); return r; }
DEVI float shx(float v, int o, int lane) { return __int_as_float(__builtin_amdgcn_ds_bpermute((lane ^ o) << 2, __float_as_int(v))); }
DEVI float dpp_f(float v, const int ctrl_sel) {
    const int x = __float_as_int(v);
    int r;
    if (ctrl_sel == 0) r = __builtin_amdgcn_update_dpp(x, x, 0xB1, 0xf, 0xf, false);
    else if (ctrl_sel == 1) r = __builtin_amdgcn_update_dpp(x, x, 0x4E, 0xf, 0xf, false);
    else if (ctrl_sel == 2) r = __builtin_amdgcn_update_dpp(x, x, 0x141, 0xf, 0xf, false);
    else r = __builtin_amdgcn_update_dpp(x, x, 0x140, 0xf, 0xf, false);
    return __int_as_float(r);
}
DEVI float wave_sum(float v, int lane) {
    (void)lane;
    v += dpp_f(v, 0); v += dpp_f(v, 1); v += dpp_f(v, 2); v += dpp_f(v, 3);
    const int x = __float_as_int(v);
    const float s0 = __int_as_float(__builtin_amdgcn_readlane(x, 0)), s1 = __int_as_float(__builtin_amdgcn_readlane(x, 16));
    const float s2 = __int_as_float(__builtin_amdgcn_readlane(x, 32)), s3 = __int_as_float(__builtin_amdgcn_readlane(x, 48));
    return (s0 + s1) + (s2 + s3);
}
DEVI float rcp_(float x) { return __builtin_amdgcn_rcpf(x); }
DEVI float ex2_(float x) { return __builtin_amdgcn_exp2f(x); }
DEVI float exp_(float x) { return __builtin_amdgcn_exp2f(x * 1.4426950408889634f); }
DEVI float sigmoidf_(float x) { return rcp_(1.f + exp_(-x)); }
DEVI float gelu_tanh(float x) { const float z = 1.5957691216057308f * (x + 0.044715f * x * x * x); return x * rcp_(1.f + exp_(-z)); }
DEVI int zero_() { int z = 0; asm volatile("" : "+s"(z)); return z; }
DEVI int bid_() { int b = blockIdx.x; asm volatile("" : "+s"(b)); return b; }
DEVI int nblk_() { int b = gridDim.x; asm volatile("" : "+s"(b)); return b; }
DEVI unsigned zv_() { unsigned z = 0; asm volatile("" : "+v"(z)); return z; }
DEVI int tid_() { int t = threadIdx.x; asm volatile("" : "+v"(t)); return t; }
DEVI f32x4 mfma16(bf16x8 a, bf16x8 b, f32x4 c) { return __builtin_amdgcn_mfma_f32_16x16x32_bf16(a, b, c, 0, 0, 0); }

DEVI float rstd_of(const float* ss, int row) {
    const f32x4* p = (const f32x4*)(ss + (unsigned)row * 32u);
    f32x4 a = p[0];
#pragma unroll
    for (int i = 1; i < 8; ++i) a += p[i];
    return __builtin_amdgcn_rsqf(__fadd_rn(__fmul_rn((a[0] + a[1]) + (a[2] + a[3]), 1.f / 1024.f), 1e-6f));
}

namespace pg8 {
constexpr int BM = 256, BK = 64, HALF = 128, HTB = HALF * BK * 2, NXCD = 8, WGM = 8;
__host__ __device__ __forceinline__ int lds_byte(int r, int c) { const int st = (r >> 4) * 2 + (c >> 5), rr = r & 15, cc = c & 31, ob = rr * 64 + cc * 2; return st * 1024 + (ob ^ (((ob >> 9) & 1) << 5)); }
__host__ __device__ __forceinline__ void stage_rc(int b, int& R, int& C) { const int st = b / 1024, sb = b % 1024, swz = sb ^ (((sb >> 9) & 1) << 5); R = (st >> 1) * 16 + swz / 64; C = (st & 1) * 32 + (swz % 64) / 2; }
__host__ __device__ __forceinline__ int perm32(int rho) { const int n = rho >> 4, i = rho & 15; return 8 * (i >> 2) + 4 * n + (i & 3); }
struct Unit { int pm, pn; };
struct Gemm { const bf16_t* A; const bf16_t* Bt; int M, N, K, lda, ldb, diag; };
struct StaticOrder {
    int nM, nN, nwg, G, c;
    DEVI void init(int M, int N, int G_, int c_) { nM = M / BM; nN = N / BM; nwg = nM * nN; G = G_; c = c_; }
    DEVI bool next(int i, Unit& u) const {
        const long L = (long)i * G + c; if (L >= nwg) return false;
        int wgid = (int)L; { const int q = nwg / NXCD, r = nwg % NXCD, xcd = wgid % NXCD, off = wgid / NXCD; wgid = (xcd < r ? xcd * (q + 1) : r * (q + 1) + (xcd - r) * q) + off; }
        const int nig = WGM * nN, gid = wgid / nig, fm = gid * WGM, gsz = (nM - fm) < WGM ? (nM - fm) : WGM;
        u.pm = fm + ((wgid % nig) % gsz); u.pn = (wgid % nig) / gsz; return true;
    }
};

template <class Q>
DEVI void gemm_phase(LAS unsigned char* lds, const Gemm g, const StaticOrder& S, const Q& E) {
    const int tid = tid_(), wid = __builtin_amdgcn_readfirstlane(tid >> 6), lane = tid & 63, wr = wid >> 2, wc = wid & 3, fr = lane & 15, fq = lane >> 4;
    const int K = g.K, nt = K / BK;
    unsigned voffA, voffB;
    { int R, C; stage_rc(tid * 16, R, C); const int Rb = Q::PERM ? ((R & ~31) + perm32(R & 31)) : R; voffA = (unsigned)(R * g.lda + C) * 2u; voffB = (unsigned)(Rb * g.ldb + C) * 2u; }
    const size_t r64voffA = (size_t)64 * g.lda * 2, r64voffB = (size_t)64 * g.ldb * 2;
    const size_t kstep = (size_t)(BK * 2);
    const size_t hstepA = (size_t)HALF * g.lda * 2, hstepB = (g.diag == 2 ? (size_t)3072 : (size_t)HALF) * g.ldb * 2;
    const size_t tstepA = 2 * hstepA, tstepB = (g.diag == 2 ? (size_t)HALF : (size_t)2 * HALF) * g.ldb * 2;
    const unsigned ldsw = (unsigned)wid * 1024u;
    const int aoff = lds_byte(wr * 64 + fr, fq * 8), boff = lds_byte(wc * 32 + fr, fq * 8);
#define PG8_SA(b, h) (((b) * 2 + (h)) * HTB)
#define PG8_SB(b, h) ((4 + (b) * 2 + (h)) * HTB)
#define PG8_STAGE(bufoff, gbase, voff) do { _Pragma("unroll") for (int _i = 0; _i < 2; ++_i) \
        __builtin_amdgcn_global_load_lds((const unsigned*)((const char*)(gbase) + (size_t)_i * r64##voff + voff), (LAS unsigned*)(lds + (bufoff) + ldsw + _i * 8192), 16, 0, 0); } while (0)
#define PG8_LDA(dst, b, h) do { _Pragma("unroll") for (int m = 0; m < 4; ++m) _Pragma("unroll") for (int k = 0; k < 2; ++k) dst[m][k] = *(const LAS bf16x8*)(lds + PG8_SA(b, h) + aoff + m * 2048 + k * 1024); } while (0)
#define PG8_LDB(dst, b, h) do { _Pragma("unroll") for (int n = 0; n < 2; ++n) _Pragma("unroll") for (int k = 0; k < 2; ++k) dst[n][k] = *(const LAS bf16x8*)(lds + PG8_SB(b, h) + boff + n * 2048 + k * 1024); } while (0)
#define PG8_MMA(ai, bj, At, Bt) do { __builtin_amdgcn_s_setprio(1); _Pragma("unroll") for (int m = 0; m < 4; ++m) _Pragma("unroll") for (int n = 0; n < 2; ++n) _Pragma("unroll") for (int k = 0; k < 2; ++k) \
        acc[ai][bj][m][n] = __builtin_amdgcn_mfma_f32_16x16x32_bf16(Bt[n][k], At[m][k], acc[ai][bj][m][n], 0, 0, 0); __builtin_amdgcn_s_setprio(0); } while (0)
#define PG8_WAIT_V(n) asm volatile("s_waitcnt vmcnt(" #n ")" ::: "memory")
#define PG8_WAIT_L(n) asm volatile("s_waitcnt lgkmcnt(" #n ")" ::: "memory")
#define PG8_BAR __builtin_amdgcn_s_barrier()
#define PG8_SCHED __builtin_amdgcn_sched_barrier(0)
    Unit cur, nxt; int ui = 0;
    if (!S.next(0, cur)) return;
    f32x4 acc[2][2][4][2];
#pragma unroll
    for (int a = 0; a < 2; ++a)
#pragma unroll
        for (int b = 0; b < 2; ++b)
#pragma unroll
            for (int m = 0; m < 4; ++m)
#pragma unroll
                for (int n = 0; n < 2; ++n) acc[a][b][m][n] = (f32x4){0.f, 0.f, 0.f, 0.f};
    bf16x8 At[4][2], B0[2][2], B1[2][2];
    const char* cA = (const char*)g.A + (size_t)cur.pm * tstepA + (g.diag == 1 ? (size_t)(cur.pn >> 1) * 512 : 0); const char* cB = (const char*)g.Bt + (size_t)cur.pn * tstepB;
#define PG8_RSTD(unit, par) do { if constexpr (Q::NEEDS_RSTD) { \
        const int _rl = tid >> 1, _hf = tid & 1; \
        const f32x4* _p = (const f32x4*)(E.ss + ((size_t)((unit).pm * BM + _rl)) * 32 + _hf * 16); \
        const f32x4 _a = (_p[0] + _p[1]) + (_p[2] + _p[3]); \
        float _sm = (_a[0] + _a[1]) + (_a[2] + _a[3]); \
        _sm += shx(_sm, 1, lane); \
        if (!_hf) *(LAS float*)(lds + 131072 + (par) * 1024 + _rl * 4) = __builtin_amdgcn_rsqf(__fadd_rn(__fmul_rn(_sm, 1.f / 1024.f), 1e-6f)); } } while (0)
    PG8_RSTD(cur, 0);
    PG8_STAGE(PG8_SB(0, 0), cB, voffB); PG8_STAGE(PG8_SA(0, 0), cA, voffA); PG8_STAGE(PG8_SB(0, 1), cB + hstepB, voffB); PG8_STAGE(PG8_SA(0, 1), cA + hstepA, voffA);
    if (wr == 1) PG8_BAR;
    PG8_WAIT_V(4); PG8_BAR;
    PG8_STAGE(PG8_SB(1, 0), cB + kstep, voffB); PG8_STAGE(PG8_SA(1, 0), cA + kstep, voffA); PG8_STAGE(PG8_SB(1, 1), cB + hstepB + kstep, voffB);
    PG8_WAIT_V(6); PG8_BAR;
    for (;;) {
        const bool has_next = S.next(ui + 1, nxt);
        const char* nA = has_next ? (const char*)g.A + (size_t)nxt.pm * tstepA + (g.diag == 1 ? (size_t)(nxt.pn >> 1) * 512 : 0) : cA; const char* nB = has_next ? (const char*)g.Bt + (size_t)nxt.pn * tstepB : cB;
        for (int t = 0; t < nt; t += 2) {
            const bool last = (t == nt - 2);
            const char* a1 = cA + (size_t)(t + 1) * kstep;
            const char* a2 = last ? nA : cA + (size_t)(t + 2) * kstep; const char* b2 = last ? nB : cB + (size_t)(t + 2) * kstep;
            const char* a3 = a2 + kstep; const char* b3 = b2 + kstep;
            PG8_LDB(B0, 0, 0); PG8_SCHED; PG8_LDA(At, 0, 0); PG8_STAGE(PG8_SA(1, 1), a1 + hstepA, voffA);
            PG8_WAIT_L(8); PG8_BAR; PG8_WAIT_L(0); PG8_MMA(0, 0, At, B0); PG8_BAR; PG8_SCHED;
            PG8_LDB(B1, 0, 1); PG8_STAGE(PG8_SB(0, 0), b2, voffB);
            PG8_BAR; PG8_WAIT_L(0); PG8_MMA(0, 1, At, B1); PG8_BAR;
            PG8_LDA(At, 0, 1); PG8_STAGE(PG8_SA(0, 0), a2, voffA);
            PG8_BAR; PG8_WAIT_L(0); PG8_MMA(1, 0, At, B0); PG8_BAR; PG8_SCHED;
            PG8_STAGE(PG8_SB(0, 1), b2 + hstepB, voffB);
            PG8_WAIT_V(6); PG8_BAR; PG8_MMA(1, 1, At, B1); PG8_BAR;
            PG8_LDB(B0, 1, 0); PG8_SCHED; PG8_LDA(At, 1, 0); PG8_STAGE(PG8_SA(0, 1), a2 + hstepA, voffA);
            PG8_WAIT_L(8); PG8_BAR; PG8_WAIT_L(0); PG8_MMA(0, 0, At, B0); PG8_BAR; PG8_SCHED;
            PG8_LDB(B1, 1, 1); PG8_STAGE(PG8_SB(1, 0), b3, voffB);
            PG8_BAR; PG8_WAIT_L(0); PG8_MMA(0, 1, At, B1); PG8_BAR;
            PG8_LDA(At, 1, 1); PG8_STAGE(PG8_SA(1, 0), a3, voffA);
            PG8_BAR; PG8_WAIT_L(0); PG8_MMA(1, 0, At, B0); PG8_BAR; PG8_SCHED;
            PG8_STAGE(PG8_SB(1, 1), b3 + hstepB, voffB);
            PG8_WAIT_V(6); PG8_BAR; PG8_MMA(1, 1, At, B1); PG8_BAR;
        }
#pragma unroll
        for (int ai = 0; ai < 2; ++ai)
#pragma unroll
            for (int m = 0; m < 4; ++m) {
                int l2 = lane; asm volatile("" : "+v"(l2));
                const int rloc = ai * HALF + wr * 64 + m * 16 + (l2 & 15);
                float rsc = 1.f;
                if constexpr (Q::NEEDS_RSTD) rsc = *(const LAS float*)(lds + 131072 + (ui & 1) * 1024 + rloc * 4);
                if constexpr (Q::PERM) E.oct(cur.pm * BM + rloc, cur.pn, wc * 32 + (l2 >> 4) * 8, acc[ai][0][m][0], acc[ai][0][m][1], acc[ai][1][m][0], acc[ai][1][m][1], rsc);
                else {
#pragma unroll
                    for (int n = 0; n < 2; ++n)
                        E.quad(cur.pm * BM + rloc, cur.pn, wc * 32 + n * 16 + (l2 >> 4) * 4, acc[ai][0][m][n], acc[ai][1][m][n], rsc);
                }
            }
        if (!has_next) break;
        PG8_RSTD(nxt, (ui + 1) & 1);
#pragma unroll
        for (int a = 0; a < 2; ++a)
#pragma unroll
            for (int b = 0; b < 2; ++b)
#pragma unroll
                for (int m = 0; m < 4; ++m)
#pragma unroll
                    for (int n = 0; n < 2; ++n) acc[a][b][m][n] = (f32x4){0.f, 0.f, 0.f, 0.f};
        cur = nxt; cA = nA; cB = nB; ++ui;
    }
    PG8_WAIT_V(0);
    if (wr == 0) PG8_BAR;
    PG8_BAR;
#undef PG8_RSTD
#undef PG8_SA
#undef PG8_SB
#undef PG8_STAGE
#undef PG8_LDA
#undef PG8_LDB
#undef PG8_MMA
#undef PG8_WAIT_V
#undef PG8_WAIT_L
#undef PG8_BAR
#undef PG8_SCHED
}
}

template <class Q>
DEVI void run_gemm(LAS unsigned char* lds, const bf16_t* A, int lda, const bf16_t* Bt, int ldb, int M, int N, int K, int diag, int rot, const Q& q) {
    pg8::Gemm g; g.A = A; g.Bt = Bt; g.M = M; g.N = N; g.K = K; g.lda = lda; g.ldb = ldb; g.diag = diag;
    pg8::StaticOrder S; const int G_ = nblk_(); S.init(M, N, G_, (bid_() + G_ - (rot % G_)) % G_);
    pg8::gemm_phase<Q>(lds, g, S, q);
}

template <int RT, class Q>
DEVI void skinny_phase_t(LAS unsigned char* lds, const bf16_t* A, int lda, const bf16_t* Bt, int ldb, int N, int K, int diag, const Q& q, int nbuse = 0) {
    constexpr int RS = 8 / RT;
    const int tid = tid_(), w = tid >> 6, lane = tid & 63, fr = lane & 15, fq = lane >> 4;
    const int nitems = (N / 32) * RS, kw = K / 8;
    const int stride_ = nbuse > 0 ? nbuse : nblk_();
    for (int it = bid_() < stride_ ? bid_() : nitems; it < nitems; it += stride_) {
        const int ci = it / RS, rs = it - ci * RS, pn = ci >> 3, g = ci & 7;
        const bf16_t* a0 = A + (size_t)(rs * RT * 16 + fr) * lda + (diag == 1 ? (pn >> 1) * 256 : 0) + w * kw + fq * 8;
        const bf16_t* b0 = Bt + (size_t)((diag == 2 ? pn * 128 : pn * 256) + g * 16 + fr) * ldb + w * kw + fq * 8;
        const bf16_t* b1 = b0 + (size_t)(diag == 2 ? 3072 : 128) * ldb;
        f32x4 acc[RT][2];
#pragma unroll
        for (int rt = 0; rt < RT; ++rt) { acc[rt][0] = (f32x4){0.f, 0.f, 0.f, 0.f}; acc[rt][1] = (f32x4){0.f, 0.f, 0.f, 0.f}; }
        bf16x8 cb0 = *(const bf16x8*)(b0), cb1 = *(const bf16x8*)(b1), ca[RT];
#pragma unroll
        for (int rt = 0; rt < RT; ++rt) ca[rt] = *(const bf16x8*)(a0 + (size_t)rt * 16 * lda);
#pragma unroll 1
        for (int k = 32; k <= kw; k += 32) {
            const int kn = k < kw ? k : 0;
            const bf16x8 nb0 = *(const bf16x8*)(b0 + kn), nb1 = *(const bf16x8*)(b1 + kn);
            bf16x8 na[RT];
#pragma unroll
            for (int rt = 0; rt < RT; ++rt) na[rt] = *(const bf16x8*)(a0 + (size_t)rt * 16 * lda + kn);
#pragma unroll
            for (int rt = 0; rt < RT; ++rt) { acc[rt][0] = mfma16(cb0, ca[rt], acc[rt][0]); acc[rt][1] = mfma16(cb1, ca[rt], acc[rt][1]); }
            cb0 = nb0; cb1 = nb1;
#pragma unroll
            for (int rt = 0; rt < RT; ++rt) ca[rt] = na[rt];
        }
#pragma unroll
        for (int rt = 0; rt < RT; ++rt) {
            *(LAS f32x4*)(lds + (size_t)((((w * 8 + rt) * 2 + 0) * 64 + lane) * 16)) = acc[rt][0];
            *(LAS f32x4*)(lds + (size_t)((((w * 8 + rt) * 2 + 1) * 64 + lane) * 16)) = acc[rt][1];
        }
        __syncthreads();
        if (w < RT) {
            f32x4 v0 = *(const LAS f32x4*)(lds + (size_t)((((0 * 8 + w) * 2 + 0) * 64 + lane) * 16));
            f32x4 v1 = *(const LAS f32x4*)(lds + (size_t)((((0 * 8 + w) * 2 + 1) * 64 + lane) * 16));
#pragma unroll
            for (int ww = 1; ww < 8; ++ww) {
                v0 += *(const LAS f32x4*)(lds + (size_t)((((ww * 8 + w) * 2 + 0) * 64 + lane) * 16));
                v1 += *(const LAS f32x4*)(lds + (size_t)((((ww * 8 + w) * 2 + 1) * 64 + lane) * 16));
            }
            const int row = PR + (rs * RT + w) * 16 + fr;
            float rsc = 1.f;
            if constexpr (Q::NEEDS_RSTD) rsc = rstd_of(q.ss, row);
            q.quad(row, pn, g * 16 + fq * 4, v0, v1, rsc);
        }
        __syncthreads();
    }
}
template <class Q>
DEVI void skinny_phase(LAS unsigned char* lds, const bf16_t* A, int lda, const bf16_t* Bt, int ldb, int N, int K, int diag, const Q& q, int nbuse = 0) {
    skinny_phase_t<8, Q>(lds, A, lda, Bt, ldb, N, K, diag, q, nbuse);
}
template <class Q>
DEVI void skinny_phase1(LAS unsigned char* lds, const bf16_t* A, int lda, const bf16_t* Bt, int ldb, int N, int K, int diag, const Q& q) {
    skinny_phase_t<1, Q>(lds, A, lda, Bt, ldb, N, K, diag, q);
}

struct QRetIn {
    static constexpr bool PERM = true;
    DEVI void oct(int row, int pn, int cl8, f32x4 a0, f32x4 a1, f32x4 b0, f32x4 b1, float rsc) const {
        a0 *= rsc; a1 *= rsc; b0 *= rsc; b1 *= rsc;
        const int b = row >> 11, t = row & 2047;
        bf16_t* nat = big + ((unsigned)row * 6144u + (unsigned)(pn * 256 + cl8));
        if (pn < 8) {
            const int h = pn & 3;
            const float* pc = rc + t * 128 + cl8; const float* ps = rs + t * 128 + cl8;
            const f32x4 c0 = *(const f32x4*)pc, c1 = *(const f32x4*)(pc + 4), s0 = *(const f32x4*)ps, s1 = *(const f32x4*)(ps + 4);
            const float sc = dec[pn * 128 + (t & 127)];
            const f32x4 o0 = (a0 * c0 - b0 * s0) * sc, o1 = (a1 * c1 - b1 * s1) * sc, o2 = (a0 * s0 + b0 * c0) * sc, o3 = (a1 * s1 + b1 * c1) * sc;
            const u32x2 p0 = pack4(o0), p1 = pack4(o1), p2 = pack4(o2), p3 = pack4(o3);
            *(u32x4*)nat = (u32x4){p0.x, p0.y, p1.x, p1.y}; *(u32x4*)(nat + 128) = (u32x4){p2.x, p2.y, p3.x, p3.y};
            if (pn >= 4) {
                bf16_t* q = kt + (((unsigned)(b * 4 + h) * 256u + (unsigned)cl8) * 2048u + (unsigned)t);
#pragma unroll
                for (int r = 0; r < 4; ++r) { q[(size_t)r * 2048] = f2bf(o0[r]); q[(size_t)(4 + r) * 2048] = f2bf(o1[r]); q[(size_t)(128 + r) * 2048] = f2bf(o2[r]); q[(size_t)(132 + r) * 2048] = f2bf(o3[r]); }
            }
        } else if (pn < 16) {
            const int c0i = (pn - 8) * 256 + cl8; const int head = c0i >> 9, e0 = c0i & 511;
            bf16_t* q = vt + (((unsigned)(b * 4 + head) * 512u + (unsigned)e0) * 2048u + (unsigned)t);
#pragma unroll
            for (int r = 0; r < 4; ++r) { q[(size_t)r * 2048] = f2bf(a0[r]); q[(size_t)(4 + r) * 2048] = f2bf(a1[r]); q[(size_t)(128 + r) * 2048] = f2bf(b0[r]); q[(size_t)(132 + r) * 2048] = f2bf(b1[r]); }
        } else {
            const u32x2 p0 = pack4(a0), p1 = pack4(a1), p2 = pack4(b0), p3 = pack4(b1);
            *(u32x4*)nat = (u32x4){p0.x, p0.y, p1.x, p1.y}; *(u32x4*)(nat + 128) = (u32x4){p2.x, p2.y, p3.x, p3.y};
        }
    }
    static constexpr bool NEEDS_RSTD = true;
    bf16_t* big; bf16_t* kt; bf16_t* vt; const float* rc; const float* rs; const float* dec; const float* ss;
    DEVI void quad(int row, int pn, int cl, f32x4 v0, f32x4 v1, float rsc) const {
        v0 *= rsc; v1 *= rsc;
        const bool smp = row >= PR; const int b = row >> 11, t = row & 2047;
        bf16_t* nat = big + ((unsigned)row * 6144u + (unsigned)(pn * 256 + cl));
        if (pn < 8) {
            const int h = pn & 3; const int pi = smp ? 2048 : t;
            const f32x4 c = *(const f32x4*)(rc + pi * 128 + cl), s = *(const f32x4*)(rs + pi * 128 + cl);
            f32x4 o0 = v0 * c - v1 * s, o1 = v0 * s + v1 * c;
            const float sc = dec[pn * 128 + (smp ? 0 : (t & 127))];
            o0 *= sc; o1 *= sc;
            *(u32x2*)nat = pack4(o0); *(u32x2*)(nat + 128) = pack4(o1);
            if (pn >= 4 && !smp) {
                bf16_t* q = kt + (((unsigned)(b * 4 + h) * 256u + (unsigned)cl) * 2048u + (unsigned)t);
#pragma unroll
                for (int r = 0; r < 4; ++r) { q[(size_t)r * 2048] = f2bf(o0[r]); q[(size_t)(128 + r) * 2048] = f2bf(o1[r]); }
            }
        } else if (pn < 16) {
            if (smp) { *(u32x2*)nat = pack4(v0); *(u32x2*)(nat + 128) = pack4(v1); }
            else {
                const int c0 = (pn - 8) * 256 + cl; const int head = c0 >> 9, e0 = c0 & 511;
                bf16_t* q = vt + (((unsigned)(b * 4 + head) * 512u + (unsigned)e0) * 2048u + (unsigned)t);
#pragma unroll
                for (int r = 0; r < 4; ++r) { q[(size_t)r * 2048] = f2bf(v0[r]); q[(size_t)(128 + r) * 2048] = f2bf(v1[r]); }
            }
        } else { *(u32x2*)nat = pack4(v0); *(u32x2*)(nat + 128) = pack4(v1); }
    }
};
struct QResid {
    static constexpr bool PERM = true;
    DEVI void oct(int row, int pn, int cl8, f32x4 a0, f32x4 a1, f32x4 b0, f32x4 b1, float rsc) const {
        (void)rsc;
        const float* r = (row < PR ? rinP + (size_t)row * 1024 : rinS + (size_t)(row - PR) * 1024) + pn * 256 + cl8;
        const unsigned off = (unsigned)row * 1024u + (unsigned)(pn * 256 + cl8);
        a0 += __builtin_nontemporal_load((const f32x4*)r); a1 += __builtin_nontemporal_load((const f32x4*)(r + 4)); b0 += __builtin_nontemporal_load((const f32x4*)(r + 128)); b1 += __builtin_nontemporal_load((const f32x4*)(r + 132));
        __builtin_nontemporal_store(a0, (f32x4*)(xout + off)); __builtin_nontemporal_store(a1, (f32x4*)(xout + off + 4)); __builtin_nontemporal_store(b0, (f32x4*)(xout + off + 128)); __builtin_nontemporal_store(b1, (f32x4*)(xout + off + 132));
        const u32x2 pa0 = pack4(a0), pa1 = pack4(a1), pb0 = pack4(b0), pb1 = pack4(b1);
        *(u32x4*)(xb + off) = (u32x4){pa0.x, pa0.y, pa1.x, pa1.y}; *(u32x4*)(xb + off + 128) = (u32x4){pb0.x, pb0.y, pb1.x, pb1.y};
        float sa = a0[0] * a0[0] + a0[1] * a0[1] + a0[2] * a0[2] + a0[3] * a0[3] + a1[0] * a1[0] + a1[1] * a1[1] + a1[2] * a1[2] + a1[3] * a1[3];
        float sb = b0[0] * b0[0] + b0[1] * b0[1] + b0[2] * b0[2] + b0[3] * b0[3] + b1[0] * b1[0] + b1[1] * b1[1] + b1[2] * b1[2] + b1[3] * b1[3];
        const int lane = (row & 15) | (((cl8 >> 3) & 3) << 4);
        sa += shx(sa, 16, lane); sa += shx(sa, 32, lane); sb += shx(sb, 16, lane); sb += shx(sb, 32, lane);
        if (lane < 16) { float* sp = ssout + ((unsigned)row * 32u + (unsigned)(pn * 8 + (cl8 >> 5))); sp[0] = sa; sp[4] = sb; }
    }
    static constexpr bool NEEDS_RSTD = false;
    const float* rinP; const float* rinS; float* xout; bf16_t* xb; float* ssout;
    DEVI void quad(int row, int pn, int cl, f32x4 v0, f32x4 v1, float rsc) const {
        (void)rsc;
        const float* r = (row < PR ? rinP + (size_t)row * 1024 : rinS + (size_t)(row - PR) * 1024) + pn * 256 + cl;
        const unsigned off = (unsigned)row * 1024u + (unsigned)(pn * 256 + cl);
        const f32x4 a = *(const f32x4*)r + v0, b = *(const f32x4*)(r + 128) + v1;
        *(f32x4*)(xout + off) = a; *(f32x4*)(xout + off + 128) = b;
        *(u32x2*)(xb + off) = pack4(a); *(u32x2*)(xb + off + 128) = pack4(b);
        float sq = a[0] * a[0] + a[1] * a[1] + a[2] * a[2] + a[3] * a[3] + b[0] * b[0] + b[1] * b[1] + b[2] * b[2] + b[3] * b[3];
        const int lane = (row & 15) | (((cl >> 2) & 3) << 4);
        sq += shx(sq, 16, lane); sq += shx(sq, 32, lane);
        if (lane < 16) ssout[(unsigned)row * 32u + (unsigned)(pn * 8 + (cl >> 4))] = sq;
    }
};
struct QBf16 {
    static constexpr bool NEEDS_RSTD = true;
    static constexpr bool PERM = true;
    bf16_t* out; int ld; const float* ss;
    DEVI void oct(int row, int pn, int cl8, f32x4 a0, f32x4 a1, f32x4 b0, f32x4 b1, float rsc) const {
        bf16_t* o = out + ((unsigned)row * (unsigned)ld + (unsigned)(pn * 256 + cl8));
        const u32x2 pa0 = pack4(a0 * rsc), pa1 = pack4(a1 * rsc), pb0 = pack4(b0 * rsc), pb1 = pack4(b1 * rsc);
        *(u32x4*)o = (u32x4){pa0.x, pa0.y, pa1.x, pa1.y}; *(u32x4*)(o + 128) = (u32x4){pb0.x, pb0.y, pb1.x, pb1.y};
    }
    DEVI void quad(int row, int pn, int cl, f32x4 v0, f32x4 v1, float rsc) const {
        v0 *= rsc; v1 *= rsc;
        bf16_t* o = out + ((unsigned)row * (unsigned)ld + (unsigned)(pn * 256 + cl));
        *(u32x2*)o = pack4(v0); *(u32x2*)(o + 128) = pack4(v1);
    }
};
DEVI float dpp_shr(float v, const int n) {
    const int x = __float_as_int(v);
    return __int_as_float(n == 1 ? __builtin_amdgcn_update_dpp(x, x, 0x111, 0xf, 0xf, false) : __builtin_amdgcn_update_dpp(x, x, 0x112, 0xf, 0xf, false));
}
struct QFfn {
    static constexpr bool NEEDS_RSTD = true;
    static constexpr bool PERM = true;
    bf16_t* y; bf16_t* big; const float* ss; const float* cw; const float* cb; const float* sbuf; float* outp; float* outs;
    DEVI void oct(int row, int pn, int cl8, f32x4 a0, f32x4 a1, f32x4 b0, f32x4 b1, float rsc) const {
        a0 *= rsc; a1 *= rsc; b0 *= rsc; b1 *= rsc;
        const int ch = pn * 128 + cl8, fr = row & 15;
        f32x4 p10, p11, p20, p21;
#pragma unroll
        for (int k = 0; k < 4; ++k) { p10[k] = dpp_shr(a0[k], 1); p11[k] = dpp_shr(a1[k], 1); p20[k] = dpp_shr(a0[k], 2); p21[k] = dpp_shr(a1[k], 2); }
        if (fr >= 2) {
            const f32x4 w00 = *(const f32x4*)(cw + ch), w01 = *(const f32x4*)(cw + ch + 4), w10 = *(const f32x4*)(cw + 3072 + ch), w11 = *(const f32x4*)(cw + 3072 + ch + 4);
            const f32x4 w20 = *(const f32x4*)(cw + 6144 + ch), w21 = *(const f32x4*)(cw + 6144 + ch + 4), c0 = *(const f32x4*)(cb + ch), c1 = *(const f32x4*)(cb + ch + 4);
            float o[8];
#pragma unroll
            for (int k = 0; k < 4; ++k) {
                o[k] = gelu_tanh(c0[k] + p20[k] * w00[k] + p10[k] * w10[k] + a0[k] * w20[k]) * b0[k];
                o[4 + k] = gelu_tanh(c1[k] + p21[k] * w01[k] + p11[k] * w11[k] + a1[k] * w21[k]) * b1[k];
            }
            u32x4 w; w.x = cvt_pk_bf16(o[0], o[1]); w.y = cvt_pk_bf16(o[2], o[3]); w.z = cvt_pk_bf16(o[4], o[5]); w.w = cvt_pk_bf16(o[6], o[7]);
            *(u32x4*)(y + ((unsigned)row * 3072u + (unsigned)ch)) = w;
        }
        if (fr < 2 || fr >= 14) {
            const u32x2 p0 = pack4(a0), p1 = pack4(a1);
            *(u32x4*)(big + ((unsigned)row * 6144u + (unsigned)ch)) = (u32x4){p0.x, p0.y, p1.x, p1.y};
            if (fr < 2) { const u32x2 g0 = pack4(b0), g1 = pack4(b1); *(u32x4*)(big + ((unsigned)row * 6144u + 3072u + (unsigned)ch)) = (u32x4){g0.x, g0.y, g1.x, g1.y}; }
            else if ((row & 2047) >= 2046) { float* q = outp + ((size_t)(row >> 11) * 2 + ((row & 2047) - 2046)) * 3072 + ch; *(f32x4*)q = a0; *(f32x4*)(q + 4) = a1; }
        }
    }
    DEVI void quad(int row, int pn, int cl, f32x4 v0, f32x4 v1, float rsc) const {
        v0 *= rsc; v1 *= rsc;
        const int ch = pn * 128 + cl, sb = row - PR;
        const float* b0 = sbuf + ((size_t)sb * 2) * 3072 + ch;
        const f32x4 h2 = *(const f32x4*)b0, h1 = *(const f32x4*)(b0 + 3072);
        const f32x4 w0 = *(const f32x4*)(cw + ch), w1 = *(const f32x4*)(cw + 3072 + ch), w2 = *(const f32x4*)(cw + 6144 + ch), c = *(const f32x4*)(cb + ch);
        float* q = outs + ((size_t)sb * 2) * 3072 + ch;
        *(f32x4*)q = h1; *(f32x4*)(q + 3072) = v0;
        f32x4 o;
#pragma unroll
        for (int k = 0; k < 4; ++k) o[k] = gelu_tanh(c[k] + h2[k] * w0[k] + h1[k] * w1[k] + v0[k] * w2[k]) * v1[k];
        *(u32x2*)(y + ((unsigned)row * 3072u + (unsigned)ch)) = pack4(o);
    }
};
struct QMemKV {
    static constexpr bool PERM = false;
    static constexpr bool NEEDS_RSTD = false;
    float* outk; float* outv; bf16_t* mk; bf16_t* mvt;
    DEVI void quad(int row, int pn, int cl, f32x4 v0, f32x4 v1, float rsc) const {
        if (pn < 4) {
            const size_t o = (size_t)row * 1024 + pn * 256 + cl;
            __builtin_nontemporal_store(v0, (f32x4*)(outk + o)); __builtin_nontemporal_store(v1, (f32x4*)(outk + o + 128));
            *(u32x2*)(mk + o) = pack4(v0); *(u32x2*)(mk + o + 128) = pack4(v1);
        } else {
            const int h = pn - 4; const size_t o = (size_t)row * 1024 + h * 256 + cl;
            __builtin_nontemporal_store(v0, (f32x4*)(outv + o)); __builtin_nontemporal_store(v1, (f32x4*)(outv + o + 128));
            const int b = row >> 8, m = row & 255;
            bf16_t* q = mvt + ((size_t)(b * 4 + h) * 256 + cl) * 256 + m;
#pragma unroll
            for (int r = 0; r < 4; ++r) { q[r * 256] = f2bf(v0[r]); q[(128 + r) * 256] = f2bf(v1[r]); }
        }
    }
};
struct QLru {
    static constexpr bool PERM = false;
    static constexpr bool NEEDS_RSTD = false;
    const float* ba; const float* bx; const float* lam; const bf16_t* xc; float* aa; float* uu;
    const float* h0; float* hout; const bf16_t* big; bf16_t* yl;
    DEVI void quad(int row, int pn, int cl, f32x4 v0, f32x4 v1, float rsc) const {
        const int ch = (pn >> 1) * 256 + (pn & 1) * 128 + cl;
        const f32x4 ba4 = *(const f32x4*)(ba + ch), bx4 = *(const f32x4*)(bx + ch), lm4 = *(const f32x4*)(lam + ch);
        const u32x2 xp = *(const u32x2*)(xc + (size_t)row * 1024 + ch);
        const float xv[4] = {bflo(xp.x), bfhi(xp.x), bflo(xp.y), bfhi(xp.y)};
        f32x4 a4, u4;
#pragma unroll
        for (int r = 0; r < 4; ++r) {
            const float rr = sigmoidf_(v0[r] + ba4[r]), ii = sigmoidf_(v1[r] + bx4[r]);
            const float la = 8.f * rr * lm4[r];
            const float av = exp_(la);
            a4[r] = av; u4[r] = __builtin_amdgcn_sqrtf(fmaxf(1.f - av * av, 0.f)) * (ii * xv[r]);
        }
        if (row < PR) { *(f32x4*)(aa + (size_t)row * 1024 + ch) = a4; *(f32x4*)(uu + (size_t)row * 1024 + ch) = u4; }
        else {
            const int sb = row - PR;
            const f32x4 hp = *(const f32x4*)(h0 + (size_t)sb * 1024 + ch);
            const f32x4 hn = a4 * hp + u4;
            *(f32x4*)(hout + (size_t)sb * 1024 + ch) = hn;
            const u32x2 gp = *(const u32x2*)(big + (size_t)row * 2048 + 1024 + ch);
            f32x4 y; y[0] = gelu_tanh(bflo(gp.x)) * hn[0]; y[1] = gelu_tanh(bfhi(gp.x)) * hn[1]; y[2] = gelu_tanh(bflo(gp.y)) * hn[2]; y[3] = gelu_tanh(bfhi(gp.y)) * hn[3];
            *(u32x2*)(yl + (size_t)row * 1024 + ch) = pack4(y);
        }
    }
};

template <bool F32OUT>
DEVI void norm_phase(const float* srcP, const float* srcS, const float* gain, bf16_t* dstb, float* dstP, float* dstS, int nrows) {
    const int tid = tid_(); const int lane = tid & 63, wave = bid_() * 8 + (tid >> 6), nw = nblk_() * 8;
    f32x4 g[4];
#pragma unroll
    for (int i = 0; i < 4; ++i) g[i] = *(const f32x4*)(gain + i * 256 + lane * 4);
    for (int r0 = wave; r0 < nrows; r0 += 2 * nw) {
        f32x4 v[2][4]; float ss[2];
#pragma unroll
        for (int u = 0; u < 2; ++u) {
            const int r = r0 + u * nw < nrows ? r0 + u * nw : r0;
            const float* s = r < PR ? srcP + (size_t)r * 1024 : srcS + (size_t)(r - PR) * 1024;
#pragma unroll
            for (int i = 0; i < 4; ++i) v[u][i] = *(const f32x4*)(s + i * 256 + lane * 4);
        }
#pragma unroll
        for (int u = 0; u < 2; ++u) {
            float q = 0.f;
#pragma unroll
            for (int i = 0; i < 4; ++i) q += v[u][i][0] * v[u][i][0] + v[u][i][1] * v[u][i][1] + v[u][i][2] * v[u][i][2] + v[u][i][3] * v[u][i][3];
            ss[u] = q;
        }
#pragma unroll
        for (int o = 32; o; o >>= 1) { ss[0] += shx(ss[0], o, lane); ss[1] += shx(ss[1], o, lane); }
#pragma unroll
        for (int u = 0; u < 2; ++u) {
            const int r = r0 + u * nw;
            if (r < nrows) {
                const float rs = __builtin_amdgcn_rsqf(__fadd_rn(__fmul_rn(ss[u], 1.f / 1024.f), 1e-6f));
                if (F32OUT) {
                    float* d = r < PR ? dstP + (size_t)r * 1024 : dstS + (size_t)(r - PR) * 1024;
#pragma unroll
                    for (int i = 0; i < 4; ++i) __builtin_nontemporal_store(v[u][i] * rs * g[i], (f32x4*)(d + i * 256 + lane * 4));
                } else {
                    bf16_t* d = dstb + (size_t)r * 1024;
#pragma unroll
                    for (int i = 0; i < 4; ++i) *(u32x2*)(d + i * 256 + lane * 4) = pack4(v[u][i] * rs * g[i]);
                }
            }
        }
    }
}

DEVI void cast_ss_phase(const float* srcP, const float* srcS, bf16_t* xb, float* ss) {
    const int tid = tid_(); const int lane = tid & 63, wave = bid_() * 8 + (tid >> 6), nw = nblk_() * 8;
    for (int r = wave; r < TR; r += nw) {
        const float* s = r < PR ? srcP + (size_t)r * 1024 : srcS + (size_t)(r - PR) * 1024;
        f32x4 v[4]; float q = 0.f;
#pragma unroll
        for (int i = 0; i < 4; ++i) { v[i] = *(const f32x4*)(s + i * 256 + lane * 4); q += v[i][0] * v[i][0] + v[i][1] * v[i][1] + v[i][2] * v[i][2] + v[i][3] * v[i][3]; }
        q = wave_sum(q, lane);
#pragma unroll
        for (int i = 0; i < 4; ++i) *(u32x2*)(xb + (size_t)r * 1024 + i * 256 + lane * 4) = pack4(v[i]);
        if (lane < 32) ss[(size_t)r * 32 + lane] = lane == 0 ? q : 0.f;
    }
}

DEVI void transpose_phase(LAS unsigned char* lds, const Params& p) {
    LAS float* tile = (LAS float*)lds;
    const int tid = tid_();
    const int kk = tid >> 4, nq = tid & 15, n = tid >> 3, kq = tid & 7;
    const int nb = nblk_(), b0 = bid_();
    f32x4 v[2]; float gk[2]; bf16_t* cdst = nullptr; int cK = 0;
    bool have = false;
    int j = 0;
    for (int step = 0;; ++step) {
        const int tl = b0 + step * nb;
        const bool doload = tl < p.ntiles;
        if (have) {
#pragma unroll
            for (int i = 0; i < 2; ++i)
#pragma unroll
                for (int c = 0; c < 4; ++c) tile[(kk + 32 * i) * 65 + nq * 4 + c] = v[i][c] * gk[i];
            __syncthreads();
        }
        f32x4 nv[2] = {v[0], v[1]}; float ngk[2] = {1.f, 1.f}; bf16_t* ndst = nullptr; int nK = 0;
        if (doload) {
            while (j + 1 < NJOBS && p.jobs[j + 1].tile0 <= tl) ++j;
            const TJob jb = p.jobs[j];
            const int lt = tl - jb.tile0, ntn = jb.N >> 6, tk = lt / ntn, tn = lt - tk * ntn, k0 = tk * 64, n0 = tn * 64;
#pragma unroll
            for (int i = 0; i < 2; ++i) {
                nv[i] = __builtin_nontemporal_load((const f32x4*)(jb.src + (size_t)(k0 + kk + 32 * i) * jb.ld + n0 + nq * 4));
                ngk[i] = jb.gain ? jb.gain[k0 + kk + 32 * i] : 1.f;
            }
            ndst = jb.dst + (size_t)n0 * jb.K + k0; nK = jb.K;
        }
        if (have) {
            float f[8];
#pragma unroll
            for (int c = 0; c < 8; ++c) f[c] = tile[(kq * 8 + c) * 65 + n];
            u32x4 o; o.x = cvt_pk_bf16(f[0], f[1]); o.y = cvt_pk_bf16(f[2], f[3]); o.z = cvt_pk_bf16(f[4], f[5]); o.w = cvt_pk_bf16(f[6], f[7]);
            *(u32x4*)(cdst + (size_t)n * cK + kq * 8) = o;
            __syncthreads();
        }
        if (!doload) break;
        v[0] = nv[0]; v[1] = nv[1]; gk[0] = ngk[0]; gk[1] = ngk[1]; cdst = ndst; cK = nK; have = true;
    }
}

DEVI void rot_phase(float* rc, float* rs, double c1) {
    const int gt = bid_() * 512 + tid_(), ng = nblk_() * 512;
    for (int i = gt; i < 2049 * 128; i += ng) {
        const int pi = i >> 7, j = i & 127;
        double inv = 1.0, bb = c1; int e = j;
        while (e) { if (e & 1) inv *= bb; bb *= bb; e >>= 1; }
        const double pos = pi == 2048 ? 16384.0 : (double)pi;
        const double ang = pos * inv;
        const double rev = ang * 0.15915494309189534561;
        const float fr_ = (float)(rev - rint(rev));
        rs[i] = __builtin_amdgcn_sinf(fr_);
        rc[i] = __builtin_amdgcn_cosf(fr_);
    }
}

DEVI void dec_phase(float* dec) { for (int i = bid_() * 512 + tid_(); i < 1024; i += nblk_() * 512) { const int r = i >> 7, t = i & 127, h = r & 3; const float l2g = __builtin_amdgcn_logf(1.f - 1.f / (float)(32 << h)); dec[i] = r < 4 ? ex2_(l2g * (float)t) : 0.0625f * ex2_(-l2g * (float)t); } }
DEVI void lsg_phase(const float* lam, float* lsg) { for (int i = bid_() * 512 + tid_(); i < 1024; i += nblk_() * 512) { const float e = exp_(-lam[i]); const float ser = e * (1.f - e * (0.5f - e * (0.33333333f - e * (0.25f - e * 0.2f)))); lsg[i] = e < 0.03f ? -ser : -0.69314718056f * __builtin_amdgcn_logf(1.f + e); } }

DEVI void gate_phase(const bf16_t* o, const bf16_t* big, bf16_t* og) {
    const int tid = tid_(); const int lane = tid & 63, wave = bid_() * 8 + (tid >> 6), nw = nblk_() * 8;
    for (int it0 = wave; it0 < TR * 4; it0 += 4 * nw) {
        u32x4 ov[4], gv[4];
#pragma unroll
        for (int u = 0; u < 4; ++u) {
            const int it = it0 + u * nw < TR * 4 ? it0 + u * nw : it0;
            const int row = it >> 2, h = it & 3;
            ov[u] = *(const u32x4*)(o + (size_t)row * 2048 + h * 512 + lane * 8);
            gv[u] = *(const u32x4*)(big + (size_t)row * 6144 + 4096 + h * 512 + lane * 8);
        }
#pragma unroll
        for (int u = 0; u < 4; ++u) {
            const int it = it0 + u * nw;
            const int row = it >> 2, h = it & 3;
            float of[8], gf[8];
            of[0] = bflo(ov[u].x); of[1] = bfhi(ov[u].x); of[2] = bflo(ov[u].y); of[3] = bfhi(ov[u].y); of[4] = bflo(ov[u].z); of[5] = bfhi(ov[u].z); of[6] = bflo(ov[u].w); of[7] = bfhi(ov[u].w);
            gf[0] = bflo(gv[u].x); gf[1] = bfhi(gv[u].x); gf[2] = bflo(gv[u].y); gf[3] = bfhi(gv[u].y); gf[4] = bflo(gv[u].z); gf[5] = bfhi(gv[u].z); gf[6] = bflo(gv[u].w); gf[7] = bfhi(gv[u].w);
            float ss = 0.f;
#pragma unroll
            for (int c = 0; c < 8; ++c) ss += of[c] * of[c];
            ss = wave_sum(ss, lane);
            const float rs = __builtin_amdgcn_rsqf(__fadd_rn(__fmul_rn(ss, 1.f / 512.f), 1e-6f));
            float y[8];
#pragma unroll
            for (int c = 0; c < 8; ++c) y[c] = gf[c] * sigmoidf_(gf[c]) * of[c] * rs;
            u32x4 w; w.x = cvt_pk_bf16(y[0], y[1]); w.y = cvt_pk_bf16(y[2], y[3]); w.z = cvt_pk_bf16(y[4], y[5]); w.w = cvt_pk_bf16(y[6], y[7]);
            if (it < TR * 4) *(u32x4*)(og + (size_t)row * 2048 + h * 512 + lane * 8) = w;
        }
    }
}

DEVI void unpack8(u32x4 v, float* f) { f[0] = bflo(v.x); f[1] = bfhi(v.x); f[2] = bflo(v.y); f[3] = bfhi(v.y); f[4] = bflo(v.z); f[5] = bfhi(v.z); f[6] = bflo(v.w); f[7] = bfhi(v.w); }

DEVI void ffn_gate_phase(const bf16_t* big, bf16_t* y, const float* cw, const float* cb, const float* sbuf  , float* outp  , float* outs  ) {
    const int gt = bid_() * 512 + tid_(), ng = nblk_() * 512;
    for (int it = gt; it < 256 * 384 + SR * 384; it += ng) {
        const bool smp = it >= 256 * 384;
        const int li = smp ? it - 256 * 384 : it;
        const int seg = li / 384, c = (li - seg * 384) * 8;
        float w0[8], w1[8], w2[8], bb[8];
#pragma unroll
        for (int k = 0; k < 8; k += 4) {
            const f32x4 a0 = *(const f32x4*)(cw + c + k), a1 = *(const f32x4*)(cw + 3072 + c + k), a2 = *(const f32x4*)(cw + 6144 + c + k), a3 = *(const f32x4*)(cb + c + k);
#pragma unroll
            for (int j = 0; j < 4; ++j) { w0[k + j] = a0[j]; w1[k + j] = a1[j]; w2[k + j] = a2[j]; bb[k + j] = a3[j]; }
        }
        float u1[8], u2[8];
        if (!smp) {
            const int row0 = seg * 64, t0 = row0 & 2047;
            if (t0 > 0) { unpack8(*(const u32x4*)(big + (size_t)(row0 - 1) * 6144 + c), u1); unpack8(*(const u32x4*)(big + (size_t)(row0 - 2) * 6144 + c), u2); }
            else {
#pragma unroll
                for (int k = 0; k < 8; ++k) { u1[k] = 0.f; u2[k] = 0.f; }
            }
#pragma unroll 8
            for (int r = 0; r < 64; ++r) {
                const size_t row = (size_t)row0 + r;
                float u0[8], gg[8], o[8];
                unpack8(*(const u32x4*)(big + row * 6144 + c), u0);
                unpack8(*(const u32x4*)(big + row * 6144 + 3072 + c), gg);
#pragma unroll
                for (int k = 0; k < 8; ++k) { const float uc = bb[k] + u2[k] * w0[k] + u1[k] * w1[k] + u0[k] * w2[k]; o[k] = gelu_tanh(uc) * gg[k]; }
                u32x4 w; w.x = cvt_pk_bf16(o[0], o[1]); w.y = cvt_pk_bf16(o[2], o[3]); w.z = cvt_pk_bf16(o[4], o[5]); w.w = cvt_pk_bf16(o[6], o[7]);
                *(u32x4*)(y + row * 3072 + c) = w;
                if (t0 + r >= 2046) { float* q = outp + ((size_t)(row >> 11) * 2 + (t0 + r - 2046)) * 3072 + c; *(f32x4*)q = (f32x4){u0[0], u0[1], u0[2], u0[3]}; *(f32x4*)(q + 4) = (f32x4){u0[4], u0[5], u0[6], u0[7]}; }
#pragma unroll
                for (int k = 0; k < 8; ++k) { u2[k] = u1[k]; u1[k] = u0[k]; }
            }
        } else {
            const int sb = seg; const size_t row = (size_t)PR + sb;
            float u0[8], gg[8], o[8];
            unpack8(*(const u32x4*)(big + row * 6144 + c), u0);
            unpack8(*(const u32x4*)(big + row * 6144 + 3072 + c), gg);
            const float* b0 = sbuf + ((size_t)sb * 2 + 0) * 3072 + c; const float* b1 = b0 + 3072;
            const f32x4 p0 = *(const f32x4*)b0, p1 = *(const f32x4*)(b0 + 4), q0 = *(const f32x4*)b1, q1 = *(const f32x4*)(b1 + 4);
#pragma unroll
            for (int k = 0; k < 4; ++k) { u2[k] = p0[k]; u2[4 + k] = p1[k]; u1[k] = q0[k]; u1[4 + k] = q1[k]; }
            float* q = outs + ((size_t)sb * 2) * 3072 + c;
            *(f32x4*)q = q0; *(f32x4*)(q + 4) = q1;
            *(f32x4*)(q + 3072) = (f32x4){u0[0], u0[1], u0[2], u0[3]}; *(f32x4*)(q + 3072 + 4) = (f32x4){u0[4], u0[5], u0[6], u0[7]};
#pragma unroll
            for (int k = 0; k < 8; ++k) { const float uc = bb[k] + u2[k] * w0[k] + u1[k] * w1[k] + u0[k] * w2[k]; o[k] = gelu_tanh(uc) * gg[k]; }
            u32x4 w; w.x = cvt_pk_bf16(o[0], o[1]); w.y = cvt_pk_bf16(o[2], o[3]); w.z = cvt_pk_bf16(o[4], o[5]); w.w = cvt_pk_bf16(o[6], o[7]);
            *(u32x4*)(y + row * 3072 + c) = w;
        }
    }
}

DEVI void ffn_fix_phase(const bf16_t* big, bf16_t* y, const float* cw, const float* cb) {
    const int gt = bid_() * 512 + tid_(), ng = nblk_() * 512;
    for (int it = gt; it < 2048 * 384; it += ng) {
        const int ri = it / 384, c = (it - ri * 384) * 8;
        const int row = (ri >> 1) * 16 + (ri & 1), t = row & 2047;
        float u0[8], u1[8], u2[8], gg[8];
        unpack8(*(const u32x4*)(big + (size_t)row * 6144 + c), u0);
        unpack8(*(const u32x4*)(big + (size_t)row * 6144 + 3072 + c), gg);
        unpack8(*(const u32x4*)(big + (size_t)(t >= 1 ? row - 1 : row) * 6144 + c), u1);
        unpack8(*(const u32x4*)(big + (size_t)(t >= 2 ? row - 2 : row) * 6144 + c), u2);
#pragma unroll
        for (int k = 0; k < 8; ++k) { u1[k] = t >= 1 ? u1[k] : 0.f; u2[k] = t >= 2 ? u2[k] : 0.f; }
        float r[8];
#pragma unroll
        for (int k = 0; k < 8; ++k) {
            const float uc = cb[c + k] + u2[k] * cw[c + k] + u1[k] * cw[3072 + c + k] + u0[k] * cw[6144 + c + k];
            r[k] = gelu_tanh(uc) * gg[k];
        }
        u32x4 w; w.x = cvt_pk_bf16(r[0], r[1]); w.y = cvt_pk_bf16(r[2], r[3]); w.z = cvt_pk_bf16(r[4], r[5]); w.w = cvt_pk_bf16(r[6], r[7]);
        *(u32x4*)(y + (size_t)row * 3072 + c) = w;
    }
}

DEVI void lru_conv_phase(const bf16_t* big, bf16_t* xc, const float* cw, const float* cb, const float* sbuf  , float* outp  , float* outs  ) {
    const int gt = bid_() * 512 + tid_(), ng = nblk_() * 512;
    for (int it = gt; it < 1024 * 128 + SR * 128; it += ng) {
        const bool smp = it >= 1024 * 128;
        const int li = smp ? it - 1024 * 128 : it;
        const int seg = li >> 7, c = (li & 127) * 8;
        float w0[8], w1[8], w2[8], w3[8], bb[8];
#pragma unroll
        for (int k = 0; k < 8; k += 4) {
            const f32x4 a0 = *(const f32x4*)(cw + c + k), a1 = *(const f32x4*)(cw + 1024 + c + k), a2 = *(const f32x4*)(cw + 2048 + c + k), a3 = *(const f32x4*)(cw + 3072 + c + k), a4 = *(const f32x4*)(cb + c + k);
#pragma unroll
            for (int j = 0; j < 4; ++j) { w0[k + j] = a0[j]; w1[k + j] = a1[j]; w2[k + j] = a2[j]; w3[k + j] = a3[j]; bb[k + j] = a4[j]; }
        }
        if (!smp) {
            const int row0 = seg * 16, t0 = row0 & 2047;
            u32x4 raw[19];
#pragma unroll
            for (int r = 0; r < 19; ++r) {
                const int rr = (t0 == 0 && r < 3) ? row0 : row0 - 3 + r;
                raw[r] = *(const u32x4*)(big + (size_t)rr * 2048 + c);
            }
            float x1[8], x2[8], x3[8];
            if (t0 > 0) { unpack8(raw[0], x3); unpack8(raw[1], x2); unpack8(raw[2], x1); }
            else {
#pragma unroll
                for (int k = 0; k < 8; ++k) { x1[k] = 0.f; x2[k] = 0.f; x3[k] = 0.f; }
            }
#pragma unroll
            for (int r = 0; r < 16; ++r) {
                const size_t row = (size_t)row0 + r;
                float x0[8], o[8];
                unpack8(raw[3 + r], x0);
#pragma unroll
                for (int k = 0; k < 8; ++k) o[k] = bb[k] + x3[k] * w0[k] + x2[k] * w1[k] + x1[k] * w2[k] + x0[k] * w3[k];
                u32x4 w; w.x = cvt_pk_bf16(o[0], o[1]); w.y = cvt_pk_bf16(o[2], o[3]); w.z = cvt_pk_bf16(o[4], o[5]); w.w = cvt_pk_bf16(o[6], o[7]);
                *(u32x4*)(xc + row * 1024 + c) = w;
                if (t0 + r >= 2045) { float* q = outp + ((size_t)(row >> 11) * 3 + (t0 + r - 2045)) * 1024 + c; *(f32x4*)q = (f32x4){x0[0], x0[1], x0[2], x0[3]}; *(f32x4*)(q + 4) = (f32x4){x0[4], x0[5], x0[6], x0[7]}; }
#pragma unroll
                for (int k = 0; k < 8; ++k) { x3[k] = x2[k]; x2[k] = x1[k]; x1[k] = x0[k]; }
            }
        } else {
            const int sb = seg; const size_t row = (size_t)PR + sb;
            float x0[8], x1[8], x2[8], x3[8], o[8];
            unpack8(*(const u32x4*)(big + row * 2048 + c), x0);
            const float* b0 = sbuf + (size_t)sb * 3 * 1024 + c;
            float* q = outs + (size_t)sb * 3 * 1024 + c;
#pragma unroll
            for (int k = 0; k < 8; k += 4) {
                const f32x4 p3 = *(const f32x4*)(b0 + k), p2 = *(const f32x4*)(b0 + 1024 + k), p1 = *(const f32x4*)(b0 + 2048 + k);
#pragma unroll
                for (int j = 0; j < 4; ++j) { x3[k + j] = p3[j]; x2[k + j] = p2[j]; x1[k + j] = p1[j]; }
                *(f32x4*)(q + k) = p2; *(f32x4*)(q + 1024 + k) = p1; *(f32x4*)(q + 2048 + k) = (f32x4){x0[k], x0[k + 1], x0[k + 2], x0[k + 3]};
            }
#pragma unroll
            for (int k = 0; k < 8; ++k) o[k] = bb[k] + x3[k] * w0[k] + x2[k] * w1[k] + x1[k] * w2[k] + x0[k] * w3[k];
            u32x4 w; w.x = cvt_pk_bf16(o[0], o[1]); w.y = cvt_pk_bf16(o[2], o[3]); w.z = cvt_pk_bf16(o[4], o[5]); w.w = cvt_pk_bf16(o[6], o[7]);
            *(u32x4*)(xc + row * 1024 + c) = w;
        }
    }
}

DEVI void scan1_phase(const float* aa, const float* uu, float* chs  ) {
    const int gt = bid_() * 512 + tid_(), ng = nblk_() * 512;
    for (int it = gt; it < 8 * 64 * 256; it += ng) {
        const int c = (it & 255) * 4, ck = (it >> 8) & 63, b = it >> 14;
        const size_t base = ((size_t)b * 2048 + ck * 32) * 1024 + c;
        f32x4 ap = (f32x4){1.f, 1.f, 1.f, 1.f}, h = (f32x4){0.f, 0.f, 0.f, 0.f};
#pragma unroll 8
        for (int t = 0; t < 32; ++t) { const f32x4 a = *(const f32x4*)(aa + base + (size_t)t * 1024), u = *(const f32x4*)(uu + base + (size_t)t * 1024); h = a * h + u; ap *= a; }
        float* o = chs + ((size_t)(b * 64 + ck) * 1024 + c) * 2;
        *(f32x4*)o = (f32x4){ap[0], h[0], ap[1], h[1]}; *(f32x4*)(o + 4) = (f32x4){ap[2], h[2], ap[3], h[3]};
    }
}
DEVI void scan2_phase(const float* aa, const float* uu, const float* chs, const bf16_t* big, bf16_t* yl, float* hout  ) {
    const int gt = bid_() * 512 + tid_(), ng = nblk_() * 512;
    for (int it = gt; it < 8 * 64 * 256; it += ng) {
        const int c = (it & 255) * 4, ck = (it >> 8) & 63, b = it >> 14;
        f32x4 h = (f32x4){0.f, 0.f, 0.f, 0.f};
        for (int k = 0; k < ck; ++k) {
            const float* ci = chs + ((size_t)(b * 64 + k) * 1024 + c) * 2;
            const f32x4 p0 = *(const f32x4*)ci, p1 = *(const f32x4*)(ci + 4);
            h[0] = p0[0] * h[0] + p0[1]; h[1] = p0[2] * h[1] + p0[3]; h[2] = p1[0] * h[2] + p1[1]; h[3] = p1[2] * h[3] + p1[3];
        }
        const size_t row0 = (size_t)b * 2048 + ck * 32;
#pragma unroll 8
        for (int t = 0; t < 32; ++t) {
            const size_t row = row0 + t;
            h = *(const f32x4*)(aa + row * 1024 + c) * h + *(const f32x4*)(uu + row * 1024 + c);
            const u32x2 gp = *(const u32x2*)(big + row * 2048 + 1024 + c);
            f32x4 y; y[0] = gelu_tanh(bflo(gp.x)) * h[0]; y[1] = gelu_tanh(bfhi(gp.x)) * h[1]; y[2] = gelu_tanh(bflo(gp.y)) * h[2]; y[3] = gelu_tanh(bfhi(gp.y)) * h[3];
            *(u32x2*)(yl + row * 1024 + c) = pack4(y);
        }
        if (ck == 63) *(f32x4*)(hout + b * 1024 + c) = h;
    }
}

DEVI void retention_prompt_phase(LAS unsigned char* lds, const bf16_t* big, const bf16_t* ktg, const bf16_t* vtg, bf16_t* og, float* sout  , const float* dec,
                                 const bool fuse, const float* sin_, float* sout_s) {
    constexpr int KS_STR = 528, VT_STR = 272, ST_STR = 528, AT_STR = 272;
    constexpr int KS_OFF = 0, VT_OFF = 128 * KS_STR, ST_OFF = VT_OFF + 64 * VT_STR, AT_OFF = ST_OFF + 64 * ST_STR;
    const int tid = tid_(), w = tid >> 6, lane = tid & 63, fr = lane & 15, fq = lane >> 4;
    LAS unsigned char* att = lds + AT_OFF + w * (16 * AT_STR);
    for (int it = bid_(); it < 256; it += nblk_()) {
        const int b = it >> 5, h = (it >> 3) & 3, es = it & 7;
        const float gam = 1.f - 1.f / (float)(32 << h), gam127 = dec[h * 128 + 127];
        f32x4 sacc[2][4];
#pragma unroll
        for (int a = 0; a < 2; ++a)
#pragma unroll
            for (int e = 0; e < 4; ++e) sacc[a][e] = (f32x4){0.f, 0.f, 0.f, 0.f};
        __syncthreads();
        { const unsigned z = zv_(); for (int i = tid; i < 64 * ST_STR / 16; i += 512) *(LAS u32x4*)(lds + ST_OFF + i * 16) = (u32x4){z, z, z, z}; }
        f32x4 o4s = (f32x4){0.f, 0.f, 0.f, 0.f};
        u32x4 pk[8], pv[2];
        {   const bf16_t* src = big + ((size_t)b * 2048 + (tid >> 5)) * 6144 + 1024 + h * 256 + (tid & 31) * 8;
#pragma unroll
            for (int i = 0; i < 8; ++i) pk[i] = *(const u32x4*)(src + (size_t)i * 16 * 6144);
            const bf16_t* vsrc = vtg + ((size_t)(b * 4 + h) * 512 + es * 64 + (tid >> 4)) * 2048 + (tid & 15) * 8;
#pragma unroll
            for (int i = 0; i < 2; ++i) pv[i] = *(const u32x4*)(vsrc + (size_t)i * 32 * 2048);
        }
        for (int n = 0; n < 16; ++n) {
            const size_t row0 = (size_t)b * 2048 + n * 128;
            __syncthreads();
            f32x4 sv[8]; size_t s_base = 0; int s_sb = 0, s_h = 0, s_eq = 0;
            if (fuse) {
                const int sit = it * 8 + (n >> 1);
                s_sb = sit >> 4; s_h = (sit >> 2) & 3; s_eq = sit & 3;
                s_base = ((size_t)(s_sb * 4 + s_h) * 256) * 512 + s_eq * 128 + (tid & 31) * 4 + (size_t)(8 * (tid >> 5) + 128 * (n & 1)) * 512;
#pragma unroll
                for (int i = 0; i < 8; ++i) sv[i] = __builtin_nontemporal_load((const f32x4*)(sin_ + s_base + (size_t)i * 512));
            }
            {
                LAS unsigned char* dst = lds + KS_OFF + (tid >> 5) * KS_STR + (tid & 31) * 16;
#pragma unroll
                for (int i = 0; i < 8; ++i) *(LAS u32x4*)(dst + i * 16 * KS_STR) = pk[i];
                LAS unsigned char* vdst = lds + VT_OFF + (tid >> 4) * VT_STR + (tid & 15) * 16;
#pragma unroll
                for (int i = 0; i < 2; ++i) *(LAS u32x4*)(vdst + i * 32 * VT_STR) = pv[i];
            }
            bf16x8 qf[8];
#pragma unroll
            for (int ks = 0; ks < 8; ++ks) qf[ks] = *(const bf16x8*)(big + (row0 + 16 * w + fr) * 6144 + h * 256 + ks * 32 + fq * 8);
            __syncthreads();
            {   const int nn = n + 1 < 16 ? n + 1 : n;
                const bf16_t* src = big + ((size_t)b * 2048 + nn * 128 + (tid >> 5)) * 6144 + 1024 + h * 256 + (tid & 31) * 8;
#pragma unroll
                for (int i = 0; i < 8; ++i) pk[i] = *(const u32x4*)(src + (size_t)i * 16 * 6144);
                const bf16_t* vsrc = vtg + ((size_t)(b * 4 + h) * 512 + es * 64 + (tid >> 4)) * 2048 + nn * 128 + (tid & 15) * 8;
#pragma unroll
                for (int i = 0; i < 2; ++i) pv[i] = *(const u32x4*)(vsrc + (size_t)i * 32 * 2048);
            }
            for (int jt = 0; jt <= w; ++jt) {
                f32x4 acc = (f32x4){0.f, 0.f, 0.f, 0.f};
#pragma unroll
                for (int ks = 0; ks < 8; ++ks) {
                    const bf16x8 kf = *(const LAS bf16x8*)(lds + KS_OFF + (jt * 16 + fr) * KS_STR + ks * 64 + fq * 16);
                    acc = mfma16(kf, qf[ks], acc);
                }
                if (jt == w) {
#pragma unroll
                    for (int r = 0; r < 4; ++r) if (fq * 4 + r > fr) acc[r] = 0.f;
                }
                *(LAS u32x2*)(att + fr * AT_STR + (jt * 16 + fq * 4) * 2) = pack4(acc);
            }
            if ((w & 1) == 0) { const unsigned z = zv_(); *(LAS u32x2*)(att + fr * AT_STR + ((w + 1) * 16 + fq * 4) * 2) = (u32x2){z, z}; }
            __builtin_amdgcn_fence(__ATOMIC_SEQ_CST, "wavefront"); asm volatile("s_waitcnt lgkmcnt(0)" ::: "memory"); __builtin_amdgcn_wave_barrier();
#pragma unroll
            for (int et = 0; et < 4; ++et) {
                f32x4 ao = (f32x4){0.f, 0.f, 0.f, 0.f}, ac = (f32x4){0.f, 0.f, 0.f, 0.f};
                for (int js = 0; js <= (w >> 1); ++js) {
                    const bf16x8 af = *(const LAS bf16x8*)(att + fr * AT_STR + js * 64 + fq * 16);
                    const bf16x8 vf = *(const LAS bf16x8*)(lds + VT_OFF + (et * 16 + fr) * VT_STR + js * 64 + fq * 16);
                    ao = mfma16(vf, af, ao);
                }
#pragma unroll
                for (int ks = 0; ks < 8; ++ks) {
                    const bf16x8 sf = *(const LAS bf16x8*)(lds + ST_OFF + (et * 16 + fr) * ST_STR + ks * 64 + fq * 16);
                    ac = mfma16(sf, qf[ks], ac);
                }
                const f32x4 o = ao + ac * gam;
                *(u32x2*)(og + (row0 + 16 * w + fr) * 2048 + h * 512 + es * 64 + et * 16 + fq * 4) = pack4(o);
            }
#pragma unroll
            for (int a = 0; a < 2; ++a)
#pragma unroll
                for (int e = 0; e < 4; ++e) sacc[a][e] *= gam;
#pragma unroll
            for (int js = 0; js < 4; ++js) {
                bf16x8 kf[2];
#pragma unroll
                for (int a = 0; a < 2; ++a) kf[a] = *(const bf16x8*)(ktg + ((size_t)(b * 4 + h) * 256 + 32 * w + a * 16 + fr) * 2048 + n * 128 + js * 32 + fq * 8);
#pragma unroll
                for (int e = 0; e < 4; ++e) {
                    const bf16x8 vf = *(const LAS bf16x8*)(lds + VT_OFF + (e * 16 + fr) * VT_STR + js * 64 + fq * 16);
#pragma unroll
                    for (int a = 0; a < 2; ++a) sacc[a][e] = mfma16(kf[a], vf, sacc[a][e]);
                }
            }
#pragma unroll
            for (int a = 0; a < 2; ++a)
#pragma unroll
                for (int e = 0; e < 4; ++e) sacc[a][e] *= gam127;
            if (fuse) {
                const size_t srow = (size_t)PR + s_sb;
                const bf16_t* qp = big + srow * 6144 + s_h * 256 + 8 * (tid >> 5) + 128 * (n & 1);
                float qd8[8], kd8[8];
                unpack8(*(const u32x4*)qp, qd8); unpack8(*(const u32x4*)(qp + 1024), kd8);
                const u32x2 vp = *(const u32x2*)(big + srow * 6144 + 2048 + s_h * 512 + s_eq * 128 + (tid & 31) * 4);
                const f32x4 v4 = (f32x4){bflo(vp.x), bfhi(vp.x), bflo(vp.y), bfhi(vp.y)};
                const float sgam = 1.f - 1.f / (float)(32 << s_h);
                if ((n & 1) == 0) o4s = (f32x4){0.f, 0.f, 0.f, 0.f};
#pragma unroll
                for (int i = 0; i < 8; ++i) {
                    const f32x4 sn = sv[i] * sgam + v4 * kd8[i];
                    __builtin_nontemporal_store(sn, (f32x4*)(sout_s + s_base + (size_t)i * 512));
                    o4s += sn * qd8[i];
                }
                if (n & 1) *(LAS f32x4*)(lds + 153616 + tid * 16) = o4s;
            }
            __syncthreads();
            if (fuse && (n & 1) && tid < 32) {
                f32x4 sm = *(const LAS f32x4*)(lds + 153616 + tid * 16);
#pragma unroll
                for (int k = 1; k < 16; ++k) sm += *(const LAS f32x4*)(lds + 153616 + (k * 32 + tid) * 16);
                *(u32x2*)(og + ((size_t)PR + s_sb) * 2048 + s_h * 512 + s_eq * 128 + tid * 4) = pack4(sm);
            }
#pragma unroll
            for (int a = 0; a < 2; ++a)
#pragma unroll
                for (int e = 0; e < 4; ++e)
                    *(LAS u32x2*)(lds + ST_OFF + (e * 16 + fr) * ST_STR + (32 * w + a * 16 + fq * 4) * 2) = pack4(sacc[a][e]);
        }
#pragma unroll
        for (int a = 0; a < 2; ++a)
#pragma unroll
            for (int e = 0; e < 4; ++e)
#pragma unroll
                for (int r = 0; r < 4; ++r)
                    __builtin_nontemporal_store(sacc[a][e][r], sout + ((size_t)(b * 4 + h) * 256 + 32 * w + a * 16 + fq * 4 + r) * 512 + es * 64 + e * 16 + fr);
    }
}

DEVI void retention_sample_phase(LAS unsigned char* lds, const bf16_t* big, const float* sin_, float* sout, bf16_t* og) {
    const int tid = tid_(), ec = tid & 31, dr = tid >> 5;
    LAS float* red = (LAS float*)lds;
    for (int it = bid_(); it < 128 * 4 * 4; it += nblk_()) {
        const int sb = it >> 4, h = (it >> 2) & 3, eq = it & 3;
        const float gam = 1.f - 1.f / (float)(32 << h);
        const size_t row = (size_t)PR + sb;
        const bf16_t* qp = big + row * 6144 + h * 256;
        const bf16_t* kp = qp + 1024;
        const u32x2 vp = *(const u32x2*)(big + row * 6144 + 2048 + h * 512 + eq * 128 + ec * 4);
        const f32x4 v4 = (f32x4){bflo(vp.x), bfhi(vp.x), bflo(vp.y), bfhi(vp.y)};
        const size_t sbase = ((size_t)(sb * 4 + h) * 256) * 512 + eq * 128 + ec * 4;
        f32x4 o4 = (f32x4){0.f, 0.f, 0.f, 0.f};
#pragma unroll
        for (int i = 0; i < 16; ++i) {
            const int d = dr + 16 * i;
            const f32x4 s = *(const f32x4*)(sin_ + sbase + (size_t)d * 512);
            const float kd = bf2f(kp[d]), qd = bf2f(qp[d]);
            const f32x4 sn = s * gam + v4 * kd;
            *(f32x4*)(sout + sbase + (size_t)d * 512) = sn;
            o4 += sn * qd;
        }
        __syncthreads();
        *(LAS f32x4*)(red + (dr * 32 + ec) * 4) = o4;
        __syncthreads();
        if (tid < 32) {
            f32x4 s = (f32x4){0.f, 0.f, 0.f, 0.f};
#pragma unroll
            for (int k = 0; k < 16; ++k) s += *(const LAS f32x4*)(red + (k * 32 + tid) * 4);
            *(u32x2*)(og + row * 2048 + h * 512 + eq * 128 + tid * 4) = pack4(s);
        }
    }
}

DEVI void xattn_prompt_phase(LAS unsigned char* lds, const bf16_t* qx, const bf16_t* mk  , const bf16_t* mvt  , bf16_t* ao) {
    constexpr int STR = 528;
    const int tid = tid_(), w = tid >> 6, lane = tid & 63, fr = lane & 15, fq = lane >> 4;
    for (int it = bid_(); it < 512; it += nblk_()) {
        const int b = it >> 6, h = (it >> 4) & 3, qt = it & 15;
        const size_t row = (size_t)b * 2048 + qt * 128 + 16 * w + fr;
        __syncthreads();
        {   const int m0 = tid >> 5, dq = tid & 31;
            const bf16_t* src = mk + ((size_t)b * 256 + m0) * 1024 + h * 256 + dq * 8;
            LAS unsigned char* dst = lds + m0 * STR + dq * 16;
#pragma unroll
            for (int i = 0; i < 16; ++i) *(LAS u32x4*)(dst + i * 16 * STR) = *(const u32x4*)(src + (size_t)i * 16 * 1024);
        }
        bf16x8 qf[8];
#pragma unroll
        for (int ks = 0; ks < 8; ++ks) qf[ks] = *(const bf16x8*)(qx + row * 1024 + h * 256 + ks * 32 + fq * 8);
        __syncthreads();
        bf16x8 pf[8];
        float hmx[2], hsum[2];
        const float sc = 0.0625f * 1.4426950408889634f;
#pragma unroll
        for (int hf = 0; hf < 2; ++hf) {
            f32x4 s[8];
#pragma unroll
            for (int mt = 0; mt < 8; ++mt) {
                f32x4 acc = (f32x4){0.f, 0.f, 0.f, 0.f};
#pragma unroll
                for (int ks = 0; ks < 8; ++ks) {
                    const bf16x8 kf = *(const LAS bf16x8*)(lds + ((hf * 8 + mt) * 16 + fr) * STR + ks * 64 + fq * 16);
                    acc = mfma16(kf, qf[ks], acc);
                }
                s[mt] = acc;
                __builtin_amdgcn_sched_barrier(0);
            }
            float mx = -3.0e38f;
#pragma unroll
            for (int mt = 0; mt < 8; ++mt)
#pragma unroll
                for (int r = 0; r < 4; ++r) mx = fmaxf(mx, s[mt][r]);
            mx = fmaxf(mx, shx(mx, 16, lane)); mx = fmaxf(mx, shx(mx, 32, lane));
            float sum = 0.f;
#pragma unroll
            for (int mt = 0; mt < 8; ++mt)
#pragma unroll
                for (int r = 0; r < 4; ++r) { const float e = ex2_((s[mt][r] - mx) * sc); s[mt][r] = e; sum += e; }
            sum += shx(sum, 16, lane); sum += shx(sum, 32, lane);
            hmx[hf] = mx; hsum[hf] = sum;
#pragma unroll
            for (int ms = 0; ms < 4; ++ms) {
                u32x4 u; u.x = cvt_pk_bf16(s[2 * ms][0], s[2 * ms][1]); u.y = cvt_pk_bf16(s[2 * ms][2], s[2 * ms][3]);
                u.z = cvt_pk_bf16(s[2 * ms + 1][0], s[2 * ms + 1][1]); u.w = cvt_pk_bf16(s[2 * ms + 1][2], s[2 * ms + 1][3]);
                pf[hf * 4 + ms] = __builtin_bit_cast(bf16x8, u);
            }
        }
        const float mxa = fmaxf(hmx[0], hmx[1]);
        float al0 = ex2_((hmx[0] - mxa) * sc), al1 = ex2_((hmx[1] - mxa) * sc);
        const float inv = rcp_(hsum[0] * al0 + hsum[1] * al1);
        al0 *= inv; al1 *= inv;
        __syncthreads();
        {   const int d0 = tid >> 5, mq = tid & 31;
            const bf16_t* src = mvt + ((size_t)(b * 4 + h) * 256 + d0) * 256 + mq * 8;
            LAS unsigned char* dst = lds + d0 * STR + mq * 16;
#pragma unroll
            for (int i = 0; i < 16; ++i) *(LAS u32x4*)(dst + i * 16 * STR) = *(const u32x4*)(src + (size_t)i * 16 * 256);
        }
        __syncthreads();
#pragma unroll 2
        for (int dt = 0; dt < 16; ++dt) {
            f32x4 acc0 = (f32x4){0.f, 0.f, 0.f, 0.f}, acc1 = acc0;
#pragma unroll
            for (int ms = 0; ms < 8; ++ms) {
                const u32x2 lo = *(const LAS u32x2*)(lds + (dt * 16 + fr) * STR + (ms * 32 + fq * 4) * 2);
                const u32x2 hi = *(const LAS u32x2*)(lds + (dt * 16 + fr) * STR + (ms * 32 + 16 + fq * 4) * 2);
                u32x4 u; u.x = lo.x; u.y = lo.y; u.z = hi.x; u.w = hi.y;
                if (ms < 4) acc0 = mfma16(__builtin_bit_cast(bf16x8, u), pf[ms], acc0);
                else acc1 = mfma16(__builtin_bit_cast(bf16x8, u), pf[ms], acc1);
            }
            *(u32x2*)(ao + row * 1024 + h * 256 + dt * 16 + fq * 4) = pack4(acc0 * al0 + acc1 * al1);
        }
    }
}

DEVI void xattn_sample_phase(LAS unsigned char* lds, const bf16_t* qx, const float* ck, const float* cv, bf16_t* ao) {
    const int tid = tid_(), w = tid >> 6, lane = tid & 63;
    LAS float* sc = (LAS float*)lds;
    LAS float* red = (LAS float*)(lds + 2048);
    for (int it = bid_(); it < 512; it += nblk_()) {
        const int sb = it >> 2, h = it & 3;
        const size_t row = (size_t)PR + sb;
        const u32x2 qp = *(const u32x2*)(qx + row * 1024 + h * 256 + lane * 4);
        const f32x4 q4 = (f32x4){bflo(qp.x), bfhi(qp.x), bflo(qp.y), bfhi(qp.y)};
        const size_t base = ((size_t)sb * 256 * 4 + h) * 256 + lane * 4;
        __syncthreads();
#pragma unroll
        for (int i = 0; i < 32; ++i) {
            const int m = w + 8 * i;
            const f32x4 k4 = __builtin_nontemporal_load((const f32x4*)(ck + base + (size_t)m * 1024));
            float d = k4[0] * q4[0] + k4[1] * q4[1] + k4[2] * q4[2] + k4[3] * q4[3];
            d = wave_sum(d, lane);
            if (lane == 0) sc[m] = d * 0.0625f;
        }
        __syncthreads();
        float mx = -3.0e38f;
        for (int m = lane; m < 256; m += 64) mx = fmaxf(mx, sc[m]);
#pragma unroll
        for (int o = 32; o; o >>= 1) mx = fmaxf(mx, shx(mx, o, lane));
        float sum = 0.f;
        for (int m = lane; m < 256; m += 64) sum += exp_(sc[m] - mx);
        sum = wave_sum(sum, lane);
        const float inv = rcp_(sum);
        f32x4 o4 = (f32x4){0.f, 0.f, 0.f, 0.f};
#pragma unroll
        for (int i = 0; i < 32; ++i) {
            const int m = w + 8 * i;
            const float pm = exp_(sc[m] - mx) * inv;
            const f32x4 v4 = __builtin_nontemporal_load((const f32x4*)(cv + base + (size_t)m * 1024));
            o4 += v4 * pm;
        }
        *(LAS f32x4*)(red + (w * 64 + lane) * 4) = o4;
        __syncthreads();
        if (tid < 64) {
            f32x4 s = (f32x4){0.f, 0.f, 0.f, 0.f};
#pragma unroll
            for (int k = 0; k < 8; ++k) s += *(const LAS f32x4*)(red + (k * 64 + tid) * 4);
            *(u32x2*)(ao + row * 1024 + h * 256 + tid * 4) = pack4(s);
        }
    }
}

#define XB_TMO      128
#define XB_XCNT(j)  (256  + 64 * (j))
#define XB_XSUB(j)  (1280 + 64 * (j))
#define XB_XGEN(j)  (2304 + 64 * (j))
#define XB_TOP      3328
#define XB_TOPGEN   3392
#define XCD_BAR_WORDS 3456
#define XB_SPIN_CAP (1u << 18)
DEVI unsigned xb_ld(unsigned* p)              { return __hip_atomic_load(p, __ATOMIC_RELAXED, __HIP_MEMORY_SCOPE_AGENT); }
DEVI unsigned xb_add(unsigned* p, unsigned v) { return __hip_atomic_fetch_add(p, v, __ATOMIC_RELAXED, __HIP_MEMORY_SCOPE_AGENT); }
DEVI unsigned xb_xcc_id() { return (unsigned)__builtin_amdgcn_s_getreg((3 << 11) | 20) & 0xFu; }
#define XB_SPIN(cond, bar) do { unsigned _sp = 0; while (cond) { __builtin_amdgcn_s_sleep(1); \
    if ((++_sp & 255u) == 0u) { if (xb_ld(&(bar)[XB_TMO])) break; if (_sp > XB_SPIN_CAP) { atomicAdd(&(bar)[XB_TMO], 1u); break; } } } } while (0)
struct XcdBarrier { unsigned* bar; unsigned x; volatile LAS unsigned* st; };
DEVI XcdBarrier xcd_barrier_post(unsigned* bar, volatile LAS unsigned* st) {
    XcdBarrier b; b.bar = bar; b.x = xb_xcc_id(); b.st = st;
    if (threadIdx.x == 0) (void)xb_add(&bar[XB_XCNT(b.x)], 1u);
    return b;
}
DEVI void xcd_barrier_complete(unsigned* bar, unsigned x, unsigned& nloc, unsigned& nx) {
    const unsigned G = gridDim.x * gridDim.y * gridDim.z;
    unsigned sum, cnt, mine, sp = 0u;
    for (;;) {
        sum = 0u; cnt = 0u; mine = 0u;
#pragma unroll
        for (unsigned j = 0; j < 16; ++j) { const unsigned c = xb_ld(&bar[XB_XCNT(j)]); sum += c; cnt += (c > 0u) ? 1u : 0u; mine = (j == x) ? c : mine; }
        if (sum == G) break;
        __builtin_amdgcn_s_sleep(1);
        if ((++sp & 255u) == 0u) { if (xb_ld(&bar[XB_TMO])) break; if (sp > XB_SPIN_CAP) { atomicAdd(&bar[XB_TMO], 1u); break; } }
    }
    nloc = mine > 0u ? mine : 1u; nx = cnt > 0u ? cnt : 1u;
}
DEVI void xcd_barrier(const XcdBarrier& b) {
    asm volatile("s_waitcnt vmcnt(0)" ::: "memory");
    __syncthreads();
    if (threadIdx.x == 0) {
        unsigned* bar = b.bar;
        __builtin_amdgcn_s_waitcnt(0);
        unsigned nloc = b.st[0], nx = b.st[1];
        if (nloc == 0u) { xcd_barrier_complete(bar, b.x, nloc, nx); b.st[0] = nloc; b.st[1] = nx; }
        const unsigned old = xb_add(&bar[XB_XSUB(b.x)], 1u);
        const unsigned gen = old / nloc;
        if (old + 1u == (gen + 1u) * nloc) {
            __builtin_amdgcn_fence(__ATOMIC_RELEASE, "agent");
            asm volatile("s_waitcnt vmcnt(0)" ::: "memory");
            const unsigned og = xb_add(&bar[XB_TOP], 1u);
            const unsigned tg = og / nx;
            if (og + 1u == (tg + 1u) * nx) xb_add(&bar[XB_TOPGEN], 1u);
            else XB_SPIN(xb_ld(&bar[XB_TOPGEN]) == tg, bar);
            __builtin_amdgcn_fence(__ATOMIC_ACQUIRE, "agent");
            xb_add(&bar[XB_XGEN(b.x)], 1u);
            asm volatile("s_waitcnt vmcnt(0)" ::: "memory");
        } else {
            XB_SPIN(xb_ld(&bar[XB_XGEN(b.x)]) == gen, bar);
            __builtin_amdgcn_fence(__ATOMIC_ACQUIRE, "agent");
            asm volatile("s_waitcnt vmcnt(0)" ::: "memory");
        }
    }
    __syncthreads();
}

enum { K_PREP = 0, K_RETIN, K_RET, K_GATE, K_RESID, K_NORM, K_BF16, K_XATTN, K_FFNGATE, K_LRUCONV, K_LRU, K_SCAN1, K_SCAN2, K_NORMF };
constexpr int NPH = 24;
struct Step { int kind, L, lda, N, K, ldo, ssi; const bf16_t* A; const bf16_t* Bt; bf16_t* ob; const float* rinP; const float* rinS; };

template <int ONLY>
__global__ void __launch_bounds__(512) mega(Params p, int lo, int hi) {
    extern __shared__ __attribute__((aligned(16))) unsigned char shm[];
    LAS unsigned char* lds = (LAS unsigned char*)shm;
    cg::grid_group grid = cg::this_grid();
#define WS_ ((unsigned char*)p.in[33 + zero_()])
#define OUT_ ((float*)p.in[32 + zero_()])
#define x_prompt (p.in[0 + zero_()])
#define x_sample (p.in[1 + zero_()])
#define state_ret (p.in[2 + zero_()])
#define state_lru_h (p.in[3 + zero_()])
#define state_lru_conv (p.in[4 + zero_()])
#define state_ffn_conv (p.in[5 + zero_()])
#define cache_k (p.in[6 + zero_()])
#define cache_v (p.in[7 + zero_()])
#define mem_prompt (p.in[8 + zero_()])
#define norm_mix (p.in[9 + zero_()])
#define norm_xa (p.in[10 + zero_()])
#define norm_mem (p.in[11 + zero_()])
#define norm_ffn (p.in[12 + zero_()])
#define norm_final (p.in[13 + zero_()])
#define lru_conv_w (p.in[17 + zero_()])
#define lru_conv_b (p.in[18 + zero_()])
#define lru_ba (p.in[20 + zero_()])
#define lru_bx (p.in[22 + zero_()])
#define lru_lambda (p.in[23 + zero_()])
#define ffn_conv_w (p.in[29 + zero_()])
#define ffn_conv_b (p.in[30 + zero_()])
#define HN ((bf16_t*)(WS_ + W_HN))
#define MN ((bf16_t*)(WS_ + W_MN))
#define MK ((bf16_t*)(WS_ + W_MK))
#define MVT ((bf16_t*)(WS_ + W_MVT))
#define BIG ((bf16_t*)(WS_ + W_BIG))
#define X ((float*)(WS_ + W_X))
#define XS ((float*)(WS_ + W_X) + (size_t)PR * 1024)
#define QX ((bf16_t*)(WS_ + W_QX))
#define AO ((bf16_t*)(WS_ + W_AO))
#define Y ((bf16_t*)(WS_ + W_Y))
#define KT ((bf16_t*)(WS_ + W_KT))
#define VT ((bf16_t*)(WS_ + W_VT))
#define O ((bf16_t*)(WS_ + W_O))
#define OG ((bf16_t*)(WS_ + W_OG))
#define XC ((bf16_t*)(WS_ + W_XC))
#define AA ((float*)(WS_ + W_AA))
#define UU ((float*)(WS_ + W_UU))
#define CH ((float*)(WS_ + W_CH))
#define YL ((bf16_t*)(WS_ + W_YL))
#define ROTC ((float*)(WS_ + W_ROTC))
#define ROTS ((float*)(WS_ + W_ROTS))
#define LSG ((float*)(WS_ + W_LSG))
#define SS ((float*)(WS_ + W_SS))
#define DEC ((float*)(WS_ + W_DEC))
    volatile LAS unsigned* xst = (volatile LAS unsigned*)(lds + 153600);
    if (threadIdx.x < 4) xst[threadIdx.x] = 0u;
    __syncthreads();
    const XcdBarrier xbar = xcd_barrier_post((unsigned*)(WS_ + W_BAR), xst);
    const int hi2 = hi < NPH ? hi : NPH;
    for (int ph = lo; ph < hi2; ++ph) {
        Step st; st.kind = K_NORMF; st.L = ph >= 11 ? 1 : 0; st.lda = 1024; st.N = 1024; st.K = 1024; st.ldo = 1024; st.ssi = 0; st.A = HN; st.Bt = nullptr; st.ob = nullptr; st.rinP = X; st.rinS = XS;
        switch (ph) {
            case 0: st.kind = K_PREP; break;
            case 1: st.kind = K_RETIN; break;
            case 2: st.kind = K_RET; break;
            case 3: st.kind = K_GATE; break;
            case 4: st.kind = K_RESID; st.ssi = 1; st.A = OG; st.lda = 2048; st.K = 2048; st.Bt = (const bf16_t*)(WS_ + W_ROUT); st.rinP = x_prompt; st.rinS = x_sample; break;
            case 5: st.kind = K_BF16; st.ssi = 1; st.Bt = (const bf16_t*)(WS_ + W_XQ); st.ob = QX; break;
            case 6: st.kind = K_XATTN; break;
            case 7: st.kind = K_RESID; st.ssi = 2; st.A = AO; st.Bt = (const bf16_t*)(WS_ + W_XO); break;
            case 8: st.kind = K_BF16; st.ssi = 2; st.Bt = (const bf16_t*)(WS_ + W_UP); st.N = 6144; st.ob = BIG; st.ldo = 6144; break;
            case 9: st.kind = K_FFNGATE; break;
            case 10: st.kind = K_RESID; st.ssi = 3; st.A = Y; st.lda = 3072; st.K = 3072; st.Bt = (const bf16_t*)(WS_ + W_DN); break;
            case 11: st.kind = K_BF16; st.ssi = 3; st.Bt = (const bf16_t*)(WS_ + W_LIN); st.N = 2048; st.ob = BIG; st.ldo = 2048; break;
            case 12: st.kind = K_LRUCONV; break;
            case 13: st.kind = K_LRU; break;
            case 14: st.kind = K_SCAN1; break;
            case 15: st.kind = K_SCAN2; break;
            case 16: st.kind = K_RESID; st.ssi = 4; st.A = YL; st.Bt = (const bf16_t*)(WS_ + W_LOUT); break;
            case 17: st.kind = K_BF16; st.ssi = 4; st.Bt = (const bf16_t*)(WS_ + W_XQ + 2097152); st.ob = QX; break;
            case 18: st.kind = K_XATTN; break;
            case 19: st.kind = K_RESID; st.ssi = 5; st.A = AO; st.Bt = (const bf16_t*)(WS_ + W_XO + 2097152); break;
            case 20: st.kind = K_BF16; st.ssi = 5; st.Bt = (const bf16_t*)(WS_ + W_UP + 12582912); st.N = 6144; st.ob = BIG; st.ldo = 6144; break;
            case 21: st.kind = K_FFNGATE; break;
            case 22: st.kind = K_RESID; st.ssi = 6; st.A = Y; st.lda = 3072; st.K = 3072; st.Bt = (const bf16_t*)(WS_ + W_DN + 6291456); break;
            default: st.kind = K_NORMF; break;
        }
        const int L = st.L;
#ifndef DUP_MASK
#define DUP_MASK 0
#endif
        const int nrep = 1 + (int)(((unsigned)(DUP_MASK) >> st.kind) & 1u);
        for (int rep = 0; rep < nrep; ++rep) {
        if (rep) grid.sync();
        switch (st.kind) {
            case K_PREP: if constexpr (ONLY < 0 || ONLY == K_PREP) {
#if EN(0)
                transpose_phase(lds, p);
                rot_phase(ROTC, ROTS, p.rope_c1);
                lsg_phase(lru_lambda, LSG);
                dec_phase(DEC);
                cast_ss_phase(x_prompt, x_sample, HN, SS);
                for (int i = 0; i < 2; ++i) norm_phase<false>(mem_prompt, nullptr, norm_mem + i * 1024, MN + (size_t)i * 2097152, nullptr, nullptr, 2048);
#endif
            } break;
            case K_RETIN: if constexpr (ONLY < 0 || ONLY == K_RETIN) {
                QRetIn q; q.big = BIG; q.kt = KT; q.vt = VT; q.rc = ROTC; q.rs = ROTS; q.dec = DEC; q.ss = SS;
#if EN(1)
                run_gemm(lds, HN, 1024, (const bf16_t*)(WS_ + W_RIN), 1024, PR, 6144, 1024, 0, 0, q);
#endif
#if EN(13)
                skinny_phase_t<4>(lds, HN + (size_t)PR * 1024, 1024, (const bf16_t*)(WS_ + W_RIN), 1024, 6144, 1024, 0, q, nblk_() == 256 ? 128 : 0);
#endif
#if EN(14)
                for (int i = 0; i < 2; ++i) {
                    QMemKV m; m.outk = OUT_ + O_MKP + (size_t)i * 2097152; m.outv = OUT_ + O_MVP + (size_t)i * 2097152; m.mk = MK + (size_t)i * 2097152; m.mvt = MVT + (size_t)i * 2097152;
                    run_gemm(lds, MN + (size_t)i * 2097152, 1024, (const bf16_t*)(WS_ + W_XKV + (size_t)i * 4194304), 1024, 2048, 2048, 1024, 0, 128 + 64 * i, m);
                }
#endif
            } break;
            case K_RET: if constexpr (ONLY < 0 || ONLY == K_RET) {
#if EN(2)
                retention_prompt_phase(lds, BIG, KT, VT, O, OUT_ + O_RETP, DEC, nblk_() == 256, state_ret, OUT_ + O_RETS);
#endif
#if EN(3)
                if (nblk_() != 256) retention_sample_phase(lds, BIG, state_ret, OUT_ + O_RETS, O);
#endif
            } break;
            case K_GATE: if constexpr (ONLY < 0 || ONLY == K_GATE) {
#if EN(4)
                gate_phase(O, BIG, OG);
#endif
            } break;
            case K_RESID: if constexpr (ONLY < 0 || ONLY == K_RESID) {
                QResid q; q.rinP = st.rinP; q.rinS = st.rinS; q.xout = X; q.xb = HN; q.ssout = SS + (size_t)st.ssi * TP * 32;
#if EN(5)
                run_gemm(lds, st.A, st.lda, st.Bt, st.K, PR, 1024, st.K, 0, 0, q);
#endif
#if EN(15)
                skinny_phase1(lds, st.A + (size_t)PR * st.lda, st.lda, st.Bt, st.K, 1024, st.K, 0, q);
#endif
            } break;
            case K_BF16: if constexpr (ONLY < 0 || ONLY == K_BF16) {
                if (st.N == 6144) {
                    unsigned char* wsb = WS_; float* ob = OUT_;
                    QFfn q; q.y = (bf16_t*)(wsb + W_Y); q.big = (bf16_t*)(wsb + W_BIG); q.ss = (const float*)(wsb + W_SS) + (size_t)st.ssi * TP * 32; q.cw = ffn_conv_w + (size_t)L * 9216; q.cb = ffn_conv_b + (size_t)L * 3072;
                    q.sbuf = state_ffn_conv + (size_t)L * 786432; q.outp = ob + O_FCP + (size_t)L * 49152; q.outs = ob + O_FCS + (size_t)L * 786432;
                    const bf16_t* hn = (const bf16_t*)(wsb + W_HN);
                    run_gemm(lds, hn, 1024, st.Bt, 1024, PR, 6144, 1024, 2, 0, q);
                    skinny_phase(lds, hn + (size_t)PR * 1024, 1024, st.Bt, 1024, 6144, 1024, 2, q);
                } else {
                QBf16 q; q.out = st.ob; q.ld = st.ldo; q.ss = SS + (size_t)st.ssi * TP * 32;
#if EN(6)
                run_gemm(lds, HN, 1024, st.Bt, 1024, PR, st.N, 1024, 0, 0, q);
#endif
#if EN(16)
                if (st.N == 1024) skinny_phase1(lds, HN + (size_t)PR * 1024, 1024, st.Bt, 1024, 1024, 1024, 0, q);
                else skinny_phase_t<2>(lds, HN + (size_t)PR * 1024, 1024, st.Bt, 1024, st.N, 1024, 0, q);
#endif
                }
            } break;
            case K_XATTN: if constexpr (ONLY < 0 || ONLY == K_XATTN) {
#if EN(10)
                xattn_prompt_phase(lds, QX, MK + (size_t)L * 2097152, MVT + (size_t)L * 2097152, AO);
#endif
#if EN(11)
                xattn_sample_phase(lds, QX, cache_k + (size_t)L * 33554432, cache_v + (size_t)L * 33554432, AO);
#endif
            } break;
            case K_FFNGATE: if constexpr (ONLY < 0 || ONLY == K_FFNGATE) {
#if EN(12)
                ffn_fix_phase(BIG, Y, ffn_conv_w + (size_t)L * 9216, ffn_conv_b + (size_t)L * 3072);
#endif
            } break;
            case K_LRUCONV: if constexpr (ONLY < 0 || ONLY == K_LRUCONV) {
#if EN(7)
                lru_conv_phase(BIG, XC, lru_conv_w, lru_conv_b, state_lru_conv, OUT_ + O_LCP, OUT_ + O_LCS);
#endif
            } break;
            case K_LRU: if constexpr (ONLY < 0 || ONLY == K_LRU) {
                QLru q; q.ba = lru_ba; q.bx = lru_bx; q.lam = LSG; q.xc = XC; q.aa = AA; q.uu = UU; q.h0 = state_lru_h; q.hout = OUT_ + O_LHS; q.big = BIG; q.yl = YL;
#if EN(8)
                run_gemm(lds, XC, 1024, (const bf16_t*)(WS_ + W_AX), 256, PR, 2048, 256, 1, 0, q);
#endif
#if EN(18)
                skinny_phase_t<2>(lds, XC + (size_t)PR * 1024, 1024, (const bf16_t*)(WS_ + W_AX), 256, 2048, 256, 1, q);
#endif
            } break;
            case K_SCAN1: if constexpr (ONLY < 0 || ONLY == K_SCAN1) {
#if EN(9)
                scan1_phase(AA, UU, CH);
#endif
            } break;
            case K_SCAN2: if constexpr (ONLY < 0 || ONLY == K_SCAN2) {
#if EN(9)
                scan2_phase(AA, UU, CH, BIG, YL, OUT_ + O_LHP);
#endif
            } break;
            default: if constexpr (ONLY < 0 || ONLY == K_NORMF) {
#if EN(0)
                norm_phase<true>(X, XS, norm_final, nullptr, OUT_ + O_YP, OUT_ + O_YS, TR);
#endif
            } break;
        }
        }
        if (ph + 1 < hi2) { if (lo < 0) grid.sync(); else xcd_barrier(xbar); }
    }
#ifdef EXTRA_SYNCS
    for (int i = 0; i < EXTRA_SYNCS; ++i) grid.sync();
#endif
}

#undef WS_
#undef OUT_
#undef x_prompt
#undef x_sample
#undef state_ret
#undef state_lru_h
#undef state_lru_conv
#undef state_ffn_conv
#undef cache_k
#undef cache_v
#undef mem_prompt
#undef norm_mix
#undef norm_xa
#undef norm_mem
#undef norm_ffn
#undef norm_final
#undef lru_conv_w
#undef lru_conv_b
#undef lru_ba
#undef lru_bx
#undef lru_lambda
#undef ffn_conv_w
#undef ffn_conv_b
#undef HN
#undef MN
#undef MK
#undef MVT
#undef BIG
#undef X
#undef XS
#undef QX
#undef AO
#undef Y
#undef KT
#undef VT
#undef O
#undef OG
#undef XC
#undef AA
#undef UU
#undef CH
#undef YL
#undef ROTC
#undef ROTS
#undef LSG
#undef SS
#undef DEC
__global__ void dump_k(const float* src, float* dst, size_t n) { for (size_t i = (size_t)bid_() * blockDim.x + threadIdx.x; i < n; i += (size_t)nblk_() * blockDim.x) dst[i] = src[i]; }
#ifndef MULTI
#define MULTI 0
#endif
static const int h_kinds[NPH] = {K_PREP, K_RETIN, K_RET, K_GATE, K_RESID, K_BF16, K_XATTN, K_RESID, K_BF16, K_FFNGATE, K_RESID, K_BF16, K_LRUCONV, K_LRU, K_SCAN1, K_SCAN2,
                                 K_RESID, K_BF16, K_XATTN, K_RESID, K_BF16, K_FFNGATE, K_RESID, K_NORMF};
typedef void (*mega_fn)(Params, int, int);
template <int K> static mega_fn get_fn() { return mega<K>; }
static mega_fn fn_of_kind(int k) {
    switch (k) {
        case 0: return get_fn<0>(); case 1: return get_fn<1>(); case 2: return get_fn<2>(); case 3: return get_fn<3>(); case 4: return get_fn<4>(); case 5: return get_fn<5>(); case 6: return get_fn<6>();
        case 7: return get_fn<7>(); case 8: return get_fn<8>(); case 9: return get_fn<9>(); case 10: return get_fn<10>(); case 11: return get_fn<11>(); case 12: return get_fn<12>(); default: return get_fn<13>();
    }
}

extern "C" void kernel_launch(void* const* d_in, const int* in_sizes, int n_in, void* d_out, int out_size, void* d_ws, size_t ws_size, hipStream_t stream) {
    (void)in_sizes; (void)n_in; (void)out_size;
    static int grid_blocks = 0;
    if (!grid_blocks) {
        int dev = 0, cus = 0;
        (void)hipGetDevice(&dev);
        (void)hipDeviceGetAttribute(&cus, hipDeviceAttributeMultiprocessorCount, dev);
#if MULTI
        for (int k = 0; k < 14; ++k) (void)hipFuncSetAttribute((const void*)fn_of_kind(k), hipFuncAttributeMaxDynamicSharedMemorySize, LDS_BYTES);
#else
        (void)hipFuncSetAttribute((const void*)mega<-1>, hipFuncAttributeMaxDynamicSharedMemorySize, LDS_BYTES);
#endif
        grid_blocks = cus;
        if (ws_size < W_TOTAL) fprintf(stderr, "workspace too small: %zu < %zu\n", ws_size, (size_t)W_TOTAL);
    }
    Params p; memset(&p, 0, sizeof(p));
    for (int i = 0; i < 32; ++i) p.in[i] = (const float*)d_in[i];
    p.in[32] = (const float*)d_out; p.in[33] = (const float*)d_ws;
    p.rope_c1 = pow(10000.0, -1.0 / 128.0);
    unsigned char* ws = (unsigned char*)d_ws;
    int nj = 0, tiles = 0;
    auto add = [&](const float* src, size_t dst_off, int ld, int K, int N, const float* gain = nullptr) {
        TJob& j = p.jobs[nj++]; j.gain = gain; j.src = src; j.dst = (bf16_t*)(ws + dst_off); j.ld = ld; j.K = K; j.N = N; j.tile0 = tiles; tiles += (K / 64) * (N / 64);
    };
    const float* ret_w_in = p.in[14]; const float* ret_w_out = p.in[15]; const float* lru_w_in = p.in[16]; const float* lru_wa = p.in[19]; const float* lru_wx = p.in[21];
    const float* lru_w_out = p.in[24]; const float* xa_w_q = p.in[25]; const float* xa_w_kv = p.in[26]; const float* xa_w_o = p.in[27]; const float* ffn_w_up = p.in[28]; const float* ffn_w_down = p.in[31];
    const float* g_mix = p.in[9]; const float* g_xa = p.in[10]; const float* g_ffn = p.in[12];
    add(ret_w_in, W_RIN, 6144, 1024, 6144, g_mix);
    add(ffn_w_up, W_UP, 6144, 1024, 6144, g_ffn);
    add(ffn_w_up + (size_t)1024 * 6144, W_UP + 12582912, 6144, 1024, 6144, g_ffn + 1024);
    add(ret_w_out, W_ROUT, 1024, 2048, 1024);
    add(lru_w_in, W_LIN, 2048, 1024, 2048, g_mix + 1024);
    for (int h = 0; h < 4; ++h)
        for (int s = 0; s < 2; ++s)
            for (int half = 0; half < 2; ++half)
                add((half ? lru_wx : lru_wa) + (size_t)h * 65536 + s * 128, W_AX + (size_t)(h * 512 + s * 256 + half * 128) * 256 * 2, 256, 256, 128);
    add(lru_w_out, W_LOUT, 1024, 1024, 1024);
    for (int i = 0; i < 2; ++i) add(xa_w_q + (size_t)i * 1048576, W_XQ + (size_t)i * 2097152, 1024, 1024, 1024, g_xa + i * 1024);
    for (int i = 0; i < 2; ++i) add(xa_w_kv + (size_t)i * 2097152, W_XKV + (size_t)i * 4194304, 2048, 1024, 2048);
    for (int i = 0; i < 2; ++i) add(xa_w_o + (size_t)i * 1048576, W_XO + (size_t)i * 2097152, 1024, 1024, 1024);
    for (int i = 0; i < 2; ++i) add(ffn_w_down + (size_t)i * 3145728, W_DN + (size_t)i * 6291456, 1024, 3072, 1024);
    p.ntiles = tiles;
    if (nj != NJOBS) fprintf(stderr, "job count mismatch %d\n", nj);
#if MULTI
#ifndef HI_LIMIT
#define HI_LIMIT NPH
#endif
    for (int ph0 = 0; ph0 < HI_LIMIT; ++ph0) {
        const int ph = ph0;
        int lo = ph, hi = ph + 1;
        void* args[] = {&p, &lo, &hi};
        hipError_t e = hipLaunchKernel((const void*)fn_of_kind(h_kinds[ph]), dim3(grid_blocks), dim3(512), args, LDS_BYTES, stream);
        if (e != hipSuccess) fprintf(stderr, "launch %d failed: %s\n", ph, hipGetErrorString(e));
    }
#ifdef DUMP_OFF
    dump_k<<<1024, 256, 0, stream>>>((const float*)((unsigned char*)d_ws + DUMP_OFF), (float*)d_out, (size_t)16000000);
#endif
#else
    (void)hipMemsetAsync((unsigned char*)d_ws + W_BAR, 0, 16384, stream);
    int lo = 0, hi = NPH;
    void* args[] = {&p, &lo, &hi};
    hipError_t e = hipLaunchCooperativeKernel((const void*)mega<-1>, dim3(grid_blocks), dim3(512), args, LDS_BYTES, stream);
    if (e != hipSuccess) fprintf(stderr, "cooperative launch failed: %s (grid %d)\n", hipGetErrorString(e), grid_blocks);
#endif
}
```
